# Optimizing an MI355X kernel written in HIP

```python
import math
import jax, jax.numpy as jnp
from jax import lax
import numpy as np

D_MODEL = 2048
BATCH = 4
SEQ = 2048
DEPTH = 1

HEAD_DIM = 128
SB_WIDTH = D_MODEL // 2
N_SB_HEADS = SB_WIDTH // HEAD_DIM
POOL_WIDTH = D_MODEL - SB_WIDTH
POOL_WINDOWS = (2, 4, 8, 16)
N_POOL_GROUPS = len(POOL_WINDOWS)
POOL_GROUP_DIM = POOL_WIDTH // N_POOL_GROUPS
MIX_WIDTH = SB_WIDTH + POOL_WIDTH
IN_PROJ_WIDTH = 3 * SB_WIDTH + POOL_WIDTH
N_EXPERTS = 32
TOP_K = 4
D_FF = D_MODEL
SWIGLU_ALPHA = 1.702
SWIGLU_LIMIT = 7.0
Q_BLOCK = 128
EXPERT_BLOCK = 256
EPS = 1e-6

kernel_name = "hybrid_stickbreak_pool_moe_adaln"


def rms_norm(x, w):
    xf = x.astype(jnp.float32)
    y = xf * lax.rsqrt(jnp.mean(xf * xf, axis=-1, keepdims=True) + EPS)
    return (y * w.astype(jnp.float32)).astype(x.dtype)


def stick_breaking_attention(q, k, v):
    B, S, H, d = q.shape
    nb = S // Q_BLOCK
    qh = q.astype(jnp.float32).transpose(0, 2, 1, 3)
    kh = k.astype(jnp.float32).transpose(0, 2, 1, 3)
    vh = v.astype(jnp.float32).transpose(0, 2, 1, 3)
    q_blocks = qh.reshape(B, H, nb, Q_BLOCK, d).transpose(2, 0, 1, 3, 4)
    starts = jnp.arange(nb, dtype=jnp.int32) * Q_BLOCK
    s_idx = jnp.arange(S, dtype=jnp.int32)
    inv_sqrt_d = 1.0 / math.sqrt(d)

    def one_block(args):
        qblk, start = args
        z = jnp.einsum('bhqd,bhkd->bhqk', qblk, kh) * inv_sqrt_d
        t_idx = start + jnp.arange(Q_BLOCK, dtype=jnp.int32)
        causal = s_idx[None, :] < t_idx[:, None]
        log_1m_beta = jnp.where(causal, jax.nn.log_sigmoid(-z), 0.0)
        later = lax.cumsum(log_1m_beta, axis=3, reverse=True) - log_1m_beta
        log_a = jax.nn.log_sigmoid(z) + later
        a = jnp.where(causal, jnp.exp(log_a), 0.0)
        return jnp.einsum('bhqk,bhkd->bhqd', a, vh)

    o = lax.map(one_block, (q_blocks, starts))
    return o.transpose(1, 0, 3, 2, 4).reshape(B, S, H * d)


def pool_mixer(u, w_pool, pool_scale):
    B, S, _ = u.shape
    uf = u.astype(jnp.float32)
    cs = jnp.cumsum(uf, axis=1)
    t = jnp.arange(S, dtype=jnp.int32)
    outs = []
    for g, w in enumerate(POOL_WINDOWS):
        lo, hi = g * POOL_GROUP_DIM, (g + 1) * POOL_GROUP_DIM
        cs_g = cs[..., lo:hi]
        prev = jnp.pad(cs_g, ((0, 0), (w, 0), (0, 0)))[:, :S]
        cnt = jnp.minimum(t + 1, w).astype(jnp.float32)[None, :, None]
        outs.append((cs_g - prev) / cnt - uf[..., lo:hi])
    p = jnp.stack(outs, axis=2)
    y = jnp.einsum('bsgc,gcd->bsgd', p, w_pool.astype(jnp.float32)).reshape(B, S, POOL_WIDTH)
    return (y * pool_scale.astype(jnp.float32)).astype(u.dtype)


def clamped_swiglu_expert(xb, w_in_e, b_in_e, w_out_e, b_out_e):
    gu = xb @ w_in_e + b_in_e
    g, lin = gu[:, :D_FF], gu[:, D_FF:]
    g = jnp.minimum(g, SWIGLU_LIMIT)
    lin = jnp.clip(lin, -SWIGLU_LIMIT, SWIGLU_LIMIT)
    act = g * jax.nn.sigmoid(SWIGLU_ALPHA * g) * (lin + 1.0)
    return act @ w_out_e + b_out_e


def moe_ffn(h, w_router, b_router, w_exp_in, b_exp_in, w_exp_out, b_exp_out):
    B, S, D = h.shape
    T = B * S
    N = T * TOP_K
    xf = h.reshape(T, D)
    logits = (xf @ w_router + b_router).astype(jnp.float32)
    top_vals, top_idx = lax.top_k(logits, TOP_K)
    gates = jax.nn.softmax(top_vals, axis=-1)

    eid = top_idx.reshape(N).astype(jnp.int32)
    tok = jnp.repeat(jnp.arange(T, dtype=jnp.int32), TOP_K)
    order = jnp.argsort(eid)
    eid_s, tok_s = eid[order], tok[order]
    counts = jnp.bincount(eid, length=N_EXPERTS).astype(jnp.int32)
    starts = jnp.cumsum(counts) - counts
    padded = ((counts + EXPERT_BLOCK - 1) // EXPERT_BLOCK) * EXPERT_BLOCK
    pends = jnp.cumsum(padded)
    pstarts = pends - padded
    dest_s = pstarts[eid_s] + (jnp.arange(N, dtype=jnp.int32) - starts[eid_s])

    n_blocks = (N + N_EXPERTS * (EXPERT_BLOCK - 1)) // EXPERT_BLOCK
    P = n_blocks * EXPERT_BLOCK
    tok_buf = jnp.full((P,), T, dtype=jnp.int32).at[dest_s].set(tok_s)
    x_ext = jnp.concatenate([xf, jnp.zeros((1, D), xf.dtype)], axis=0)
    x_pad = x_ext[tok_buf].reshape(n_blocks, EXPERT_BLOCK, D)
    block_start = jnp.arange(n_blocks, dtype=jnp.int32) * EXPERT_BLOCK
    block_e = jnp.minimum(jnp.searchsorted(pends, block_start, side='right'), N_EXPERTS - 1)

    def run_block(args):
        xb, e = args
        return clamped_swiglu_expert(xb, w_exp_in[e], b_exp_in[e], w_exp_out[e], b_exp_out[e])

    y_pad = lax.map(run_block, (x_pad, block_e)).reshape(P, D)
    dest = jnp.zeros((N,), jnp.int32).at[order].set(dest_s)
    y = jnp.sum(y_pad[dest].reshape(T, TOP_K, D).astype(jnp.float32) * gates[..., None], axis=1)
    return y.reshape(B, S, D).astype(h.dtype)


def setup_inputs(seed: int = 0) -> dict:
    key = jax.random.key(seed)
    ks = jax.random.split(key, 18)
    L = DEPTH

    def nrm(k, shape, scale):
        return jax.random.normal(k, shape, jnp.float32) * scale

    return {
        "x": nrm(ks[0], (BATCH, SEQ, D_MODEL), 1.0),
        "c": nrm(ks[1], (BATCH, D_MODEL), 1.0),
        "norm1_w": 1.0 + nrm(ks[2], (L, D_MODEL), 0.05),
        "norm2_w": 1.0 + nrm(ks[3], (L, D_MODEL), 0.05),
        "w_ada": nrm(ks[4], (L, D_MODEL, 6 * D_MODEL), 0.3 * D_MODEL ** -0.5),
        "b_ada": nrm(ks[5], (L, 6 * D_MODEL), 0.02),
        "w_in": nrm(ks[6], (L, D_MODEL, IN_PROJ_WIDTH), D_MODEL ** -0.5),
        "q_norm_w": 1.0 + nrm(ks[7], (L, HEAD_DIM), 0.05),
        "k_norm_w": 1.0 + nrm(ks[8], (L, HEAD_DIM), 0.05),
        "w_pool": nrm(ks[9], (L, N_POOL_GROUPS, POOL_GROUP_DIM, POOL_GROUP_DIM), POOL_GROUP_DIM ** -0.5),
        "pool_scale": 1.0 + nrm(ks[10], (L, POOL_WIDTH), 0.1),
        "w_o": nrm(ks[11], (L, MIX_WIDTH, D_MODEL), MIX_WIDTH ** -0.5),
        "w_router": nrm(ks[12], (L, D_MODEL, N_EXPERTS), D_MODEL ** -0.5),
        "b_router": nrm(ks[13], (L, N_EXPERTS), 0.01),
        "w_exp_in": nrm(ks[14], (L, N_EXPERTS, D_MODEL, 2 * D_FF), D_MODEL ** -0.5),
        "b_exp_in": nrm(ks[15], (L, N_EXPERTS, 2 * D_FF), 0.02),
        "w_exp_out": nrm(ks[16], (L, N_EXPERTS, D_FF, D_MODEL), D_FF ** -0.5),
        "b_exp_out": nrm(ks[17], (L, N_EXPERTS, D_MODEL), 0.02),
    }


def reference(x, c, norm1_w, norm2_w, w_ada, b_ada, w_in, q_norm_w, k_norm_w, w_pool,
              pool_scale, w_o, w_router, b_router, w_exp_in, b_exp_in, w_exp_out, b_exp_out):
    B, S, D = x.shape
    c_act = jax.nn.silu(c)
    for l in range(DEPTH):
        mod = c_act @ w_ada[l] + b_ada[l]
        shift1, scale1, gate1, shift2, scale2, gate2 = [m[:, None, :] for m in jnp.split(mod, 6, axis=-1)]

        h = rms_norm(x, norm1_w[l]) * (1.0 + scale1) + shift1
        proj = h @ w_in[l]
        q = proj[..., :SB_WIDTH].reshape(B, S, N_SB_HEADS, HEAD_DIM)
        k = proj[..., SB_WIDTH:2 * SB_WIDTH].reshape(B, S, N_SB_HEADS, HEAD_DIM)
        v = proj[..., 2 * SB_WIDTH:3 * SB_WIDTH].reshape(B, S, N_SB_HEADS, HEAD_DIM)
        u = proj[..., 3 * SB_WIDTH:]
        q = rms_norm(q, q_norm_w[l])
        k = rms_norm(k, k_norm_w[l])
        o_sb = stick_breaking_attention(q, k, v).astype(x.dtype)
        o_pool = pool_mixer(u, w_pool[l], pool_scale[l])
        mixed = jnp.concatenate([o_sb, o_pool], axis=-1) @ w_o[l]
        x = x + gate1 * mixed

        h2 = rms_norm(x, norm2_w[l]) * (1.0 + scale2) + shift2
        y = moe_ffn(h2, w_router[l], b_router[l], w_exp_in[l], b_exp_in[l], w_exp_out[l], b_exp_out[l])
        x = x + gate2 * y
    return x
```

```cpp
#include <hip/hip_runtime.h>
#include <stdint.h>

constexpr int kB = 4, kS = 2048, kD = 2048, kT = kB * kS;
constexpr int kHD = 128, kNH = 8, kSB = 1024, kPW = 1024, kPG = 256;
constexpr int kNPROJ = 4096, kE = 32, kTOPK = 4, kDFF = 2048;
constexpr float kEPS = 1e-6f;
constexpr int kMaxSlots = 160 * 256;

typedef unsigned short bf16_t;
__device__ __forceinline__ bf16_t f2bf(float f) { unsigned u = __float_as_uint(f); u += 0x7FFFu + ((u >> 16) & 1u); return (bf16_t)(u >> 16); }
__device__ __forceinline__ float bf2f(bf16_t b) { return __uint_as_float(((unsigned)b) << 16); }

constexpr size_t WS_CTRL   = 0;
constexpr size_t WS_MOD    = 65536;
constexpr size_t WS_H      = WS_MOD + (size_t)4 * 12288 * 4;
constexpr size_t WS_PROJ   = WS_H + (size_t)kT * kD * 2;
constexpr size_t WS_CAT    = WS_PROJ + (size_t)kT * kNPROJ * 2;
constexpr size_t WS_P      = WS_CAT + (size_t)kT * kD * 2;
constexpr size_t WS_X1     = WS_P + (size_t)kT * kPW * 2;
constexpr size_t WS_H2     = WS_X1 + (size_t)kT * kD * 4;
constexpr size_t WS_GATES  = WS_H2 + (size_t)kT * kD * 2;
constexpr size_t WS_PAIRE  = WS_GATES + (size_t)kT * 4 * 4;
constexpr size_t WS_PAIRP  = WS_PAIRE + (size_t)kT * 4 * 4;
constexpr size_t WS_LIST   = WS_PAIRP + (size_t)kT * 4 * 4;
constexpr size_t WS_ACT    = WS_LIST + (size_t)kE * kT * 4;
constexpr size_t WS_YP     = WS_ACT + (size_t)kMaxSlots * kDFF * 2;
constexpr size_t WS_END    = WS_YP + (size_t)kMaxSlots * kD * 2;
constexpr int CT_CNT = 4096;
constexpr int CT_ROWBASE = 4160;

__global__ void k_ada(const float* __restrict__ c, const float* __restrict__ w_ada, const float* __restrict__ b_ada, float* __restrict__ mod) {
    __shared__ float ca[kB][kD];
    for (int i = threadIdx.x; i < kB * kD; i += blockDim.x) { const float v = c[i]; ca[i / kD][i % kD] = v / (1.f + __expf(-v)); }
    __syncthreads();
    const int n = blockIdx.x * blockDim.x + threadIdx.x;
    float a0 = 0.f, a1 = 0.f, a2 = 0.f, a3 = 0.f;
    for (int k = 0; k < kD; ++k) { const float w = w_ada[(size_t)k * (6 * kD) + n]; a0 += ca[0][k] * w; a1 += ca[1][k] * w; a2 += ca[2][k] * w; a3 += ca[3][k] * w; }
    const float bb = b_ada[n];
    mod[0 * 6 * kD + n] = a0 + bb; mod[1 * 6 * kD + n] = a1 + bb; mod[2 * 6 * kD + n] = a2 + bb; mod[3 * 6 * kD + n] = a3 + bb;
}

__device__ __forceinline__ float block_sum_256(float v, float* red) {
    for (int o = 32; o > 0; o >>= 1) v += __shfl_down(v, o);
    const int w = threadIdx.x >> 6, l = threadIdx.x & 63;
    __syncthreads();
    if (l == 0) red[w] = v;
    __syncthreads();
    return red[0] + red[1] + red[2] + red[3];
}
__global__ void k_norm_mod(const float* __restrict__ x, const float* __restrict__ nw, const float* __restrict__ mod, int shift_off, int scale_off, bf16_t* __restrict__ out) {
    __shared__ float red[4];
    const int t = blockIdx.x, b = t / kS;
    const float* xr = x + (size_t)t * kD;
    float v[8]; float ss = 0.f;
    for (int i = 0; i < 8; ++i) { v[i] = xr[threadIdx.x + 256 * i]; ss += v[i] * v[i]; }
    ss = block_sum_256(ss, red);
    const float r = rsqrtf(ss / kD + kEPS);
    for (int i = 0; i < 8; ++i) { const int n = threadIdx.x + 256 * i;
        const float y = v[i] * r * nw[n] * (1.f + mod[b * 6 * kD + scale_off + n]) + mod[b * 6 * kD + shift_off + n];
        out[(size_t)t * kD + n] = f2bf(y); }
}

struct GemmArgs { const bf16_t* A; const float* B; int lda; int ldb; int K; int pad; };
template <class RowFn, class Epi>
__global__ void __launch_bounds__(256) k_gemm_naive(GemmArgs g, RowFn rowfn, Epi epi) {
    __shared__ float As[16][68], Bs[16][64];
    const int z = blockIdx.z;
    int mrows; const bf16_t* Abase; const float* Bbase;
    if (!rowfn.setup(z, g, mrows, Abase, Bbase)) return;
    const int m0 = blockIdx.y * 64, n0 = blockIdx.x * 64;
    if (m0 >= mrows) return;
    const int tid = threadIdx.x, ty = tid >> 4, tx = tid & 15;
    const int ar = tid >> 2, ak = (tid & 3) * 4;
    const int bk = tid >> 4, bn = (tid & 15) * 4;
    const long arow = rowfn.row(z, m0 + ar, mrows);
    const bf16_t* ap = Abase + arow * (long)g.lda + ak;
    const float* bp = Bbase + (size_t)bk * g.ldb + n0 + bn;
    float acc[4][4] = {};
    for (int k0 = 0; k0 < g.K; k0 += 16) {
        const uint2 av = *(const uint2*)(ap + k0);
        const float4 bv = *(const float4*)(bp + (size_t)k0 * g.ldb);
        __syncthreads();
        As[ak + 0][ar] = __uint_as_float(av.x << 16); As[ak + 1][ar] = __uint_as_float(av.x & 0xFFFF0000u);
        As[ak + 2][ar] = __uint_as_float(av.y << 16); As[ak + 3][ar] = __uint_as_float(av.y & 0xFFFF0000u);
        *(float4*)&Bs[bk][bn] = bv;
        __syncthreads();
#pragma unroll
        for (int k = 0; k < 16; ++k) {
            const float4 a4 = *(const float4*)&As[k][ty * 4]; const float4 b4 = *(const float4*)&Bs[k][tx * 4];
            const float a[4] = {a4.x, a4.y, a4.z, a4.w}, b[4] = {b4.x, b4.y, b4.z, b4.w};
#pragma unroll
            for (int i = 0; i < 4; ++i)
#pragma unroll
                for (int j = 0; j < 4; ++j) acc[i][j] += a[i] * b[j];
        }
    }
#pragma unroll
    for (int i = 0; i < 4; ++i)
#pragma unroll
        for (int j = 0; j < 4; ++j) epi(z, m0 + ty * 4 + i, n0 + tx * 4 + j, acc[i][j], mrows);
}
struct RowDense { int M;
    __device__ bool setup(int, const GemmArgs& g, int& mrows, const bf16_t*& A, const float*& B) const { mrows = M; A = g.A; B = g.B; return true; }
    __device__ long row(int, int r, int) const { return r; } };
struct EpiStoreBf16 { bf16_t* C; int ldc; int pad;
    __device__ void operator()(int, int r, int c, float v, int) const { C[(size_t)r * ldc + c] = f2bf(v); } };
struct EpiOutProj { const float* x; const float* mod; float* x1;
    __device__ void operator()(int, int r, int c, float v, int) const { const int b = r / kS; x1[(size_t)r * kD + c] = x[(size_t)r * kD + c] + mod[b * 6 * kD + 2 * kD + c] * v; } };
struct RowPool { int pad; __device__ bool setup(int z, const GemmArgs& g, int& mrows, const bf16_t*& A, const float*& B) const { mrows = kT; A = g.A + z * kPG; B = g.B + (size_t)z * kPG * kPG; return true; }
    __device__ long row(int, int r, int) const { return r; } };
struct EpiPool { const float* pool_scale; bf16_t* cat;
    __device__ void operator()(int z, int r, int c, float v, int) const { cat[(size_t)r * kD + kSB + z * kPG + c] = f2bf(v * pool_scale[z * kPG + c]); } };

__global__ void __launch_bounds__(256) k_attn_naive(const bf16_t* __restrict__ proj, const float* __restrict__ qw, const float* __restrict__ kw, bf16_t* __restrict__ cat) {
    __shared__ float qs[4][kHD];
    const int w = threadIdx.x >> 6, lane = threadIdx.x & 63;
    const int rowid = blockIdx.x * 4 + w;
    const int t = rowid % kS, bh = rowid / kS, h = bh % kNH, b = bh / kNH;
    const bf16_t* qrow = proj + (size_t)(b * kS + t) * kNPROJ + h * kHD;
    float q0 = bf2f(qrow[lane]), q1 = bf2f(qrow[lane + 64]);
    float ss = q0 * q0 + q1 * q1;
    for (int o = 32; o > 0; o >>= 1) ss += __shfl_xor(ss, o);
    const float rq = rsqrtf(ss / kHD + kEPS) * 0.08838834764831845f;
    qs[w][lane] = q0 * rq * qw[lane] * kw[lane]; qs[w][lane + 64] = q1 * rq * qw[lane + 64] * kw[lane + 64];
    __syncthreads();
    float o0 = 0.f, o1 = 0.f, carry = 0.f;
    for (int jb = ((t - 1) >> 6) << 6; jb >= 0 && t > 0; jb -= 64) {
        const int j = jb + lane; const bool valid = j < t;
        float z = 0.f, sp = 0.f;
        if (valid) {
            const bf16_t* krow = proj + (size_t)(b * kS + j) * kNPROJ + kSB + h * kHD;
            float dot = 0.f, kss = 0.f;
            for (int d = 0; d < kHD; d += 8) { const uint4 kv = *(const uint4*)(krow + d); const unsigned u[4] = {kv.x, kv.y, kv.z, kv.w};
#pragma unroll
                for (int e = 0; e < 4; ++e) { const float k0 = __uint_as_float(u[e] << 16), k1 = __uint_as_float(u[e] & 0xFFFF0000u);
                    dot += qs[w][d + 2 * e] * k0 + qs[w][d + 2 * e + 1] * k1; kss += k0 * k0 + k1 * k1; } }
            z = dot * rsqrtf(kss / kHD + kEPS);
            sp = (z > 15.f) ? z : log1pf(__expf(z));
        }
        float s = sp;
        for (int o = 1; o < 64; o <<= 1) { const float v = __shfl_down(s, o); if (lane + o < 64) s += v; }
        const float a = valid ? __expf(z - (carry + s)) : 0.f;
        carry += __shfl(s, 0);
        const int jmax = min(64, t - jb);
        const bf16_t* vb = proj + (size_t)(b * kS + jb) * kNPROJ + 2 * kSB + h * kHD;
        for (int l = 0; l < jmax; ++l) { const float al = __shfl(a, l); o0 += al * bf2f(vb[(size_t)l * kNPROJ + lane]); o1 += al * bf2f(vb[(size_t)l * kNPROJ + lane + 64]); }
    }
    bf16_t* orow = cat + (size_t)(b * kS + t) * kD + h * kHD;
    orow[lane] = f2bf(o0); orow[lane + 64] = f2bf(o1);
}

__global__ void k_pool_p(const bf16_t* __restrict__ proj, bf16_t* __restrict__ p) {
    const int idx = blockIdx.x * blockDim.x + threadIdx.x;
    const int c = idx & (kPW - 1), t = idx >> 10, s = t % kS, g = c >> 8;
    const int w = 2 << g;
    const int cnt = min(s + 1, w);
    float sum = 0.f;
    for (int i = 0; i < cnt; ++i) sum += bf2f(proj[(size_t)(t - i) * kNPROJ + 3 * kSB + c]);
    const float u = bf2f(proj[(size_t)t * kNPROJ + 3 * kSB + c]);
    p[(size_t)t * kPW + c] = f2bf(sum / (float)cnt - u);
}

__global__ void __launch_bounds__(256) k_norm2_router(const float* __restrict__ x1, const float* __restrict__ nw, const float* __restrict__ mod,
                               const float* __restrict__ w_router, const float* __restrict__ b_router, bf16_t* __restrict__ h2,
                               float* __restrict__ gates, int* __restrict__ pair_e, int* __restrict__ pair_p, int* __restrict__ list, unsigned* __restrict__ ctrl) {
    __shared__ float red[4]; __shared__ float lg[4][kE];
    const int t = blockIdx.x, b = t / kS;
    const float* xr = x1 + (size_t)t * kD;
    float v[8]; float ss = 0.f;
    for (int i = 0; i < 8; ++i) { v[i] = xr[threadIdx.x + 256 * i]; ss += v[i] * v[i]; }
    ss = block_sum_256(ss, red);
    const float r = rsqrtf(ss / kD + kEPS);
    float part[kE];
#pragma unroll
    for (int e = 0; e < kE; ++e) part[e] = 0.f;
    for (int i = 0; i < 8; ++i) { const int n = threadIdx.x + 256 * i;
        const float y = v[i] * r * nw[n] * (1.f + mod[b * 6 * kD + 4 * kD + n]) + mod[b * 6 * kD + 3 * kD + n];
        h2[(size_t)t * kD + n] = f2bf(y);
        const float4* wr = (const float4*)(w_router + (size_t)n * kE);
#pragma unroll
        for (int e4 = 0; e4 < 8; ++e4) { const float4 w4 = wr[e4]; part[e4 * 4] += y * w4.x; part[e4 * 4 + 1] += y * w4.y; part[e4 * 4 + 2] += y * w4.z; part[e4 * 4 + 3] += y * w4.w; } }
    const int wv = threadIdx.x >> 6, l = threadIdx.x & 63;
#pragma unroll
    for (int e = 0; e < kE; ++e) { float s = part[e]; for (int o = 32; o > 0; o >>= 1) s += __shfl_down(s, o); if (l == 0) lg[wv][e] = s; }
    __syncthreads();
    if (threadIdx.x < 64) {
        const int e = l & 31;
        float mine = lg[0][e] + lg[1][e] + lg[2][e] + lg[3][e] + b_router[e];
        if (l >= 32) mine = -3.4e38f;
        int idx[4]; float val[4];
#pragma unroll
        for (int k = 0; k < 4; ++k) {
            float bv = mine; int bi = l;
            for (int o = 32; o > 0; o >>= 1) { const float ov = __shfl_xor(bv, o); const int oi = __shfl_xor(bi, o); if (ov > bv || (ov == bv && oi < bi)) { bv = ov; bi = oi; } }
            idx[k] = bi; val[k] = bv; if (l == bi) mine = -3.4e38f;
        }
        if (l == 0) {
            float ex[4], sum = 0.f;
#pragma unroll
            for (int k = 0; k < 4; ++k) { ex[k] = __expf(val[k] - val[0]); sum += ex[k]; }
#pragma unroll
            for (int k = 0; k < 4; ++k) { gates[t * 4 + k] = ex[k] / sum; pair_e[t * 4 + k] = idx[k];
                const unsigned pos = atomicAdd(&ctrl[CT_CNT + idx[k]], 1u); pair_p[t * 4 + k] = (int)pos; list[(size_t)idx[k] * kT + pos] = t; }
        }
    }
}
__global__ void k_moe_plan(unsigned* ctrl) {
    if (threadIdx.x == 0) { unsigned base = 0; for (int e = 0; e < kE; ++e) { ctrl[CT_ROWBASE + e] = base; base += ((ctrl[CT_CNT + e] + 255u) / 256u) * 256u; } ctrl[CT_ROWBASE + kE] = base; }
}

__global__ void __launch_bounds__(256) k_moe1_naive(const bf16_t* __restrict__ h2, const float* __restrict__ w_in, const float* __restrict__ b_in, const int* __restrict__ list,
                                                    const unsigned* __restrict__ ctrl, bf16_t* __restrict__ act) {
    __shared__ float As[16][68], Bg[16][64], Bl[16][64];
    const int e = blockIdx.z; const int mrows = (int)ctrl[CT_CNT + e];
    const int m0 = blockIdx.y * 64, n0 = blockIdx.x * 64;
    if (m0 >= mrows) return;
    const int rowbase = (int)ctrl[CT_ROWBASE + e];
    const int tid = threadIdx.x, ty = tid >> 4, tx = tid & 15;
    const int ar = tid >> 2, ak = (tid & 3) * 4, bk = tid >> 4, bn = (tid & 15) * 4;
    const int tok = list[(size_t)e * kT + min(m0 + ar, mrows - 1)];
    const bf16_t* ap = h2 + (size_t)tok * kD + ak;
    const float* bp = w_in + (size_t)e * kD * 2 * kDFF + (size_t)bk * (2 * kDFF) + n0 + bn;
    float ag[4][4] = {}, al[4][4] = {};
    for (int k0 = 0; k0 < kD; k0 += 16) {
        const uint2 av = *(const uint2*)(ap + k0);
        const float4 g4 = *(const float4*)(bp + (size_t)k0 * (2 * kDFF)); const float4 l4 = *(const float4*)(bp + (size_t)k0 * (2 * kDFF) + kDFF);
        __syncthreads();
        As[ak + 0][ar] = __uint_as_float(av.x << 16); As[ak + 1][ar] = __uint_as_float(av.x & 0xFFFF0000u);
        As[ak + 2][ar] = __uint_as_float(av.y << 16); As[ak + 3][ar] = __uint_as_float(av.y & 0xFFFF0000u);
        *(float4*)&Bg[bk][bn] = g4; *(float4*)&Bl[bk][bn] = l4;
        __syncthreads();
#pragma unroll
        for (int k = 0; k < 16; ++k) {
            const float4 a4 = *(const float4*)&As[k][ty * 4]; const float4 g44 = *(const float4*)&Bg[k][tx * 4]; const float4 l44 = *(const float4*)&Bl[k][tx * 4];
            const float a[4] = {a4.x, a4.y, a4.z, a4.w}, gg[4] = {g44.x, g44.y, g44.z, g44.w}, ll[4] = {l44.x, l44.y, l44.z, l44.w};
#pragma unroll
            for (int i = 0; i < 4; ++i)
#pragma unroll
                for (int j = 0; j < 4; ++j) { ag[i][j] += a[i] * gg[j]; al[i][j] += a[i] * ll[j]; }
        }
    }
    for (int i = 0; i < 4; ++i) { const int r = m0 + ty * 4 + i; if (r >= mrows) continue;
        for (int j = 0; j < 4; ++j) { const int c = n0 + tx * 4 + j;
            float gv = ag[i][j] + b_in[(size_t)e * 2 * kDFF + c], lv = al[i][j] + b_in[(size_t)e * 2 * kDFF + kDFF + c];
            gv = fminf(gv, 7.f); lv = fminf(fmaxf(lv, -7.f), 7.f);
            const float a = gv / (1.f + __expf(-1.702f * gv)) * (lv + 1.f);
            act[(size_t)(rowbase + r) * kDFF + c] = f2bf(a); } }
}
struct RowMoe2 { const unsigned* ctrl; const float* w;
    __device__ bool setup(int z, const GemmArgs& g, int& mrows, const bf16_t*& A, const float*& B) const { mrows = (int)ctrl[CT_CNT + z]; A = g.A + (size_t)ctrl[CT_ROWBASE + z] * kDFF; B = w + (size_t)z * kDFF * kD; return mrows > 0; }
    __device__ long row(int, int r, int mrows) const { return r < mrows ? r : mrows - 1; } };
struct EpiMoe2 { const unsigned* ctrl; const float* b_out; bf16_t* yp;
    __device__ void operator()(int z, int r, int c, float v, int mrows) const { if (r < mrows) yp[(size_t)(ctrl[CT_ROWBASE + z] + r) * kD + c] = f2bf(v + b_out[(size_t)z * kD + c]); } };

__global__ void k_final(const float* __restrict__ x1, const float* __restrict__ mod, const float* __restrict__ gates, const int* __restrict__ pair_e, const int* __restrict__ pair_p,
                        const unsigned* __restrict__ ctrl, const bf16_t* __restrict__ yp, float* __restrict__ out) {
    const int t = blockIdx.x, b = t / kS;
    float gk[4]; size_t rows[4];
#pragma unroll
    for (int k = 0; k < 4; ++k) { gk[k] = gates[t * 4 + k]; rows[k] = (size_t)(ctrl[CT_ROWBASE + pair_e[t * 4 + k]] + (unsigned)pair_p[t * 4 + k]); }
    for (int n = threadIdx.x; n < kD; n += blockDim.x) {
        float y = 0.f;
#pragma unroll
        for (int k = 0; k < 4; ++k) y += gk[k] * bf2f(yp[rows[k] * kD + n]);
        out[(size_t)t * kD + n] = x1[(size_t)t * kD + n] + mod[b * 6 * kD + 5 * kD + n] * y;
    }
}

extern "C" void kernel_launch(void* const* d_in, const int* in_sizes, int n_in, void* d_out, int out_size, void* d_ws, size_t ws_size, hipStream_t stream) {
    const float* x = (const float*)d_in[0]; const float* c = (const float*)d_in[1]; const float* norm1_w = (const float*)d_in[2]; const float* norm2_w = (const float*)d_in[3];
    const float* w_ada = (const float*)d_in[4]; const float* b_ada = (const float*)d_in[5]; const float* w_in = (const float*)d_in[6];
    const float* q_norm_w = (const float*)d_in[7]; const float* k_norm_w = (const float*)d_in[8]; const float* w_pool = (const float*)d_in[9]; const float* pool_scale = (const float*)d_in[10];
    const float* w_o = (const float*)d_in[11]; const float* w_router = (const float*)d_in[12]; const float* b_router = (const float*)d_in[13];
    const float* w_exp_in = (const float*)d_in[14]; const float* b_exp_in = (const float*)d_in[15]; const float* w_exp_out = (const float*)d_in[16]; const float* b_exp_out = (const float*)d_in[17];
    float* out = (float*)d_out;
    char* ws = (char*)d_ws;
    unsigned* ctrl = (unsigned*)(ws + WS_CTRL); float* mod = (float*)(ws + WS_MOD); bf16_t* h = (bf16_t*)(ws + WS_H); bf16_t* proj = (bf16_t*)(ws + WS_PROJ);
    bf16_t* cat = (bf16_t*)(ws + WS_CAT); bf16_t* p = (bf16_t*)(ws + WS_P); float* x1 = (float*)(ws + WS_X1); bf16_t* h2 = (bf16_t*)(ws + WS_H2);
    float* gates = (float*)(ws + WS_GATES); int* pair_e = (int*)(ws + WS_PAIRE); int* pair_p = (int*)(ws + WS_PAIRP); int* list = (int*)(ws + WS_LIST);
    bf16_t* act = (bf16_t*)(ws + WS_ACT); bf16_t* yp = (bf16_t*)(ws + WS_YP);
    (void)hipMemsetAsync(ctrl, 0, 65536, stream);
    k_ada<<<6 * kD / 256, 256, 0, stream>>>(c, w_ada, b_ada, mod);
    k_norm_mod<<<kT, 256, 0, stream>>>(x, norm1_w, mod, 0, kD, h);
    { GemmArgs g{h, w_in, kD, kNPROJ, kD, 0}; k_gemm_naive<<<dim3(kNPROJ / 64, kT / 64, 1), 256, 0, stream>>>(g, RowDense{kT}, EpiStoreBf16{proj, kNPROJ, 0}); }
    k_attn_naive<<<kB * kNH * kS / 4, 256, 0, stream>>>(proj, q_norm_w, k_norm_w, cat);
    k_pool_p<<<kT * kPW / 256, 256, 0, stream>>>(proj, p);
    { GemmArgs g{p, w_pool, kPW, kPG, kPG, 0}; k_gemm_naive<<<dim3(kPG / 64, kT / 64, 4), 256, 0, stream>>>(g, RowPool{0}, EpiPool{pool_scale, cat}); }
    { GemmArgs g{cat, w_o, kD, kD, kD, 0}; k_gemm_naive<<<dim3(kD / 64, kT / 64, 1), 256, 0, stream>>>(g, RowDense{kT}, EpiOutProj{x, mod, x1}); }
    k_norm2_router<<<kT, 256, 0, stream>>>(x1, norm2_w, mod, w_router, b_router, h2, gates, pair_e, pair_p, list, ctrl);
    k_moe_plan<<<1, 64, 0, stream>>>(ctrl);
    k_moe1_naive<<<dim3(kDFF / 64, kT / 64, kE), 256, 0, stream>>>(h2, w_exp_in, b_exp_in, list, ctrl, act);
    { GemmArgs g{act, w_exp_out, kDFF, kD, kDFF, 0}; k_gemm_naive<<<dim3(kD / 64, kT / 64, kE), 256, 0, stream>>>(g, RowMoe2{ctrl, w_exp_out}, EpiMoe2{ctrl, b_exp_out, yp}); }
    k_final<<<kT, 256, 0, stream>>>(x1, mod, gates, pair_e, pair_p, ctrl, yp, out);
}
```

```cpp
#include <hip/hip_runtime.h>
#include <stdint.h>

constexpr int kB = 4, kS = 2048, kD = 2048, kT = kB * kS;
constexpr int kHD = 128, kNH = 8, kSB = 1024, kPW = 1024, kPG = 256;
constexpr int kNPROJ = 4096, kE = 32, kTOPK = 4, kDFF = 2048;
constexpr float kEPS = 1e-6f;
constexpr int kMaxSlots = 160 * 256;

typedef unsigned short bf16_t;
__device__ __forceinline__ bf16_t f2bf(float f) { unsigned u = __float_as_uint(f); u += 0x7FFFu + ((u >> 16) & 1u); return (bf16_t)(u >> 16); }
__device__ __forceinline__ float bf2f(bf16_t b) { return __uint_as_float(((unsigned)b) << 16); }

constexpr size_t WS_CTRL   = 0;
constexpr size_t WS_MOD    = 65536;
constexpr size_t WS_H      = WS_MOD + (size_t)4 * 12288 * 4;
constexpr size_t WS_PROJ   = WS_H + (size_t)kT * kD * 2;
constexpr size_t WS_CAT    = WS_PROJ + (size_t)kT * kNPROJ * 2;
constexpr size_t WS_P      = WS_CAT + (size_t)kT * kD * 2;
constexpr size_t WS_X1     = WS_P + (size_t)kT * kPW * 2;
constexpr size_t WS_H2     = WS_X1 + (size_t)kT * kD * 4;
constexpr size_t WS_GATES  = WS_H2 + (size_t)kT * kD * 2;
constexpr size_t WS_PAIRE  = WS_GATES + (size_t)kT * 4 * 4;
constexpr size_t WS_PAIRP  = WS_PAIRE + (size_t)kT * 4 * 4;
constexpr size_t WS_LIST   = WS_PAIRP + (size_t)kT * 4 * 4;
constexpr size_t WS_ACT    = WS_LIST + (size_t)kE * kT * 4;
constexpr size_t WS_YP     = WS_ACT + (size_t)kMaxSlots * kDFF * 2;
constexpr size_t WS_END    = WS_YP + (size_t)kMaxSlots * kD * 2;
constexpr int CT_CNT = 4096;
constexpr int CT_ROWBASE = 4160;

__global__ void k_ada(const float* __restrict__ c, const float* __restrict__ w_ada, const float* __restrict__ b_ada, float* __restrict__ mod) {
    __shared__ float ca[kB][kD];
    for (int i = threadIdx.x; i < kB * kD; i += blockDim.x) { const float v = c[i]; ca[i / kD][i % kD] = v / (1.f + __expf(-v)); }
    __syncthreads();
    const int n = blockIdx.x * blockDim.x + threadIdx.x;
    float a0 = 0.f, a1 = 0.f, a2 = 0.f, a3 = 0.f;
    for (int k = 0; k < kD; ++k) { const float w = w_ada[(size_t)k * (6 * kD) + n]; a0 += ca[0][k] * w; a1 += ca[1][k] * w; a2 += ca[2][k] * w; a3 += ca[3][k] * w; }
    const float bb = b_ada[n];
    mod[0 * 6 * kD + n] = a0 + bb; mod[1 * 6 * kD + n] = a1 + bb; mod[2 * 6 * kD + n] = a2 + bb; mod[3 * 6 * kD + n] = a3 + bb;
}

__device__ __forceinline__ float block_sum_256(float v, float* red) {
    for (int o = 32; o > 0; o >>= 1) v += __shfl_down(v, o);
    const int w = threadIdx.x >> 6, l = threadIdx.x & 63;
    __syncthreads();
    if (l == 0) red[w] = v;
    __syncthreads();
    return red[0] + red[1] + red[2] + red[3];
}
__global__ void k_norm_mod(const float* __restrict__ x, const float* __restrict__ nw, const float* __restrict__ mod, int shift_off, int scale_off, bf16_t* __restrict__ out) {
    __shared__ float red[4];
    const int t = blockIdx.x, b = t / kS;
    const float* xr = x + (size_t)t * kD;
    float v[8]; float ss = 0.f;
    for (int i = 0; i < 8; ++i) { v[i] = xr[threadIdx.x + 256 * i]; ss += v[i] * v[i]; }
    ss = block_sum_256(ss, red);
    const float r = rsqrtf(ss / kD + kEPS);
    for (int i = 0; i < 8; ++i) { const int n = threadIdx.x + 256 * i;
        const float y = v[i] * r * nw[n] * (1.f + mod[b * 6 * kD + scale_off + n]) + mod[b * 6 * kD + shift_off + n];
        out[(size_t)t * kD + n] = f2bf(y); }
}

struct GemmArgs { const bf16_t* A; const float* B; int lda; int ldb; int K; int pad; };
template <class RowFn, class Epi>
__global__ void __launch_bounds__(256) k_gemm_naive(GemmArgs g, RowFn rowfn, Epi epi) {
    __shared__ float As[16][68], Bs[16][64];
    const int z = blockIdx.z;
    int mrows; const bf16_t* Abase; const float* Bbase;
    if (!rowfn.setup(z, g, mrows, Abase, Bbase)) return;
    const int m0 = blockIdx.y * 64, n0 = blockIdx.x * 64;
    if (m0 >= mrows) return;
    const int tid = threadIdx.x, ty = tid >> 4, tx = tid & 15;
    const int ar = tid >> 2, ak = (tid & 3) * 4;
    const int bk = tid >> 4, bn = (tid & 15) * 4;
    const long arow = rowfn.row(z, m0 + ar, mrows);
    const bf16_t* ap = Abase + arow * (long)g.lda + ak;
    const float* bp = Bbase + (size_t)bk * g.ldb + n0 + bn;
    float acc[4][4] = {};
    for (int k0 = 0; k0 < g.K; k0 += 16) {
        const uint2 av = *(const uint2*)(ap + k0);
        const float4 bv = *(const float4*)(bp + (size_t)k0 * g.ldb);
        __syncthreads();
        As[ak + 0][ar] = __uint_as_float(av.x << 16); As[ak + 1][ar] = __uint_as_float(av.x & 0xFFFF0000u);
        As[ak + 2][ar] = __uint_as_float(av.y << 16); As[ak + 3][ar] = __uint_as_float(av.y & 0xFFFF0000u);
        *(float4*)&Bs[bk][bn] = bv;
        __syncthreads();
#pragma unroll
        for (int k = 0; k < 16; ++k) {
            const float4 a4 = *(const float4*)&As[k][ty * 4]; const float4 b4 = *(const float4*)&Bs[k][tx * 4];
            const float a[4] = {a4.x, a4.y, a4.z, a4.w}, b[4] = {b4.x, b4.y, b4.z, b4.w};
#pragma unroll
            for (int i = 0; i < 4; ++i)
#pragma unroll
                for (int j = 0; j < 4; ++j) acc[i][j] += a[i] * b[j];
        }
    }
#pragma unroll
    for (int i = 0; i < 4; ++i)
#pragma unroll
        for (int j = 0; j < 4; ++j) epi(z, m0 + ty * 4 + i, n0 + tx * 4 + j, acc[i][j], mrows);
}
struct RowDense { int M;
    __device__ bool setup(int, const GemmArgs& g, int& mrows, const bf16_t*& A, const float*& B) const { mrows = M; A = g.A; B = g.B; return true; }
    __device__ long row(int, int r, int) const { return r; } };
struct EpiStoreBf16 { bf16_t* C; int ldc; int pad;
    __device__ void operator()(int, int r, int c, float v, int) const { C[(size_t)r * ldc + c] = f2bf(v); } };
struct EpiOutProj { const float* x; const float* mod; float* x1;
    __device__ void operator()(int, int r, int c, float v, int) const { const int b = r / kS; x1[(size_t)r * kD + c] = x[(size_t)r * kD + c] + mod[b * 6 * kD + 2 * kD + c] * v; } };
struct RowPool { int pad; __device__ bool setup(int z, const GemmArgs& g, int& mrows, const bf16_t*& A, const float*& B) const { mrows = kT; A = g.A + z * kPG; B = g.B + (size_t)z * kPG * kPG; return true; }
    __device__ long row(int, int r, int) const { return r; } };
struct EpiPool { const float* pool_scale; bf16_t* cat;
    __device__ void operator()(int z, int r, int c, float v, int) const { cat[(size_t)r * kD + kSB + z * kPG + c] = f2bf(v * pool_scale[z * kPG + c]); } };

__global__ void __launch_bounds__(256) k_attn_naive(const bf16_t* __restrict__ proj, const float* __restrict__ qw, const float* __restrict__ kw, bf16_t* __restrict__ cat) {
    __shared__ float qs[4][kHD];
    const int w = threadIdx.x >> 6, lane = threadIdx.x & 63;
    const int rowid = blockIdx.x * 4 + w;
    const int t = rowid % kS, bh = rowid / kS, h = bh % kNH, b = bh / kNH;
    const bf16_t* qrow = proj + (size_t)(b * kS + t) * kNPROJ + h * kHD;
    float q0 = bf2f(qrow[lane]), q1 = bf2f(qrow[lane + 64]);
    float ss = q0 * q0 + q1 * q1;
    for (int o = 32; o > 0; o >>= 1) ss += __shfl_xor(ss, o);
    const float rq = rsqrtf(ss / kHD + kEPS) * 0.08838834764831845f;
    qs[w][lane] = q0 * rq * qw[lane] * kw[lane]; qs[w][lane + 64] = q1 * rq * qw[lane + 64] * kw[lane + 64];
    __syncthreads();
    float o0 = 0.f, o1 = 0.f, carry = 0.f;
    for (int jb = ((t - 1) >> 6) << 6; jb >= 0 && t > 0; jb -= 64) {
        const int j = jb + lane; const bool valid = j < t;
        float z = 0.f, sp = 0.f;
        if (valid) {
            const bf16_t* krow = proj + (size_t)(b * kS + j) * kNPROJ + kSB + h * kHD;
            float dot = 0.f, kss = 0.f;
            for (int d = 0; d < kHD; d += 8) { const uint4 kv = *(const uint4*)(krow + d); const unsigned u[4] = {kv.x, kv.y, kv.z, kv.w};
#pragma unroll
                for (int e = 0; e < 4; ++e) { const float k0 = __uint_as_float(u[e] << 16), k1 = __uint_as_float(u[e] & 0xFFFF0000u);
                    dot += qs[w][d + 2 * e] * k0 + qs[w][d + 2 * e + 1] * k1; kss += k0 * k0 + k1 * k1; } }
            z = dot * rsqrtf(kss / kHD + kEPS);
            sp = (z > 15.f) ? z : log1pf(__expf(z));
        }
        float s = sp;
        for (int o = 1; o < 64; o <<= 1) { const float v = __shfl_down(s, o); if (lane + o < 64) s += v; }
        const float a = valid ? __expf(z - (carry + s)) : 0.f;
        carry += __shfl(s, 0);
        const int jmax = min(64, t - jb);
        const bf16_t* vb = proj + (size_t)(b * kS + jb) * kNPROJ + 2 * kSB + h * kHD;
        for (int l = 0; l < jmax; ++l) { const float al = __shfl(a, l); o0 += al * bf2f(vb[(size_t)l * kNPROJ + lane]); o1 += al * bf2f(vb[(size_t)l * kNPROJ + lane + 64]); }
    }
    bf16_t* orow = cat + (size_t)(b * kS + t) * kD + h * kHD;
    orow[lane] = f2bf(o0); orow[lane + 64] = f2bf(o1);
}

__global__ void k_pool_p(const bf16_t* __restrict__ proj, bf16_t* __restrict__ p) {
    const int idx = blockIdx.x * blockDim.x + threadIdx.x;
    const int c = idx & (kPW - 1), t = idx >> 10, s = t % kS, g = c >> 8;
    const int w = 2 << g;
    const int cnt = min(s + 1, w);
    float sum = 0.f;
    for (int i = 0; i < cnt; ++i) sum += bf2f(proj[(size_t)(t - i) * kNPROJ + 3 * kSB + c]);
    const float u = bf2f(proj[(size_t)t * kNPROJ + 3 * kSB + c]);
    p[(size_t)t * kPW + c] = f2bf(sum / (float)cnt - u);
}

__global__ void __launch_bounds__(256) k_norm2_router(const float* __restrict__ x1, const float* __restrict__ nw, const float* __restrict__ mod,
                               const float* __restrict__ w_router, const float* __restrict__ b_router, bf16_t* __restrict__ h2,
                               float* __restrict__ gates, int* __restrict__ pair_e, int* __restrict__ pair_p, int* __restrict__ list, unsigned* __restrict__ ctrl) {
    __shared__ float red[4]; __shared__ float lg[4][kE];
    const int t = blockIdx.x, b = t / kS;
    const float* xr = x1 + (size_t)t * kD;
    float v[8]; float ss = 0.f;
    for (int i = 0; i < 8; ++i) { v[i] = xr[threadIdx.x + 256 * i]; ss += v[i] * v[i]; }
    ss = block_sum_256(ss, red);
    const float r = rsqrtf(ss / kD + kEPS);
    float part[kE];
#pragma unroll
    for (int e = 0; e < kE; ++e) part[e] = 0.f;
    for (int i = 0; i < 8; ++i) { const int n = threadIdx.x + 256 * i;
        const float y = v[i] * r * nw[n] * (1.f + mod[b * 6 * kD + 4 * kD + n]) + mod[b * 6 * kD + 3 * kD + n];
        h2[(size_t)t * kD + n] = f2bf(y);
        const float4* wr = (const float4*)(w_router + (size_t)n * kE);
#pragma unroll
        for (int e4 = 0; e4 < 8; ++e4) { const float4 w4 = wr[e4]; part[e4 * 4] += y * w4.x; part[e4 * 4 + 1] += y * w4.y; part[e4 * 4 + 2] += y * w4.z; part[e4 * 4 + 3] += y * w4.w; } }
    const int wv = threadIdx.x >> 6, l = threadIdx.x & 63;
#pragma unroll
    for (int e = 0; e < kE; ++e) { float s = part[e]; for (int o = 32; o > 0; o >>= 1) s += __shfl_down(s, o); if (l == 0) lg[wv][e] = s; }
    __syncthreads();
    if (threadIdx.x < 64) {
        const int e = l & 31;
        float mine = lg[0][e] + lg[1][e] + lg[2][e] + lg[3][e] + b_router[e];
        if (l >= 32) mine = -3.4e38f;
        int idx[4]; float val[4];
#pragma unroll
        for (int k = 0; k < 4; ++k) {
            float bv = mine; int bi = l;
            for (int o = 32; o > 0; o >>= 1) { const float ov = __shfl_xor(bv, o); const int oi = __shfl_xor(bi, o); if (ov > bv || (ov == bv && oi < bi)) { bv = ov; bi = oi; } }
            idx[k] = bi; val[k] = bv; if (l == bi) mine = -3.4e38f;
        }
        if (l == 0) {
            float ex[4], sum = 0.f;
#pragma unroll
            for (int k = 0; k < 4; ++k) { ex[k] = __expf(val[k] - val[0]); sum += ex[k]; }
#pragma unroll
            for (int k = 0; k < 4; ++k) { gates[t * 4 + k] = ex[k] / sum; pair_e[t * 4 + k] = idx[k];
                const unsigned pos = atomicAdd(&ctrl[CT_CNT + idx[k]], 1u); pair_p[t * 4 + k] = (int)pos; list[(size_t)idx[k] * kT + pos] = t; }
        }
    }
}
__global__ void k_moe_plan(unsigned* ctrl) {
    if (threadIdx.x == 0) { unsigned base = 0; for (int e = 0; e < kE; ++e) { ctrl[CT_ROWBASE + e] = base; base += ((ctrl[CT_CNT + e] + 255u) / 256u) * 256u; } ctrl[CT_ROWBASE + kE] = base; }
}

__global__ void __launch_bounds__(256) k_moe1_naive(const bf16_t* __restrict__ h2, const float* __restrict__ w_in, const float* __restrict__ b_in, const int* __restrict__ list,
                                                    const unsigned* __restrict__ ctrl, bf16_t* __restrict__ act) {
    __shared__ float As[16][68], Bg[16][64], Bl[16][64];
    const int e = blockIdx.z; const int mrows = (int)ctrl[CT_CNT + e];
    const int m0 = blockIdx.y * 64, n0 = blockIdx.x * 64;
    if (m0 >= mrows) return;
    const int rowbase = (int)ctrl[CT_ROWBASE + e];
    const int tid = threadIdx.x, ty = tid >> 4, tx = tid & 15;
    const int ar = tid >> 2, ak = (tid & 3) * 4, bk = tid >> 4, bn = (tid & 15) * 4;
    const int tok = list[(size_t)e * kT + min(m0 + ar, mrows - 1)];
    const bf16_t* ap = h2 + (size_t)tok * kD + ak;
    const float* bp = w_in + (size_t)e * kD * 2 * kDFF + (size_t)bk * (2 * kDFF) + n0 + bn;
    float ag[4][4] = {}, al[4][4] = {};
    for (int k0 = 0; k0 < kD; k0 += 16) {
        const uint2 av = *(const uint2*)(ap + k0);
        const float4 g4 = *(const float4*)(bp + (size_t)k0 * (2 * kDFF)); const float4 l4 = *(const float4*)(bp + (size_t)k0 * (2 * kDFF) + kDFF);
        __syncthreads();
        As[ak + 0][ar] = __uint_as_float(av.x << 16); As[ak + 1][ar] = __uint_as_float(av.x & 0xFFFF0000u);
        As[ak + 2][ar] = __uint_as_float(av.y << 16); As[ak + 3][ar] = __uint_as_float(av.y & 0xFFFF0000u);
        *(float4*)&Bg[bk][bn] = g4; *(float4*)&Bl[bk][bn] = l4;
        __syncthreads();
#pragma unroll
        for (int k = 0; k < 16; ++k) {
            const float4 a4 = *(const float4*)&As[k][ty * 4]; const float4 g44 = *(const float4*)&Bg[k][tx * 4]; const float4 l44 = *(const float4*)&Bl[k][tx * 4];
            const float a[4] = {a4.x, a4.y, a4.z, a4.w}, gg[4] = {g44.x, g44.y, g44.z, g44.w}, ll[4] = {l44.x, l44.y, l44.z, l44.w};
#pragma unroll
            for (int i = 0; i < 4; ++i)
#pragma unroll
                for (int j = 0; j < 4; ++j) { ag[i][j] += a[i] * gg[j]; al[i][j] += a[i] * ll[j]; }
        }
    }
    for (int i = 0; i < 4; ++i) { const int r = m0 + ty * 4 + i; if (r >= mrows) continue;
        for (int j = 0; j < 4; ++j) { const int c = n0 + tx * 4 + j;
            float gv = ag[i][j] + b_in[(size_t)e * 2 * kDFF + c], lv = al[i][j] + b_in[(size_t)e * 2 * kDFF + kDFF + c];
            gv = fminf(gv, 7.f); lv = fminf(fmaxf(lv, -7.f), 7.f);
            const float a = gv / (1.f + __expf(-1.702f * gv)) * (lv + 1.f);
            act[(size_t)(rowbase + r) * kDFF + c] = f2bf(a); } }
}
struct RowMoe2 { const unsigned* ctrl; const float* w;
    __device__ bool setup(int z, const GemmArgs& g, int& mrows, const bf16_t*& A, const float*& B) const { mrows = (int)ctrl[CT_CNT + z]; A = g.A + (size_t)ctrl[CT_ROWBASE + z] * kDFF; B = w + (size_t)z * kDFF * kD; return mrows > 0; }
    __device__ long row(int, int r, int mrows) const { return r < mrows ? r : mrows - 1; } };
struct EpiMoe2 { const unsigned* ctrl; const float* b_out; bf16_t* yp;
    __device__ void operator()(int z, int r, int c, float v, int mrows) const { if (r < mrows) yp[(size_t)(ctrl[CT_ROWBASE + z] + r) * kD + c] = f2bf(v + b_out[(size_t)z * kD + c]); } };

__global__ void k_final(const float* __restrict__ x1, const float* __restrict__ mod, const float* __restrict__ gates, const int* __restrict__ pair_e, const int* __restrict__ pair_p,
                        const unsigned* __restrict__ ctrl, const bf16_t* __restrict__ yp, float* __restrict__ out) {
    const int t = blockIdx.x, b = t / kS;
    float gk[4]; size_t rows[4];
#pragma unroll
    for (int k = 0; k < 4; ++k) { gk[k] = gates[t * 4 + k]; rows[k] = (size_t)(ctrl[CT_ROWBASE + pair_e[t * 4 + k]] + (unsigned)pair_p[t * 4 + k]); }
    for (int n = threadIdx.x; n < kD; n += blockDim.x) {
        float y = 0.f;
#pragma unroll
        for (int k = 0; k < 4; ++k) y += gk[k] * bf2f(yp[rows[k] * kD + n]);
        out[(size_t)t * kD + n] = x1[(size_t)t * kD + n] + mod[b * 6 * kD + 5 * kD + n] * y;
    }
}


#define LAS __attribute__((address_space(3)))
typedef short bf16x8 __attribute__((ext_vector_type(8)));
typedef short s16x4 __attribute__((ext_vector_type(4)));
typedef float f32x4 __attribute__((ext_vector_type(4)));
typedef float f32x2 __attribute__((ext_vector_type(2)));
typedef __bf16 bf16v2 __attribute__((ext_vector_type(2)));
typedef unsigned u32x2 __attribute__((ext_vector_type(2)));
typedef unsigned u32x4 __attribute__((ext_vector_type(4)));
__device__ __forceinline__ unsigned pk_bf16(float a, float b) { f32x2 v = {a, b}; bf16v2 r = __builtin_convertvector(v, bf16v2); return __builtin_bit_cast(unsigned, r); }

constexpr size_t WS_WIN  = WS_END;
constexpr size_t WS_WO   = WS_WIN + (size_t)kD * kNPROJ * 2;
constexpr size_t WS_WPL  = WS_WO + (size_t)kD * kD * 2;
constexpr size_t WS_WE1  = WS_WPL + (size_t)4 * kPG * kPG * 2;
constexpr size_t WS_WE2  = WS_WE1 + (size_t)kE * kD * 2 * kDFF * 2;
constexpr size_t WS_END2 = WS_WE2 + (size_t)kE * kDFF * kD * 2;

namespace fg {
constexpr int BM = 256, BK = 64, HALF = 128, HTB = 16384, STAGE_BYTES = 131072, NXCD = 8, WGM = 8;
constexpr int TAB_OFF = STAGE_BYTES;
constexpr int MISC_OFF = STAGE_BYTES + 2048;
constexpr int LDS_BYTES = STAGE_BYTES + 4096;
__device__ __forceinline__ int lds_byte(int r, int c) { const int st = (r >> 4) * 2 + (c >> 5), rr = r & 15, cc = c & 31, ob = rr * 64 + cc * 2; return st * 1024 + (ob ^ (((ob >> 9) & 1) << 5)); }
__device__ __forceinline__ void stage_rc(int b, int& R, int& C) { const int st = b / 1024, sb = b % 1024, swz = sb ^ (((sb >> 9) & 1) << 5); R = (st >> 1) * 16 + swz / 64; C = (st & 1) * 32 + (swz % 64) / 2; }

struct Unit { const char* bBase; int arow0; int nvalid; int e; int orow0; int ocol0; int acol2; };

struct StaticOrder {
    int nM, nN, nwg, G, c;
    __device__ void init(int M, int N, int G_, int c_) { nM = M / BM; nN = N / BM; nwg = nM * nN; G = G_; c = c_; }
    __device__ bool next(int i, int& pm, int& pn) const {
        const long L = (long)i * G + c; if (L >= nwg) return false;
        int wgid = (int)L; { const int q = nwg / NXCD, r = nwg % NXCD, xcd = wgid % NXCD, off = wgid / NXCD; wgid = (xcd < r ? xcd * (q + 1) : r * (q + 1) + (xcd - r) * q) + off; }
        const int nig = WGM * nN, gid = wgid / nig, fm = gid * WGM, gsz = (nM - fm) < WGM ? (nM - fm) : WGM;
        pm = fm + ((wgid % nig) % gsz); pn = (wgid % nig) / gsz; return true;
    }
};

template <int OFF> __device__ __forceinline__ s16x4 tr_read(unsigned addr) { s16x4 r; asm volatile("ds_read_b64_tr_b16 %0, %1 offset:%2" : "=&v"(r) : "v"(addr), "i"(OFF) : "memory"); return r; }
template <class Job>
__device__ __forceinline__ void gemm_phase(LAS unsigned char* lds, const Job& J) {
    const int tid = threadIdx.x, wid = __builtin_amdgcn_readfirstlane(tid >> 6), lane = tid & 63, wr = wid >> 2, wc = wid & 3, fr = lane & 15, fq = lane >> 4;
    const int nt = J.K / BK;
    int RA[2], CA2[2]; unsigned voffB[2];
#pragma unroll
    for (int i = 0; i < 2; ++i) { int R, C; stage_rc(tid * 16 + i * 8192, R, C); RA[i] = R; CA2[i] = C * 2;
        const int b = tid * 16 + i * 8192, row = b >> 8, slot = (b >> 4) & 15, ch = slot ^ (((row & 3) << 2) | ((row >> 2) & 3)); voffB[i] = (unsigned)row * J.ldb2 + (unsigned)ch * 16u; }
    const size_t kstepB = (size_t)BK * J.ldb2;
    const unsigned ldsw = (unsigned)wid * 1024u;
    const int aoff = lds_byte(wr * 64 + fr, fq * 8);
    const int tq = (lane & 15) >> 2, tp = lane & 3;
    unsigned ba[2][2];
#pragma unroll
    for (int n = 0; n < 2; ++n)
#pragma unroll
        for (int t = 0; t < 2; ++t) ba[n][t] = (unsigned)(uintptr_t)lds + 256u * (8 * fq + 4 * t + tq) + 16u * ((4 * wc + 2 * n + (tp >> 1)) ^ ((tq << 2) | ((2 * fq + t) & 3))) + 8u * (tp & 1);
#define FG_SA(b, h) (65536 + ((b) * 2 + (h)) * HTB)
#define FG_SB(b, h) (((b) * 2 + (h)) * HTB)
#define FG_STAGE_A(bufoff, gk, vo) do { _Pragma("unroll") for (int _i = 0; _i < 2; ++_i) \
        __builtin_amdgcn_global_load_lds((const unsigned*)((gk) + (vo)[_i]), (LAS unsigned*)(lds + (bufoff) + ldsw + _i * 8192), 16, 0, 0); } while (0)
#define FG_STAGE_B(bufoff, gk) do { _Pragma("unroll") for (int _i = 0; _i < 2; ++_i) \
        __builtin_amdgcn_global_load_lds((const unsigned*)((gk) + voffB[_i]), (LAS unsigned*)(lds + (bufoff) + ldsw + _i * 8192), 16, 0, 0); } while (0)
#define FG_LDA(dst, b, h) do { _Pragma("unroll") for (int m = 0; m < 4; ++m) _Pragma("unroll") for (int k = 0; k < 2; ++k) dst[m][k] = *(const LAS bf16x8*)(lds + FG_SA(b, h) + aoff + m * 2048 + k * 1024); } while (0)
#define FG_LDB(dst, b, h) do { \
        dst##lo[0][0] = tr_read<FG_SB(b, h)>(ba[0][0]);        dst##hi[0][0] = tr_read<FG_SB(b, h)>(ba[0][1]); \
        dst##lo[0][1] = tr_read<FG_SB(b, h) + 8192>(ba[0][0]); dst##hi[0][1] = tr_read<FG_SB(b, h) + 8192>(ba[0][1]); \
        dst##lo[1][0] = tr_read<FG_SB(b, h)>(ba[1][0]);        dst##hi[1][0] = tr_read<FG_SB(b, h)>(ba[1][1]); \
        dst##lo[1][1] = tr_read<FG_SB(b, h) + 8192>(ba[1][0]); dst##hi[1][1] = tr_read<FG_SB(b, h) + 8192>(ba[1][1]); } while (0)
#define FG_PK(L, H) (bf16x8){L[0], L[1], L[2], L[3], H[0], H[1], H[2], H[3]}
#define FG_MMA(ai, bj, At, Bt) do { __builtin_amdgcn_s_setprio(1); _Pragma("unroll") for (int m = 0; m < 4; ++m) _Pragma("unroll") for (int n = 0; n < 2; ++n) _Pragma("unroll") for (int k = 0; k < 2; ++k) \
        acc[ai][bj][m][n] = __builtin_amdgcn_mfma_f32_16x16x32_bf16(FG_PK(Bt##lo[n][k], Bt##hi[n][k]), At[m][k], acc[ai][bj][m][n], 0, 0, 0); __builtin_amdgcn_s_setprio(0); } while (0)
#define FG_WAIT_V(n) asm volatile("s_waitcnt vmcnt(" #n ")" ::: "memory")
#define FG_WAIT_L(n) asm volatile("s_waitcnt lgkmcnt(" #n ")" ::: "memory")
#define FG_BAR __builtin_amdgcn_s_barrier()
#define FG_SCHED __builtin_amdgcn_sched_barrier(0)
#define FG_AOFF(dst, u, tabp) do { _Pragma("unroll") for (int _h = 0; _h < 2; ++_h) _Pragma("unroll") for (int _i = 0; _i < 2; ++_i) { const int _r = _h * 128 + RA[_i]; \
        if (Job::GATHER) { const int _tok = (tabp)[_r < (u).nvalid ? _r : 0]; dst[_h][_i] = (unsigned)_tok * J.lda2 + (unsigned)CA2[_i]; } \
        else dst[_h][_i] = (unsigned)((u).arow0 + _r) * J.lda2 + (unsigned)((u).acol2 + CA2[_i]); } } while (0)
    Unit cur, nxt; int ui = 0;
    if (!J.next(0, cur)) return;
    LAS const int* tab0 = (LAS const int*)(lds + TAB_OFF);
    if (Job::GATHER) {
        if (wid == 0) __builtin_amdgcn_global_load_lds((const unsigned*)(J.list + cur.arow0 + lane * 4), (LAS unsigned*)(lds + TAB_OFF), 16, 0, 0);
        FG_WAIT_V(0); __syncthreads();
    }
    f32x4 acc[2][2][4][2];
#pragma unroll
    for (int a = 0; a < 2; ++a)
#pragma unroll
        for (int b = 0; b < 2; ++b)
#pragma unroll
            for (int m = 0; m < 4; ++m)
#pragma unroll
                for (int n = 0; n < 2; ++n) acc[a][b][m][n] = (f32x4){0.f, 0.f, 0.f, 0.f};
    bf16x8 At[4][2]; s16x4 B0lo[2][2], B0hi[2][2], B1lo[2][2], B1hi[2][2];
    unsigned vc[2][2], vn[2][2];
    FG_AOFF(vc, cur, tab0);
    const char* const gA = J.A;
    const char* cB = cur.bBase;
    const unsigned bh2 = J.bhalf2;
    FG_STAGE_B(FG_SB(0, 0), cB); FG_STAGE_A(FG_SA(0, 0), gA, vc[0]); FG_STAGE_B(FG_SB(0, 1), cB + bh2); FG_STAGE_A(FG_SA(0, 1), gA, vc[1]);
    if (wr == 1) FG_BAR;
    FG_WAIT_V(4); FG_BAR;
    FG_STAGE_B(FG_SB(1, 0), cB + kstepB); FG_STAGE_A(FG_SA(1, 0), gA + 128, vc[0]); FG_STAGE_B(FG_SB(1, 1), cB + kstepB + bh2);
    FG_WAIT_V(6); FG_BAR;
    for (;;) {
        const bool has_next = J.next(ui + 1, nxt);
        if (!has_next) nxt = cur;
        if (Job::GATHER && has_next && wid == 0)
            __builtin_amdgcn_global_load_lds((const unsigned*)(J.list + nxt.arow0 + lane * 4), (LAS unsigned*)(lds + TAB_OFF + ((ui + 1) & 1) * 1024), 16, 0, 0);
        const char* nB = nxt.bBase;
        for (int t = 0; t < nt; t += 2) {
            const bool last = (t == nt - 2);
            const char* a1 = gA + (size_t)(t + 1) * 128;
            const char* a2 = last ? gA : gA + (size_t)(t + 2) * 128; const char* b2 = last ? nB : cB + (size_t)(t + 2) * kstepB;
            const char* a3 = a2 + 128; const char* b3 = b2 + kstepB;
            if (last) { if (has_next) { LAS const int* tabn = (LAS const int*)(lds + TAB_OFF + ((ui + 1) & 1) * 1024); FG_AOFF(vn, nxt, tabn); }
                        else { _Pragma("unroll") for (int _h = 0; _h < 2; ++_h) _Pragma("unroll") for (int _i = 0; _i < 2; ++_i) vn[_h][_i] = vc[_h][_i]; } }
            FG_LDB(B0, 0, 0); FG_SCHED; FG_LDA(At, 0, 0); FG_STAGE_A(FG_SA(1, 1), a1, vc[1]);
            if (last) { _Pragma("unroll") for (int _h = 0; _h < 2; ++_h) _Pragma("unroll") for (int _i = 0; _i < 2; ++_i) vc[_h][_i] = vn[_h][_i]; }
            FG_WAIT_L(8); FG_BAR; FG_WAIT_L(0); FG_SCHED; FG_MMA(0, 0, At, B0); FG_BAR; FG_SCHED;
            FG_LDB(B1, 0, 1); FG_STAGE_B(FG_SB(0, 0), b2);
            FG_BAR; FG_WAIT_L(0); FG_SCHED; FG_MMA(0, 1, At, B1); FG_BAR;
            FG_LDA(At, 0, 1); FG_STAGE_A(FG_SA(0, 0), a2, vc[0]);
            FG_BAR; FG_WAIT_L(0); FG_MMA(1, 0, At, B0); FG_BAR; FG_SCHED;
            FG_STAGE_B(FG_SB(0, 1), b2 + bh2);
            FG_WAIT_V(6); FG_BAR; FG_MMA(1, 1, At, B1); FG_BAR;
            FG_LDB(B0, 1, 0); FG_SCHED; FG_LDA(At, 1, 0); FG_STAGE_A(FG_SA(0, 1), a2, vc[1]);
            FG_WAIT_L(8); FG_BAR; FG_WAIT_L(0); FG_SCHED; FG_MMA(0, 0, At, B0); FG_BAR; FG_SCHED;
            FG_LDB(B1, 1, 1); FG_STAGE_B(FG_SB(1, 0), b3);
            FG_BAR; FG_WAIT_L(0); FG_SCHED; FG_MMA(0, 1, At, B1); FG_BAR;
            FG_LDA(At, 1, 1); FG_STAGE_A(FG_SA(1, 0), a3, vc[0]);
            FG_BAR; FG_WAIT_L(0); FG_MMA(1, 0, At, B0); FG_BAR; FG_SCHED;
            FG_STAGE_B(FG_SB(1, 1), b3 + bh2);
            FG_WAIT_V(6); FG_BAR; FG_MMA(1, 1, At, B1); FG_BAR;
        }
        J.epi(acc, cur, wr, wc, fr, fq);
        if (!has_next) break;
#pragma unroll
        for (int a = 0; a < 2; ++a)
#pragma unroll
            for (int b = 0; b < 2; ++b)
#pragma unroll
                for (int m = 0; m < 4; ++m)
#pragma unroll
                    for (int n = 0; n < 2; ++n) acc[a][b][m][n] = (f32x4){0.f, 0.f, 0.f, 0.f};
        cur = nxt; cB = nB; ++ui;
    }
    FG_WAIT_V(0);
    if (wr == 0) FG_BAR;
    FG_BAR;
}
}

#define FG_FOR_ROWS for (int ai = 0; ai < 2; ++ai) _Pragma("unroll") for (int m = 0; m < 4; ++m)
struct JobInProj {
    static constexpr bool GATHER = false;
    const char* A; unsigned lda2, ldb2, bhalf2; int K; const int* list;
    const char* B; bf16_t* out; fg::StaticOrder S;
    __device__ __forceinline__ bool next(int i, fg::Unit& u) const { int pm, pn; if (!S.next(i, pm, pn)) return false;
        u.bBase = B + (size_t)pn * 512; u.arow0 = pm * 256; u.nvalid = 256; u.e = 0; u.orow0 = pm * 256; u.ocol0 = pn * 256; u.acol2 = 0; return true; }
    __device__ __forceinline__ void epi(const f32x4 (&acc)[2][2][4][2], const fg::Unit& u, int wr, int wc, int fr, int fq) const {
#pragma unroll
        FG_FOR_ROWS { bf16_t* rowp = out + (size_t)(u.orow0 + ai * 128 + wr * 64 + m * 16 + fr) * kNPROJ + u.ocol0 + wc * 32 + fq * 4;
#pragma unroll
            for (int bj = 0; bj < 2; ++bj)
#pragma unroll
                for (int n = 0; n < 2; ++n) { const f32x4 v = acc[ai][bj][m][n]; u32x2 w; w.x = pk_bf16(v[0], v[1]); w.y = pk_bf16(v[2], v[3]); *(u32x2*)(rowp + bj * 128 + n * 16) = w; } }
    }
};
struct JobPool {
    static constexpr bool GATHER = false;
    const char* A; unsigned lda2, ldb2, bhalf2; int K; const int* list;
    const char* B; bf16_t* cat; int G, c;
    __device__ __forceinline__ bool next(int i, fg::Unit& u) const { const int L = i * G + c; if (L >= 128) return false; const int g = L >> 5, pm = L & 31;
        u.bBase = B + (size_t)g * kPG * kPG * 2; u.arow0 = pm * 256; u.nvalid = 256; u.e = g; u.orow0 = pm * 256; u.ocol0 = kSB + g * kPG; u.acol2 = g * kPG * 2; return true; }
    __device__ __forceinline__ void epi(const f32x4 (&acc)[2][2][4][2], const fg::Unit& u, int wr, int wc, int fr, int fq) const {
#pragma unroll
        FG_FOR_ROWS { bf16_t* rowp = cat + (size_t)(u.orow0 + ai * 128 + wr * 64 + m * 16 + fr) * kD + u.ocol0 + wc * 32 + fq * 4;
#pragma unroll
            for (int bj = 0; bj < 2; ++bj)
#pragma unroll
                for (int n = 0; n < 2; ++n) { const f32x4 v = acc[ai][bj][m][n]; u32x2 w; w.x = pk_bf16(v[0], v[1]); w.y = pk_bf16(v[2], v[3]); *(u32x2*)(rowp + bj * 128 + n * 16) = w; } }
    }
};
struct JobOutProj {
    static constexpr bool GATHER = false;
    const char* A; unsigned lda2, ldb2, bhalf2; int K; const int* list;
    const char* B; const float* x; const float* mod; float* x1; fg::StaticOrder S;
    __device__ __forceinline__ bool next(int i, fg::Unit& u) const { int pm, pn; if (!S.next(i, pm, pn)) return false;
        u.bBase = B + (size_t)pn * 512; u.arow0 = pm * 256; u.nvalid = 256; u.e = 0; u.orow0 = pm * 256; u.ocol0 = pn * 256; u.acol2 = 0; return true; }
    __device__ __forceinline__ void epi(const f32x4 (&acc)[2][2][4][2], const fg::Unit& u, int wr, int wc, int fr, int fq) const {
        const int b = u.orow0 / kS; f32x4 gt[2][2];
#pragma unroll
        for (int bj = 0; bj < 2; ++bj)
#pragma unroll
            for (int n = 0; n < 2; ++n) gt[bj][n] = *(const f32x4*)(mod + b * 6 * kD + 2 * kD + u.ocol0 + bj * 128 + wc * 32 + n * 16 + fq * 4);
#pragma unroll
        FG_FOR_ROWS { const size_t ro = (size_t)(u.orow0 + ai * 128 + wr * 64 + m * 16 + fr) * kD + u.ocol0 + wc * 32 + fq * 4;
#pragma unroll
            for (int bj = 0; bj < 2; ++bj)
#pragma unroll
                for (int n = 0; n < 2; ++n) { const f32x4 xv = *(const f32x4*)(x + ro + bj * 128 + n * 16); *(f32x4*)(x1 + ro + bj * 128 + n * 16) = xv + gt[bj][n] * acc[ai][bj][m][n]; } }
    }
};
struct MoeTab { LAS const int* t; int total;
    __device__ __forceinline__ bool decode(int i, int G, int c, int& e, int& jcol, int& rb, int& cnt, int& rowbase) const {
        const int L = (G % 8 == 0) ? i * G + (c % 8) * (G / 8) + c / 8 : i * G + c; if (L >= total) return false;
        int ee = 0; while (ee < kE - 1 && t[64 + ee + 1] <= L) ++ee;
        const int local = L - t[64 + ee], nrb = t[100 + ee]; jcol = local / nrb; rb = local - jcol * nrb; e = ee; cnt = t[ee]; rowbase = t[32 + ee]; return true; }
};
__device__ __forceinline__ MoeTab moe_tables(LAS unsigned char* lds, const unsigned* ctrl, int ncol) {
    LAS int* t = (LAS int*)(lds + fg::MISC_OFF + 64);
    __syncthreads();
    if (threadIdx.x == 0) { int base = 0, us = 0; for (int e = 0; e < kE; ++e) { const int cn = (int)ctrl[CT_CNT + e], nrb = (cn + 255) >> 8; t[e] = cn; t[32 + e] = base; t[64 + e] = us; t[100 + e] = nrb; base += nrb * 256; us += nrb * ncol; } t[64 + kE] = us; }
    __syncthreads();
    MoeTab M; M.t = t; M.total = t[64 + kE]; return M;
}
struct JobMoe1 {
    static constexpr bool GATHER = true;
    const char* A; unsigned lda2, ldb2, bhalf2; int K; const int* list;
    const char* B; const float* b_in; bf16_t* act; MoeTab M; int G, c;
    __device__ __forceinline__ bool next(int i, fg::Unit& u) const { int e, j, rb, cnt, rowbase; if (!M.decode(i, G, c, e, j, rb, cnt, rowbase)) return false;
        e = __builtin_amdgcn_readfirstlane(e); j = __builtin_amdgcn_readfirstlane(j); rb = __builtin_amdgcn_readfirstlane(rb); cnt = __builtin_amdgcn_readfirstlane(cnt); rowbase = __builtin_amdgcn_readfirstlane(rowbase);
        u.bBase = B + (size_t)e * ((size_t)kD * 2 * kDFF * 2) + (size_t)j * 256; u.arow0 = e * kT + rb * 256; u.nvalid = min(256, cnt - rb * 256); u.e = e; u.orow0 = rowbase + rb * 256; u.ocol0 = j * 128; u.acol2 = 0; return true; }
    __device__ __forceinline__ void epi(const f32x4 (&acc)[2][2][4][2], const fg::Unit& u, int wr, int wc, int fr, int fq) const {
        f32x4 bg[2], bl[2];
#pragma unroll
        for (int n = 0; n < 2; ++n) { const float* bp = b_in + (size_t)u.e * 2 * kDFF + u.ocol0 + wc * 32 + n * 16 + fq * 4; bg[n] = *(const f32x4*)bp; bl[n] = *(const f32x4*)(bp + kDFF); }
#pragma unroll
        FG_FOR_ROWS { bf16_t* rowp = act + (size_t)(u.orow0 + ai * 128 + wr * 64 + m * 16 + fr) * kDFF + u.ocol0 + wc * 32 + fq * 4;
#pragma unroll
            for (int n = 0; n < 2; ++n) { const f32x4 gv = acc[ai][0][m][n] + bg[n], lv = acc[ai][1][m][n] + bl[n]; float o[4];
#pragma unroll
                for (int j = 0; j < 4; ++j) { const float g = fminf(gv[j], 7.f), l = fminf(fmaxf(lv[j], -7.f), 7.f); o[j] = g * __builtin_amdgcn_rcpf(1.f + __expf(-1.702f * g)) * (l + 1.f); }
                u32x2 w; w.x = pk_bf16(o[0], o[1]); w.y = pk_bf16(o[2], o[3]); *(u32x2*)(rowp + n * 16) = w; } }
    }
};
struct JobMoe2 {
    static constexpr bool GATHER = false;
    const char* A; unsigned lda2, ldb2, bhalf2; int K; const int* list;
    const char* B; const float* b_out; bf16_t* yp; MoeTab M; int G, c;
    __device__ __forceinline__ bool next(int i, fg::Unit& u) const { int e, j, rb, cnt, rowbase; if (!M.decode(i, G, c, e, j, rb, cnt, rowbase)) return false;
        e = __builtin_amdgcn_readfirstlane(e); j = __builtin_amdgcn_readfirstlane(j); rb = __builtin_amdgcn_readfirstlane(rb); rowbase = __builtin_amdgcn_readfirstlane(rowbase);
        u.bBase = B + (size_t)e * ((size_t)kDFF * kD * 2) + (size_t)j * 512; u.arow0 = rowbase + rb * 256; u.nvalid = 256; u.e = e; u.orow0 = rowbase + rb * 256; u.ocol0 = j * 256; u.acol2 = 0; return true; }
    __device__ __forceinline__ void epi(const f32x4 (&acc)[2][2][4][2], const fg::Unit& u, int wr, int wc, int fr, int fq) const {
        f32x4 bo[2][2];
#pragma unroll
        for (int bj = 0; bj < 2; ++bj)
#pragma unroll
            for (int n = 0; n < 2; ++n) bo[bj][n] = *(const f32x4*)(b_out + (size_t)u.e * kD + u.ocol0 + bj * 128 + wc * 32 + n * 16 + fq * 4);
#pragma unroll
        FG_FOR_ROWS { bf16_t* rowp = yp + (size_t)(u.orow0 + ai * 128 + wr * 64 + m * 16 + fr) * kD + u.ocol0 + wc * 32 + fq * 4;
#pragma unroll
            for (int bj = 0; bj < 2; ++bj)
#pragma unroll
                for (int n = 0; n < 2; ++n) { const f32x4 v = acc[ai][bj][m][n] + bo[bj][n]; u32x2 w; w.x = pk_bf16(v[0], v[1]); w.y = pk_bf16(v[2], v[3]); *(u32x2*)(rowp + bj * 128 + n * 16) = w; } }
    }
};

__device__ __forceinline__ void convert_seg(const float* __restrict__ src, bf16_t* __restrict__ dst, size_t n8, size_t gtid, size_t gstride) {
    const f32x4* s4 = (const f32x4*)src; u32x4* d4 = (u32x4*)dst;
#pragma unroll 4
    for (size_t i = gtid; i < n8; i += gstride) { const f32x4 a = __builtin_nontemporal_load(s4 + 2 * i), b = __builtin_nontemporal_load(s4 + 2 * i + 1);
        u32x4 w; w.x = pk_bf16(a[0], a[1]); w.y = pk_bf16(a[2], a[3]); w.z = pk_bf16(b[0], b[1]); w.w = pk_bf16(b[2], b[3]); d4[i] = w; }
}

struct MegaArgs { const float* in[18]; float* out; unsigned char* ws; int ph_lo, ph_hi; };
__global__ void __launch_bounds__(512, 2) mega(MegaArgs a) {
    extern __shared__ __attribute__((aligned(16))) unsigned char lds_raw[];
    LAS unsigned char* lds = (LAS unsigned char*)lds_raw;
    unsigned char* ws = a.ws;
    const int lo = a.ph_lo, hi = a.ph_hi;
#define IN(k) (lo <= (k) && (k) < hi)
    const int G = gridDim.x, c = blockIdx.x;
    if (IN(0)) {
        const size_t gtid = (size_t)blockIdx.x * 512 + threadIdx.x, gstride = (size_t)G * 512;
        convert_seg(a.in[6], (bf16_t*)(ws + WS_WIN), (size_t)kD * kNPROJ / 8, gtid, gstride);
        convert_seg(a.in[11], (bf16_t*)(ws + WS_WO), (size_t)kD * kD / 8, gtid, gstride);
        { const f32x4* s4 = (const f32x4*)a.in[9]; const f32x4* sc4 = (const f32x4*)a.in[10]; u32x4* d4 = (u32x4*)(ws + WS_WPL);
          for (size_t i = gtid; i < (size_t)4 * kPG * kPG / 8; i += gstride) { const int g = (int)(i >> 13), n8 = (int)(i & 31);
              const f32x4 sa = sc4[g * 64 + n8 * 2], sb = sc4[g * 64 + n8 * 2 + 1]; const f32x4 a0 = s4[2 * i] * sa, b0 = s4[2 * i + 1] * sb;
              u32x4 w; w.x = pk_bf16(a0[0], a0[1]); w.y = pk_bf16(a0[2], a0[3]); w.z = pk_bf16(b0[0], b0[1]); w.w = pk_bf16(b0[2], b0[3]); d4[i] = w; } }
        convert_seg(a.in[14], (bf16_t*)(ws + WS_WE1), (size_t)kE * kD * 2 * kDFF / 8, gtid, gstride);
        convert_seg(a.in[16], (bf16_t*)(ws + WS_WE2), (size_t)kE * kDFF * kD / 8, gtid, gstride);
    }
    if (IN(1)) { JobInProj J; J.A = (const char*)(ws + WS_H); J.lda2 = kD * 2; J.ldb2 = kNPROJ * 2; J.bhalf2 = 256; J.K = kD; J.list = nullptr;
        J.B = (const char*)(ws + WS_WIN); J.out = (bf16_t*)(ws + WS_PROJ); J.S.init(kT, kNPROJ, G, c); fg::gemm_phase(lds, J); }
    if (IN(2)) { JobPool J; J.A = (const char*)(ws + WS_P); J.lda2 = kPW * 2; J.ldb2 = kPG * 2; J.bhalf2 = 256; J.K = kPG; J.list = nullptr;
        J.B = (const char*)(ws + WS_WPL); J.cat = (bf16_t*)(ws + WS_CAT); J.G = G; J.c = c; fg::gemm_phase(lds, J); }
    if (IN(3)) { JobOutProj J; J.A = (const char*)(ws + WS_CAT); J.lda2 = kD * 2; J.ldb2 = kD * 2; J.bhalf2 = 256; J.K = kD; J.list = nullptr;
        J.B = (const char*)(ws + WS_WO); J.x = a.in[0]; J.mod = (const float*)(ws + WS_MOD); J.x1 = (float*)(ws + WS_X1); J.S.init(kT, kD, G, c); fg::gemm_phase(lds, J); }
    if (IN(4)) { JobMoe1 J; J.A = (const char*)(ws + WS_H2); J.lda2 = kD * 2; J.ldb2 = 2 * kDFF * 2; J.bhalf2 = kDFF * 2; J.K = kD; J.list = (const int*)(ws + WS_LIST);
        J.B = (const char*)(ws + WS_WE1); J.b_in = a.in[15]; J.act = (bf16_t*)(ws + WS_ACT); J.M = moe_tables(lds, (const unsigned*)(ws + WS_CTRL), kDFF / 128); J.G = G; J.c = c; fg::gemm_phase(lds, J); }
    if (IN(5)) { JobMoe2 J; J.A = (const char*)(ws + WS_ACT); J.lda2 = kDFF * 2; J.ldb2 = kD * 2; J.bhalf2 = 256; J.K = kDFF; J.list = nullptr;
        J.B = (const char*)(ws + WS_WE2); J.b_out = a.in[17]; J.yp = (bf16_t*)(ws + WS_YP); J.M = moe_tables(lds, (const unsigned*)(ws + WS_CTRL), kD / 256); J.G = G; J.c = c; fg::gemm_phase(lds, J); }
#undef IN
}

extern "C" void kernel_launch(void* const* d_in, const int* in_sizes, int n_in, void* d_out, int out_size, void* d_ws, size_t ws_size, hipStream_t stream) {
    const float* x = (const float*)d_in[0]; const float* c = (const float*)d_in[1]; const float* norm1_w = (const float*)d_in[2]; const float* norm2_w = (const float*)d_in[3];
    const float* w_ada = (const float*)d_in[4]; const float* b_ada = (const float*)d_in[5];
    const float* q_norm_w = (const float*)d_in[7]; const float* k_norm_w = (const float*)d_in[8];
    const float* w_router = (const float*)d_in[12]; const float* b_router = (const float*)d_in[13];
    float* out = (float*)d_out;
    char* ws = (char*)d_ws;
    unsigned* ctrl = (unsigned*)(ws + WS_CTRL); float* mod = (float*)(ws + WS_MOD); bf16_t* h = (bf16_t*)(ws + WS_H); bf16_t* proj = (bf16_t*)(ws + WS_PROJ);
    bf16_t* cat = (bf16_t*)(ws + WS_CAT); bf16_t* p = (bf16_t*)(ws + WS_P); float* x1 = (float*)(ws + WS_X1); bf16_t* h2 = (bf16_t*)(ws + WS_H2);
    float* gates = (float*)(ws + WS_GATES); int* pair_e = (int*)(ws + WS_PAIRE); int* pair_p = (int*)(ws + WS_PAIRP); int* list = (int*)(ws + WS_LIST);
    bf16_t* yp = (bf16_t*)(ws + WS_YP);
    static int inited = 0;
    if (!inited) { (void)hipFuncSetAttribute((const void*)mega, hipFuncAttributeMaxDynamicSharedMemorySize, fg::LDS_BYTES); inited = 1; }
    const int grid = 256;
    MegaArgs a{}; for (int i = 0; i < 18; ++i) a.in[i] = (const float*)d_in[i]; a.out = out; a.ws = (unsigned char*)d_ws;
#define MEGA(lo_, hi_) do { a.ph_lo = lo_; a.ph_hi = hi_; hipLaunchKernelGGL(mega, dim3(grid), dim3(512), fg::LDS_BYTES, stream, a); } while (0)
    (void)hipMemsetAsync(ctrl, 0, 65536, stream);
    k_ada<<<6 * kD / 256, 256, 0, stream>>>(c, w_ada, b_ada, mod);
    k_norm_mod<<<kT, 256, 0, stream>>>(x, norm1_w, mod, 0, kD, h);
    MEGA(0, 1);
    MEGA(1, 2);
    k_attn_naive<<<kB * kNH * kS / 4, 256, 0, stream>>>(proj, q_norm_w, k_norm_w, cat);
    k_pool_p<<<kT * kPW / 256, 256, 0, stream>>>(proj, p);
    MEGA(2, 3);
    MEGA(3, 4);
    k_norm2_router<<<kT, 256, 0, stream>>>(x1, norm2_w, mod, w_router, b_router, h2, gates, pair_e, pair_p, list, ctrl);
    k_moe_plan<<<1, 64, 0, stream>>>(ctrl);
    MEGA(4, 5);
    MEGA(5, 6);
    k_final<<<kT, 256, 0, stream>>>(x1, mod, gates, pair_e, pair_p, ctrl, yp, out);
}
```

```cpp
#include <hip/hip_runtime.h>
#include <stdint.h>

constexpr int kB = 4, kS = 2048, kD = 2048, kT = kB * kS;
constexpr int kHD = 128, kNH = 8, kSB = 1024, kPW = 1024, kPG = 256;
constexpr int kNPROJ = 4096, kE = 32, kTOPK = 4, kDFF = 2048;
constexpr float kEPS = 1e-6f;
constexpr int kMaxSlots = 160 * 256;

typedef unsigned short bf16_t;
__device__ __forceinline__ bf16_t f2bf(float f) { unsigned u = __float_as_uint(f); u += 0x7FFFu + ((u >> 16) & 1u); return (bf16_t)(u >> 16); }
__device__ __forceinline__ float bf2f(bf16_t b) { return __uint_as_float(((unsigned)b) << 16); }

constexpr size_t WS_CTRL   = 0;
constexpr size_t WS_MOD    = 65536;
constexpr size_t WS_H      = WS_MOD + (size_t)4 * 12288 * 4;
constexpr size_t WS_PROJ   = WS_H + (size_t)kT * kD * 2;
constexpr size_t WS_CAT    = WS_PROJ + (size_t)kT * kNPROJ * 2;
constexpr size_t WS_P      = WS_CAT + (size_t)kT * kD * 2;
constexpr size_t WS_X1     = WS_P + (size_t)kT * kPW * 2;
constexpr size_t WS_H2     = WS_X1 + (size_t)kT * kD * 4;
constexpr size_t WS_GATES  = WS_H2 + (size_t)kT * kD * 2;
constexpr size_t WS_PAIRE  = WS_GATES + (size_t)kT * 4 * 4;
constexpr size_t WS_PAIRP  = WS_PAIRE + (size_t)kT * 4 * 4;
constexpr size_t WS_LIST   = WS_PAIRP + (size_t)kT * 4 * 4;
constexpr size_t WS_ACT    = WS_LIST + (size_t)kE * kT * 4;
constexpr size_t WS_YP     = WS_ACT + (size_t)kMaxSlots * kDFF * 2;
constexpr size_t WS_END    = WS_YP + (size_t)kMaxSlots * kD * 2;
constexpr int CT_CNT = 4096;
constexpr int CT_ROWBASE = 4160;

__global__ void k_ada(const float* __restrict__ c, const float* __restrict__ w_ada, const float* __restrict__ b_ada, float* __restrict__ mod) {
    __shared__ float ca[kB][kD];
    for (int i = threadIdx.x; i < kB * kD; i += blockDim.x) { const float v = c[i]; ca[i / kD][i % kD] = v / (1.f + __expf(-v)); }
    __syncthreads();
    const int n = blockIdx.x * blockDim.x + threadIdx.x;
    float a0 = 0.f, a1 = 0.f, a2 = 0.f, a3 = 0.f;
    for (int k = 0; k < kD; ++k) { const float w = w_ada[(size_t)k * (6 * kD) + n]; a0 += ca[0][k] * w; a1 += ca[1][k] * w; a2 += ca[2][k] * w; a3 += ca[3][k] * w; }
    const float bb = b_ada[n];
    mod[0 * 6 * kD + n] = a0 + bb; mod[1 * 6 * kD + n] = a1 + bb; mod[2 * 6 * kD + n] = a2 + bb; mod[3 * 6 * kD + n] = a3 + bb;
}

__device__ __forceinline__ float block_sum_256(float v, float* red) {
    for (int o = 32; o > 0; o >>= 1) v += __shfl_down(v, o);
    const int w = threadIdx.x >> 6, l = threadIdx.x & 63;
    __syncthreads();
    if (l == 0) red[w] = v;
    __syncthreads();
    return red[0] + red[1] + red[2] + red[3];
}
__global__ void k_norm_mod(const float* __restrict__ x, const float* __restrict__ nw, const float* __restrict__ mod, int shift_off, int scale_off, bf16_t* __restrict__ out) {
    __shared__ float red[4];
    const int t = blockIdx.x, b = t / kS;
    const float* xr = x + (size_t)t * kD;
    float v[8]; float ss = 0.f;
    for (int i = 0; i < 8; ++i) { v[i] = xr[threadIdx.x + 256 * i]; ss += v[i] * v[i]; }
    ss = block_sum_256(ss, red);
    const float r = rsqrtf(ss / kD + kEPS);
    for (int i = 0; i < 8; ++i) { const int n = threadIdx.x + 256 * i;
        const float y = v[i] * r * nw[n] * (1.f + mod[b * 6 * kD + scale_off + n]) + mod[b * 6 * kD + shift_off + n];
        out[(size_t)t * kD + n] = f2bf(y); }
}

struct GemmArgs { const bf16_t* A; const float* B; int lda; int ldb; int K; int pad; };
template <class RowFn, class Epi>
__global__ void __launch_bounds__(256) k_gemm_naive(GemmArgs g, RowFn rowfn, Epi epi) {
    __shared__ float As[16][68], Bs[16][64];
    const int z = blockIdx.z;
    int mrows; const bf16_t* Abase; const float* Bbase;
    if (!rowfn.setup(z, g, mrows, Abase, Bbase)) return;
    const int m0 = blockIdx.y * 64, n0 = blockIdx.x * 64;
    if (m0 >= mrows) return;
    const int tid = threadIdx.x, ty = tid >> 4, tx = tid & 15;
    const int ar = tid >> 2, ak = (tid & 3) * 4;
    const int bk = tid >> 4, bn = (tid & 15) * 4;
    const long arow = rowfn.row(z, m0 + ar, mrows);
    const bf16_t* ap = Abase + arow * (long)g.lda + ak;
    const float* bp = Bbase + (size_t)bk * g.ldb + n0 + bn;
    float acc[4][4] = {};
    for (int k0 = 0; k0 < g.K; k0 += 16) {
        const uint2 av = *(const uint2*)(ap + k0);
        const float4 bv = *(const float4*)(bp + (size_t)k0 * g.ldb);
        __syncthreads();
        As[ak + 0][ar] = __uint_as_float(av.x << 16); As[ak + 1][ar] = __uint_as_float(av.x & 0xFFFF0000u);
        As[ak + 2][ar] = __uint_as_float(av.y << 16); As[ak + 3][ar] = __uint_as_float(av.y & 0xFFFF0000u);
        *(float4*)&Bs[bk][bn] = bv;
        __syncthreads();
#pragma unroll
        for (int k = 0; k < 16; ++k) {
            const float4 a4 = *(const float4*)&As[k][ty * 4]; const float4 b4 = *(const float4*)&Bs[k][tx * 4];
            const float a[4] = {a4.x, a4.y, a4.z, a4.w}, b[4] = {b4.x, b4.y, b4.z, b4.w};
#pragma unroll
            for (int i = 0; i < 4; ++i)
#pragma unroll
                for (int j = 0; j < 4; ++j) acc[i][j] += a[i] * b[j];
        }
    }
#pragma unroll
    for (int i = 0; i < 4; ++i)
#pragma unroll
        for (int j = 0; j < 4; ++j) epi(z, m0 + ty * 4 + i, n0 + tx * 4 + j, acc[i][j], mrows);
}
struct RowDense { int M;
    __device__ bool setup(int, const GemmArgs& g, int& mrows, const bf16_t*& A, const float*& B) const { mrows = M; A = g.A; B = g.B; return true; }
    __device__ long row(int, int r, int) const { return r; } };
struct EpiStoreBf16 { bf16_t* C; int ldc; int pad;
    __device__ void operator()(int, int r, int c, float v, int) const { C[(size_t)r * ldc + c] = f2bf(v); } };
struct EpiOutProj { const float* x; const float* mod; float* x1;
    __device__ void operator()(int, int r, int c, float v, int) const { const int b = r / kS; x1[(size_t)r * kD + c] = x[(size_t)r * kD + c] + mod[b * 6 * kD + 2 * kD + c] * v; } };
struct RowPool { int pad; __device__ bool setup(int z, const GemmArgs& g, int& mrows, const bf16_t*& A, const float*& B) const { mrows = kT; A = g.A + z * kPG; B = g.B + (size_t)z * kPG * kPG; return true; }
    __device__ long row(int, int r, int) const { return r; } };
struct EpiPool { const float* pool_scale; bf16_t* cat;
    __device__ void operator()(int z, int r, int c, float v, int) const { cat[(size_t)r * kD + kSB + z * kPG + c] = f2bf(v * pool_scale[z * kPG + c]); } };

__global__ void __launch_bounds__(256) k_attn_naive(const bf16_t* __restrict__ proj, const float* __restrict__ qw, const float* __restrict__ kw, bf16_t* __restrict__ cat) {
    __shared__ float qs[4][kHD];
    const int w = threadIdx.x >> 6, lane = threadIdx.x & 63;
    const int rowid = blockIdx.x * 4 + w;
    const int t = rowid % kS, bh = rowid / kS, h = bh % kNH, b = bh / kNH;
    const bf16_t* qrow = proj + (size_t)(b * kS + t) * kNPROJ + h * kHD;
    float q0 = bf2f(qrow[lane]), q1 = bf2f(qrow[lane + 64]);
    float ss = q0 * q0 + q1 * q1;
    for (int o = 32; o > 0; o >>= 1) ss += __shfl_xor(ss, o);
    const float rq = rsqrtf(ss / kHD + kEPS) * 0.08838834764831845f;
    qs[w][lane] = q0 * rq * qw[lane] * kw[lane]; qs[w][lane + 64] = q1 * rq * qw[lane + 64] * kw[lane + 64];
    __syncthreads();
    float o0 = 0.f, o1 = 0.f, carry = 0.f;
    for (int jb = ((t - 1) >> 6) << 6; jb >= 0 && t > 0; jb -= 64) {
        const int j = jb + lane; const bool valid = j < t;
        float z = 0.f, sp = 0.f;
        if (valid) {
            const bf16_t* krow = proj + (size_t)(b * kS + j) * kNPROJ + kSB + h * kHD;
            float dot = 0.f, kss = 0.f;
            for (int d = 0; d < kHD; d += 8) { const uint4 kv = *(const uint4*)(krow + d); const unsigned u[4] = {kv.x, kv.y, kv.z, kv.w};
#pragma unroll
                for (int e = 0; e < 4; ++e) { const float k0 = __uint_as_float(u[e] << 16), k1 = __uint_as_float(u[e] & 0xFFFF0000u);
                    dot += qs[w][d + 2 * e] * k0 + qs[w][d + 2 * e + 1] * k1; kss += k0 * k0 + k1 * k1; } }
            z = dot * rsqrtf(kss / kHD + kEPS);
            sp = (z > 15.f) ? z : log1pf(__expf(z));
        }
        float s = sp;
        for (int o = 1; o < 64; o <<= 1) { const float v = __shfl_down(s, o); if (lane + o < 64) s += v; }
        const float a = valid ? __expf(z - (carry + s)) : 0.f;
        carry += __shfl(s, 0);
        const int jmax = min(64, t - jb);
        const bf16_t* vb = proj + (size_t)(b * kS + jb) * kNPROJ + 2 * kSB + h * kHD;
        for (int l = 0; l < jmax; ++l) { const float al = __shfl(a, l); o0 += al * bf2f(vb[(size_t)l * kNPROJ + lane]); o1 += al * bf2f(vb[(size_t)l * kNPROJ + lane + 64]); }
    }
    bf16_t* orow = cat + (size_t)(b * kS + t) * kD + h * kHD;
    orow[lane] = f2bf(o0); orow[lane + 64] = f2bf(o1);
}

__global__ void k_pool_p(const bf16_t* __restrict__ proj, bf16_t* __restrict__ p) {
    const int idx = blockIdx.x * blockDim.x + threadIdx.x;
    const int c = idx & (kPW - 1), t = idx >> 10, s = t % kS, g = c >> 8;
    const int w = 2 << g;
    const int cnt = min(s + 1, w);
    float sum = 0.f;
    for (int i = 0; i < cnt; ++i) sum += bf2f(proj[(size_t)(t - i) * kNPROJ + 3 * kSB + c]);
    const float u = bf2f(proj[(size_t)t * kNPROJ + 3 * kSB + c]);
    p[(size_t)t * kPW + c] = f2bf(sum / (float)cnt - u);
}

__global__ void __launch_bounds__(256) k_norm2_router(const float* __restrict__ x1, const float* __restrict__ nw, const float* __restrict__ mod,
                               const float* __restrict__ w_router, const float* __restrict__ b_router, bf16_t* __restrict__ h2,
                               float* __restrict__ gates, int* __restrict__ pair_e, int* __restrict__ pair_p, int* __restrict__ list, unsigned* __restrict__ ctrl) {
    __shared__ float red[4]; __shared__ float lg[4][kE];
    const int t = blockIdx.x, b = t / kS;
    const float* xr = x1 + (size_t)t * kD;
    float v[8]; float ss = 0.f;
    for (int i = 0; i < 8; ++i) { v[i] = xr[threadIdx.x + 256 * i]; ss += v[i] * v[i]; }
    ss = block_sum_256(ss, red);
    const float r = rsqrtf(ss / kD + kEPS);
    float part[kE];
#pragma unroll
    for (int e = 0; e < kE; ++e) part[e] = 0.f;
    for (int i = 0; i < 8; ++i) { const int n = threadIdx.x + 256 * i;
        const float y = v[i] * r * nw[n] * (1.f + mod[b * 6 * kD + 4 * kD + n]) + mod[b * 6 * kD + 3 * kD + n];
        h2[(size_t)t * kD + n] = f2bf(y);
        const float4* wr = (const float4*)(w_router + (size_t)n * kE);
#pragma unroll
        for (int e4 = 0; e4 < 8; ++e4) { const float4 w4 = wr[e4]; part[e4 * 4] += y * w4.x; part[e4 * 4 + 1] += y * w4.y; part[e4 * 4 + 2] += y * w4.z; part[e4 * 4 + 3] += y * w4.w; } }
    const int wv = threadIdx.x >> 6, l = threadIdx.x & 63;
#pragma unroll
    for (int e = 0; e < kE; ++e) { float s = part[e]; for (int o = 32; o > 0; o >>= 1) s += __shfl_down(s, o); if (l == 0) lg[wv][e] = s; }
    __syncthreads();
    if (threadIdx.x < 64) {
        const int e = l & 31;
        float mine = lg[0][e] + lg[1][e] + lg[2][e] + lg[3][e] + b_router[e];
        if (l >= 32) mine = -3.4e38f;
        int idx[4]; float val[4];
#pragma unroll
        for (int k = 0; k < 4; ++k) {
            float bv = mine; int bi = l;
            for (int o = 32; o > 0; o >>= 1) { const float ov = __shfl_xor(bv, o); const int oi = __shfl_xor(bi, o); if (ov > bv || (ov == bv && oi < bi)) { bv = ov; bi = oi; } }
            idx[k] = bi; val[k] = bv; if (l == bi) mine = -3.4e38f;
        }
        if (l == 0) {
            float ex[4], sum = 0.f;
#pragma unroll
            for (int k = 0; k < 4; ++k) { ex[k] = __expf(val[k] - val[0]); sum += ex[k]; }
#pragma unroll
            for (int k = 0; k < 4; ++k) { gates[t * 4 + k] = ex[k] / sum; pair_e[t * 4 + k] = idx[k];
                const unsigned pos = atomicAdd(&ctrl[CT_CNT + idx[k]], 1u); pair_p[t * 4 + k] = (int)pos; list[(size_t)idx[k] * kT + pos] = t; }
        }
    }
}
__global__ void k_moe_plan(unsigned* ctrl) {
    if (threadIdx.x == 0) { unsigned base = 0; for (int e = 0; e < kE; ++e) { ctrl[CT_ROWBASE + e] = base; base += ((ctrl[CT_CNT + e] + 255u) / 256u) * 256u; } ctrl[CT_ROWBASE + kE] = base; }
}

__global__ void __launch_bounds__(256) k_moe1_naive(const bf16_t* __restrict__ h2, const float* __restrict__ w_in, const float* __restrict__ b_in, const int* __restrict__ list,
                                                    const unsigned* __restrict__ ctrl, bf16_t* __restrict__ act) {
    __shared__ float As[16][68], Bg[16][64], Bl[16][64];
    const int e = blockIdx.z; const int mrows = (int)ctrl[CT_CNT + e];
    const int m0 = blockIdx.y * 64, n0 = blockIdx.x * 64;
    if (m0 >= mrows) return;
    const int rowbase = (int)ctrl[CT_ROWBASE + e];
    const int tid = threadIdx.x, ty = tid >> 4, tx = tid & 15;
    const int ar = tid >> 2, ak = (tid & 3) * 4, bk = tid >> 4, bn = (tid & 15) * 4;
    const int tok = list[(size_t)e * kT + min(m0 + ar, mrows - 1)];
    const bf16_t* ap = h2 + (size_t)tok * kD + ak;
    const float* bp = w_in + (size_t)e * kD * 2 * kDFF + (size_t)bk * (2 * kDFF) + n0 + bn;
    float ag[4][4] = {}, al[4][4] = {};
    for (int k0 = 0; k0 < kD; k0 += 16) {
        const uint2 av = *(const uint2*)(ap + k0);
        const float4 g4 = *(const float4*)(bp + (size_t)k0 * (2 * kDFF)); const float4 l4 = *(const float4*)(bp + (size_t)k0 * (2 * kDFF) + kDFF);
        __syncthreads();
        As[ak + 0][ar] = __uint_as_float(av.x << 16); As[ak + 1][ar] = __uint_as_float(av.x & 0xFFFF0000u);
        As[ak + 2][ar] = __uint_as_float(av.y << 16); As[ak + 3][ar] = __uint_as_float(av.y & 0xFFFF0000u);
        *(float4*)&Bg[bk][bn] = g4; *(float4*)&Bl[bk][bn] = l4;
        __syncthreads();
#pragma unroll
        for (int k = 0; k < 16; ++k) {
            const float4 a4 = *(const float4*)&As[k][ty * 4]; const float4 g44 = *(const float4*)&Bg[k][tx * 4]; const float4 l44 = *(const float4*)&Bl[k][tx * 4];
            const float a[4] = {a4.x, a4.y, a4.z, a4.w}, gg[4] = {g44.x, g44.y, g44.z, g44.w}, ll[4] = {l44.x, l44.y, l44.z, l44.w};
#pragma unroll
            for (int i = 0; i < 4; ++i)
#pragma unroll
                for (int j = 0; j < 4; ++j) { ag[i][j] += a[i] * gg[j]; al[i][j] += a[i] * ll[j]; }
        }
    }
    for (int i = 0; i < 4; ++i) { const int r = m0 + ty * 4 + i; if (r >= mrows) continue;
        for (int j = 0; j < 4; ++j) { const int c = n0 + tx * 4 + j;
            float gv = ag[i][j] + b_in[(size_t)e * 2 * kDFF + c], lv = al[i][j] + b_in[(size_t)e * 2 * kDFF + kDFF + c];
            gv = fminf(gv, 7.f); lv = fminf(fmaxf(lv, -7.f), 7.f);
            const float a = gv / (1.f + __expf(-1.702f * gv)) * (lv + 1.f);
            act[(size_t)(rowbase + r) * kDFF + c] = f2bf(a); } }
}
struct RowMoe2 { const unsigned* ctrl; const float* w;
    __device__ bool setup(int z, const GemmArgs& g, int& mrows, const bf16_t*& A, const float*& B) const { mrows = (int)ctrl[CT_CNT + z]; A = g.A + (size_t)ctrl[CT_ROWBASE + z] * kDFF; B = w + (size_t)z * kDFF * kD; return mrows > 0; }
    __device__ long row(int, int r, int mrows) const { return r < mrows ? r : mrows - 1; } };
struct EpiMoe2 { const unsigned* ctrl; const float* b_out; bf16_t* yp;
    __device__ void operator()(int z, int r, int c, float v, int mrows) const { if (r < mrows) yp[(size_t)(ctrl[CT_ROWBASE + z] + r) * kD + c] = f2bf(v + b_out[(size_t)z * kD + c]); } };

__global__ void k_final(const float* __restrict__ x1, const float* __restrict__ mod, const float* __restrict__ gates, const int* __restrict__ pair_e, const int* __restrict__ pair_p,
                        const unsigned* __restrict__ ctrl, const bf16_t* __restrict__ yp, float* __restrict__ out) {
    const int t = blockIdx.x, b = t / kS;
    float gk[4]; size_t rows[4];
#pragma unroll
    for (int k = 0; k < 4; ++k) { gk[k] = gates[t * 4 + k]; rows[k] = (size_t)(ctrl[CT_ROWBASE + pair_e[t * 4 + k]] + (unsigned)pair_p[t * 4 + k]); }
    for (int n = threadIdx.x; n < kD; n += blockDim.x) {
        float y = 0.f;
#pragma unroll
        for (int k = 0; k < 4; ++k) y += gk[k] * bf2f(yp[rows[k] * kD + n]);
        out[(size_t)t * kD + n] = x1[(size_t)t * kD + n] + mod[b * 6 * kD + 5 * kD + n] * y;
    }
}


#define LAS __attribute__((address_space(3)))
typedef short bf16x8 __attribute__((ext_vector_type(8)));
typedef short s16x4 __attribute__((ext_vector_type(4)));
typedef float f32x4 __attribute__((ext_vector_type(4)));
typedef float f32x2 __attribute__((ext_vector_type(2)));
typedef __bf16 bf16v2 __attribute__((ext_vector_type(2)));
typedef unsigned u32x2 __attribute__((ext_vector_type(2)));
typedef unsigned u32x4 __attribute__((ext_vector_type(4)));
__device__ __forceinline__ unsigned pk_bf16(float a, float b) { f32x2 v = {a, b}; bf16v2 r = __builtin_convertvector(v, bf16v2); return __builtin_bit_cast(unsigned, r); }

constexpr size_t WS_WIN  = WS_END;
constexpr size_t WS_WO   = WS_WIN + (size_t)kD * kNPROJ * 2;
constexpr size_t WS_WPL  = WS_WO + (size_t)kD * kD * 2;
constexpr size_t WS_WE1  = WS_WPL + (size_t)4 * kPG * kPG * 2;
constexpr size_t WS_WE2  = WS_WE1 + (size_t)kE * kD * 2 * kDFF * 2;
constexpr size_t WS_END2 = WS_WE2 + (size_t)kE * kDFF * kD * 2;

namespace fg {
constexpr int BM = 256, BK = 64, HALF = 128, HTB = 16384, STAGE_BYTES = 131072, NXCD = 8, WGM = 8;
constexpr int TAB_OFF = STAGE_BYTES;
constexpr int MISC_OFF = STAGE_BYTES + 2048;
constexpr int LDS_BYTES = STAGE_BYTES + 4096;
__device__ __forceinline__ int lds_byte(int r, int c) { const int st = (r >> 4) * 2 + (c >> 5), rr = r & 15, cc = c & 31, ob = rr * 64 + cc * 2; return st * 1024 + (ob ^ (((ob >> 9) & 1) << 5)); }
__device__ __forceinline__ void stage_rc(int b, int& R, int& C) { const int st = b / 1024, sb = b % 1024, swz = sb ^ (((sb >> 9) & 1) << 5); R = (st >> 1) * 16 + swz / 64; C = (st & 1) * 32 + (swz % 64) / 2; }

struct Unit { const char* bBase; int arow0; int nvalid; int e; int orow0; int ocol0; int acol2; };

struct StaticOrder {
    int nM, nN, nwg, G, c;
    __device__ void init(int M, int N, int G_, int c_) { nM = M / BM; nN = N / BM; nwg = nM * nN; G = G_; c = c_; }
    __device__ bool next(int i, int& pm, int& pn) const {
        const long L = (long)i * G + c; if (L >= nwg) return false;
        int wgid = (int)L; { const int q = nwg / NXCD, r = nwg % NXCD, xcd = wgid % NXCD, off = wgid / NXCD; wgid = (xcd < r ? xcd * (q + 1) : r * (q + 1) + (xcd - r) * q) + off; }
        const int nig = WGM * nN, gid = wgid / nig, fm = gid * WGM, gsz = (nM - fm) < WGM ? (nM - fm) : WGM;
        pm = fm + ((wgid % nig) % gsz); pn = (wgid % nig) / gsz; return true;
    }
};

template <int OFF> __device__ __forceinline__ s16x4 tr_read(unsigned addr) { s16x4 r; asm volatile("ds_read_b64_tr_b16 %0, %1 offset:%2" : "=&v"(r) : "v"(addr), "i"(OFF) : "memory"); return r; }
template <class Job>
__device__ __forceinline__ void gemm_phase(LAS unsigned char* lds, const Job& J) {
    const int tid = threadIdx.x, wid = __builtin_amdgcn_readfirstlane(tid >> 6), lane = tid & 63, wr = wid >> 2, wc = wid & 3, fr = lane & 15, fq = lane >> 4;
    const int nt = J.K / BK;
    int RA[2], CA2[2]; unsigned voffB[2];
#pragma unroll
    for (int i = 0; i < 2; ++i) { int R, C; stage_rc(tid * 16 + i * 8192, R, C); RA[i] = R; CA2[i] = C * 2;
        const int b = tid * 16 + i * 8192, row = b >> 8, slot = (b >> 4) & 15, ch = slot ^ (((row & 3) << 2) | ((row >> 2) & 3)); voffB[i] = (unsigned)row * J.ldb2 + (unsigned)ch * 16u; }
    const size_t kstepB = (size_t)BK * J.ldb2;
    const unsigned ldsw = (unsigned)wid * 1024u;
    const int aoff = lds_byte(wr * 64 + fr, fq * 8);
    const int tq = (lane & 15) >> 2, tp = lane & 3;
    unsigned ba[2][2];
#pragma unroll
    for (int n = 0; n < 2; ++n)
#pragma unroll
        for (int t = 0; t < 2; ++t) ba[n][t] = (unsigned)(uintptr_t)lds + 256u * (8 * fq + 4 * t + tq) + 16u * ((4 * wc + 2 * n + (tp >> 1)) ^ ((tq << 2) | ((2 * fq + t) & 3))) + 8u * (tp & 1);
#define FG_SA(b, h) (65536 + ((b) * 2 + (h)) * HTB)
#define FG_SB(b, h) (((b) * 2 + (h)) * HTB)
#define FG_STAGE_A(bufoff, gk, vo) do { _Pragma("unroll") for (int _i = 0; _i < 2; ++_i) \
        __builtin_amdgcn_global_load_lds((const unsigned*)((gk) + (vo)[_i]), (LAS unsigned*)(lds + (bufoff) + ldsw + _i * 8192), 16, 0, 0); } while (0)
#define FG_STAGE_B(bufoff, gk) do { _Pragma("unroll") for (int _i = 0; _i < 2; ++_i) \
        __builtin_amdgcn_global_load_lds((const unsigned*)((gk) + voffB[_i]), (LAS unsigned*)(lds + (bufoff) + ldsw + _i * 8192), 16, 0, 0); } while (0)
#define FG_LDA(dst, b, h) do { _Pragma("unroll") for (int m = 0; m < 4; ++m) _Pragma("unroll") for (int k = 0; k < 2; ++k) dst[m][k] = *(const LAS bf16x8*)(lds + FG_SA(b, h) + aoff + m * 2048 + k * 1024); } while (0)
#define FG_LDB(dst, b, h) do { \
        dst##lo[0][0] = tr_read<FG_SB(b, h)>(ba[0][0]);        dst##hi[0][0] = tr_read<FG_SB(b, h)>(ba[0][1]); \
        dst##lo[0][1] = tr_read<FG_SB(b, h) + 8192>(ba[0][0]); dst##hi[0][1] = tr_read<FG_SB(b, h) + 8192>(ba[0][1]); \
        dst##lo[1][0] = tr_read<FG_SB(b, h)>(ba[1][0]);        dst##hi[1][0] = tr_read<FG_SB(b, h)>(ba[1][1]); \
        dst##lo[1][1] = tr_read<FG_SB(b, h) + 8192>(ba[1][0]); dst##hi[1][1] = tr_read<FG_SB(b, h) + 8192>(ba[1][1]); } while (0)
#define FG_PK(L, H) (bf16x8){L[0], L[1], L[2], L[3], H[0], H[1], H[2], H[3]}
#define FG_MMA(ai, bj, At, Bt) do { __builtin_amdgcn_s_setprio(1); _Pragma("unroll") for (int m = 0; m < 4; ++m) _Pragma("unroll") for (int n = 0; n < 2; ++n) _Pragma("unroll") for (int k = 0; k < 2; ++k) \
        acc[ai][bj][m][n] = __builtin_amdgcn_mfma_f32_16x16x32_bf16(FG_PK(Bt##lo[n][k], Bt##hi[n][k]), At[m][k], acc[ai][bj][m][n], 0, 0, 0); __builtin_amdgcn_s_setprio(0); } while (0)
#define FG_WAIT_V(n) asm volatile("s_waitcnt vmcnt(" #n ")" ::: "memory")
#define FG_WAIT_L(n) asm volatile("s_waitcnt lgkmcnt(" #n ")" ::: "memory")
#define FG_BAR __builtin_amdgcn_s_barrier()
#define FG_SCHED __builtin_amdgcn_sched_barrier(0)
#define FG_AOFF(dst, u, tabp) do { _Pragma("unroll") for (int _h = 0; _h < 2; ++_h) _Pragma("unroll") for (int _i = 0; _i < 2; ++_i) { const int _r = _h * 128 + RA[_i]; \
        if (Job::GATHER) { const int _tok = (tabp)[_r < (u).nvalid ? _r : 0]; dst[_h][_i] = (unsigned)_tok * J.lda2 + (unsigned)CA2[_i]; } \
        else dst[_h][_i] = (unsigned)((u).arow0 + _r) * J.lda2 + (unsigned)((u).acol2 + CA2[_i]); } } while (0)
    Unit cur, nxt; int ui = 0;
    if (!J.next(0, cur)) return;
    LAS const int* tab0 = (LAS const int*)(lds + TAB_OFF);
    if (Job::GATHER) {
        if (wid == 0) __builtin_amdgcn_global_load_lds((const unsigned*)(J.list + cur.arow0 + lane * 4), (LAS unsigned*)(lds + TAB_OFF), 16, 0, 0);
        FG_WAIT_V(0); __syncthreads();
    }
    f32x4 acc[2][2][4][2];
#pragma unroll
    for (int a = 0; a < 2; ++a)
#pragma unroll
        for (int b = 0; b < 2; ++b)
#pragma unroll
            for (int m = 0; m < 4; ++m)
#pragma unroll
                for (int n = 0; n < 2; ++n) acc[a][b][m][n] = (f32x4){0.f, 0.f, 0.f, 0.f};
    bf16x8 At[4][2]; s16x4 B0lo[2][2], B0hi[2][2], B1lo[2][2], B1hi[2][2];
    unsigned vc[2][2], vn[2][2];
    FG_AOFF(vc, cur, tab0);
    const char* const gA = J.A;
    const char* cB = cur.bBase;
    const unsigned bh2 = J.bhalf2;
    FG_STAGE_B(FG_SB(0, 0), cB); FG_STAGE_A(FG_SA(0, 0), gA, vc[0]); FG_STAGE_B(FG_SB(0, 1), cB + bh2); FG_STAGE_A(FG_SA(0, 1), gA, vc[1]);
    if (wr == 1) FG_BAR;
    FG_WAIT_V(4); FG_BAR;
    FG_STAGE_B(FG_SB(1, 0), cB + kstepB); FG_STAGE_A(FG_SA(1, 0), gA + 128, vc[0]); FG_STAGE_B(FG_SB(1, 1), cB + kstepB + bh2);
    FG_WAIT_V(6); FG_BAR;
    for (;;) {
        const bool has_next = J.next(ui + 1, nxt);
        if (!has_next) nxt = cur;
        if (Job::GATHER && has_next && wid == 0)
            __builtin_amdgcn_global_load_lds((const unsigned*)(J.list + nxt.arow0 + lane * 4), (LAS unsigned*)(lds + TAB_OFF + ((ui + 1) & 1) * 1024), 16, 0, 0);
        const char* nB = nxt.bBase;
        for (int t = 0; t < nt; t += 2) {
            const bool last = (t == nt - 2);
            const char* a1 = gA + (size_t)(t + 1) * 128;
            const char* a2 = last ? gA : gA + (size_t)(t + 2) * 128; const char* b2 = last ? nB : cB + (size_t)(t + 2) * kstepB;
            const char* a3 = a2 + 128; const char* b3 = b2 + kstepB;
            if (last) { if (has_next) { LAS const int* tabn = (LAS const int*)(lds + TAB_OFF + ((ui + 1) & 1) * 1024); FG_AOFF(vn, nxt, tabn); }
                        else { _Pragma("unroll") for (int _h = 0; _h < 2; ++_h) _Pragma("unroll") for (int _i = 0; _i < 2; ++_i) vn[_h][_i] = vc[_h][_i]; } }
            FG_LDB(B0, 0, 0); FG_SCHED; FG_LDA(At, 0, 0); FG_STAGE_A(FG_SA(1, 1), a1, vc[1]);
            if (last) { _Pragma("unroll") for (int _h = 0; _h < 2; ++_h) _Pragma("unroll") for (int _i = 0; _i < 2; ++_i) vc[_h][_i] = vn[_h][_i]; }
            FG_WAIT_L(8); FG_BAR; FG_WAIT_L(0); FG_SCHED; FG_MMA(0, 0, At, B0); FG_BAR; FG_SCHED;
            FG_LDB(B1, 0, 1); FG_STAGE_B(FG_SB(0, 0), b2);
            FG_BAR; FG_WAIT_L(0); FG_SCHED; FG_MMA(0, 1, At, B1); FG_BAR;
            FG_LDA(At, 0, 1); FG_STAGE_A(FG_SA(0, 0), a2, vc[0]);
            FG_BAR; FG_WAIT_L(0); FG_MMA(1, 0, At, B0); FG_BAR; FG_SCHED;
            FG_STAGE_B(FG_SB(0, 1), b2 + bh2);
            FG_WAIT_V(6); FG_BAR; FG_MMA(1, 1, At, B1); FG_BAR;
            FG_LDB(B0, 1, 0); FG_SCHED; FG_LDA(At, 1, 0); FG_STAGE_A(FG_SA(0, 1), a2, vc[1]);
            FG_WAIT_L(8); FG_BAR; FG_WAIT_L(0); FG_SCHED; FG_MMA(0, 0, At, B0); FG_BAR; FG_SCHED;
            FG_LDB(B1, 1, 1); FG_STAGE_B(FG_SB(1, 0), b3);
            FG_BAR; FG_WAIT_L(0); FG_SCHED; FG_MMA(0, 1, At, B1); FG_BAR;
            FG_LDA(At, 1, 1); FG_STAGE_A(FG_SA(1, 0), a3, vc[0]);
            FG_BAR; FG_WAIT_L(0); FG_MMA(1, 0, At, B0); FG_BAR; FG_SCHED;
            FG_STAGE_B(FG_SB(1, 1), b3 + bh2);
            FG_WAIT_V(6); FG_BAR; FG_MMA(1, 1, At, B1); FG_BAR;
        }
        J.epi(acc, cur, wr, wc, fr, fq);
        if (!has_next) break;
#pragma unroll
        for (int a = 0; a < 2; ++a)
#pragma unroll
            for (int b = 0; b < 2; ++b)
#pragma unroll
                for (int m = 0; m < 4; ++m)
#pragma unroll
                    for (int n = 0; n < 2; ++n) acc[a][b][m][n] = (f32x4){0.f, 0.f, 0.f, 0.f};
        cur = nxt; cB = nB; ++ui;
    }
    FG_WAIT_V(0);
    if (wr == 0) FG_BAR;
    FG_BAR;
}
}

#define FG_FOR_ROWS for (int ai = 0; ai < 2; ++ai) _Pragma("unroll") for (int m = 0; m < 4; ++m)
struct JobInProj {
    static constexpr bool GATHER = false;
    const char* A; unsigned lda2, ldb2, bhalf2; int K; const int* list;
    const char* B; bf16_t* out; fg::StaticOrder S;
    __device__ __forceinline__ bool next(int i, fg::Unit& u) const { int pm, pn; if (!S.next(i, pm, pn)) return false;
        u.bBase = B + (size_t)pn * 512; u.arow0 = pm * 256; u.nvalid = 256; u.e = 0; u.orow0 = pm * 256; u.ocol0 = pn * 256; u.acol2 = 0; return true; }
    __device__ __forceinline__ void epi(const f32x4 (&acc)[2][2][4][2], const fg::Unit& u, int wr, int wc, int fr, int fq) const {
#pragma unroll
        FG_FOR_ROWS { bf16_t* rowp = out + (size_t)(u.orow0 + ai * 128 + wr * 64 + m * 16 + fr) * kNPROJ + u.ocol0 + wc * 32 + fq * 4;
#pragma unroll
            for (int bj = 0; bj < 2; ++bj)
#pragma unroll
                for (int n = 0; n < 2; ++n) { const f32x4 v = acc[ai][bj][m][n]; u32x2 w; w.x = pk_bf16(v[0], v[1]); w.y = pk_bf16(v[2], v[3]); *(u32x2*)(rowp + bj * 128 + n * 16) = w; } }
    }
};
struct JobPool {
    static constexpr bool GATHER = false;
    const char* A; unsigned lda2, ldb2, bhalf2; int K; const int* list;
    const char* B; bf16_t* cat; int G, c;
    __device__ __forceinline__ bool next(int i, fg::Unit& u) const { const int L = i * G + c; if (L >= 128) return false; const int g = L >> 5, pm = L & 31;
        u.bBase = B + (size_t)g * kPG * kPG * 2; u.arow0 = pm * 256; u.nvalid = 256; u.e = g; u.orow0 = pm * 256; u.ocol0 = kSB + g * kPG; u.acol2 = g * kPG * 2; return true; }
    __device__ __forceinline__ void epi(const f32x4 (&acc)[2][2][4][2], const fg::Unit& u, int wr, int wc, int fr, int fq) const {
#pragma unroll
        FG_FOR_ROWS { bf16_t* rowp = cat + (size_t)(u.orow0 + ai * 128 + wr * 64 + m * 16 + fr) * kD + u.ocol0 + wc * 32 + fq * 4;
#pragma unroll
            for (int bj = 0; bj < 2; ++bj)
#pragma unroll
                for (int n = 0; n < 2; ++n) { const f32x4 v = acc[ai][bj][m][n]; u32x2 w; w.x = pk_bf16(v[0], v[1]); w.y = pk_bf16(v[2], v[3]); *(u32x2*)(rowp + bj * 128 + n * 16) = w; } }
    }
};
struct JobOutProj {
    static constexpr bool GATHER = false;
    const char* A; unsigned lda2, ldb2, bhalf2; int K; const int* list;
    const char* B; const float* x; const float* mod; float* x1; fg::StaticOrder S;
    __device__ __forceinline__ bool next(int i, fg::Unit& u) const { int pm, pn; if (!S.next(i, pm, pn)) return false;
        u.bBase = B + (size_t)pn * 512; u.arow0 = pm * 256; u.nvalid = 256; u.e = 0; u.orow0 = pm * 256; u.ocol0 = pn * 256; u.acol2 = 0; return true; }
    __device__ __forceinline__ void epi(const f32x4 (&acc)[2][2][4][2], const fg::Unit& u, int wr, int wc, int fr, int fq) const {
        const int b = u.orow0 / kS; f32x4 gt[2][2];
#pragma unroll
        for (int bj = 0; bj < 2; ++bj)
#pragma unroll
            for (int n = 0; n < 2; ++n) gt[bj][n] = *(const f32x4*)(mod + b * 6 * kD + 2 * kD + u.ocol0 + bj * 128 + wc * 32 + n * 16 + fq * 4);
#pragma unroll
        FG_FOR_ROWS { const size_t ro = (size_t)(u.orow0 + ai * 128 + wr * 64 + m * 16 + fr) * kD + u.ocol0 + wc * 32 + fq * 4;
#pragma unroll
            for (int bj = 0; bj < 2; ++bj)
#pragma unroll
                for (int n = 0; n < 2; ++n) { const f32x4 xv = *(const f32x4*)(x + ro + bj * 128 + n * 16); *(f32x4*)(x1 + ro + bj * 128 + n * 16) = xv + gt[bj][n] * acc[ai][bj][m][n]; } }
    }
};
struct MoeTab { LAS const int* t; int total;
    __device__ __forceinline__ bool decode(int i, int G, int c, int& e, int& jcol, int& rb, int& cnt, int& rowbase) const {
        const int L = (G % 8 == 0) ? i * G + (c % 8) * (G / 8) + c / 8 : i * G + c; if (L >= total) return false;
        int ee = 0; while (ee < kE - 1 && t[64 + ee + 1] <= L) ++ee;
        const int local = L - t[64 + ee], nrb = t[100 + ee]; jcol = local / nrb; rb = local - jcol * nrb; e = ee; cnt = t[ee]; rowbase = t[32 + ee]; return true; }
};
__device__ __forceinline__ MoeTab moe_tables(LAS unsigned char* lds, const unsigned* ctrl, int ncol) {
    LAS int* t = (LAS int*)(lds + fg::MISC_OFF + 64);
    __syncthreads();
    if (threadIdx.x == 0) { int base = 0, us = 0; for (int e = 0; e < kE; ++e) { const int cn = (int)ctrl[CT_CNT + e], nrb = (cn + 255) >> 8; t[e] = cn; t[32 + e] = base; t[64 + e] = us; t[100 + e] = nrb; base += nrb * 256; us += nrb * ncol; } t[64 + kE] = us; }
    __syncthreads();
    MoeTab M; M.t = t; M.total = t[64 + kE]; return M;
}
struct JobMoe1 {
    static constexpr bool GATHER = true;
    const char* A; unsigned lda2, ldb2, bhalf2; int K; const int* list;
    const char* B; const float* b_in; bf16_t* act; MoeTab M; int G, c;
    __device__ __forceinline__ bool next(int i, fg::Unit& u) const { int e, j, rb, cnt, rowbase; if (!M.decode(i, G, c, e, j, rb, cnt, rowbase)) return false;
        e = __builtin_amdgcn_readfirstlane(e); j = __builtin_amdgcn_readfirstlane(j); rb = __builtin_amdgcn_readfirstlane(rb); cnt = __builtin_amdgcn_readfirstlane(cnt); rowbase = __builtin_amdgcn_readfirstlane(rowbase);
        u.bBase = B + (size_t)e * ((size_t)kD * 2 * kDFF * 2) + (size_t)j * 256; u.arow0 = e * kT + rb * 256; u.nvalid = min(256, cnt - rb * 256); u.e = e; u.orow0 = rowbase + rb * 256; u.ocol0 = j * 128; u.acol2 = 0; return true; }
    __device__ __forceinline__ void epi(const f32x4 (&acc)[2][2][4][2], const fg::Unit& u, int wr, int wc, int fr, int fq) const {
        f32x4 bg[2], bl[2];
#pragma unroll
        for (int n = 0; n < 2; ++n) { const float* bp = b_in + (size_t)u.e * 2 * kDFF + u.ocol0 + wc * 32 + n * 16 + fq * 4; bg[n] = *(const f32x4*)bp; bl[n] = *(const f32x4*)(bp + kDFF); }
#pragma unroll
        FG_FOR_ROWS { bf16_t* rowp = act + (size_t)(u.orow0 + ai * 128 + wr * 64 + m * 16 + fr) * kDFF + u.ocol0 + wc * 32 + fq * 4;
#pragma unroll
            for (int n = 0; n < 2; ++n) { const f32x4 gv = acc[ai][0][m][n] + bg[n], lv = acc[ai][1][m][n] + bl[n]; float o[4];
#pragma unroll
                for (int j = 0; j < 4; ++j) { const float g = fminf(gv[j], 7.f), l = fminf(fmaxf(lv[j], -7.f), 7.f); o[j] = g * __builtin_amdgcn_rcpf(1.f + __expf(-1.702f * g)) * (l + 1.f); }
                u32x2 w; w.x = pk_bf16(o[0], o[1]); w.y = pk_bf16(o[2], o[3]); *(u32x2*)(rowp + n * 16) = w; } }
    }
};
struct JobMoe2 {
    static constexpr bool GATHER = false;
    const char* A; unsigned lda2, ldb2, bhalf2; int K; const int* list;
    const char* B; const float* b_out; bf16_t* yp; MoeTab M; int G, c;
    __device__ __forceinline__ bool next(int i, fg::Unit& u) const { int e, j, rb, cnt, rowbase; if (!M.decode(i, G, c, e, j, rb, cnt, rowbase)) return false;
        e = __builtin_amdgcn_readfirstlane(e); j = __builtin_amdgcn_readfirstlane(j); rb = __builtin_amdgcn_readfirstlane(rb); rowbase = __builtin_amdgcn_readfirstlane(rowbase);
        u.bBase = B + (size_t)e * ((size_t)kDFF * kD * 2) + (size_t)j * 512; u.arow0 = rowbase + rb * 256; u.nvalid = 256; u.e = e; u.orow0 = rowbase + rb * 256; u.ocol0 = j * 256; u.acol2 = 0; return true; }
    __device__ __forceinline__ void epi(const f32x4 (&acc)[2][2][4][2], const fg::Unit& u, int wr, int wc, int fr, int fq) const {
        f32x4 bo[2][2];
#pragma unroll
        for (int bj = 0; bj < 2; ++bj)
#pragma unroll
            for (int n = 0; n < 2; ++n) bo[bj][n] = *(const f32x4*)(b_out + (size_t)u.e * kD + u.ocol0 + bj * 128 + wc * 32 + n * 16 + fq * 4);
#pragma unroll
        FG_FOR_ROWS { bf16_t* rowp = yp + (size_t)(u.orow0 + ai * 128 + wr * 64 + m * 16 + fr) * kD + u.ocol0 + wc * 32 + fq * 4;
#pragma unroll
            for (int bj = 0; bj < 2; ++bj)
#pragma unroll
                for (int n = 0; n < 2; ++n) { const f32x4 v = acc[ai][bj][m][n] + bo[bj][n]; u32x2 w; w.x = pk_bf16(v[0], v[1]); w.y = pk_bf16(v[2], v[3]); *(u32x2*)(rowp + bj * 128 + n * 16) = w; } }
    }
};


__device__ __forceinline__ float wave_sum(float v) {
#pragma unroll
    for (int o = 32; o > 0; o >>= 1) v += __shfl_xor(v, o);
    return v; }
__device__ __forceinline__ float bflo(unsigned u) { return __uint_as_float(u << 16); }
__device__ __forceinline__ float bfhi(unsigned u) { return __uint_as_float(u & 0xFFFF0000u); }

namespace at {
typedef float f32x16 __attribute__((ext_vector_type(16)));
__device__ __forceinline__ unsigned off_b(unsigned row, unsigned ch) { return 256u * row + 16u * (ch ^ (((row & 3) << 2) | ((row >> 2) & 3))); }
constexpr float kC2 = 0.08838834764831845f * 1.4426950408889634f;
constexpr float kDoneThresh = 160.f;

__device__ __forceinline__ void attn_phase(LAS unsigned char* lds, const bf16_t* __restrict__ proj, const float* __restrict__ qw, const float* __restrict__ kw,
                                           bf16_t* __restrict__ cat, int G, int c) {
    const int tid = threadIdx.x, wid = __builtin_amdgcn_readfirstlane(tid >> 6), lane = tid & 63, ql = lane & 31, hf = lane >> 5;
    const unsigned ldsb = (unsigned)(uintptr_t)lds;
    const int skey = tid >> 4, sch = tid & 15;
    const unsigned X = ((ql & 3) << 2) | ((ql >> 2) & 3);
    const unsigned krow = 256u * ql, kY = 16u * (X ^ (unsigned)hf);
    const int tq = (lane & 15) >> 2, tp = lane & 3, blk = (lane >> 4) & 1;
    unsigned va[4][2];
#pragma unroll
    for (int cc = 0; cc < 4; ++cc)
#pragma unroll
        for (int t = 0; t < 2; ++t) va[cc][t] = 256u * (8 * t + 4 * hf + tq) + 16u * ((4 * cc + 2 * blk + (tp >> 1)) ^ ((tq << 2) | ((2 * t + hf) & 3))) + 8u * (tp & 1);
    for (int unit = c; unit < kB * kNH * 8; unit += G) {
        const int qb = unit & 7, bh = unit >> 3, h = bh & 7, b = bh >> 3;
        const int q0 = qb * 256, r0 = q0 + wid * 32;
        const bf16_t* base = proj + (size_t)(b * kS) * kNPROJ + h * kHD;
        LAS unsigned char* qlds = lds + 65536 + wid * 8192 + lane * 16;
        { u32x4 qr[8]; float ss = 0.f;
#pragma unroll
          for (int s = 0; s < 8; ++s) { qr[s] = *(const u32x4*)(base + (size_t)(r0 + ql) * kNPROJ + 16 * s + 8 * hf);
              const unsigned u[4] = {qr[s].x, qr[s].y, qr[s].z, qr[s].w};
#pragma unroll
              for (int e = 0; e < 4; ++e) { const float a = bflo(u[e]), bb = bfhi(u[e]); ss += a * a + bb * bb; } }
          ss += __shfl_xor(ss, 32);
          const float rq = rsqrtf(ss * (1.f / kHD) + kEPS) * kC2;
#pragma unroll
          for (int s = 0; s < 8; ++s) { const int d0 = 16 * s + 8 * hf;
              const f32x4 w0 = *(const f32x4*)(qw + d0) * *(const f32x4*)(kw + d0), w1 = *(const f32x4*)(qw + d0 + 4) * *(const f32x4*)(kw + d0 + 4);
              const unsigned u[4] = {qr[s].x, qr[s].y, qr[s].z, qr[s].w};
              u32x4 pk; pk.x = pk_bf16(bflo(u[0]) * rq * w0[0], bfhi(u[0]) * rq * w0[1]); pk.y = pk_bf16(bflo(u[1]) * rq * w0[2], bfhi(u[1]) * rq * w0[3]);
              pk.z = pk_bf16(bflo(u[2]) * rq * w1[0], bfhi(u[2]) * rq * w1[1]); pk.w = pk_bf16(bflo(u[3]) * rq * w1[2], bfhi(u[3]) * rq * w1[3]);
              *(LAS u32x4*)(qlds + 1024 * s) = pk; } }
        f32x16 o[4];
#pragma unroll
        for (int cc = 0; cc < 4; ++cc)
#pragma unroll
            for (int r = 0; r < 16; ++r) o[cc][r] = 0.f;
        float carry = 0.f; bool wactive = true;
        int jt = (q0 + 255) >> 6, cur = 0;
        u32x4 kr[2], vr[2];
#define AT_LOAD(jt_) do { _Pragma("unroll") for (int i = 0; i < 2; ++i) { const bf16_t* rp = base + (size_t)(64 * (jt_) + skey + 32 * i) * kNPROJ + sch * 8; \
            kr[i] = *(const u32x4*)(rp + kSB); vr[i] = *(const u32x4*)(rp + 2 * kSB); } } while (0)
        AT_LOAD(jt);
        for (;;) {
            LAS unsigned char* kbuf = lds + cur * 32768; LAS unsigned char* vbuf = kbuf + 16384;
#pragma unroll
            for (int i = 0; i < 2; ++i) { const unsigned u[4] = {kr[i].x, kr[i].y, kr[i].z, kr[i].w}; float f[8]; float ss = 0.f;
#pragma unroll
                for (int e = 0; e < 4; ++e) { f[2 * e] = bflo(u[e]); f[2 * e + 1] = bfhi(u[e]); ss += f[2 * e] * f[2 * e] + f[2 * e + 1] * f[2 * e + 1]; }
                ss += __shfl_xor(ss, 1); ss += __shfl_xor(ss, 2); ss += __shfl_xor(ss, 4); ss += __shfl_xor(ss, 8);
                const float rk = rsqrtf(ss * (1.f / kHD) + kEPS);
                u32x4 pk; pk.x = pk_bf16(f[0] * rk, f[1] * rk); pk.y = pk_bf16(f[2] * rk, f[3] * rk); pk.z = pk_bf16(f[4] * rk, f[5] * rk); pk.w = pk_bf16(f[6] * rk, f[7] * rk);
                const unsigned a = off_b(skey + 32 * i, sch);
                *(LAS u32x4*)(kbuf + a) = pk; *(LAS u32x4*)(vbuf + a) = vr[i]; }
            const int any = __syncthreads_or(wactive ? 1 : 0);
            if (!any) break;
            const int jtc = jt;
            if (jt > 0) AT_LOAD(jt - 1);
            if (wactive && 64 * jtc < r0 + 31) {
                f32x16 s0, s1;
#pragma unroll
                for (int r = 0; r < 16; ++r) { s0[r] = 0.f; s1[r] = 0.f; }
#pragma unroll
                for (int s = 0; s < 8; ++s) { const unsigned a = krow + ((32u * s) ^ kY);
                    const bf16x8 k0 = *(const LAS bf16x8*)(kbuf + a), k1 = *(const LAS bf16x8*)(kbuf + 8192 + a), qv = *(const LAS bf16x8*)(qlds + 1024 * s);
                    s0 = __builtin_amdgcn_mfma_f32_32x32x16_bf16(k0, qv, s0, 0, 0, 0); s1 = __builtin_amdgcn_mfma_f32_32x32x16_bf16(k1, qv, s1, 0, 0, 0); }
                const int tabs = r0 + ql, kbase0 = 64 * jtc + 4 * hf;
                float run = carry; u32x4 pfr[2][2];
#pragma unroll
                for (int kb = 1; kb >= 0; --kb) {
                    float sp[16], gp[4], T[4];
#pragma unroll
                    for (int r = 0; r < 16; ++r) { const float z = kb ? s1[r] : s0[r]; const int key = kbase0 + 32 * kb + 8 * (r >> 2) + (r & 3);
                        const float v = __builtin_amdgcn_logf(1.f + __builtin_amdgcn_exp2f(z)); sp[r] = key < tabs ? v : 0.f; }
#pragma unroll
                    for (int g = 0; g < 4; ++g) { const float gsum = (sp[4 * g] + sp[4 * g + 1]) + (sp[4 * g + 2] + sp[4 * g + 3]);
                        const auto sw = __builtin_amdgcn_permlane32_swap(__float_as_uint(gsum), __float_as_uint(gsum), false, false);
                        const float lo = __uint_as_float(sw[0]), hi = __uint_as_float(sw[1]);
                        T[g] = lo + hi; gp[g] = hf ? 0.f : hi; }
#pragma unroll
                    for (int g = 3; g >= 0; --g) { const float offs = run + gp[g];
                        const float c3 = offs + sp[4 * g + 3], c2 = c3 + sp[4 * g + 2], c1 = c2 + sp[4 * g + 1], c0 = c1 + sp[4 * g];
                        const float cs[4] = {c0, c1, c2, c3};
#pragma unroll
                        for (int i = 0; i < 4; ++i) { const int r = 4 * g + i; const float z = kb ? s1[r] : s0[r]; const int key = kbase0 + 32 * kb + 8 * g + i;
                            const float e = __builtin_amdgcn_exp2f(z - cs[i]); sp[r] = key < tabs ? e : 0.f; }
                        run += T[g]; }
#pragma unroll
                    for (int s2 = 0; s2 < 2; ++s2) { u32x4 pk; pk.x = pk_bf16(sp[8 * s2], sp[8 * s2 + 1]); pk.y = pk_bf16(sp[8 * s2 + 2], sp[8 * s2 + 3]);
                        pk.z = pk_bf16(sp[8 * s2 + 4], sp[8 * s2 + 5]); pk.w = pk_bf16(sp[8 * s2 + 6], sp[8 * s2 + 7]); pfr[kb][s2] = pk; }
                }
                carry = run;
                const unsigned vb0 = ldsb + (unsigned)cur * 32768u + 16384u;
#define AT_PV(cc) do { const unsigned a0 = vb0 + va[cc][0], a1 = vb0 + va[cc][1]; \
                    const s16x4 l00 = fg::tr_read<0>(a0), h00 = fg::tr_read<0>(a1), l01 = fg::tr_read<4096>(a0), h01 = fg::tr_read<4096>(a1); \
                    const s16x4 l10 = fg::tr_read<8192>(a0), h10 = fg::tr_read<8192>(a1), l11 = fg::tr_read<12288>(a0), h11 = fg::tr_read<12288>(a1); \
                    asm volatile("s_waitcnt lgkmcnt(0)" ::: "memory"); __builtin_amdgcn_sched_barrier(0); \
                    o[cc] = __builtin_amdgcn_mfma_f32_32x32x16_bf16(FG_PK(l00, h00), __builtin_bit_cast(bf16x8, pfr[0][0]), o[cc], 0, 0, 0); \
                    o[cc] = __builtin_amdgcn_mfma_f32_32x32x16_bf16(FG_PK(l01, h01), __builtin_bit_cast(bf16x8, pfr[0][1]), o[cc], 0, 0, 0); \
                    o[cc] = __builtin_amdgcn_mfma_f32_32x32x16_bf16(FG_PK(l10, h10), __builtin_bit_cast(bf16x8, pfr[1][0]), o[cc], 0, 0, 0); \
                    o[cc] = __builtin_amdgcn_mfma_f32_32x32x16_bf16(FG_PK(l11, h11), __builtin_bit_cast(bf16x8, pfr[1][1]), o[cc], 0, 0, 0); } while (0)
                AT_PV(0); AT_PV(1); AT_PV(2); AT_PV(3);
#undef AT_PV
                wactive = __any(carry <= kDoneThresh);
            }
            if (jt == 0) break;
            --jt; cur ^= 1;
        }
#undef AT_LOAD
        bf16_t* orow = cat + (size_t)(b * kS + r0 + ql) * kD + h * kHD + 4 * hf;
#pragma unroll
        for (int cc = 0; cc < 4; ++cc)
#pragma unroll
            for (int g = 0; g < 4; ++g) { u32x2 w; w.x = pk_bf16(o[cc][4 * g], o[cc][4 * g + 1]); w.y = pk_bf16(o[cc][4 * g + 2], o[cc][4 * g + 3]); *(u32x2*)(orow + 32 * cc + 8 * g) = w; }
        __syncthreads();
    }
}
}

__device__ __forceinline__ void pool_p_phase(const bf16_t* __restrict__ proj, bf16_t* __restrict__ p, int G, int c) {
    for (int idx = c * 512 + threadIdx.x; idx < kT * (kPW / 8); idx += G * 512) {
        const int c8 = idx & 127, t = idx >> 7, s = t & (kS - 1), g = c8 >> 5, w = 2 << g, cnt = min(s + 1, w);
        const bf16_t* up = proj + (size_t)t * kNPROJ + 3 * kSB + c8 * 8;
        float acc[8], u0[8];
#pragma unroll
        for (int e = 0; e < 8; ++e) acc[e] = 0.f;
        for (int i = 0; i < cnt; ++i) { const uint4 v = *(const uint4*)(up - (size_t)i * kNPROJ); const unsigned u[4] = {v.x, v.y, v.z, v.w};
#pragma unroll
            for (int e = 0; e < 4; ++e) { const float a = bflo(u[e]), bb = bfhi(u[e]); acc[2 * e] += a; acc[2 * e + 1] += bb; if (i == 0) { u0[2 * e] = a; u0[2 * e + 1] = bb; } } }
        const float inv = 1.f / (float)cnt;
        u32x4 pk; pk.x = pk_bf16(acc[0] * inv - u0[0], acc[1] * inv - u0[1]); pk.y = pk_bf16(acc[2] * inv - u0[2], acc[3] * inv - u0[3]);
        pk.z = pk_bf16(acc[4] * inv - u0[4], acc[5] * inv - u0[5]); pk.w = pk_bf16(acc[6] * inv - u0[6], acc[7] * inv - u0[7]);
        *(u32x4*)(p + (size_t)t * kPW + c8 * 8) = pk;
    }
}

__device__ __forceinline__ void convert_seg(const float* __restrict__ src, bf16_t* __restrict__ dst, size_t n8, size_t gtid, size_t gstride) {
    const f32x4* s4 = (const f32x4*)src; u32x4* d4 = (u32x4*)dst;
#pragma unroll 4
    for (size_t i = gtid; i < n8; i += gstride) { const f32x4 a = __builtin_nontemporal_load(s4 + 2 * i), b = __builtin_nontemporal_load(s4 + 2 * i + 1);
        u32x4 w; w.x = pk_bf16(a[0], a[1]); w.y = pk_bf16(a[2], a[3]); w.z = pk_bf16(b[0], b[1]); w.w = pk_bf16(b[2], b[3]); d4[i] = w; }
}


#define XB_TMO      128
#define XB_XCNT(j)  (256  + 64 * (j))
#define XB_XSUB(j)  (1280 + 64 * (j))
#define XB_XGEN(j)  (2304 + 64 * (j))
#define XB_TOP      3328
#define XB_TOPGEN   3392
#define XCD_BAR_WORDS 3456
#define XB_SPIN_CAP (1u << 18)
__device__ __forceinline__ unsigned xb_ld(unsigned* p)              { return __hip_atomic_load(p, __ATOMIC_RELAXED, __HIP_MEMORY_SCOPE_AGENT); }
__device__ __forceinline__ unsigned xb_add(unsigned* p, unsigned v) { return __hip_atomic_fetch_add(p, v, __ATOMIC_RELAXED, __HIP_MEMORY_SCOPE_AGENT); }
__device__ __forceinline__ unsigned xb_xcc_id() { return (unsigned)__builtin_amdgcn_s_getreg((3 << 11) | 20) & 0xFu; }
#define XB_SPIN(cond, bar) do { unsigned _sp = 0; while (cond) { __builtin_amdgcn_s_sleep(1); \
    if ((++_sp & 255u) == 0u) { if (xb_ld(&(bar)[XB_TMO])) break; if (_sp > XB_SPIN_CAP) { atomicAdd(&(bar)[XB_TMO], 1u); break; } } } } while (0)
struct XcdBarrier { unsigned* bar; unsigned x; volatile LAS unsigned* st; };
__device__ __forceinline__ XcdBarrier xcd_barrier_post(unsigned* bar, volatile LAS unsigned* st) {
    XcdBarrier b; b.bar = bar; b.x = xb_xcc_id(); b.st = st;
    if (threadIdx.x == 0) (void)xb_add(&bar[XB_XCNT(b.x)], 1u);
    return b;
}
__device__ __forceinline__ void xcd_barrier_complete(unsigned* bar, unsigned x, unsigned& nloc, unsigned& nx) {
    const unsigned G = gridDim.x * gridDim.y * gridDim.z;
    unsigned sum, cnt, mine, sp = 0u;
    for (;;) {
        sum = 0u; cnt = 0u; mine = 0u;
#pragma unroll
        for (unsigned j = 0; j < 16; ++j) { const unsigned c = xb_ld(&bar[XB_XCNT(j)]); sum += c; cnt += (c > 0u) ? 1u : 0u; mine = (j == x) ? c : mine; }
        if (sum == G) break;
        __builtin_amdgcn_s_sleep(1);
        if ((++sp & 255u) == 0u) { if (xb_ld(&bar[XB_TMO])) break; if (sp > XB_SPIN_CAP) { atomicAdd(&bar[XB_TMO], 1u); break; } }
    }
    nloc = mine > 0u ? mine : 1u; nx = cnt > 0u ? cnt : 1u;
}
__device__ __forceinline__ void xcd_barrier(const XcdBarrier& b) {
    asm volatile("s_waitcnt vmcnt(0)" ::: "memory");
    __syncthreads();
    if (threadIdx.x == 0) {
        unsigned* bar = b.bar;
        __builtin_amdgcn_s_waitcnt(0);
        unsigned nloc = b.st[0], nx = b.st[1];
        if (nloc == 0u) { xcd_barrier_complete(bar, b.x, nloc, nx); b.st[0] = nloc; b.st[1] = nx; }
        const unsigned old = xb_add(&bar[XB_XSUB(b.x)], 1u);
        const unsigned gen = old / nloc;
        if (old + 1u == (gen + 1u) * nloc) {
            __builtin_amdgcn_fence(__ATOMIC_RELEASE, "agent");
            asm volatile("s_waitcnt vmcnt(0)" ::: "memory");
            const unsigned og = xb_add(&bar[XB_TOP], 1u);
            const unsigned tg = og / nx;
            if (og + 1u == (tg + 1u) * nx) xb_add(&bar[XB_TOPGEN], 1u);
            else XB_SPIN(xb_ld(&bar[XB_TOPGEN]) == tg, bar);
            __builtin_amdgcn_fence(__ATOMIC_ACQUIRE, "agent");
            xb_add(&bar[XB_XGEN(b.x)], 1u);
            asm volatile("s_waitcnt vmcnt(0)" ::: "memory");
        } else {
            XB_SPIN(xb_ld(&bar[XB_XGEN(b.x)]) == gen, bar);
            __builtin_amdgcn_fence(__ATOMIC_ACQUIRE, "agent");
            asm volatile("s_waitcnt vmcnt(0)" ::: "memory");
        }
    }
    __syncthreads();
}

__device__ __forceinline__ void ada_phase(LAS unsigned char* lds, const float* __restrict__ cvec, const float* __restrict__ w_ada, const float* __restrict__ b_ada, float* __restrict__ mod, int G, int c) {
    LAS float* ca = (LAS float*)lds;
    LAS float* part = (LAS float*)(lds + 32768);
    const int tid = threadIdx.x;
    __syncthreads();
    for (int i = tid; i < kB * kD; i += 512) { const float v = cvec[i]; ca[i] = v / (1.f + __expf(-v)); }
    __syncthreads();
    for (int cb = c; cb < 6 * kD / 48; cb += G) {
        const int n0 = cb * 48, cg = tid % 12, kr = tid / 12;
        if (tid < 504) {
            f32x4 a0 = {0.f, 0.f, 0.f, 0.f}, a1 = a0, a2 = a0, a3 = a0;
#pragma unroll 8
            for (int k = kr; k < kD; k += 42) { const f32x4 w = __builtin_nontemporal_load((const f32x4*)(w_ada + (size_t)k * (6 * kD) + n0 + cg * 4));
                a0 += ca[k] * w; a1 += ca[kD + k] * w; a2 += ca[2 * kD + k] * w; a3 += ca[3 * kD + k] * w; }
            LAS f32x4* pp = (LAS f32x4*)(part + (kr * 12 + cg) * 16); pp[0] = a0; pp[1] = a1; pp[2] = a2; pp[3] = a3;
        }
        __syncthreads();
        if (tid < 192) { const int col = tid % 48, b = tid / 48; float sum = 0.f;
            for (int r = 0; r < 42; ++r) sum += part[(r * 12 + (col >> 2)) * 16 + b * 4 + (col & 3)];
            mod[b * 6 * kD + n0 + col] = sum + b_ada[n0 + col]; }
        __syncthreads();
    }
}

__device__ __forceinline__ void norm1_phase(const float* __restrict__ x, const float* __restrict__ nw, const float* __restrict__ mod, bf16_t* __restrict__ out, int G, int c) {
    const int wid = threadIdx.x >> 6, lane = threadIdx.x & 63;
    for (int t = c * 8 + wid; t < kT; t += G * 8) {
        const int b = t / kS; const float* xr = x + (size_t)t * kD + lane * 4; const float* mb = mod + b * 6 * kD + lane * 4;
        f32x4 v[8]; float ss = 0.f;
#pragma unroll
        for (int j = 0; j < 8; ++j) { v[j] = *(const f32x4*)(xr + 256 * j); ss += v[j][0] * v[j][0] + v[j][1] * v[j][1] + v[j][2] * v[j][2] + v[j][3] * v[j][3]; }
        ss = wave_sum(ss);
        const float r = rsqrtf(ss * (1.f / kD) + kEPS);
#pragma unroll
        for (int j = 0; j < 8; ++j) { const f32x4 w = *(const f32x4*)(nw + lane * 4 + 256 * j), sh = *(const f32x4*)(mb + 256 * j), sc = *(const f32x4*)(mb + kD + 256 * j);
            const f32x4 y = v[j] * r * w * (1.f + sc) + sh; u32x2 o; o.x = pk_bf16(y[0], y[1]); o.y = pk_bf16(y[2], y[3]);
            *(u32x2*)(out + (size_t)t * kD + lane * 4 + 256 * j) = o; }
    }
}

constexpr int RT_STRIDE = 144;
__device__ __forceinline__ void norm2_router_phase(LAS unsigned char* lds, const float* __restrict__ x1, const float* __restrict__ nw, const float* __restrict__ mod,
                                                   const float* __restrict__ w_router, const float* __restrict__ b_router, bf16_t* __restrict__ h2,
                                                   float* __restrict__ gates, int* __restrict__ pair_e, int* __restrict__ pair_p, int* __restrict__ list, unsigned* __restrict__ ctrl, int G, int c) {
    const int tid = threadIdx.x, wid = tid >> 6, lane = tid & 63;
    for (int blk = c; blk < kT / 32; blk += G) {
#pragma unroll 1
        for (int pass = 0; pass < 2; ++pass) {
            const int t0 = blk * 32 + wid * 4 + pass * 2, b = t0 / kS;
            float rs[2];
#pragma unroll
            for (int rr = 0; rr < 2; ++rr) { const float* xr = x1 + (size_t)(t0 + rr) * kD + 2 * lane; float ss = 0.f;
#pragma unroll
                for (int i = 0; i < 16; ++i) { const f32x2 v = *(const f32x2*)(xr + 128 * i); ss += v[0] * v[0] + v[1] * v[1]; }
                ss = wave_sum(ss); rs[rr] = rsqrtf(ss * (1.f / kD) + kEPS); }
            f32x4 acc[2][8];
#pragma unroll
            for (int rr = 0; rr < 2; ++rr)
#pragma unroll
                for (int q = 0; q < 8; ++q) acc[rr][q] = (f32x4){0.f, 0.f, 0.f, 0.f};
#pragma unroll 1
            for (int q = 0; q < 4; ++q) {
                __syncthreads();
#pragma unroll
                for (int j = 0; j < 8; ++j) { const int idx = tid + 512 * j, row = idx >> 3, ch = idx & 7;
                    *(LAS f32x4*)(lds + row * RT_STRIDE + ch * 16) = *(const f32x4*)(w_router + (size_t)(512 * q + row) * kE + ch * 4); }
                f32x2 yq[2][4];
#pragma unroll
                for (int ii = 0; ii < 4; ++ii) { const int n = 2 * lane + 128 * (4 * q + ii);
                    const f32x2 w = *(const f32x2*)(nw + n), sh = *(const f32x2*)(mod + b * 6 * kD + 3 * kD + n), sc = *(const f32x2*)(mod + b * 6 * kD + 4 * kD + n);
#pragma unroll
                    for (int rr = 0; rr < 2; ++rr) { const f32x2 v = *(const f32x2*)(x1 + (size_t)(t0 + rr) * kD + n); yq[rr][ii] = v * rs[rr] * w * (1.f + sc) + sh;
                        *(unsigned*)(h2 + (size_t)(t0 + rr) * kD + n) = pk_bf16(yq[rr][ii][0], yq[rr][ii][1]); } }
                __syncthreads();
#pragma unroll
                for (int ii = 0; ii < 4; ++ii)
#pragma unroll
                    for (int e = 0; e < 2; ++e) { const LAS unsigned char* wp = lds + (2 * lane + 128 * ii + e) * RT_STRIDE;
#pragma unroll
                        for (int ch = 0; ch < 8; ++ch) { const f32x4 wv = *(const LAS f32x4*)(wp + ch * 16);
                            acc[0][ch] += yq[0][ii][e] * wv; acc[1][ch] += yq[1][ii][e] * wv; } }
            }
#pragma unroll
            for (int rr = 0; rr < 2; ++rr) {
                float v16[16], v8[8], v4[4], v2[2], v1;
                { const bool up = lane & 32;
#pragma unroll
                  for (int j = 0; j < 16; ++j) { const float lo = acc[rr][j >> 2][j & 3], hi = acc[rr][4 + (j >> 2)][j & 3]; const float send = up ? lo : hi, keep = up ? hi : lo; v16[j] = keep + __shfl_xor(send, 32); } }
                { const bool up = lane & 16;
#pragma unroll
                  for (int j = 0; j < 8; ++j) { const float send = up ? v16[j] : v16[j + 8], keep = up ? v16[j + 8] : v16[j]; v8[j] = keep + __shfl_xor(send, 16); } }
                { const bool up = lane & 8;
#pragma unroll
                  for (int j = 0; j < 4; ++j) { const float send = up ? v8[j] : v8[j + 4], keep = up ? v8[j + 4] : v8[j]; v4[j] = keep + __shfl_xor(send, 8); } }
                { const bool up = lane & 4;
#pragma unroll
                  for (int j = 0; j < 2; ++j) { const float send = up ? v4[j] : v4[j + 2], keep = up ? v4[j + 2] : v4[j]; v2[j] = keep + __shfl_xor(send, 4); } }
                { const bool up = lane & 2; const float send = up ? v2[0] : v2[1], keep = up ? v2[1] : v2[0]; v1 = keep + __shfl_xor(send, 2); }
                v1 += __shfl_xor(v1, 1);
                const int e_mine = (lane >> 1) & 31;
                float mine = (lane & 1) ? -3.4e38f : v1 + b_router[e_mine];
                int idx[4]; float val[4];
#pragma unroll
                for (int k = 0; k < 4; ++k) { float bv = mine; int bi = e_mine + ((lane & 1) << 6);
#pragma unroll
                    for (int o = 32; o > 0; o >>= 1) { const float ov = __shfl_xor(bv, o); const int oi = __shfl_xor(bi, o); if (ov > bv || (ov == bv && oi < bi)) { bv = ov; bi = oi; } }
                    idx[k] = bi; val[k] = bv; if (!(lane & 1) && e_mine == bi) mine = -3.4e38f; }
                if (lane == 0) { const int t = t0 + rr; float ex[4], sum = 0.f;
#pragma unroll
                    for (int k = 0; k < 4; ++k) { ex[k] = __expf(val[k] - val[0]); sum += ex[k]; }
                    const float inv = 1.f / sum;
#pragma unroll
                    for (int k = 0; k < 4; ++k) { gates[t * 4 + k] = ex[k] * inv; pair_e[t * 4 + k] = idx[k];
                        const unsigned pos = atomicAdd(&ctrl[CT_CNT + idx[k]], 1u); pair_p[t * 4 + k] = (int)pos; list[(size_t)idx[k] * kT + pos] = t; } }
            }
        }
    }
}

__device__ __forceinline__ void final_phase(const float* __restrict__ x1, const float* __restrict__ mod, const float* __restrict__ gates, const int* __restrict__ pair_e, const int* __restrict__ pair_p,
                                            const MoeTab M, const bf16_t* __restrict__ yp, float* __restrict__ out, int G, int c) {
    const int wid = threadIdx.x >> 6, lane = threadIdx.x & 63;
    for (int t = c * 8 + wid; t < kT; t += G * 8) {
        const int b = t / kS; float gk[4]; const bf16_t* rp[4];
#pragma unroll
        for (int k = 0; k < 4; ++k) { gk[k] = gates[t * 4 + k]; const int e = pair_e[t * 4 + k];
            rp[k] = yp + (size_t)(M.t[32 + e] + pair_p[t * 4 + k]) * kD + lane * 8; }
#pragma unroll
        for (int j = 0; j < 4; ++j) { f32x4 y0 = {0.f, 0.f, 0.f, 0.f}, y1 = y0;
#pragma unroll
            for (int k = 0; k < 4; ++k) { const u32x4 v = *(const u32x4*)(rp[k] + 512 * j);
                y0 += gk[k] * (f32x4){bflo(v.x), bfhi(v.x), bflo(v.y), bfhi(v.y)}; y1 += gk[k] * (f32x4){bflo(v.z), bfhi(v.z), bflo(v.w), bfhi(v.w)}; }
            const size_t o = (size_t)t * kD + lane * 8 + 512 * j; const float* gp = mod + b * 6 * kD + 5 * kD + lane * 8 + 512 * j;
            *(f32x4*)(out + o) = *(const f32x4*)(x1 + o) + *(const f32x4*)gp * y0; *(f32x4*)(out + o + 4) = *(const f32x4*)(x1 + o + 4) + *(const f32x4*)(gp + 4) * y1; }
    }
}

struct MegaArgs { const float* in[18]; float* out; unsigned char* ws; int ph_lo, ph_hi; };
constexpr int NPHASE = 10;
__global__ void __launch_bounds__(512, 2) mega(MegaArgs a) {
    extern __shared__ __attribute__((aligned(16))) unsigned char lds_raw[];
    LAS unsigned char* lds = (LAS unsigned char*)lds_raw;
    unsigned char* ws = a.ws;
    const int lo = a.ph_lo, hi = a.ph_hi;
#define IN(k) (lo <= (k) && (k) < hi)
#define SEAM(k) do { if (IN(k) && IN((k) + 1)) xcd_barrier(bar); } while (0)
    const int G = gridDim.x, c = blockIdx.x;
    unsigned* ctrl = (unsigned*)(ws + WS_CTRL);
    if (threadIdx.x == 0) *(LAS u32x4*)(lds + fg::MISC_OFF) = (u32x4){0u, 0u, 0u, 0u};
    __syncthreads();
    XcdBarrier bar; bar.bar = ctrl; bar.x = 0; bar.st = (volatile LAS unsigned*)(lds + fg::MISC_OFF);
    if (hi - lo > 1) bar = xcd_barrier_post(ctrl, (volatile LAS unsigned*)(lds + fg::MISC_OFF));
    float* mod = (float*)(ws + WS_MOD);
    if (IN(0)) {
        ada_phase(lds, a.in[1], a.in[4], a.in[5], mod, G, c);
        const size_t gtid = (size_t)blockIdx.x * 512 + threadIdx.x, gstride = (size_t)G * 512;
        convert_seg(a.in[6], (bf16_t*)(ws + WS_WIN), (size_t)kD * kNPROJ / 8, gtid, gstride);
        convert_seg(a.in[11], (bf16_t*)(ws + WS_WO), (size_t)kD * kD / 8, gtid, gstride);
        { const f32x4* s4 = (const f32x4*)a.in[9]; const f32x4* sc4 = (const f32x4*)a.in[10]; u32x4* d4 = (u32x4*)(ws + WS_WPL);
          for (size_t i = gtid; i < (size_t)4 * kPG * kPG / 8; i += gstride) { const int g = (int)(i >> 13), n8 = (int)(i & 31);
              const f32x4 sa = sc4[g * 64 + n8 * 2], sb = sc4[g * 64 + n8 * 2 + 1]; const f32x4 a0 = s4[2 * i] * sa, b0 = s4[2 * i + 1] * sb;
              u32x4 w; w.x = pk_bf16(a0[0], a0[1]); w.y = pk_bf16(a0[2], a0[3]); w.z = pk_bf16(b0[0], b0[1]); w.w = pk_bf16(b0[2], b0[3]); d4[i] = w; } }
        convert_seg(a.in[14], (bf16_t*)(ws + WS_WE1), (size_t)kE * kD * 2 * kDFF / 8, gtid, gstride);
        convert_seg(a.in[16], (bf16_t*)(ws + WS_WE2), (size_t)kE * kDFF * kD / 8, gtid, gstride);
    }
    SEAM(0);
    if (IN(1)) norm1_phase(a.in[0], a.in[2], mod, (bf16_t*)(ws + WS_H), G, c);
    SEAM(1);
    if (IN(2)) { JobInProj J; J.A = (const char*)(ws + WS_H); J.lda2 = kD * 2; J.ldb2 = kNPROJ * 2; J.bhalf2 = 256; J.K = kD; J.list = nullptr;
        J.B = (const char*)(ws + WS_WIN); J.out = (bf16_t*)(ws + WS_PROJ); J.S.init(kT, kNPROJ, G, c); fg::gemm_phase(lds, J); }
    SEAM(2);
    if (IN(3)) { at::attn_phase(lds, (const bf16_t*)(ws + WS_PROJ), a.in[7], a.in[8], (bf16_t*)(ws + WS_CAT), G, c);
        pool_p_phase((const bf16_t*)(ws + WS_PROJ), (bf16_t*)(ws + WS_P), G, c); }
    SEAM(3);
    if (IN(4)) { JobPool J; J.A = (const char*)(ws + WS_P); J.lda2 = kPW * 2; J.ldb2 = kPG * 2; J.bhalf2 = 256; J.K = kPG; J.list = nullptr;
        J.B = (const char*)(ws + WS_WPL); J.cat = (bf16_t*)(ws + WS_CAT); J.G = G; J.c = c; fg::gemm_phase(lds, J); }
    SEAM(4);
    if (IN(5)) { JobOutProj J; J.A = (const char*)(ws + WS_CAT); J.lda2 = kD * 2; J.ldb2 = kD * 2; J.bhalf2 = 256; J.K = kD; J.list = nullptr;
        J.B = (const char*)(ws + WS_WO); J.x = a.in[0]; J.mod = mod; J.x1 = (float*)(ws + WS_X1); J.S.init(kT, kD, G, c); fg::gemm_phase(lds, J); }
    SEAM(5);
    if (IN(6)) norm2_router_phase(lds, (const float*)(ws + WS_X1), a.in[3], mod, a.in[12], a.in[13], (bf16_t*)(ws + WS_H2), (float*)(ws + WS_GATES), (int*)(ws + WS_PAIRE), (int*)(ws + WS_PAIRP),
                                  (int*)(ws + WS_LIST), ctrl, G, c);
    SEAM(6);
    if (IN(7)) { JobMoe1 J; J.A = (const char*)(ws + WS_H2); J.lda2 = kD * 2; J.ldb2 = 2 * kDFF * 2; J.bhalf2 = kDFF * 2; J.K = kD; J.list = (const int*)(ws + WS_LIST);
        J.B = (const char*)(ws + WS_WE1); J.b_in = a.in[15]; J.act = (bf16_t*)(ws + WS_ACT); J.M = moe_tables(lds, ctrl, kDFF / 128); J.G = G; J.c = c; fg::gemm_phase(lds, J); }
    SEAM(7);
    if (IN(8)) { JobMoe2 J; J.A = (const char*)(ws + WS_ACT); J.lda2 = kDFF * 2; J.ldb2 = kD * 2; J.bhalf2 = 256; J.K = kDFF; J.list = nullptr;
        J.B = (const char*)(ws + WS_WE2); J.b_out = a.in[17]; J.yp = (bf16_t*)(ws + WS_YP); J.M = moe_tables(lds, ctrl, kD / 256); J.G = G; J.c = c; fg::gemm_phase(lds, J); }
    SEAM(8);
    if (IN(9)) final_phase((const float*)(ws + WS_X1), mod, (const float*)(ws + WS_GATES), (const int*)(ws + WS_PAIRE), (const int*)(ws + WS_PAIRP), moe_tables(lds, ctrl, 1), (const bf16_t*)(ws + WS_YP), a.out, G, c);
#undef IN
#undef SEAM
}

#ifndef N_LAUNCHES
#define N_LAUNCHES 1
#endif
extern "C" void kernel_launch(void* const* d_in, const int* in_sizes, int n_in, void* d_out, int out_size, void* d_ws, size_t ws_size, hipStream_t stream) {
    static int grid = 0;
    if (grid == 0) {
        int dev = 0, cus = 0;
        (void)hipGetDevice(&dev); (void)hipDeviceGetAttribute(&cus, hipDeviceAttributeMultiprocessorCount, dev);
        (void)hipFuncSetAttribute((const void*)mega, hipFuncAttributeMaxDynamicSharedMemorySize, fg::LDS_BYTES);
        grid = cus > 0 ? cus : 256;
    }
    MegaArgs a{}; for (int i = 0; i < 18; ++i) a.in[i] = (const float*)d_in[i]; a.out = (float*)d_out; a.ws = (unsigned char*)d_ws;
    (void)hipMemsetAsync((char*)d_ws + WS_CTRL, 0, 65536, stream);
    if (N_LAUNCHES == 1) { a.ph_lo = 0; a.ph_hi = NPHASE; hipLaunchKernelGGL(mega, dim3(grid), dim3(512), fg::LDS_BYTES, stream, a); }
    else for (int p = 0; p < NPHASE; ++p) { a.ph_lo = p; a.ph_hi = p + 1; hipLaunchKernelGGL(mega, dim3(grid), dim3(512), fg::LDS_BYTES, stream, a); }
}
```

```cpp
#include <hip/hip_runtime.h>
#include <stdint.h>

constexpr int kB = 4, kS = 2048, kD = 2048, kT = kB * kS;
constexpr int kHD = 128, kNH = 8, kSB = 1024, kPW = 1024, kPG = 256;
constexpr int kNPROJ = 4096, kE = 32, kTOPK = 4, kDFF = 2048;
constexpr float kEPS = 1e-6f;
constexpr int kMaxSlots = 160 * 256;

typedef unsigned short bf16_t;
__device__ __forceinline__ bf16_t f2bf(float f) { unsigned u = __float_as_uint(f); u += 0x7FFFu + ((u >> 16) & 1u); return (bf16_t)(u >> 16); }
__device__ __forceinline__ float bf2f(bf16_t b) { return __uint_as_float(((unsigned)b) << 16); }

constexpr size_t WS_CTRL   = 0;
constexpr size_t WS_MOD    = 65536;
constexpr size_t WS_H      = WS_MOD + (size_t)4 * 12288 * 4;
constexpr size_t WS_PROJ   = WS_H + (size_t)kT * kD * 2;
constexpr size_t WS_CAT    = WS_PROJ + (size_t)kT * kNPROJ * 2;
constexpr size_t WS_P      = WS_CAT + (size_t)kT * kD * 2;
constexpr size_t WS_X1     = WS_P + (size_t)kT * kPW * 2;
constexpr size_t WS_H2     = WS_X1 + (size_t)kT * kD * 4;
constexpr size_t WS_GATES  = WS_H2 + (size_t)kT * kD * 2;
constexpr size_t WS_PAIRE  = WS_GATES + (size_t)kT * 4 * 4;
constexpr size_t WS_PAIRP  = WS_PAIRE + (size_t)kT * 4 * 4;
constexpr size_t WS_LIST   = WS_PAIRP + (size_t)kT * 4 * 4;
constexpr size_t WS_ACT    = WS_LIST + (size_t)kE * kT * 4;
constexpr size_t WS_YP     = WS_ACT + (size_t)kMaxSlots * kDFF * 2;
constexpr size_t WS_END    = WS_YP + (size_t)kMaxSlots * kD * 2;
constexpr int CT_CNT = 4096;
constexpr int CT_ROWBASE = 4160;

__global__ void k_ada(const float* __restrict__ c, const float* __restrict__ w_ada, const float* __restrict__ b_ada, float* __restrict__ mod) {
    __shared__ float ca[kB][kD];
    for (int i = threadIdx.x; i < kB * kD; i += blockDim.x) { const float v = c[i]; ca[i / kD][i % kD] = v / (1.f + __expf(-v)); }
    __syncthreads();
    const int n = blockIdx.x * blockDim.x + threadIdx.x;
    float a0 = 0.f, a1 = 0.f, a2 = 0.f, a3 = 0.f;
    for (int k = 0; k < kD; ++k) { const float w = w_ada[(size_t)k * (6 * kD) + n]; a0 += ca[0][k] * w; a1 += ca[1][k] * w; a2 += ca[2][k] * w; a3 += ca[3][k] * w; }
    const float bb = b_ada[n];
    mod[0 * 6 * kD + n] = a0 + bb; mod[1 * 6 * kD + n] = a1 + bb; mod[2 * 6 * kD + n] = a2 + bb; mod[3 * 6 * kD + n] = a3 + bb;
}

__device__ __forceinline__ float block_sum_256(float v, float* red) {
    for (int o = 32; o > 0; o >>= 1) v += __shfl_down(v, o);
    const int w = threadIdx.x >> 6, l = threadIdx.x & 63;
    __syncthreads();
    if (l == 0) red[w] = v;
    __syncthreads();
    return red[0] + red[1] + red[2] + red[3];
}
__global__ void k_norm_mod(const float* __restrict__ x, const float* __restrict__ nw, const float* __restrict__ mod, int shift_off, int scale_off, bf16_t* __restrict__ out) {
    __shared__ float red[4];
    const int t = blockIdx.x, b = t / kS;
    const float* xr = x + (size_t)t * kD;
    float v[8]; float ss = 0.f;
    for (int i = 0; i < 8; ++i) { v[i] = xr[threadIdx.x + 256 * i]; ss += v[i] * v[i]; }
    ss = block_sum_256(ss, red);
    const float r = rsqrtf(ss / kD + kEPS);
    for (int i = 0; i < 8; ++i) { const int n = threadIdx.x + 256 * i;
        const float y = v[i] * r * nw[n] * (1.f + mod[b * 6 * kD + scale_off + n]) + mod[b * 6 * kD + shift_off + n];
        out[(size_t)t * kD + n] = f2bf(y); }
}

struct GemmArgs { const bf16_t* A; const float* B; int lda; int ldb; int K; int pad; };
template <class RowFn, class Epi>
__global__ void __launch_bounds__(256) k_gemm_naive(GemmArgs g, RowFn rowfn, Epi epi) {
    __shared__ float As[16][68], Bs[16][64];
    const int z = blockIdx.z;
    int mrows; const bf16_t* Abase; const float* Bbase;
    if (!rowfn.setup(z, g, mrows, Abase, Bbase)) return;
    const int m0 = blockIdx.y * 64, n0 = blockIdx.x * 64;
    if (m0 >= mrows) return;
    const int tid = threadIdx.x, ty = tid >> 4, tx = tid & 15;
    const int ar = tid >> 2, ak = (tid & 3) * 4;
    const int bk = tid >> 4, bn = (tid & 15) * 4;
    const long arow = rowfn.row(z, m0 + ar, mrows);
    const bf16_t* ap = Abase + arow * (long)g.lda + ak;
    const float* bp = Bbase + (size_t)bk * g.ldb + n0 + bn;
    float acc[4][4] = {};
    for (int k0 = 0; k0 < g.K; k0 += 16) {
        const uint2 av = *(const uint2*)(ap + k0);
        const float4 bv = *(const float4*)(bp + (size_t)k0 * g.ldb);
        __syncthreads();
        As[ak + 0][ar] = __uint_as_float(av.x << 16); As[ak + 1][ar] = __uint_as_float(av.x & 0xFFFF0000u);
        As[ak + 2][ar] = __uint_as_float(av.y << 16); As[ak + 3][ar] = __uint_as_float(av.y & 0xFFFF0000u);
        *(float4*)&Bs[bk][bn] = bv;
        __syncthreads();
#pragma unroll
        for (int k = 0; k < 16; ++k) {
            const float4 a4 = *(const float4*)&As[k][ty * 4]; const float4 b4 = *(const float4*)&Bs[k][tx * 4];
            const float a[4] = {a4.x, a4.y, a4.z, a4.w}, b[4] = {b4.x, b4.y, b4.z, b4.w};
#pragma unroll
            for (int i = 0; i < 4; ++i)
#pragma unroll
                for (int j = 0; j < 4; ++j) acc[i][j] += a[i] * b[j];
        }
    }
#pragma unroll
    for (int i = 0; i < 4; ++i)
#pragma unroll
        for (int j = 0; j < 4; ++j) epi(z, m0 + ty * 4 + i, n0 + tx * 4 + j, acc[i][j], mrows);
}
struct RowDense { int M;
    __device__ bool setup(int, const GemmArgs& g, int& mrows, const bf16_t*& A, const float*& B) const { mrows = M; A = g.A; B = g.B; return true; }
    __device__ long row(int, int r, int) const { return r; } };
struct EpiStoreBf16 { bf16_t* C; int ldc; int pad;
    __device__ void operator()(int, int r, int c, float v, int) const { C[(size_t)r * ldc + c] = f2bf(v); } };
struct EpiOutProj { const float* x; const float* mod; float* x1;
    __device__ void operator()(int, int r, int c, float v, int) const { const int b = r / kS; x1[(size_t)r * kD + c] = x[(size_t)r * kD + c] + mod[b * 6 * kD + 2 * kD + c] * v; } };
struct RowPool { int pad; __device__ bool setup(int z, const GemmArgs& g, int& mrows, const bf16_t*& A, const float*& B) const { mrows = kT; A = g.A + z * kPG; B = g.B + (size_t)z * kPG * kPG; return true; }
    __device__ long row(int, int r, int) const { return r; } };
struct EpiPool { const float* pool_scale; bf16_t* cat;
    __device__ void operator()(int z, int r, int c, float v, int) const { cat[(size_t)r * kD + kSB + z * kPG + c] = f2bf(v * pool_scale[z * kPG + c]); } };

__global__ void __launch_bounds__(256) k_attn_naive(const bf16_t* __restrict__ proj, const float* __restrict__ qw, const float* __restrict__ kw, bf16_t* __restrict__ cat) {
    __shared__ float qs[4][kHD];
    const int w = threadIdx.x >> 6, lane = threadIdx.x & 63;
    const int rowid = blockIdx.x * 4 + w;
    const int t = rowid % kS, bh = rowid / kS, h = bh % kNH, b = bh / kNH;
    const bf16_t* qrow = proj + (size_t)(b * kS + t) * kNPROJ + h * kHD;
    float q0 = bf2f(qrow[lane]), q1 = bf2f(qrow[lane + 64]);
    float ss = q0 * q0 + q1 * q1;
    for (int o = 32; o > 0; o >>= 1) ss += __shfl_xor(ss, o);
    const float rq = rsqrtf(ss / kHD + kEPS) * 0.08838834764831845f;
    qs[w][lane] = q0 * rq * qw[lane] * kw[lane]; qs[w][lane + 64] = q1 * rq * qw[lane + 64] * kw[lane + 64];
    __syncthreads();
    float o0 = 0.f, o1 = 0.f, carry = 0.f;
    for (int jb = ((t - 1) >> 6) << 6; jb >= 0 && t > 0; jb -= 64) {
        const int j = jb + lane; const bool valid = j < t;
        float z = 0.f, sp = 0.f;
        if (valid) {
            const bf16_t* krow = proj + (size_t)(b * kS + j) * kNPROJ + kSB + h * kHD;
            float dot = 0.f, kss = 0.f;
            for (int d = 0; d < kHD; d += 8) { const uint4 kv = *(const uint4*)(krow + d); const unsigned u[4] = {kv.x, kv.y, kv.z, kv.w};
#pragma unroll
                for (int e = 0; e < 4; ++e) { const float k0 = __uint_as_float(u[e] << 16), k1 = __uint_as_float(u[e] & 0xFFFF0000u);
                    dot += qs[w][d + 2 * e] * k0 + qs[w][d + 2 * e + 1] * k1; kss += k0 * k0 + k1 * k1; } }
            z = dot * rsqrtf(kss / kHD + kEPS);
            sp = (z > 15.f) ? z : log1pf(__expf(z));
        }
        float s = sp;
        for (int o = 1; o < 64; o <<= 1) { const float v = __shfl_down(s, o); if (lane + o < 64) s += v; }
        const float a = valid ? __expf(z - (carry + s)) : 0.f;
        carry += __shfl(s, 0);
        const int jmax = min(64, t - jb);
        const bf16_t* vb = proj + (size_t)(b * kS + jb) * kNPROJ + 2 * kSB + h * kHD;
        for (int l = 0; l < jmax; ++l) { const float al = __shfl(a, l); o0 += al * bf2f(vb[(size_t)l * kNPROJ + lane]); o1 += al * bf2f(vb[(size_t)l * kNPROJ + lane + 64]); }
    }
    bf16_t* orow = cat + (size_t)(b * kS + t) * kD + h * kHD;
    orow[lane] = f2bf(o0); orow[lane + 64] = f2bf(o1);
}

__global__ void k_pool_p(const bf16_t* __restrict__ proj, bf16_t* __restrict__ p) {
    const int idx = blockIdx.x * blockDim.x + threadIdx.x;
    const int c = idx & (kPW - 1), t = idx >> 10, s = t % kS, g = c >> 8;
    const int w = 2 << g;
    const int cnt = min(s + 1, w);
    float sum = 0.f;
    for (int i = 0; i < cnt; ++i) sum += bf2f(proj[(size_t)(t - i) * kNPROJ + 3 * kSB + c]);
    const float u = bf2f(proj[(size_t)t * kNPROJ + 3 * kSB + c]);
    p[(size_t)t * kPW + c] = f2bf(sum / (float)cnt - u);
}

__global__ void __launch_bounds__(256) k_norm2_router(const float* __restrict__ x1, const float* __restrict__ nw, const float* __restrict__ mod,
                               const float* __restrict__ w_router, const float* __restrict__ b_router, unsigned char* __restrict__ h2,
                               float* __restrict__ gates, int* __restrict__ pair_e, int* __restrict__ pair_p, int* __restrict__ list, unsigned* __restrict__ ctrl) {
    __shared__ float red[4]; __shared__ float lg[4][kE];
    const int t = blockIdx.x, b = t / kS;
    const float* xr = x1 + (size_t)t * kD;
    float v[8]; float ss = 0.f;
    for (int i = 0; i < 8; ++i) { v[i] = xr[threadIdx.x + 256 * i]; ss += v[i] * v[i]; }
    ss = block_sum_256(ss, red);
    const float r = rsqrtf(ss / kD + kEPS);
    float part[kE];
#pragma unroll
    for (int e = 0; e < kE; ++e) part[e] = 0.f;
    for (int i = 0; i < 8; ++i) { const int n = threadIdx.x + 256 * i;
        const float y = v[i] * r * nw[n] * (1.f + mod[b * 6 * kD + 4 * kD + n]) + mod[b * 6 * kD + 3 * kD + n];
        h2[(size_t)t * kD + n] = f2bf(y);
        const float4* wr = (const float4*)(w_router + (size_t)n * kE);
#pragma unroll
        for (int e4 = 0; e4 < 8; ++e4) { const float4 w4 = wr[e4]; part[e4 * 4] += y * w4.x; part[e4 * 4 + 1] += y * w4.y; part[e4 * 4 + 2] += y * w4.z; part[e4 * 4 + 3] += y * w4.w; } }
    const int wv = threadIdx.x >> 6, l = threadIdx.x & 63;
#pragma unroll
    for (int e = 0; e < kE; ++e) { float s = part[e]; for (int o = 32; o > 0; o >>= 1) s += __shfl_down(s, o); if (l == 0) lg[wv][e] = s; }
    __syncthreads();
    if (threadIdx.x < 64) {
        const int e = l & 31;
        float mine = lg[0][e] + lg[1][e] + lg[2][e] + lg[3][e] + b_router[e];
        if (l >= 32) mine = -3.4e38f;
        int idx[4]; float val[4];
#pragma unroll
        for (int k = 0; k < 4; ++k) {
            float bv = mine; int bi = l;
            for (int o = 32; o > 0; o >>= 1) { const float ov = __shfl_xor(bv, o); const int oi = __shfl_xor(bi, o); if (ov > bv || (ov == bv && oi < bi)) { bv = ov; bi = oi; } }
            idx[k] = bi; val[k] = bv; if (l == bi) mine = -3.4e38f;
        }
        if (l == 0) {
            float ex[4], sum = 0.f;
#pragma unroll
            for (int k = 0; k < 4; ++k) { ex[k] = __expf(val[k] - val[0]); sum += ex[k]; }
#pragma unroll
            for (int k = 0; k < 4; ++k) { gates[t * 4 + k] = ex[k] / sum; pair_e[t * 4 + k] = idx[k];
                const unsigned pos = atomicAdd(&ctrl[CT_CNT + idx[k]], 1u); pair_p[t * 4 + k] = (int)pos; list[(size_t)idx[k] * kT + pos] = t; }
        }
    }
}
__global__ void k_moe_plan(unsigned* ctrl) {
    if (threadIdx.x == 0) { unsigned base = 0; for (int e = 0; e < kE; ++e) { ctrl[CT_ROWBASE + e] = base; base += ((ctrl[CT_CNT + e] + 255u) / 256u) * 256u; } ctrl[CT_ROWBASE + kE] = base; }
}

__global__ void __launch_bounds__(256) k_moe1_naive(const bf16_t* __restrict__ h2, const float* __restrict__ w_in, const float* __restrict__ b_in, const int* __restrict__ list,
                                                    const unsigned* __restrict__ ctrl, bf16_t* __restrict__ act) {
    __shared__ float As[16][68], Bg[16][64], Bl[16][64];
    const int e = blockIdx.z; const int mrows = (int)ctrl[CT_CNT + e];
    const int m0 = blockIdx.y * 64, n0 = blockIdx.x * 64;
    if (m0 >= mrows) return;
    const int rowbase = (int)ctrl[CT_ROWBASE + e];
    const int tid = threadIdx.x, ty = tid >> 4, tx = tid & 15;
    const int ar = tid >> 2, ak = (tid & 3) * 4, bk = tid >> 4, bn = (tid & 15) * 4;
    const int tok = list[(size_t)e * kT + min(m0 + ar, mrows - 1)];
    const bf16_t* ap = h2 + (size_t)tok * kD + ak;
    const float* bp = w_in + (size_t)e * kD * 2 * kDFF + (size_t)bk * (2 * kDFF) + n0 + bn;
    float ag[4][4] = {}, al[4][4] = {};
    for (int k0 = 0; k0 < kD; k0 += 16) {
        const uint2 av = *(const uint2*)(ap + k0);
        const float4 g4 = *(const float4*)(bp + (size_t)k0 * (2 * kDFF)); const float4 l4 = *(const float4*)(bp + (size_t)k0 * (2 * kDFF) + kDFF);
        __syncthreads();
        As[ak + 0][ar] = __uint_as_float(av.x << 16); As[ak + 1][ar] = __uint_as_float(av.x & 0xFFFF0000u);
        As[ak + 2][ar] = __uint_as_float(av.y << 16); As[ak + 3][ar] = __uint_as_float(av.y & 0xFFFF0000u);
        *(float4*)&Bg[bk][bn] = g4; *(float4*)&Bl[bk][bn] = l4;
        __syncthreads();
#pragma unroll
        for (int k = 0; k < 16; ++k) {
            const float4 a4 = *(const float4*)&As[k][ty * 4]; const float4 g44 = *(const float4*)&Bg[k][tx * 4]; const float4 l44 = *(const float4*)&Bl[k][tx * 4];
            const float a[4] = {a4.x, a4.y, a4.z, a4.w}, gg[4] = {g44.x, g44.y, g44.z, g44.w}, ll[4] = {l44.x, l44.y, l44.z, l44.w};
#pragma unroll
            for (int i = 0; i < 4; ++i)
#pragma unroll
                for (int j = 0; j < 4; ++j) { ag[i][j] += a[i] * gg[j]; al[i][j] += a[i] * ll[j]; }
        }
    }
    for (int i = 0; i < 4; ++i) { const int r = m0 + ty * 4 + i; if (r >= mrows) continue;
        for (int j = 0; j < 4; ++j) { const int c = n0 + tx * 4 + j;
            float gv = ag[i][j] + b_in[(size_t)e * 2 * kDFF + c], lv = al[i][j] + b_in[(size_t)e * 2 * kDFF + kDFF + c];
            gv = fminf(gv, 7.f); lv = fminf(fmaxf(lv, -7.f), 7.f);
            const float a = gv / (1.f + __expf(-1.702f * gv)) * (lv + 1.f);
            act[(size_t)(rowbase + r) * kDFF + c] = f2bf(a); } }
}
struct RowMoe2 { const unsigned* ctrl; const float* w;
    __device__ bool setup(int z, const GemmArgs& g, int& mrows, const bf16_t*& A, const float*& B) const { mrows = (int)ctrl[CT_CNT + z]; A = g.A + (size_t)ctrl[CT_ROWBASE + z] * kDFF; B = w + (size_t)z * kDFF * kD; return mrows > 0; }
    __device__ long row(int, int r, int mrows) const { return r < mrows ? r : mrows - 1; } };
struct EpiMoe2 { const unsigned* ctrl; const float* b_out; bf16_t* yp;
    __device__ void operator()(int z, int r, int c, float v, int mrows) const { if (r < mrows) yp[(size_t)(ctrl[CT_ROWBASE + z] + r) * kD + c] = f2bf(v + b_out[(size_t)z * kD + c]); } };

__global__ void k_final(const float* __restrict__ x1, const float* __restrict__ mod, const float* __restrict__ gates, const int* __restrict__ pair_e, const int* __restrict__ pair_p,
                        const unsigned* __restrict__ ctrl, const bf16_t* __restrict__ yp, float* __restrict__ out) {
    const int t = blockIdx.x, b = t / kS;
    float gk[4]; size_t rows[4];
#pragma unroll
    for (int k = 0; k < 4; ++k) { gk[k] = gates[t * 4 + k]; rows[k] = (size_t)(ctrl[CT_ROWBASE + pair_e[t * 4 + k]] + (unsigned)pair_p[t * 4 + k]); }
    for (int n = threadIdx.x; n < kD; n += blockDim.x) {
        float y = 0.f;
#pragma unroll
        for (int k = 0; k < 4; ++k) y += gk[k] * bf2f(yp[rows[k] * kD + n]);
        out[(size_t)t * kD + n] = x1[(size_t)t * kD + n] + mod[b * 6 * kD + 5 * kD + n] * y;
    }
}


#define LAS __attribute__((address_space(3)))
typedef short bf16x8 __attribute__((ext_vector_type(8)));
typedef short s16x4 __attribute__((ext_vector_type(4)));
typedef float f32x4 __attribute__((ext_vector_type(4)));
typedef float f32x2 __attribute__((ext_vector_type(2)));
typedef __bf16 bf16v2 __attribute__((ext_vector_type(2)));
typedef unsigned u32x2 __attribute__((ext_vector_type(2)));
typedef unsigned u32x4 __attribute__((ext_vector_type(4)));
typedef int i32x4 __attribute__((ext_vector_type(4)));
typedef int i32x8 __attribute__((ext_vector_type(8)));
__device__ __forceinline__ unsigned pk_bf16(float a, float b) { f32x2 v = {a, b}; bf16v2 r = __builtin_convertvector(v, bf16v2); return __builtin_bit_cast(unsigned, r); }

constexpr size_t WS_WIN  = WS_END;
constexpr size_t WS_WO   = WS_WIN + (size_t)kD * kNPROJ * 2;
constexpr size_t WS_WPL  = WS_WO + (size_t)kD * kD * 2;
constexpr size_t WS_WE1  = WS_WPL + (size_t)4 * kPG * kPG * 2;
constexpr size_t WS_WE2  = WS_WE1 + (size_t)kE * kD * 2 * kDFF * 2;
constexpr size_t WS_END2 = WS_WE2 + (size_t)kE * kDFF * kD * 2;

namespace fg {
constexpr int BM = 256, BK = 64, HALF = 128, HTB = 16384, STAGE_BYTES = 131072, NXCD = 8, WGM = 8;
constexpr int TAB_OFF = STAGE_BYTES;
constexpr int MISC_OFF = STAGE_BYTES + 2048;
constexpr int LDS_BYTES = STAGE_BYTES + 4096;
__device__ __forceinline__ int lds_byte(int r, int c) { const int st = (r >> 4) * 2 + (c >> 5), rr = r & 15, cc = c & 31, ob = rr * 64 + cc * 2; return st * 1024 + (ob ^ (((ob >> 9) & 1) << 5)); }
__device__ __forceinline__ void stage_rc(int b, int& R, int& C) { const int st = b / 1024, sb = b % 1024, swz = sb ^ (((sb >> 9) & 1) << 5); R = (st >> 1) * 16 + swz / 64; C = (st & 1) * 32 + (swz % 64) / 2; }

struct Unit { const char* bBase; int arow0; int nvalid; int e; int orow0; int ocol0; int acol2; };

struct StaticOrder {
    int nM, nN, nwg, G, c;
    __device__ void init(int M, int N, int G_, int c_) { nM = M / BM; nN = N / BM; nwg = nM * nN; G = G_; c = c_; }
    __device__ bool next(int i, int& pm, int& pn) const {
        const long L = (long)i * G + c; if (L >= nwg) return false;
        int wgid = (int)L; { const int q = nwg / NXCD, r = nwg % NXCD, xcd = wgid % NXCD, off = wgid / NXCD; wgid = (xcd < r ? xcd * (q + 1) : r * (q + 1) + (xcd - r) * q) + off; }
        const int nig = WGM * nN, gid = wgid / nig, fm = gid * WGM, gsz = (nM - fm) < WGM ? (nM - fm) : WGM;
        pm = fm + ((wgid % nig) % gsz); pn = (wgid % nig) / gsz; return true;
    }
};

template <int OFF> __device__ __forceinline__ s16x4 tr_read(unsigned addr) { s16x4 r; asm volatile("ds_read_b64_tr_b16 %0, %1 offset:%2" : "=&v"(r) : "v"(addr), "i"(OFF) : "memory"); return r; }
template <class Job>
__device__ __forceinline__ void gemm_phase(LAS unsigned char* lds, const Job& J) {
    const int tid = threadIdx.x, wid = __builtin_amdgcn_readfirstlane(tid >> 6), lane = tid & 63, wr = wid >> 2, wc = wid & 3, fr = lane & 15, fq = lane >> 4;
    const int nt = J.K / BK;
    unsigned voffB[2];
#pragma unroll
    for (int i = 0; i < 2; ++i) { int R, C; stage_rc(tid * 16 + i * 8192, R, C);
        const int b = tid * 16 + i * 8192, row = b >> 8, slot = (b >> 4) & 15, ch = slot ^ (((row & 3) << 2) | ((row >> 2) & 3)); voffB[i] = (unsigned)row * J.ldb2 + (unsigned)ch * 16u; }
    const size_t kstepB = (size_t)BK * J.ldb2;
    const unsigned ldsw = (unsigned)wid * 1024u;
    const int aoff = lds_byte(wr * 64 + fr, fq * 8);
    const int tq = (lane & 15) >> 2, tp = lane & 3;
    unsigned ba[2][2];
#pragma unroll
    for (int n = 0; n < 2; ++n)
#pragma unroll
        for (int t = 0; t < 2; ++t) ba[n][t] = (unsigned)(uintptr_t)lds + 256u * (8 * fq + 4 * t + tq) + 16u * ((4 * wc + 2 * n + (tp >> 1)) ^ ((tq << 2) | ((2 * fq + t) & 3))) + 8u * (tp & 1);
#define FG_SA(b, h) (65536 + ((b) * 2 + (h)) * HTB)
#define FG_SB(b, h) (((b) * 2 + (h)) * HTB)
#define FG_STAGE_A(bufoff, gk, vo) do { _Pragma("unroll") for (int _i = 0; _i < 2; ++_i) \
        __builtin_amdgcn_global_load_lds((const unsigned*)((gk) + (vo)[_i]), (LAS unsigned*)(lds + (bufoff) + ldsw + _i * 8192), 16, 0, 0); } while (0)
#define FG_STAGE_B(bufoff, gk) do { _Pragma("unroll") for (int _i = 0; _i < 2; ++_i) \
        __builtin_amdgcn_global_load_lds((const unsigned*)((gk) + voffB[_i]), (LAS unsigned*)(lds + (bufoff) + ldsw + _i * 8192), 16, 0, 0); } while (0)
#define FG_LDA(dst, b, h) do { _Pragma("unroll") for (int m = 0; m < 4; ++m) _Pragma("unroll") for (int k = 0; k < 2; ++k) dst[m][k] = *(const LAS bf16x8*)(lds + FG_SA(b, h) + aoff + m * 2048 + k * 1024); } while (0)
#define FG_LDB(dst, b, h) do { \
        dst##lo[0][0] = tr_read<FG_SB(b, h)>(ba[0][0]);        dst##hi[0][0] = tr_read<FG_SB(b, h)>(ba[0][1]); \
        dst##lo[0][1] = tr_read<FG_SB(b, h) + 8192>(ba[0][0]); dst##hi[0][1] = tr_read<FG_SB(b, h) + 8192>(ba[0][1]); \
        dst##lo[1][0] = tr_read<FG_SB(b, h)>(ba[1][0]);        dst##hi[1][0] = tr_read<FG_SB(b, h)>(ba[1][1]); \
        dst##lo[1][1] = tr_read<FG_SB(b, h) + 8192>(ba[1][0]); dst##hi[1][1] = tr_read<FG_SB(b, h) + 8192>(ba[1][1]); } while (0)
#define FG_PK(L, H) (bf16x8){L[0], L[1], L[2], L[3], H[0], H[1], H[2], H[3]}
#define FG_MMA(ai, bj, At, Bt) do { __builtin_amdgcn_s_setprio(1); _Pragma("unroll") for (int m = 0; m < 4; ++m) _Pragma("unroll") for (int n = 0; n < 2; ++n) _Pragma("unroll") for (int k = 0; k < 2; ++k) \
        acc[ai][bj][m][n] = __builtin_amdgcn_mfma_f32_16x16x32_bf16(FG_PK(Bt##lo[n][k], Bt##hi[n][k]), At[m][k], acc[ai][bj][m][n], 0, 0, 0); __builtin_amdgcn_s_setprio(0); } while (0)
#define FG_WAIT_V(n) asm volatile("s_waitcnt vmcnt(" #n ")" ::: "memory")
#define FG_WAIT_L(n) asm volatile("s_waitcnt lgkmcnt(" #n ")" ::: "memory")
#define FG_BAR __builtin_amdgcn_s_barrier()
#define FG_SCHED __builtin_amdgcn_sched_barrier(0)
#define FG_AOFF(dst, u, tabp) do { int _tz = threadIdx.x; asm volatile("" : "+v"(_tz)); _Pragma("unroll") for (int _i = 0; _i < 2; ++_i) { int _R, _C; stage_rc(_tz * 16 + _i * 8192, _R, _C); \
        _Pragma("unroll") for (int _h = 0; _h < 2; ++_h) { const int _r = _h * 128 + _R; \
        if (Job::GATHER) { const int _tok = (tabp)[_r < (u).nvalid ? _r : 0]; dst[_h][_i] = (unsigned)_tok * J.lda2 + (unsigned)(_C * 2); } \
        else dst[_h][_i] = (unsigned)((u).arow0 + _r) * J.lda2 + (unsigned)((u).acol2 + _C * 2); } } } while (0)
    Unit cur, nxt; int ui = 0;
    if (!J.next(0, cur)) return;
    LAS const int* tab0 = (LAS const int*)(lds + TAB_OFF);
    if (Job::GATHER) {
        if (wid == 0) __builtin_amdgcn_global_load_lds((const unsigned*)(J.list + cur.arow0 + lane * 4), (LAS unsigned*)(lds + TAB_OFF), 16, 0, 0);
        FG_WAIT_V(0); __syncthreads();
    }
    f32x4 acc[2][2][4][2];
#pragma unroll
    for (int a = 0; a < 2; ++a)
#pragma unroll
        for (int b = 0; b < 2; ++b)
#pragma unroll
            for (int m = 0; m < 4; ++m)
#pragma unroll
                for (int n = 0; n < 2; ++n) acc[a][b][m][n] = (f32x4){0.f, 0.f, 0.f, 0.f};
    bf16x8 At[4][2]; s16x4 B0lo[2][2], B0hi[2][2], B1lo[2][2], B1hi[2][2];
    unsigned vc[2][2];
    FG_AOFF(vc, cur, tab0);
    const char* const gA = J.A;
    const char* cB = cur.bBase;
    const unsigned bh2 = J.bhalf2;
    FG_STAGE_B(FG_SB(0, 0), cB); FG_STAGE_A(FG_SA(0, 0), gA, vc[0]); FG_STAGE_B(FG_SB(0, 1), cB + bh2); FG_STAGE_A(FG_SA(0, 1), gA, vc[1]);
    if (wr == 1) FG_BAR;
    FG_WAIT_V(4); FG_BAR;
    FG_STAGE_B(FG_SB(1, 0), cB + kstepB); FG_STAGE_A(FG_SA(1, 0), gA + 128, vc[0]); FG_STAGE_B(FG_SB(1, 1), cB + kstepB + bh2);
    FG_WAIT_V(6); FG_BAR;
    for (;;) {
        const bool has_next = J.next(ui + 1, nxt);
        if (!has_next) nxt = cur;
        if (Job::GATHER && has_next && wid == 0)
            __builtin_amdgcn_global_load_lds((const unsigned*)(J.list + nxt.arow0 + lane * 4), (LAS unsigned*)(lds + TAB_OFF + ((ui + 1) & 1) * 1024), 16, 0, 0);
        const char* nB = nxt.bBase;
        for (int t = 0; t < nt; t += 2) {
            const bool last = (t == nt - 2);
            const char* a1 = gA + (size_t)(t + 1) * 128;
            const char* a2 = last ? gA : gA + (size_t)(t + 2) * 128; const char* b2 = last ? nB : cB + (size_t)(t + 2) * kstepB;
            const char* a3 = a2 + 128; const char* b3 = b2 + kstepB;
            FG_LDB(B0, 0, 0); FG_SCHED; FG_LDA(At, 0, 0); FG_STAGE_A(FG_SA(1, 1), a1, vc[1]);
            if (last && has_next) { LAS const int* tabn = (LAS const int*)(lds + TAB_OFF + ((ui + 1) & 1) * 1024); FG_AOFF(vc, nxt, tabn); }
            FG_WAIT_L(8); FG_BAR; FG_WAIT_L(0); FG_SCHED; FG_MMA(0, 0, At, B0); FG_BAR; FG_SCHED;
            FG_LDB(B1, 0, 1); FG_STAGE_B(FG_SB(0, 0), b2);
            FG_BAR; FG_WAIT_L(0); FG_SCHED; FG_MMA(0, 1, At, B1); FG_BAR;
            FG_LDA(At, 0, 1); FG_STAGE_A(FG_SA(0, 0), a2, vc[0]);
            FG_BAR; FG_WAIT_L(0); FG_MMA(1, 0, At, B0); FG_BAR; FG_SCHED;
            FG_STAGE_B(FG_SB(0, 1), b2 + bh2);
            FG_WAIT_V(6); FG_BAR; FG_MMA(1, 1, At, B1); FG_BAR;
            FG_LDB(B0, 1, 0); FG_SCHED; FG_LDA(At, 1, 0); FG_STAGE_A(FG_SA(0, 1), a2, vc[1]);
            FG_WAIT_L(8); FG_BAR; FG_WAIT_L(0); FG_SCHED; FG_MMA(0, 0, At, B0); FG_BAR; FG_SCHED;
            FG_LDB(B1, 1, 1); FG_STAGE_B(FG_SB(1, 0), b3);
            FG_BAR; FG_WAIT_L(0); FG_SCHED; FG_MMA(0, 1, At, B1); FG_BAR;
            FG_LDA(At, 1, 1); FG_STAGE_A(FG_SA(1, 0), a3, vc[0]);
            FG_BAR; FG_WAIT_L(0); FG_MMA(1, 0, At, B0); FG_BAR; FG_SCHED;
            FG_STAGE_B(FG_SB(1, 1), b3 + bh2);
            FG_WAIT_V(6); FG_BAR; FG_MMA(1, 1, At, B1); FG_BAR;
        }
        J.epi(acc, cur, wr, wc, fr, fq);
        if (!has_next) break;
#pragma unroll
        for (int a = 0; a < 2; ++a)
#pragma unroll
            for (int b = 0; b < 2; ++b)
#pragma unroll
                for (int m = 0; m < 4; ++m)
#pragma unroll
                    for (int n = 0; n < 2; ++n) acc[a][b][m][n] = (f32x4){0.f, 0.f, 0.f, 0.f};
        cur = nxt; cB = nB; ++ui;
    }
    FG_WAIT_V(0);
    if (wr == 0) FG_BAR;
    FG_BAR;
}

#undef FG_SA
#undef FG_SB
#undef FG_STAGE_A
#undef FG_STAGE_B
#undef FG_LDA
#undef FG_LDB
#undef FG_MMA
#undef FG_WAIT_V
#undef FG_WAIT_L
#undef FG_BAR
#undef FG_SCHED
#undef FG_AOFF
template <class Job>
__device__ __forceinline__ void gemm_phase_f8(LAS unsigned char* lds, const Job& J) {
    const int tid = threadIdx.x, wid = __builtin_amdgcn_readfirstlane(tid >> 6), lane = tid & 63, wr = wid >> 2, wc = wid & 3, fr = lane & 15, fq = lane >> 4;
    const int nt = J.K / 128;
    unsigned voffB[2];
#pragma unroll
    for (int i = 0; i < 2; ++i) { int R, C; stage_rc(tid * 16 + i * 8192, R, C);
        voffB[i] = (unsigned)R * J.ldb2 + (unsigned)(C * 2); }
    const size_t kstepB = 128;
    const unsigned ldsw = (unsigned)wid * 1024u;
    const int aoff = lds_byte(wr * 64 + fr, fq * 8);
    const int boff = lds_byte(wc * 32 + fr, fq * 8);
#define FG_SA(b, h) (65536 + ((b) * 2 + (h)) * HTB)
#define FG_SB(b, h) (((b) * 2 + (h)) * HTB)
#define FG_STAGE_A(bufoff, gk, vo) do { _Pragma("unroll") for (int _i = 0; _i < 2; ++_i) \
        __builtin_amdgcn_global_load_lds((const unsigned*)((gk) + (vo)[_i]), (LAS unsigned*)(lds + (bufoff) + ldsw + _i * 8192), 16, 0, 0); } while (0)
#define FG_STAGE_B(bufoff, gk) do { _Pragma("unroll") for (int _i = 0; _i < 2; ++_i) \
        __builtin_amdgcn_global_load_lds((const unsigned*)((gk) + voffB[_i]), (LAS unsigned*)(lds + (bufoff) + ldsw + _i * 8192), 16, 0, 0); } while (0)
#define FG_LDA(dst, b, h) do { _Pragma("unroll") for (int m = 0; m < 4; ++m) _Pragma("unroll") for (int k = 0; k < 2; ++k) dst[m][k] = *(const LAS i32x4*)(lds + FG_SA(b, h) + aoff + m * 2048 + k * 1024); } while (0)
#define FG_LDB(dst, b, h) do { _Pragma("unroll") for (int n = 0; n < 2; ++n) _Pragma("unroll") for (int k = 0; k < 2; ++k) dst[n][k] = *(const LAS i32x4*)(lds + FG_SB(b, h) + boff + n * 2048 + k * 1024); } while (0)
#define FG_CAT8(X, Y) __builtin_shufflevector(X, Y, 0, 1, 2, 3, 4, 5, 6, 7)
#define FG_MMA(ai, bj, At, Bt) do { __builtin_amdgcn_s_setprio(1); _Pragma("unroll") for (int m = 0; m < 4; ++m) _Pragma("unroll") for (int n = 0; n < 2; ++n) \
        acc[ai][bj][m][n] = __builtin_amdgcn_mfma_scale_f32_16x16x128_f8f6f4(FG_CAT8(Bt[n][0], Bt[n][1]), FG_CAT8(At[m][0], At[m][1]), acc[ai][bj][m][n], 0, 0, 0, 0x79797979, 0, 0x7F7F7F7F); __builtin_amdgcn_s_setprio(0); } while (0)
#define FG_WAIT_V(n) asm volatile("s_waitcnt vmcnt(" #n ")" ::: "memory")
#define FG_WAIT_L(n) asm volatile("s_waitcnt lgkmcnt(" #n ")" ::: "memory")
#define FG_BAR __builtin_amdgcn_s_barrier()
#define FG_SCHED __builtin_amdgcn_sched_barrier(0)
#define FG_AOFF(dst, u, tabp) do { int _tz = threadIdx.x; asm volatile("" : "+v"(_tz)); _Pragma("unroll") for (int _i = 0; _i < 2; ++_i) { int _R, _C; stage_rc(_tz * 16 + _i * 8192, _R, _C); \
        _Pragma("unroll") for (int _h = 0; _h < 2; ++_h) { const int _r = _h * 128 + _R; \
        if (Job::GATHER) { const int _tok = (tabp)[_r < (u).nvalid ? _r : 0]; dst[_h][_i] = (unsigned)_tok * J.lda2 + (unsigned)(_C * 2); } \
        else dst[_h][_i] = (unsigned)((u).arow0 + _r) * J.lda2 + (unsigned)((u).acol2 + _C * 2); } } } while (0)
    Unit cur, nxt; int ui = 0;
    if (!J.next(0, cur)) return;
    LAS const int* tab0 = (LAS const int*)(lds + TAB_OFF);
    if (Job::GATHER) {
        if (wid == 0) __builtin_amdgcn_global_load_lds((const unsigned*)(J.list + cur.arow0 + lane * 4), (LAS unsigned*)(lds + TAB_OFF), 16, 0, 0);
        FG_WAIT_V(0); __syncthreads();
    }
    f32x4 acc[2][2][4][2];
#pragma unroll
    for (int a = 0; a < 2; ++a)
#pragma unroll
        for (int b = 0; b < 2; ++b)
#pragma unroll
            for (int m = 0; m < 4; ++m)
#pragma unroll
                for (int n = 0; n < 2; ++n) acc[a][b][m][n] = (f32x4){0.f, 0.f, 0.f, 0.f};
    i32x4 At[4][2], B0[2][2], B1[2][2];
    unsigned vc[2][2];
    FG_AOFF(vc, cur, tab0);
    const char* const gA = J.A;
    const char* cB = cur.bBase;
    const unsigned bh2 = J.bhalf2;
    FG_STAGE_B(FG_SB(0, 0), cB); FG_STAGE_A(FG_SA(0, 0), gA, vc[0]); FG_STAGE_B(FG_SB(0, 1), cB + bh2); FG_STAGE_A(FG_SA(0, 1), gA, vc[1]);
    if (wr == 1) FG_BAR;
    FG_WAIT_V(4); FG_BAR;
    FG_STAGE_B(FG_SB(1, 0), cB + kstepB); FG_STAGE_A(FG_SA(1, 0), gA + 128, vc[0]); FG_STAGE_B(FG_SB(1, 1), cB + kstepB + bh2);
    FG_WAIT_V(6); FG_BAR;
    for (;;) {
        const bool has_next = J.next(ui + 1, nxt);
        if (!has_next) nxt = cur;
        if (Job::GATHER && has_next && wid == 0)
            __builtin_amdgcn_global_load_lds((const unsigned*)(J.list + nxt.arow0 + lane * 4), (LAS unsigned*)(lds + TAB_OFF + ((ui + 1) & 1) * 1024), 16, 0, 0);
        const char* nB = nxt.bBase;
        for (int t = 0; t < nt; t += 2) {
            const bool last = (t == nt - 2);
            const char* a1 = gA + (size_t)(t + 1) * 128;
            const char* a2 = last ? gA : gA + (size_t)(t + 2) * 128; const char* b2 = last ? nB : cB + (size_t)(t + 2) * kstepB;
            const char* a3 = a2 + 128; const char* b3 = b2 + kstepB;
            FG_LDB(B0, 0, 0); FG_SCHED; FG_LDA(At, 0, 0); FG_STAGE_A(FG_SA(1, 1), a1, vc[1]);
            if (last && has_next) { LAS const int* tabn = (LAS const int*)(lds + TAB_OFF + ((ui + 1) & 1) * 1024); FG_AOFF(vc, nxt, tabn); }
            FG_WAIT_L(8); FG_BAR; FG_WAIT_L(0); FG_SCHED; FG_MMA(0, 0, At, B0); FG_BAR; FG_SCHED;
            FG_LDB(B1, 0, 1); FG_STAGE_B(FG_SB(0, 0), b2);
            FG_BAR; FG_WAIT_L(0); FG_SCHED; FG_MMA(0, 1, At, B1); FG_BAR;
            FG_LDA(At, 0, 1); FG_STAGE_A(FG_SA(0, 0), a2, vc[0]);
            FG_BAR; FG_WAIT_L(0); FG_MMA(1, 0, At, B0); FG_BAR; FG_SCHED;
            FG_STAGE_B(FG_SB(0, 1), b2 + bh2);
            FG_WAIT_V(6); FG_BAR; FG_MMA(1, 1, At, B1); FG_BAR;
            FG_LDB(B0, 1, 0); FG_SCHED; FG_LDA(At, 1, 0); FG_STAGE_A(FG_SA(0, 1), a2, vc[1]);
            FG_WAIT_L(8); FG_BAR; FG_WAIT_L(0); FG_SCHED; FG_MMA(0, 0, At, B0); FG_BAR; FG_SCHED;
            FG_LDB(B1, 1, 1); FG_STAGE_B(FG_SB(1, 0), b3);
            FG_BAR; FG_WAIT_L(0); FG_SCHED; FG_MMA(0, 1, At, B1); FG_BAR;
            FG_LDA(At, 1, 1); FG_STAGE_A(FG_SA(1, 0), a3, vc[0]);
            FG_BAR; FG_WAIT_L(0); FG_MMA(1, 0, At, B0); FG_BAR; FG_SCHED;
            FG_STAGE_B(FG_SB(1, 1), b3 + bh2);
            FG_WAIT_V(6); FG_BAR; FG_MMA(1, 1, At, B1); FG_BAR;
        }
        J.epi(acc, cur, wr, wc, fr, fq);
        if (!has_next) break;
#pragma unroll
        for (int a = 0; a < 2; ++a)
#pragma unroll
            for (int b = 0; b < 2; ++b)
#pragma unroll
                for (int m = 0; m < 4; ++m)
#pragma unroll
                    for (int n = 0; n < 2; ++n) acc[a][b][m][n] = (f32x4){0.f, 0.f, 0.f, 0.f};
        cur = nxt; cB = nB; ++ui;
    }
    FG_WAIT_V(0);
    if (wr == 0) FG_BAR;
    FG_BAR;
}
}

#define FG_FOR_ROWS for (int ai = 0; ai < 2; ++ai) _Pragma("unroll") for (int m = 0; m < 4; ++m)
struct JobInProj {
    static constexpr bool GATHER = false;
    const char* A; unsigned lda2, ldb2, bhalf2; int K; const int* list;
    const char* B; bf16_t* out; fg::StaticOrder S;
    __device__ __forceinline__ bool next(int i, fg::Unit& u) const { int pm, pn; if (!S.next(i, pm, pn)) return false;
        u.bBase = B + (size_t)pn * 512; u.arow0 = pm * 256; u.nvalid = 256; u.e = 0; u.orow0 = pm * 256; u.ocol0 = pn * 256; u.acol2 = 0; return true; }
    __device__ __forceinline__ void epi(const f32x4 (&acc)[2][2][4][2], const fg::Unit& u, int wr, int wc, int fr, int fq) const {
#pragma unroll
        FG_FOR_ROWS { bf16_t* rowp = out + (size_t)(u.orow0 + ai * 128 + wr * 64 + m * 16 + fr) * kNPROJ + u.ocol0 + wc * 32 + fq * 4;
#pragma unroll
            for (int bj = 0; bj < 2; ++bj)
#pragma unroll
                for (int n = 0; n < 2; ++n) { const f32x4 v = acc[ai][bj][m][n]; u32x2 w; w.x = pk_bf16(v[0], v[1]); w.y = pk_bf16(v[2], v[3]); *(u32x2*)(rowp + bj * 128 + n * 16) = w; } }
    }
};
struct JobPool {
    static constexpr bool GATHER = false;
    const char* A; unsigned lda2, ldb2, bhalf2; int K; const int* list;
    const char* B; bf16_t* cat; int G, c;
    __device__ __forceinline__ bool next(int i, fg::Unit& u) const { const int L = i * G + c; if (L >= 128) return false; const int g = L >> 5, pm = L & 31;
        u.bBase = B + (size_t)g * kPG * kPG * 2; u.arow0 = pm * 256; u.nvalid = 256; u.e = g; u.orow0 = pm * 256; u.ocol0 = kSB + g * kPG; u.acol2 = g * kPG * 2; return true; }
    __device__ __forceinline__ void epi(const f32x4 (&acc)[2][2][4][2], const fg::Unit& u, int wr, int wc, int fr, int fq) const {
#pragma unroll
        FG_FOR_ROWS { bf16_t* rowp = cat + (size_t)(u.orow0 + ai * 128 + wr * 64 + m * 16 + fr) * kD + u.ocol0 + wc * 32 + fq * 4;
#pragma unroll
            for (int bj = 0; bj < 2; ++bj)
#pragma unroll
                for (int n = 0; n < 2; ++n) { const f32x4 v = acc[ai][bj][m][n]; u32x2 w; w.x = pk_bf16(v[0], v[1]); w.y = pk_bf16(v[2], v[3]); *(u32x2*)(rowp + bj * 128 + n * 16) = w; } }
    }
};
struct JobOutProj {
    static constexpr bool GATHER = false;
    const char* A; unsigned lda2, ldb2, bhalf2; int K; const int* list;
    const char* B; const float* x; const float* mod; float* x1; fg::StaticOrder S;
    __device__ __forceinline__ bool next(int i, fg::Unit& u) const { int pm, pn; if (!S.next(i, pm, pn)) return false;
        u.bBase = B + (size_t)pn * 512; u.arow0 = pm * 256; u.nvalid = 256; u.e = 0; u.orow0 = pm * 256; u.ocol0 = pn * 256; u.acol2 = 0; return true; }
    __device__ __forceinline__ void epi(const f32x4 (&acc)[2][2][4][2], const fg::Unit& u, int wr, int wc, int fr, int fq) const {
        const int b = u.orow0 / kS; f32x4 gt[2][2];
#pragma unroll
        for (int bj = 0; bj < 2; ++bj)
#pragma unroll
            for (int n = 0; n < 2; ++n) gt[bj][n] = *(const f32x4*)(mod + b * 6 * kD + 2 * kD + u.ocol0 + bj * 128 + wc * 32 + n * 16 + fq * 4);
#pragma unroll
        FG_FOR_ROWS { const size_t ro = (size_t)(u.orow0 + ai * 128 + wr * 64 + m * 16 + fr) * kD + u.ocol0 + wc * 32 + fq * 4;
#pragma unroll
            for (int bj = 0; bj < 2; ++bj)
#pragma unroll
                for (int n = 0; n < 2; ++n) { const f32x4 xv = *(const f32x4*)(x + ro + bj * 128 + n * 16); *(f32x4*)(x1 + ro + bj * 128 + n * 16) = xv + gt[bj][n] * acc[ai][bj][m][n]; } }
    }
};
struct MoeTab { LAS const int* t; int total;
    __device__ __forceinline__ bool decode(int i, int G, int c, int& e, int& jcol, int& rb, int& cnt, int& rowbase) const {
        const int L = (G % 8 == 0) ? i * G + (c % 8) * (G / 8) + c / 8 : i * G + c; if (L >= total) return false;
        int ee = 0; while (ee < kE - 1 && t[64 + ee + 1] <= L) ++ee;
        const int local = L - t[64 + ee], nrb = t[100 + ee]; jcol = local / nrb; rb = local - jcol * nrb; e = ee; cnt = t[ee]; rowbase = t[32 + ee]; return true; }
};
__device__ __forceinline__ MoeTab moe_tables(LAS unsigned char* lds, const unsigned* ctrl, int ncol) {
    LAS int* t = (LAS int*)(lds + fg::MISC_OFF + 64);
    __syncthreads();
    if (threadIdx.x == 0) { int base = 0, us = 0; for (int e = 0; e < kE; ++e) { const int cn = (int)ctrl[CT_CNT + e], nrb = (cn + 255) >> 8; t[e] = cn; t[32 + e] = base; t[64 + e] = us; t[100 + e] = nrb; base += nrb * 256; us += nrb * ncol; } t[64 + kE] = us; }
    __syncthreads();
    MoeTab M; M.t = t; M.total = t[64 + kE]; return M;
}
struct JobMoe1 {
    static constexpr bool GATHER = true;
    const char* A; unsigned lda2, ldb2, bhalf2; int K; const int* list;
    const char* B; const float* b_in; bf16_t* act; MoeTab M; int G, c;
    __device__ __forceinline__ bool next(int i, fg::Unit& u) const { int e, j, rb, cnt, rowbase; if (!M.decode(i, G, c, e, j, rb, cnt, rowbase)) return false;
        e = __builtin_amdgcn_readfirstlane(e); j = __builtin_amdgcn_readfirstlane(j); rb = __builtin_amdgcn_readfirstlane(rb); cnt = __builtin_amdgcn_readfirstlane(cnt); rowbase = __builtin_amdgcn_readfirstlane(rowbase);
        u.bBase = B + (size_t)e * ((size_t)kD * 2 * kDFF * 2) + (size_t)j * 256; u.arow0 = e * kT + rb * 256; u.nvalid = min(256, cnt - rb * 256); u.e = e; u.orow0 = rowbase + rb * 256; u.ocol0 = j * 128; u.acol2 = 0; return true; }
    __device__ __forceinline__ void epi(const f32x4 (&acc)[2][2][4][2], const fg::Unit& u, int wr, int wc, int fr, int fq) const {
        f32x4 bg[2], bl[2];
#pragma unroll
        for (int n = 0; n < 2; ++n) { const float* bp = b_in + (size_t)u.e * 2 * kDFF + u.ocol0 + wc * 32 + n * 16 + fq * 4; bg[n] = *(const f32x4*)bp; bl[n] = *(const f32x4*)(bp + kDFF); }
#pragma unroll
        FG_FOR_ROWS { bf16_t* rowp = act + (size_t)(u.orow0 + ai * 128 + wr * 64 + m * 16 + fr) * kDFF + u.ocol0 + wc * 32 + fq * 4;
#pragma unroll
            for (int n = 0; n < 2; ++n) { const f32x4 gv = acc[ai][0][m][n] + bg[n], lv = acc[ai][1][m][n] + bl[n]; float o[4];
#pragma unroll
                for (int j = 0; j < 4; ++j) { const float g = fminf(gv[j], 7.f), l = fminf(fmaxf(lv[j], -7.f), 7.f); o[j] = g * __builtin_amdgcn_rcpf(1.f + __expf(-1.702f * g)) * (l + 1.f); }
                u32x2 w; w.x = pk_bf16(o[0], o[1]); w.y = pk_bf16(o[2], o[3]); *(u32x2*)(rowp + n * 16) = w; } }
    }
};
struct JobMoe2 {
    static constexpr bool GATHER = false;
    const char* A; unsigned lda2, ldb2, bhalf2; int K; const int* list;
    const char* B; const float* b_out; bf16_t* yp; MoeTab M; int G, c;
    __device__ __forceinline__ bool next(int i, fg::Unit& u) const { int e, j, rb, cnt, rowbase; if (!M.decode(i, G, c, e, j, rb, cnt, rowbase)) return false;
        e = __builtin_amdgcn_readfirstlane(e); j = __builtin_amdgcn_readfirstlane(j); rb = __builtin_amdgcn_readfirstlane(rb); rowbase = __builtin_amdgcn_readfirstlane(rowbase);
        u.bBase = B + (size_t)e * ((size_t)kDFF * kD * 2) + (size_t)j * 512; u.arow0 = rowbase + rb * 256; u.nvalid = 256; u.e = e; u.orow0 = rowbase + rb * 256; u.ocol0 = j * 256; u.acol2 = 0; return true; }
    __device__ __forceinline__ void epi(const f32x4 (&acc)[2][2][4][2], const fg::Unit& u, int wr, int wc, int fr, int fq) const {
        f32x4 bo[2][2];
#pragma unroll
        for (int bj = 0; bj < 2; ++bj)
#pragma unroll
            for (int n = 0; n < 2; ++n) bo[bj][n] = *(const f32x4*)(b_out + (size_t)u.e * kD + u.ocol0 + bj * 128 + wc * 32 + n * 16 + fq * 4);
#pragma unroll
        FG_FOR_ROWS { bf16_t* rowp = yp + (size_t)(u.orow0 + ai * 128 + wr * 64 + m * 16 + fr) * kD + u.ocol0 + wc * 32 + fq * 4;
#pragma unroll
            for (int bj = 0; bj < 2; ++bj)
#pragma unroll
                for (int n = 0; n < 2; ++n) { const f32x4 v = acc[ai][bj][m][n] + bo[bj][n]; u32x2 w; w.x = pk_bf16(v[0], v[1]); w.y = pk_bf16(v[2], v[3]); *(u32x2*)(rowp + bj * 128 + n * 16) = w; } }
    }
};


__device__ __forceinline__ float wave_sum(float v) {
#pragma unroll
    for (int o = 32; o > 0; o >>= 1) v += __shfl_xor(v, o);
    return v; }
__device__ __forceinline__ float bflo(unsigned u) { return __uint_as_float(u << 16); }
__device__ __forceinline__ float bfhi(unsigned u) { return __uint_as_float(u & 0xFFFF0000u); }

namespace at {
typedef float f32x16 __attribute__((ext_vector_type(16)));
__device__ __forceinline__ unsigned off_b(unsigned row, unsigned ch) { return 256u * row + 16u * (ch ^ (((row & 3) << 2) | ((row >> 2) & 3))); }
constexpr float kC2 = 0.08838834764831845f * 1.4426950408889634f;
constexpr float kDoneThresh = 160.f;

__device__ __forceinline__ void attn_phase(LAS unsigned char* lds, const bf16_t* __restrict__ proj, const float* __restrict__ qw, const float* __restrict__ kw,
                                           bf16_t* __restrict__ cat, int G, int c) {
    const int tid = threadIdx.x, wid = __builtin_amdgcn_readfirstlane(tid >> 6), lane = tid & 63, ql = lane & 31, hf = lane >> 5;
    const unsigned ldsb = (unsigned)(uintptr_t)lds;
    const int skey = tid >> 4, sch = tid & 15;
    const unsigned X = ((ql & 3) << 2) | ((ql >> 2) & 3);
    const unsigned krow = 256u * ql, kY = 16u * (X ^ (unsigned)hf);
    const int tq = (lane & 15) >> 2, tp = lane & 3, blk = (lane >> 4) & 1;
    unsigned va[4][2];
#pragma unroll
    for (int cc = 0; cc < 4; ++cc)
#pragma unroll
        for (int t = 0; t < 2; ++t) va[cc][t] = 256u * (8 * t + 4 * hf + tq) + 16u * ((4 * cc + 2 * blk + (tp >> 1)) ^ ((tq << 2) | ((2 * t + hf) & 3))) + 8u * (tp & 1);
    for (int unit = c; unit < kB * kNH * 8; unit += G) {
        const int qb = unit & 7, bh = unit >> 3, h = bh & 7, b = bh >> 3;
        const int q0 = qb * 256, r0 = q0 + wid * 32;
        const bf16_t* base = proj + (size_t)(b * kS) * kNPROJ + h * kHD;
        LAS unsigned char* qlds = lds + 65536 + wid * 8192 + lane * 16;
        { u32x4 qr[8]; float ss = 0.f;
#pragma unroll
          for (int s = 0; s < 8; ++s) { qr[s] = *(const u32x4*)(base + (size_t)(r0 + ql) * kNPROJ + 16 * s + 8 * hf);
              const unsigned u[4] = {qr[s].x, qr[s].y, qr[s].z, qr[s].w};
#pragma unroll
              for (int e = 0; e < 4; ++e) { const float a = bflo(u[e]), bb = bfhi(u[e]); ss += a * a + bb * bb; } }
          ss += __shfl_xor(ss, 32);
          const float rq = rsqrtf(ss * (1.f / kHD) + kEPS) * kC2;
#pragma unroll
          for (int s = 0; s < 8; ++s) { const int d0 = 16 * s + 8 * hf;
              const f32x4 w0 = *(const f32x4*)(qw + d0) * *(const f32x4*)(kw + d0), w1 = *(const f32x4*)(qw + d0 + 4) * *(const f32x4*)(kw + d0 + 4);
              const unsigned u[4] = {qr[s].x, qr[s].y, qr[s].z, qr[s].w};
              u32x4 pk; pk.x = pk_bf16(bflo(u[0]) * rq * w0[0], bfhi(u[0]) * rq * w0[1]); pk.y = pk_bf16(bflo(u[1]) * rq * w0[2], bfhi(u[1]) * rq * w0[3]);
              pk.z = pk_bf16(bflo(u[2]) * rq * w1[0], bfhi(u[2]) * rq * w1[1]); pk.w = pk_bf16(bflo(u[3]) * rq * w1[2], bfhi(u[3]) * rq * w1[3]);
              *(LAS u32x4*)(qlds + 1024 * s) = pk; } }
        f32x16 o[4];
#pragma unroll
        for (int cc = 0; cc < 4; ++cc)
#pragma unroll
            for (int r = 0; r < 16; ++r) o[cc][r] = 0.f;
        float carry = 0.f; bool wactive = true;
        int jt = (q0 + 255) >> 6, cur = 0;
        u32x4 kr[2], vr[2];
#define AT_LOAD(jt_) do { _Pragma("unroll") for (int i = 0; i < 2; ++i) { const bf16_t* rp = base + (size_t)(64 * (jt_) + skey + 32 * i) * kNPROJ + sch * 8; \
            kr[i] = *(const u32x4*)(rp + kSB); vr[i] = *(const u32x4*)(rp + 2 * kSB); } } while (0)
        AT_LOAD(jt);
        for (;;) {
            LAS unsigned char* kbuf = lds + cur * 32768; LAS unsigned char* vbuf = kbuf + 16384;
#pragma unroll
            for (int i = 0; i < 2; ++i) { const unsigned u[4] = {kr[i].x, kr[i].y, kr[i].z, kr[i].w}; float f[8]; float ss = 0.f;
#pragma unroll
                for (int e = 0; e < 4; ++e) { f[2 * e] = bflo(u[e]); f[2 * e + 1] = bfhi(u[e]); ss += f[2 * e] * f[2 * e] + f[2 * e + 1] * f[2 * e + 1]; }
                ss += __shfl_xor(ss, 1); ss += __shfl_xor(ss, 2); ss += __shfl_xor(ss, 4); ss += __shfl_xor(ss, 8);
                const float rk = rsqrtf(ss * (1.f / kHD) + kEPS);
                u32x4 pk; pk.x = pk_bf16(f[0] * rk, f[1] * rk); pk.y = pk_bf16(f[2] * rk, f[3] * rk); pk.z = pk_bf16(f[4] * rk, f[5] * rk); pk.w = pk_bf16(f[6] * rk, f[7] * rk);
                const unsigned a = off_b(skey + 32 * i, sch);
                *(LAS u32x4*)(kbuf + a) = pk; *(LAS u32x4*)(vbuf + a) = vr[i]; }
            const int any = __syncthreads_or(wactive ? 1 : 0);
            if (!any) break;
            const int jtc = jt;
            if (jt > 0) AT_LOAD(jt - 1);
            if (wactive && 64 * jtc < r0 + 31) {
                f32x16 s0, s1;
#pragma unroll
                for (int r = 0; r < 16; ++r) { s0[r] = 0.f; s1[r] = 0.f; }
#pragma unroll
                for (int s = 0; s < 8; ++s) { const unsigned a = krow + ((32u * s) ^ kY);
                    const bf16x8 k0 = *(const LAS bf16x8*)(kbuf + a), k1 = *(const LAS bf16x8*)(kbuf + 8192 + a), qv = *(const LAS bf16x8*)(qlds + 1024 * s);
                    s0 = __builtin_amdgcn_mfma_f32_32x32x16_bf16(k0, qv, s0, 0, 0, 0); s1 = __builtin_amdgcn_mfma_f32_32x32x16_bf16(k1, qv, s1, 0, 0, 0); }
                const int tabs = r0 + ql, kbase0 = 64 * jtc + 4 * hf;
                float run = carry; u32x4 pfr[2][2];
#pragma unroll
                for (int kb = 1; kb >= 0; --kb) {
                    float sp[16], gp[4], T[4];
#pragma unroll
                    for (int r = 0; r < 16; ++r) { const float z = kb ? s1[r] : s0[r]; const int key = kbase0 + 32 * kb + 8 * (r >> 2) + (r & 3);
                        const float v = __builtin_amdgcn_logf(1.f + __builtin_amdgcn_exp2f(z)); sp[r] = key < tabs ? v : 0.f; }
#pragma unroll
                    for (int g = 0; g < 4; ++g) { const float gsum = (sp[4 * g] + sp[4 * g + 1]) + (sp[4 * g + 2] + sp[4 * g + 3]);
                        const auto sw = __builtin_amdgcn_permlane32_swap(__float_as_uint(gsum), __float_as_uint(gsum), false, false);
                        const float lo = __uint_as_float(sw[0]), hi = __uint_as_float(sw[1]);
                        T[g] = lo + hi; gp[g] = hf ? 0.f : hi; }
#pragma unroll
                    for (int g = 3; g >= 0; --g) { const float offs = run + gp[g];
                        const float c3 = offs + sp[4 * g + 3], c2 = c3 + sp[4 * g + 2], c1 = c2 + sp[4 * g + 1], c0 = c1 + sp[4 * g];
                        const float cs[4] = {c0, c1, c2, c3};
#pragma unroll
                        for (int i = 0; i < 4; ++i) { const int r = 4 * g + i; const float z = kb ? s1[r] : s0[r]; const int key = kbase0 + 32 * kb + 8 * g + i;
                            const float e = __builtin_amdgcn_exp2f(z - cs[i]); sp[r] = key < tabs ? e : 0.f; }
                        run += T[g]; }
#pragma unroll
                    for (int s2 = 0; s2 < 2; ++s2) { u32x4 pk; pk.x = pk_bf16(sp[8 * s2], sp[8 * s2 + 1]); pk.y = pk_bf16(sp[8 * s2 + 2], sp[8 * s2 + 3]);
                        pk.z = pk_bf16(sp[8 * s2 + 4], sp[8 * s2 + 5]); pk.w = pk_bf16(sp[8 * s2 + 6], sp[8 * s2 + 7]); pfr[kb][s2] = pk; }
                }
                carry = run;
                const unsigned vb0 = ldsb + (unsigned)cur * 32768u + 16384u;
#define AT_PV(cc) do { const unsigned a0 = vb0 + va[cc][0], a1 = vb0 + va[cc][1]; \
                    const s16x4 l00 = fg::tr_read<0>(a0), h00 = fg::tr_read<0>(a1), l01 = fg::tr_read<4096>(a0), h01 = fg::tr_read<4096>(a1); \
                    const s16x4 l10 = fg::tr_read<8192>(a0), h10 = fg::tr_read<8192>(a1), l11 = fg::tr_read<12288>(a0), h11 = fg::tr_read<12288>(a1); \
                    asm volatile("s_waitcnt lgkmcnt(0)" ::: "memory"); __builtin_amdgcn_sched_barrier(0); \
                    o[cc] = __builtin_amdgcn_mfma_f32_32x32x16_bf16(FG_PK(l00, h00), __builtin_bit_cast(bf16x8, pfr[0][0]), o[cc], 0, 0, 0); \
                    o[cc] = __builtin_amdgcn_mfma_f32_32x32x16_bf16(FG_PK(l01, h01), __builtin_bit_cast(bf16x8, pfr[0][1]), o[cc], 0, 0, 0); \
                    o[cc] = __builtin_amdgcn_mfma_f32_32x32x16_bf16(FG_PK(l10, h10), __builtin_bit_cast(bf16x8, pfr[1][0]), o[cc], 0, 0, 0); \
                    o[cc] = __builtin_amdgcn_mfma_f32_32x32x16_bf16(FG_PK(l11, h11), __builtin_bit_cast(bf16x8, pfr[1][1]), o[cc], 0, 0, 0); } while (0)
                AT_PV(0); AT_PV(1); AT_PV(2); AT_PV(3);
#undef AT_PV
                wactive = __any(carry <= kDoneThresh);
            }
            if (jt == 0) break;
            --jt; cur ^= 1;
        }
#undef AT_LOAD
        bf16_t* orow = cat + (size_t)(b * kS + r0 + ql) * kD + h * kHD + 4 * hf;
#pragma unroll
        for (int cc = 0; cc < 4; ++cc)
#pragma unroll
            for (int g = 0; g < 4; ++g) { u32x2 w; w.x = pk_bf16(o[cc][4 * g], o[cc][4 * g + 1]); w.y = pk_bf16(o[cc][4 * g + 2], o[cc][4 * g + 3]); *(u32x2*)(orow + 32 * cc + 8 * g) = w; }
        __syncthreads();
    }
}
}

__device__ __forceinline__ void pool_p_phase(const bf16_t* __restrict__ proj, bf16_t* __restrict__ p, int G, int c) {
    for (int idx = c * 512 + threadIdx.x; idx < kT * (kPW / 8); idx += G * 512) {
        const int c8 = idx & 127, t = idx >> 7, s = t & (kS - 1), g = c8 >> 5, w = 2 << g, cnt = min(s + 1, w);
        const bf16_t* up = proj + (size_t)t * kNPROJ + 3 * kSB + c8 * 8;
        float acc[8], u0[8];
#pragma unroll
        for (int e = 0; e < 8; ++e) acc[e] = 0.f;
        for (int i = 0; i < cnt; ++i) { const uint4 v = *(const uint4*)(up - (size_t)i * kNPROJ); const unsigned u[4] = {v.x, v.y, v.z, v.w};
#pragma unroll
            for (int e = 0; e < 4; ++e) { const float a = bflo(u[e]), bb = bfhi(u[e]); acc[2 * e] += a; acc[2 * e + 1] += bb; if (i == 0) { u0[2 * e] = a; u0[2 * e + 1] = bb; } } }
        const float inv = 1.f / (float)cnt;
        u32x4 pk; pk.x = pk_bf16(acc[0] * inv - u0[0], acc[1] * inv - u0[1]); pk.y = pk_bf16(acc[2] * inv - u0[2], acc[3] * inv - u0[3]);
        pk.z = pk_bf16(acc[4] * inv - u0[4], acc[5] * inv - u0[5]); pk.w = pk_bf16(acc[6] * inv - u0[6], acc[7] * inv - u0[7]);
        *(u32x4*)(p + (size_t)t * kPW + c8 * 8) = pk;
    }
}


__device__ __forceinline__ unsigned pk4_fp8(float a, float b, float c, float d) { int p = __builtin_amdgcn_cvt_pk_fp8_f32(a, b, 0, false); p = __builtin_amdgcn_cvt_pk_fp8_f32(c, d, p, true); return (unsigned)p; }
__device__ __forceinline__ float clamp448(float v) { return __builtin_amdgcn_fmed3f(v, -448.f, 448.f); }
constexpr float kWScale = 64.f;

struct JobMoe1F8 {
    static constexpr bool GATHER = true;
    const char* A; unsigned lda2, ldb2, bhalf2; int K; const int* list;
    const char* B; const float* b_in; unsigned char* act; MoeTab M; int G, c;
    __device__ __forceinline__ bool next(int i, fg::Unit& u) const { int e, j, rb, cnt, rowbase; if (!M.decode(i, G, c, e, j, rb, cnt, rowbase)) return false;
        e = __builtin_amdgcn_readfirstlane(e); j = __builtin_amdgcn_readfirstlane(j); rb = __builtin_amdgcn_readfirstlane(rb); cnt = __builtin_amdgcn_readfirstlane(cnt); rowbase = __builtin_amdgcn_readfirstlane(rowbase);
        u.bBase = B + (size_t)e * ((size_t)2 * kDFF * kD) + (size_t)j * 128 * kD; u.arow0 = e * kT + rb * 256; u.nvalid = min(256, cnt - rb * 256); u.e = e; u.orow0 = rowbase + rb * 256; u.ocol0 = j * 128; u.acol2 = 0; return true; }
    __device__ __forceinline__ void epi(const f32x4 (&acc)[2][2][4][2], const fg::Unit& u, int wr, int wc, int fr, int fq) const {
        f32x4 bg[2], bl[2];
#pragma unroll
        for (int n = 0; n < 2; ++n) { const float* bp = b_in + (size_t)u.e * 2 * kDFF + u.ocol0 + wc * 32 + n * 16 + fq * 4; bg[n] = *(const f32x4*)bp; bl[n] = *(const f32x4*)(bp + kDFF); }
#pragma unroll
        FG_FOR_ROWS { unsigned char* rowp = act + (size_t)(u.orow0 + ai * 128 + wr * 64 + m * 16 + fr) * kDFF + u.ocol0 + wc * 32 + fq * 4;
#pragma unroll
            for (int n = 0; n < 2; ++n) { const f32x4 gv = acc[ai][0][m][n] + bg[n], lv = acc[ai][1][m][n] + bl[n]; float o[4];
#pragma unroll
                for (int j = 0; j < 4; ++j) { const float g = fminf(gv[j], 7.f), l = fminf(fmaxf(lv[j], -7.f), 7.f); o[j] = clamp448(g * __builtin_amdgcn_rcpf(1.f + __expf(-1.702f * g)) * (l + 1.f)); }
                *(unsigned*)(rowp + n * 16) = pk4_fp8(o[0], o[1], o[2], o[3]); } }
    }
};
struct JobMoe2F8 {
    static constexpr bool GATHER = false;
    const char* A; unsigned lda2, ldb2, bhalf2; int K; const int* list;
    const char* B; const float* b_out; bf16_t* yp; MoeTab M; int G, c;
    __device__ __forceinline__ bool next(int i, fg::Unit& u) const { int e, j, rb, cnt, rowbase; if (!M.decode(i, G, c, e, j, rb, cnt, rowbase)) return false;
        e = __builtin_amdgcn_readfirstlane(e); j = __builtin_amdgcn_readfirstlane(j); rb = __builtin_amdgcn_readfirstlane(rb); rowbase = __builtin_amdgcn_readfirstlane(rowbase);
        u.bBase = B + (size_t)e * ((size_t)kDFF * kD) + (size_t)j * 256 * kDFF; u.arow0 = rowbase + rb * 256; u.nvalid = 256; u.e = e; u.orow0 = rowbase + rb * 256; u.ocol0 = j * 256; u.acol2 = 0; return true; }
    __device__ __forceinline__ void epi(const f32x4 (&acc)[2][2][4][2], const fg::Unit& u, int wr, int wc, int fr, int fq) const {
        f32x4 bo[2][2];
#pragma unroll
        for (int bj = 0; bj < 2; ++bj)
#pragma unroll
            for (int n = 0; n < 2; ++n) bo[bj][n] = *(const f32x4*)(b_out + (size_t)u.e * kD + u.ocol0 + bj * 128 + wc * 32 + n * 16 + fq * 4);
#pragma unroll
        FG_FOR_ROWS { bf16_t* rowp = yp + (size_t)(u.orow0 + ai * 128 + wr * 64 + m * 16 + fr) * kD + u.ocol0 + wc * 32 + fq * 4;
#pragma unroll
            for (int bj = 0; bj < 2; ++bj)
#pragma unroll
                for (int n = 0; n < 2; ++n) { const f32x4 v = acc[ai][bj][m][n] + bo[bj][n]; u32x2 w; w.x = pk_bf16(v[0], v[1]); w.y = pk_bf16(v[2], v[3]); *(u32x2*)(rowp + bj * 128 + n * 16) = w; } }
    }
};

__device__ __forceinline__ void convert_t_f8(LAS unsigned char* lds, const float* __restrict__ src, unsigned char* __restrict__ dst, int nmat, int K, int N, int G, int c) {
    const int tid = threadIdx.x, kq = tid >> 4, nc = tid & 15;
    const int rn = tid >> 3, rc = tid & 7;
    const int tk = K / 128, tn = N / 64, per = tk * tn, total = nmat * per;
    LAS unsigned* L = (LAS unsigned*)lds;
    for (int t = c; t < total; t += G) {
        const int mat = t / per, r = t - mat * per, kt = r / tn, nt_ = r - kt * tn;
        const float* sp = src + (size_t)mat * K * N + (size_t)(kt * 128 + 4 * kq) * N + nt_ * 64 + 4 * nc;
        const f32x4 v0 = __builtin_nontemporal_load((const f32x4*)sp), v1 = __builtin_nontemporal_load((const f32x4*)(sp + N)),
                    v2 = __builtin_nontemporal_load((const f32x4*)(sp + 2 * (size_t)N)), v3 = __builtin_nontemporal_load((const f32x4*)(sp + 3 * (size_t)N));
        __syncthreads();
#pragma unroll
        for (int j = 0; j < 4; ++j) L[(4 * nc + j) * 33 + kq] = pk4_fp8(v0[j] * kWScale, v1[j] * kWScale, v2[j] * kWScale, v3[j] * kWScale);
        __syncthreads();
        u32x4 o; o.x = L[rn * 33 + 4 * rc]; o.y = L[rn * 33 + 4 * rc + 1]; o.z = L[rn * 33 + 4 * rc + 2]; o.w = L[rn * 33 + 4 * rc + 3];
        *(u32x4*)(dst + (size_t)mat * K * N + (size_t)(nt_ * 64 + rn) * K + kt * 128 + rc * 16) = o;
    }
}

__device__ __forceinline__ void convert_seg(const float* __restrict__ src, bf16_t* __restrict__ dst, size_t n8, size_t gtid, size_t gstride) {
    const f32x4* s4 = (const f32x4*)src; u32x4* d4 = (u32x4*)dst;
#pragma unroll 4
    for (size_t i = gtid; i < n8; i += gstride) { const f32x4 a = __builtin_nontemporal_load(s4 + 2 * i), b = __builtin_nontemporal_load(s4 + 2 * i + 1);
        u32x4 w; w.x = pk_bf16(a[0], a[1]); w.y = pk_bf16(a[2], a[3]); w.z = pk_bf16(b[0], b[1]); w.w = pk_bf16(b[2], b[3]); d4[i] = w; }
}


#define XB_TMO      128
#define XB_XCNT(j)  (256  + 64 * (j))
#define XB_XSUB(j)  (1280 + 64 * (j))
#define XB_XGEN(j)  (2304 + 64 * (j))
#define XB_TOP      3328
#define XB_TOPGEN   3392
#define XCD_BAR_WORDS 3456
#define XB_SPIN_CAP (1u << 18)
__device__ __forceinline__ unsigned xb_ld(unsigned* p)              { return __hip_atomic_load(p, __ATOMIC_RELAXED, __HIP_MEMORY_SCOPE_AGENT); }
__device__ __forceinline__ unsigned xb_add(unsigned* p, unsigned v) { return __hip_atomic_fetch_add(p, v, __ATOMIC_RELAXED, __HIP_MEMORY_SCOPE_AGENT); }
__device__ __forceinline__ unsigned xb_xcc_id() { return (unsigned)__builtin_amdgcn_s_getreg((3 << 11) | 20) & 0xFu; }
#define XB_SPIN(cond, bar) do { unsigned _sp = 0; while (cond) { __builtin_amdgcn_s_sleep(1); \
    if ((++_sp & 255u) == 0u) { if (xb_ld(&(bar)[XB_TMO])) break; if (_sp > XB_SPIN_CAP) { atomicAdd(&(bar)[XB_TMO], 1u); break; } } } } while (0)
struct XcdBarrier { unsigned* bar; unsigned x; volatile LAS unsigned* st; };
__device__ __forceinline__ XcdBarrier xcd_barrier_post(unsigned* bar, volatile LAS unsigned* st) {
    XcdBarrier b; b.bar = bar; b.x = xb_xcc_id(); b.st = st;
    if (threadIdx.x == 0) (void)xb_add(&bar[XB_XCNT(b.x)], 1u);
    return b;
}
__device__ __forceinline__ void xcd_barrier_complete(unsigned* bar, unsigned x, unsigned& nloc, unsigned& nx) {
    const unsigned G = gridDim.x * gridDim.y * gridDim.z;
    unsigned sum, cnt, mine, sp = 0u;
    for (;;) {
        sum = 0u; cnt = 0u; mine = 0u;
#pragma unroll
        for (unsigned j = 0; j < 16; ++j) { const unsigned c = xb_ld(&bar[XB_XCNT(j)]); sum += c; cnt += (c > 0u) ? 1u : 0u; mine = (j == x) ? c : mine; }
        if (sum == G) break;
        __builtin_amdgcn_s_sleep(1);
        if ((++sp & 255u) == 0u) { if (xb_ld(&bar[XB_TMO])) break; if (sp > XB_SPIN_CAP) { atomicAdd(&bar[XB_TMO], 1u); break; } }
    }
    nloc = mine > 0u ? mine : 1u; nx = cnt > 0u ? cnt : 1u;
}
__device__ __forceinline__ void xcd_barrier(const XcdBarrier& b) {
    asm volatile("s_waitcnt vmcnt(0)" ::: "memory");
    __syncthreads();
    if (threadIdx.x == 0) {
        unsigned* bar = b.bar;
        __builtin_amdgcn_s_waitcnt(0);
        unsigned nloc = b.st[0], nx = b.st[1];
        if (nloc == 0u) { xcd_barrier_complete(bar, b.x, nloc, nx); b.st[0] = nloc; b.st[1] = nx; }
        const unsigned old = xb_add(&bar[XB_XSUB(b.x)], 1u);
        const unsigned gen = old / nloc;
        if (old + 1u == (gen + 1u) * nloc) {
            __builtin_amdgcn_fence(__ATOMIC_RELEASE, "agent");
            asm volatile("s_waitcnt vmcnt(0)" ::: "memory");
            const unsigned og = xb_add(&bar[XB_TOP], 1u);
            const unsigned tg = og / nx;
            if (og + 1u == (tg + 1u) * nx) xb_add(&bar[XB_TOPGEN], 1u);
            else XB_SPIN(xb_ld(&bar[XB_TOPGEN]) == tg, bar);
            __builtin_amdgcn_fence(__ATOMIC_ACQUIRE, "agent");
            xb_add(&bar[XB_XGEN(b.x)], 1u);
            asm volatile("s_waitcnt vmcnt(0)" ::: "memory");
        } else {
            XB_SPIN(xb_ld(&bar[XB_XGEN(b.x)]) == gen, bar);
            __builtin_amdgcn_fence(__ATOMIC_ACQUIRE, "agent");
            asm volatile("s_waitcnt vmcnt(0)" ::: "memory");
        }
    }
    __syncthreads();
}

__device__ __forceinline__ void ada_phase(LAS unsigned char* lds, const float* __restrict__ cvec, const float* __restrict__ w_ada, const float* __restrict__ b_ada, float* __restrict__ mod, int G, int c) {
    LAS float* ca = (LAS float*)lds;
    LAS float* part = (LAS float*)(lds + 32768);
    const int tid = threadIdx.x;
    __syncthreads();
    for (int i = tid; i < kB * kD; i += 512) { const float v = cvec[i]; ca[i] = v / (1.f + __expf(-v)); }
    __syncthreads();
    for (int cb = c; cb < 6 * kD / 48; cb += G) {
        const int n0 = cb * 48, cg = tid % 12, kr = tid / 12;
        if (tid < 504) {
            f32x4 a0 = {0.f, 0.f, 0.f, 0.f}, a1 = a0, a2 = a0, a3 = a0;
#pragma unroll 8
            for (int k = kr; k < kD; k += 42) { const f32x4 w = __builtin_nontemporal_load((const f32x4*)(w_ada + (size_t)k * (6 * kD) + n0 + cg * 4));
                a0 += ca[k] * w; a1 += ca[kD + k] * w; a2 += ca[2 * kD + k] * w; a3 += ca[3 * kD + k] * w; }
            LAS f32x4* pp = (LAS f32x4*)(part + (kr * 12 + cg) * 16); pp[0] = a0; pp[1] = a1; pp[2] = a2; pp[3] = a3;
        }
        __syncthreads();
        if (tid < 192) { const int col = tid % 48, b = tid / 48; float sum = 0.f;
            for (int r = 0; r < 42; ++r) sum += part[(r * 12 + (col >> 2)) * 16 + b * 4 + (col & 3)];
            mod[b * 6 * kD + n0 + col] = sum + b_ada[n0 + col]; }
        __syncthreads();
    }
}

__device__ __forceinline__ void norm1_phase(const float* __restrict__ x, const float* __restrict__ nw, const float* __restrict__ mod, bf16_t* __restrict__ out, int G, int c) {
    const int wid = threadIdx.x >> 6, lane = threadIdx.x & 63;
    for (int t = c * 8 + wid; t < kT; t += G * 8) {
        const int b = t / kS; const float* xr = x + (size_t)t * kD + lane * 4; const float* mb = mod + b * 6 * kD + lane * 4;
        f32x4 v[8]; float ss = 0.f;
#pragma unroll
        for (int j = 0; j < 8; ++j) { v[j] = *(const f32x4*)(xr + 256 * j); ss += v[j][0] * v[j][0] + v[j][1] * v[j][1] + v[j][2] * v[j][2] + v[j][3] * v[j][3]; }
        ss = wave_sum(ss);
        const float r = rsqrtf(ss * (1.f / kD) + kEPS);
#pragma unroll
        for (int j = 0; j < 8; ++j) { const f32x4 w = *(const f32x4*)(nw + lane * 4 + 256 * j), sh = *(const f32x4*)(mb + 256 * j), sc = *(const f32x4*)(mb + kD + 256 * j);
            const f32x4 y = v[j] * r * w * (1.f + sc) + sh; u32x2 o; o.x = pk_bf16(y[0], y[1]); o.y = pk_bf16(y[2], y[3]);
            *(u32x2*)(out + (size_t)t * kD + lane * 4 + 256 * j) = o; }
    }
}

constexpr int RT_STRIDE = 144;
__device__ __forceinline__ void norm2_router_phase(LAS unsigned char* lds, const float* __restrict__ x1, const float* __restrict__ nw, const float* __restrict__ mod,
                                                   const float* __restrict__ w_router, const float* __restrict__ b_router, unsigned char* __restrict__ h2,
                                                   float* __restrict__ gates, int* __restrict__ pair_e, int* __restrict__ pair_p, int* __restrict__ list, unsigned* __restrict__ ctrl, int G, int c) {
    const int tid = threadIdx.x, wid = tid >> 6, lane = tid & 63;
    for (int blk = c; blk < kT / 32; blk += G) {
#pragma unroll 1
        for (int pass = 0; pass < 2; ++pass) {
            const int t0 = blk * 32 + wid * 4 + pass * 2, b = t0 / kS;
            float rs[2];
#pragma unroll
            for (int rr = 0; rr < 2; ++rr) { const float* xr = x1 + (size_t)(t0 + rr) * kD + 2 * lane; float ss = 0.f;
#pragma unroll
                for (int i = 0; i < 16; ++i) { const f32x2 v = *(const f32x2*)(xr + 128 * i); ss += v[0] * v[0] + v[1] * v[1]; }
                ss = wave_sum(ss); rs[rr] = rsqrtf(ss * (1.f / kD) + kEPS); }
            f32x4 acc[2][8];
#pragma unroll
            for (int rr = 0; rr < 2; ++rr)
#pragma unroll
                for (int q = 0; q < 8; ++q) acc[rr][q] = (f32x4){0.f, 0.f, 0.f, 0.f};
#pragma unroll 1
            for (int q = 0; q < 4; ++q) {
                __syncthreads();
#pragma unroll
                for (int j = 0; j < 8; ++j) { const int idx = tid + 512 * j, row = idx >> 3, ch = idx & 7;
                    *(LAS f32x4*)(lds + row * RT_STRIDE + ch * 16) = *(const f32x4*)(w_router + (size_t)(512 * q + row) * kE + ch * 4); }
                f32x2 yq[2][4];
#pragma unroll
                for (int ii = 0; ii < 4; ++ii) { const int n = 2 * lane + 128 * (4 * q + ii);
                    const f32x2 w = *(const f32x2*)(nw + n), sh = *(const f32x2*)(mod + b * 6 * kD + 3 * kD + n), sc = *(const f32x2*)(mod + b * 6 * kD + 4 * kD + n);
#pragma unroll
                    for (int rr = 0; rr < 2; ++rr) { const f32x2 v = *(const f32x2*)(x1 + (size_t)(t0 + rr) * kD + n); yq[rr][ii] = v * rs[rr] * w * (1.f + sc) + sh;
                        *(unsigned short*)(h2 + (size_t)(t0 + rr) * kD + n) = (unsigned short)__builtin_amdgcn_cvt_pk_fp8_f32(clamp448(yq[rr][ii][0]), clamp448(yq[rr][ii][1]), 0, false); } }
                __syncthreads();
#pragma unroll
                for (int ii = 0; ii < 4; ++ii)
#pragma unroll
                    for (int e = 0; e < 2; ++e) { const LAS unsigned char* wp = lds + (2 * lane + 128 * ii + e) * RT_STRIDE;
#pragma unroll
                        for (int ch = 0; ch < 8; ++ch) { const f32x4 wv = *(const LAS f32x4*)(wp + ch * 16);
                            acc[0][ch] += yq[0][ii][e] * wv; acc[1][ch] += yq[1][ii][e] * wv; } }
            }
#pragma unroll
            for (int rr = 0; rr < 2; ++rr) {
                float v16[16], v8[8], v4[4], v2[2], v1;
                { const bool up = lane & 32;
#pragma unroll
                  for (int j = 0; j < 16; ++j) { const float lo = acc[rr][j >> 2][j & 3], hi = acc[rr][4 + (j >> 2)][j & 3]; const float send = up ? lo : hi, keep = up ? hi : lo; v16[j] = keep + __shfl_xor(send, 32); } }
                { const bool up = lane & 16;
#pragma unroll
                  for (int j = 0; j < 8; ++j) { const float send = up ? v16[j] : v16[j + 8], keep = up ? v16[j + 8] : v16[j]; v8[j] = keep + __shfl_xor(send, 16); } }
                { const bool up = lane & 8;
#pragma unroll
                  for (int j = 0; j < 4; ++j) { const float send = up ? v8[j] : v8[j + 4], keep = up ? v8[j + 4] : v8[j]; v4[j] = keep + __shfl_xor(send, 8); } }
                { const bool up = lane & 4;
#pragma unroll
                  for (int j = 0; j < 2; ++j) { const float send = up ? v4[j] : v4[j + 2], keep = up ? v4[j + 2] : v4[j]; v2[j] = keep + __shfl_xor(send, 4); } }
                { const bool up = lane & 2; const float send = up ? v2[0] : v2[1], keep = up ? v2[1] : v2[0]; v1 = keep + __shfl_xor(send, 2); }
                v1 += __shfl_xor(v1, 1);
                const int e_mine = (lane >> 1) & 31;
                float mine = (lane & 1) ? -3.4e38f : v1 + b_router[e_mine];
                int idx[4]; float val[4];
#pragma unroll
                for (int k = 0; k < 4; ++k) { float bv = mine; int bi = e_mine + ((lane & 1) << 6);
#pragma unroll
                    for (int o = 32; o > 0; o >>= 1) { const float ov = __shfl_xor(bv, o); const int oi = __shfl_xor(bi, o); if (ov > bv || (ov == bv && oi < bi)) { bv = ov; bi = oi; } }
                    idx[k] = bi; val[k] = bv; if (!(lane & 1) && e_mine == bi) mine = -3.4e38f; }
                if (lane == 0) { const int t = t0 + rr; float ex[4], sum = 0.f;
#pragma unroll
                    for (int k = 0; k < 4; ++k) { ex[k] = __expf(val[k] - val[0]); sum += ex[k]; }
                    const float inv = 1.f / sum;
#pragma unroll
                    for (int k = 0; k < 4; ++k) { gates[t * 4 + k] = ex[k] * inv; pair_e[t * 4 + k] = idx[k];
                        const unsigned pos = atomicAdd(&ctrl[CT_CNT + idx[k]], 1u); pair_p[t * 4 + k] = (int)pos; list[(size_t)idx[k] * kT + pos] = t; } }
            }
        }
    }
}

__device__ __forceinline__ void final_phase(const float* __restrict__ x1, const float* __restrict__ mod, const float* __restrict__ gates, const int* __restrict__ pair_e, const int* __restrict__ pair_p,
                                            const MoeTab M, const bf16_t* __restrict__ yp, float* __restrict__ out, int G, int c) {
    const int wid = threadIdx.x >> 6, lane = threadIdx.x & 63;
    for (int t = c * 8 + wid; t < kT; t += G * 8) {
        const int b = t / kS; float gk[4]; const bf16_t* rp[4];
#pragma unroll
        for (int k = 0; k < 4; ++k) { gk[k] = gates[t * 4 + k]; const int e = pair_e[t * 4 + k];
            rp[k] = yp + (size_t)(M.t[32 + e] + pair_p[t * 4 + k]) * kD + lane * 8; }
#pragma unroll
        for (int j = 0; j < 4; ++j) { f32x4 y0 = {0.f, 0.f, 0.f, 0.f}, y1 = y0;
#pragma unroll
            for (int k = 0; k < 4; ++k) { const u32x4 v = *(const u32x4*)(rp[k] + 512 * j);
                y0 += gk[k] * (f32x4){bflo(v.x), bfhi(v.x), bflo(v.y), bfhi(v.y)}; y1 += gk[k] * (f32x4){bflo(v.z), bfhi(v.z), bflo(v.w), bfhi(v.w)}; }
            const size_t o = (size_t)t * kD + lane * 8 + 512 * j; const float* gp = mod + b * 6 * kD + 5 * kD + lane * 8 + 512 * j;
            *(f32x4*)(out + o) = *(const f32x4*)(x1 + o) + *(const f32x4*)gp * y0; *(f32x4*)(out + o + 4) = *(const f32x4*)(x1 + o + 4) + *(const f32x4*)(gp + 4) * y1; }
    }
}

struct MegaArgs { const float* in[18]; float* out; unsigned char* ws; int ph_lo, ph_hi; };
constexpr int NPHASE = 10;
__global__ void __launch_bounds__(512, 2) mega(MegaArgs a) {
    extern __shared__ __attribute__((aligned(16))) unsigned char lds_raw[];
    LAS unsigned char* lds = (LAS unsigned char*)lds_raw;
    unsigned char* ws = a.ws;
    const int lo = a.ph_lo, hi = a.ph_hi;
#ifndef DUP_PHASE
#define DUP_PHASE -1
#endif
#define IN(k) (lo <= (k) && (k) < hi)
#define REP(k)
#define DUPQ(k) ((k) == DUP_PHASE)
#define SEAM(k) do { if (IN(k) && IN((k) + 1)) xcd_barrier(bar); } while (0)
    const int G = gridDim.x, c = blockIdx.x;
    unsigned* ctrl = (unsigned*)(ws + WS_CTRL);
    if (threadIdx.x == 0) *(LAS u32x4*)(lds + fg::MISC_OFF) = (u32x4){0u, 0u, 0u, 0u};
    __syncthreads();
    XcdBarrier bar; bar.bar = ctrl; bar.x = 0; bar.st = (volatile LAS unsigned*)(lds + fg::MISC_OFF);
    if (hi - lo > 1) bar = xcd_barrier_post(ctrl, (volatile LAS unsigned*)(lds + fg::MISC_OFF));
    float* mod = (float*)(ws + WS_MOD);
    if (IN(0)) REP(0) {
        ada_phase(lds, a.in[1], a.in[4], a.in[5], mod, G, c);
        const size_t gtid = (size_t)blockIdx.x * 512 + threadIdx.x, gstride = (size_t)G * 512;
        convert_seg(a.in[6], (bf16_t*)(ws + WS_WIN), (size_t)kD * kNPROJ / 8, gtid, gstride);
        convert_seg(a.in[11], (bf16_t*)(ws + WS_WO), (size_t)kD * kD / 8, gtid, gstride);
        { const f32x4* s4 = (const f32x4*)a.in[9]; const f32x4* sc4 = (const f32x4*)a.in[10]; u32x4* d4 = (u32x4*)(ws + WS_WPL);
          for (size_t i = gtid; i < (size_t)4 * kPG * kPG / 8; i += gstride) { const int g = (int)(i >> 13), n8 = (int)(i & 31);
              const f32x4 sa = sc4[g * 64 + n8 * 2], sb = sc4[g * 64 + n8 * 2 + 1]; const f32x4 a0 = s4[2 * i] * sa, b0 = s4[2 * i + 1] * sb;
              u32x4 w; w.x = pk_bf16(a0[0], a0[1]); w.y = pk_bf16(a0[2], a0[3]); w.z = pk_bf16(b0[0], b0[1]); w.w = pk_bf16(b0[2], b0[3]); d4[i] = w; } }
        convert_t_f8(lds, a.in[14], (unsigned char*)(ws + WS_WE1), kE, kD, 2 * kDFF, G, c);
        convert_t_f8(lds, a.in[16], (unsigned char*)(ws + WS_WE2), kE, kDFF, kD, G, c);
    }
    SEAM(0);
    if (IN(1)) REP(1) norm1_phase(a.in[0], a.in[2], mod, (bf16_t*)(ws + WS_H), G, c);
    if (IN(1) && DUPQ(1)) norm1_phase(a.in[0], a.in[2], mod, (bf16_t*)(ws + WS_H), G, c);
    SEAM(1);
    if (IN(2)) REP(2) { JobInProj J; J.A = (const char*)(ws + WS_H); J.lda2 = kD * 2; J.ldb2 = kNPROJ * 2; J.bhalf2 = 256; J.K = kD; J.list = nullptr;
        J.B = (const char*)(ws + WS_WIN); J.out = (bf16_t*)(ws + WS_PROJ); J.S.init(kT, kNPROJ, G, c); fg::gemm_phase(lds, J); }
    if (IN(2) && DUPQ(2)) { JobInProj J; J.A = (const char*)(ws + WS_H); J.lda2 = kD * 2; J.ldb2 = kNPROJ * 2; J.bhalf2 = 256; J.K = kD; J.list = nullptr;
        J.B = (const char*)(ws + WS_WIN); J.out = (bf16_t*)(ws + WS_PROJ); J.S.init(kT, kNPROJ, G, c); fg::gemm_phase(lds, J); }
    SEAM(2);
    if (IN(3)) REP(3) { at::attn_phase(lds, (const bf16_t*)(ws + WS_PROJ), a.in[7], a.in[8], (bf16_t*)(ws + WS_CAT), G, c);
        pool_p_phase((const bf16_t*)(ws + WS_PROJ), (bf16_t*)(ws + WS_P), G, c); }
    if (IN(3) && DUPQ(3)) { at::attn_phase(lds, (const bf16_t*)(ws + WS_PROJ), a.in[7], a.in[8], (bf16_t*)(ws + WS_CAT), G, c);
        pool_p_phase((const bf16_t*)(ws + WS_PROJ), (bf16_t*)(ws + WS_P), G, c); }
    SEAM(3);
    if (IN(4)) REP(4) { JobPool J; J.A = (const char*)(ws + WS_P); J.lda2 = kPW * 2; J.ldb2 = kPG * 2; J.bhalf2 = 256; J.K = kPG; J.list = nullptr;
        J.B = (const char*)(ws + WS_WPL); J.cat = (bf16_t*)(ws + WS_CAT); J.G = G; J.c = c; fg::gemm_phase(lds, J); }
    if (IN(4) && DUPQ(4)) { JobPool J; J.A = (const char*)(ws + WS_P); J.lda2 = kPW * 2; J.ldb2 = kPG * 2; J.bhalf2 = 256; J.K = kPG; J.list = nullptr;
        J.B = (const char*)(ws + WS_WPL); J.cat = (bf16_t*)(ws + WS_CAT); J.G = G; J.c = c; fg::gemm_phase(lds, J); }
    SEAM(4);
    if (IN(5)) REP(5) { JobOutProj J; J.A = (const char*)(ws + WS_CAT); J.lda2 = kD * 2; J.ldb2 = kD * 2; J.bhalf2 = 256; J.K = kD; J.list = nullptr;
        J.B = (const char*)(ws + WS_WO); J.x = a.in[0]; J.mod = mod; J.x1 = (float*)(ws + WS_X1); J.S.init(kT, kD, G, c); fg::gemm_phase(lds, J); }
    if (IN(5) && DUPQ(5)) { JobOutProj J; J.A = (const char*)(ws + WS_CAT); J.lda2 = kD * 2; J.ldb2 = kD * 2; J.bhalf2 = 256; J.K = kD; J.list = nullptr;
        J.B = (const char*)(ws + WS_WO); J.x = a.in[0]; J.mod = mod; J.x1 = (float*)(ws + WS_X1); J.S.init(kT, kD, G, c); fg::gemm_phase(lds, J); }
    SEAM(5);
    if (IN(6)) REP(6) norm2_router_phase(lds, (const float*)(ws + WS_X1), a.in[3], mod, a.in[12], a.in[13], (unsigned char*)(ws + WS_H2), (float*)(ws + WS_GATES), (int*)(ws + WS_PAIRE), (int*)(ws + WS_PAIRP),
                                  (int*)(ws + WS_LIST), ctrl, G, c);
    SEAM(6);
    if (IN(7)) REP(7) { JobMoe1F8 J; J.A = (const char*)(ws + WS_H2); J.lda2 = kD; J.ldb2 = kD; J.bhalf2 = (unsigned)kDFF * kD; J.K = kD; J.list = (const int*)(ws + WS_LIST);
        J.B = (const char*)(ws + WS_WE1); J.b_in = a.in[15]; J.act = (unsigned char*)(ws + WS_ACT); J.M = moe_tables(lds, ctrl, kDFF / 128); J.G = G; J.c = c; fg::gemm_phase_f8(lds, J); }
    if (IN(7) && DUPQ(7)) { JobMoe1F8 J; J.A = (const char*)(ws + WS_H2); J.lda2 = kD; J.ldb2 = kD; J.bhalf2 = (unsigned)kDFF * kD; J.K = kD; J.list = (const int*)(ws + WS_LIST);
        J.B = (const char*)(ws + WS_WE1); J.b_in = a.in[15]; J.act = (unsigned char*)(ws + WS_ACT); J.M = moe_tables(lds, ctrl, kDFF / 128); J.G = G; J.c = c; fg::gemm_phase_f8(lds, J); }
    SEAM(7);
    if (IN(8)) REP(8) { JobMoe2F8 J; J.A = (const char*)(ws + WS_ACT); J.lda2 = kDFF; J.ldb2 = kDFF; J.bhalf2 = 128u * kDFF; J.K = kDFF; J.list = nullptr;
        J.B = (const char*)(ws + WS_WE2); J.b_out = a.in[17]; J.yp = (bf16_t*)(ws + WS_YP); J.M = moe_tables(lds, ctrl, kD / 256); J.G = G; J.c = c; fg::gemm_phase_f8(lds, J); }
    if (IN(8) && DUPQ(8)) { JobMoe2F8 J; J.A = (const char*)(ws + WS_ACT); J.lda2 = kDFF; J.ldb2 = kDFF; J.bhalf2 = 128u * kDFF; J.K = kDFF; J.list = nullptr;
        J.B = (const char*)(ws + WS_WE2); J.b_out = a.in[17]; J.yp = (bf16_t*)(ws + WS_YP); J.M = moe_tables(lds, ctrl, kD / 256); J.G = G; J.c = c; fg::gemm_phase_f8(lds, J); }
    SEAM(8);
    if (IN(9)) REP(9) final_phase((const float*)(ws + WS_X1), mod, (const float*)(ws + WS_GATES), (const int*)(ws + WS_PAIRE), (const int*)(ws + WS_PAIRP), moe_tables(lds, ctrl, 1), (const bf16_t*)(ws + WS_YP), a.out, G, c);
    if (IN(9) && DUPQ(9)) final_phase((const float*)(ws + WS_X1), mod, (const float*)(ws + WS_GATES), (const int*)(ws + WS_PAIRE), (const int*)(ws + WS_PAIRP), moe_tables(lds, ctrl, 1), (const bf16_t*)(ws + WS_YP), a.out, G, c);
#undef IN
#undef SEAM
}

#ifndef N_LAUNCHES
#define N_LAUNCHES 1
#endif
extern "C" void kernel_launch(void* const* d_in, const int* in_sizes, int n_in, void* d_out, int out_size, void* d_ws, size_t ws_size, hipStream_t stream) {
    static int grid = 0;
    if (grid == 0) {
        int dev = 0, cus = 0;
        (void)hipGetDevice(&dev); (void)hipDeviceGetAttribute(&cus, hipDeviceAttributeMultiprocessorCount, dev);
        (void)hipFuncSetAttribute((const void*)mega, hipFuncAttributeMaxDynamicSharedMemorySize, fg::LDS_BYTES);
        grid = cus > 0 ? cus : 256;
    }
    MegaArgs a{}; for (int i = 0; i < 18; ++i) a.in[i] = (const float*)d_in[i]; a.out = (float*)d_out; a.ws = (unsigned char*)d_ws;
    (void)hipMemsetAsync((char*)d_ws + WS_CTRL, 0, 65536, stream);
    if (N_LAUNCHES == 1) { a.ph_lo = 0; a.ph_hi = NPHASE; hipLaunchKernelGGL(mega, dim3(grid), dim3(512), fg::LDS_BYTES, stream, a); }
    else for (int p = 0; p < NPHASE; ++p) { a.ph_lo = p; a.ph_hi = p + 1; hipLaunchKernelGGL(mega, dim3(grid), dim3(512), fg::LDS_BYTES, stream, a); }
}
```

```cpp
#include <hip/hip_runtime.h>
#include <stdint.h>

constexpr int kB = 4, kS = 2048, kD = 2048, kT = kB * kS;
constexpr int kHD = 128, kNH = 8, kSB = 1024, kPW = 1024, kPG = 256;
constexpr int kNPROJ = 4096, kE = 32, kTOPK = 4, kDFF = 2048;
constexpr float kEPS = 1e-6f;
constexpr int kMaxSlots = 160 * 256;

typedef unsigned short bf16_t;
__device__ __forceinline__ bf16_t f2bf(float f) { unsigned u = __float_as_uint(f); u += 0x7FFFu + ((u >> 16) & 1u); return (bf16_t)(u >> 16); }
__device__ __forceinline__ float bf2f(bf16_t b) { return __uint_as_float(((unsigned)b) << 16); }

constexpr size_t WS_CTRL   = 0;
constexpr size_t WS_MOD    = 65536;
constexpr size_t WS_H      = WS_MOD + (size_t)4 * 12288 * 4;
constexpr size_t WS_PROJ   = WS_H + (size_t)kT * kD * 2;
constexpr size_t WS_CAT    = WS_PROJ + (size_t)kT * kNPROJ * 2;
constexpr size_t WS_P      = WS_CAT + (size_t)kT * kD * 2;
constexpr size_t WS_X1     = WS_P + (size_t)kT * kPW * 2;
constexpr size_t WS_H2     = WS_X1 + (size_t)kT * kD * 4;
constexpr size_t WS_GATES  = WS_H2 + (size_t)kT * kD * 2;
constexpr size_t WS_PAIRE  = WS_GATES + (size_t)kT * 4 * 4;
constexpr size_t WS_PAIRP  = WS_PAIRE + (size_t)kT * 4 * 4;
constexpr size_t WS_LIST   = WS_PAIRP + (size_t)kT * 4 * 4;
constexpr size_t WS_ACT    = WS_LIST + (size_t)kE * kT * 4;
constexpr size_t WS_YP     = WS_ACT + (size_t)kMaxSlots * kDFF * 2;
constexpr size_t WS_END    = WS_YP + (size_t)kMaxSlots * kD * 2;
constexpr int CT_CNT = 4096;
constexpr int CT_ROWBASE = 4160;

__global__ void k_ada(const float* __restrict__ c, const float* __restrict__ w_ada, const float* __restrict__ b_ada, float* __restrict__ mod) {
    __shared__ float ca[kB][kD];
    for (int i = threadIdx.x; i < kB * kD; i += blockDim.x) { const float v = c[i]; ca[i / kD][i % kD] = v / (1.f + __expf(-v)); }
    __syncthreads();
    const int n = blockIdx.x * blockDim.x + threadIdx.x;
    float a0 = 0.f, a1 = 0.f, a2 = 0.f, a3 = 0.f;
    for (int k = 0; k < kD; ++k) { const float w = w_ada[(size_t)k * (6 * kD) + n]; a0 += ca[0][k] * w; a1 += ca[1][k] * w; a2 += ca[2][k] * w; a3 += ca[3][k] * w; }
    const float bb = b_ada[n];
    mod[0 * 6 * kD + n] = a0 + bb; mod[1 * 6 * kD + n] = a1 + bb; mod[2 * 6 * kD + n] = a2 + bb; mod[3 * 6 * kD + n] = a3 + bb;
}

__device__ __forceinline__ float block_sum_256(float v, float* red) {
    for (int o = 32; o > 0; o >>= 1) v += __shfl_down(v, o);
    const int w = threadIdx.x >> 6, l = threadIdx.x & 63;
    __syncthreads();
    if (l == 0) red[w] = v;
    __syncthreads();
    return red[0] + red[1] + red[2] + red[3];
}
__global__ void k_norm_mod(const float* __restrict__ x, const float* __restrict__ nw, const float* __restrict__ mod, int shift_off, int scale_off, bf16_t* __restrict__ out) {
    __shared__ float red[4];
    const int t = blockIdx.x, b = t / kS;
    const float* xr = x + (size_t)t * kD;
    float v[8]; float ss = 0.f;
    for (int i = 0; i < 8; ++i) { v[i] = xr[threadIdx.x + 256 * i]; ss += v[i] * v[i]; }
    ss = block_sum_256(ss, red);
    const float r = rsqrtf(ss / kD + kEPS);
    for (int i = 0; i < 8; ++i) { const int n = threadIdx.x + 256 * i;
        const float y = v[i] * r * nw[n] * (1.f + mod[b * 6 * kD + scale_off + n]) + mod[b * 6 * kD + shift_off + n];
        out[(size_t)t * kD + n] = f2bf(y); }
}

struct GemmArgs { const bf16_t* A; const float* B; int lda; int ldb; int K; int pad; };
template <class RowFn, class Epi>
__global__ void __launch_bounds__(256) k_gemm_naive(GemmArgs g, RowFn rowfn, Epi epi) {
    __shared__ float As[16][68], Bs[16][64];
    const int z = blockIdx.z;
    int mrows; const bf16_t* Abase; const float* Bbase;
    if (!rowfn.setup(z, g, mrows, Abase, Bbase)) return;
    const int m0 = blockIdx.y * 64, n0 = blockIdx.x * 64;
    if (m0 >= mrows) return;
    const int tid = threadIdx.x, ty = tid >> 4, tx = tid & 15;
    const int ar = tid >> 2, ak = (tid & 3) * 4;
    const int bk = tid >> 4, bn = (tid & 15) * 4;
    const long arow = rowfn.row(z, m0 + ar, mrows);
    const bf16_t* ap = Abase + arow * (long)g.lda + ak;
    const float* bp = Bbase + (size_t)bk * g.ldb + n0 + bn;
    float acc[4][4] = {};
    for (int k0 = 0; k0 < g.K; k0 += 16) {
        const uint2 av = *(const uint2*)(ap + k0);
        const float4 bv = *(const float4*)(bp + (size_t)k0 * g.ldb);
        __syncthreads();
        As[ak + 0][ar] = __uint_as_float(av.x << 16); As[ak + 1][ar] = __uint_as_float(av.x & 0xFFFF0000u);
        As[ak + 2][ar] = __uint_as_float(av.y << 16); As[ak + 3][ar] = __uint_as_float(av.y & 0xFFFF0000u);
        *(float4*)&Bs[bk][bn] = bv;
        __syncthreads();
#pragma unroll
        for (int k = 0; k < 16; ++k) {
            const float4 a4 = *(const float4*)&As[k][ty * 4]; const float4 b4 = *(const float4*)&Bs[k][tx * 4];
            const float a[4] = {a4.x, a4.y, a4.z, a4.w}, b[4] = {b4.x, b4.y, b4.z, b4.w};
#pragma unroll
            for (int i = 0; i < 4; ++i)
#pragma unroll
                for (int j = 0; j < 4; ++j) acc[i][j] += a[i] * b[j];
        }
    }
#pragma unroll
    for (int i = 0; i < 4; ++i)
#pragma unroll
        for (int j = 0; j < 4; ++j) epi(z, m0 + ty * 4 + i, n0 + tx * 4 + j, acc[i][j], mrows);
}
struct RowDense { int M;
    __device__ bool setup(int, const GemmArgs& g, int& mrows, const bf16_t*& A, const float*& B) const { mrows = M; A = g.A; B = g.B; return true; }
    __device__ long row(int, int r, int) const { return r; } };
struct EpiStoreBf16 { bf16_t* C; int ldc; int pad;
    __device__ void operator()(int, int r, int c, float v, int) const { C[(size_t)r * ldc + c] = f2bf(v); } };
struct EpiOutProj { const float* x; const float* mod; float* x1;
    __device__ void operator()(int, int r, int c, float v, int) const { const int b = r / kS; x1[(size_t)r * kD + c] = x[(size_t)r * kD + c] + mod[b * 6 * kD + 2 * kD + c] * v; } };
struct RowPool { int pad; __device__ bool setup(int z, const GemmArgs& g, int& mrows, const bf16_t*& A, const float*& B) const { mrows = kT; A = g.A + z * kPG; B = g.B + (size_t)z * kPG * kPG; return true; }
    __device__ long row(int, int r, int) const { return r; } };
struct EpiPool { const float* pool_scale; bf16_t* cat;
    __device__ void operator()(int z, int r, int c, float v, int) const { cat[(size_t)r * kD + kSB + z * kPG + c] = f2bf(v * pool_scale[z * kPG + c]); } };

__global__ void __launch_bounds__(256) k_attn_naive(const bf16_t* __restrict__ proj, const float* __restrict__ qw, const float* __restrict__ kw, bf16_t* __restrict__ cat) {
    __shared__ float qs[4][kHD];
    const int w = threadIdx.x >> 6, lane = threadIdx.x & 63;
    const int rowid = blockIdx.x * 4 + w;
    const int t = rowid % kS, bh = rowid / kS, h = bh % kNH, b = bh / kNH;
    const bf16_t* qrow = proj + (size_t)(b * kS + t) * kNPROJ + h * kHD;
    float q0 = bf2f(qrow[lane]), q1 = bf2f(qrow[lane + 64]);
    float ss = q0 * q0 + q1 * q1;
    for (int o = 32; o > 0; o >>= 1) ss += __shfl_xor(ss, o);
    const float rq = rsqrtf(ss / kHD + kEPS) * 0.08838834764831845f;
    qs[w][lane] = q0 * rq * qw[lane] * kw[lane]; qs[w][lane + 64] = q1 * rq * qw[lane + 64] * kw[lane + 64];
    __syncthreads();
    float o0 = 0.f, o1 = 0.f, carry = 0.f;
    for (int jb = ((t - 1) >> 6) << 6; jb >= 0 && t > 0; jb -= 64) {
        const int j = jb + lane; const bool valid = j < t;
        float z = 0.f, sp = 0.f;
        if (valid) {
            const bf16_t* krow = proj + (size_t)(b * kS + j) * kNPROJ + kSB + h * kHD;
            float dot = 0.f, kss = 0.f;
            for (int d = 0; d < kHD; d += 8) { const uint4 kv = *(const uint4*)(krow + d); const unsigned u[4] = {kv.x, kv.y, kv.z, kv.w};
#pragma unroll
                for (int e = 0; e < 4; ++e) { const float k0 = __uint_as_float(u[e] << 16), k1 = __uint_as_float(u[e] & 0xFFFF0000u);
                    dot += qs[w][d + 2 * e] * k0 + qs[w][d + 2 * e + 1] * k1; kss += k0 * k0 + k1 * k1; } }
            z = dot * rsqrtf(kss / kHD + kEPS);
            sp = (z > 15.f) ? z : log1pf(__expf(z));
        }
        float s = sp;
        for (int o = 1; o < 64; o <<= 1) { const float v = __shfl_down(s, o); if (lane + o < 64) s += v; }
        const float a = valid ? __expf(z - (carry + s)) : 0.f;
        carry += __shfl(s, 0);
        const int jmax = min(64, t - jb);
        const bf16_t* vb = proj + (size_t)(b * kS + jb) * kNPROJ + 2 * kSB + h * kHD;
        for (int l = 0; l < jmax; ++l) { const float al = __shfl(a, l); o0 += al * bf2f(vb[(size_t)l * kNPROJ + lane]); o1 += al * bf2f(vb[(size_t)l * kNPROJ + lane + 64]); }
    }
    bf16_t* orow = cat + (size_t)(b * kS + t) * kD + h * kHD;
    orow[lane] = f2bf(o0); orow[lane + 64] = f2bf(o1);
}

__global__ void k_pool_p(const bf16_t* __restrict__ proj, bf16_t* __restrict__ p) {
    const int idx = blockIdx.x * blockDim.x + threadIdx.x;
    const int c = idx & (kPW - 1), t = idx >> 10, s = t % kS, g = c >> 8;
    const int w = 2 << g;
    const int cnt = min(s + 1, w);
    float sum = 0.f;
    for (int i = 0; i < cnt; ++i) sum += bf2f(proj[(size_t)(t - i) * kNPROJ + 3 * kSB + c]);
    const float u = bf2f(proj[(size_t)t * kNPROJ + 3 * kSB + c]);
    p[(size_t)t * kPW + c] = f2bf(sum / (float)cnt - u);
}

__global__ void __launch_bounds__(256) k_norm2_router(const float* __restrict__ x1, const float* __restrict__ nw, const float* __restrict__ mod,
                               const float* __restrict__ w_router, const float* __restrict__ b_router, unsigned char* __restrict__ h2,
                               float* __restrict__ gates, int* __restrict__ pair_e, int* __restrict__ pair_p, int* __restrict__ list, unsigned* __restrict__ ctrl) {
    __shared__ float red[4]; __shared__ float lg[4][kE];
    const int t = blockIdx.x, b = t / kS;
    const float* xr = x1 + (size_t)t * kD;
    float v[8]; float ss = 0.f;
    for (int i = 0; i < 8; ++i) { v[i] = xr[threadIdx.x + 256 * i]; ss += v[i] * v[i]; }
    ss = block_sum_256(ss, red);
    const float r = rsqrtf(ss / kD + kEPS);
    float part[kE];
#pragma unroll
    for (int e = 0; e < kE; ++e) part[e] = 0.f;
    for (int i = 0; i < 8; ++i) { const int n = threadIdx.x + 256 * i;
        const float y = v[i] * r * nw[n] * (1.f + mod[b * 6 * kD + 4 * kD + n]) + mod[b * 6 * kD + 3 * kD + n];
        h2[(size_t)t * kD + n] = f2bf(y);
        const float4* wr = (const float4*)(w_router + (size_t)n * kE);
#pragma unroll
        for (int e4 = 0; e4 < 8; ++e4) { const float4 w4 = wr[e4]; part[e4 * 4] += y * w4.x; part[e4 * 4 + 1] += y * w4.y; part[e4 * 4 + 2] += y * w4.z; part[e4 * 4 + 3] += y * w4.w; } }
    const int wv = threadIdx.x >> 6, l = threadIdx.x & 63;
#pragma unroll
    for (int e = 0; e < kE; ++e) { float s = part[e]; for (int o = 32; o > 0; o >>= 1) s += __shfl_down(s, o); if (l == 0) lg[wv][e] = s; }
    __syncthreads();
    if (threadIdx.x < 64) {
        const int e = l & 31;
        float mine = lg[0][e] + lg[1][e] + lg[2][e] + lg[3][e] + b_router[e];
        if (l >= 32) mine = -3.4e38f;
        int idx[4]; float val[4];
#pragma unroll
        for (int k = 0; k < 4; ++k) {
            float bv = mine; int bi = l;
            for (int o = 32; o > 0; o >>= 1) { const float ov = __shfl_xor(bv, o); const int oi = __shfl_xor(bi, o); if (ov > bv || (ov == bv && oi < bi)) { bv = ov; bi = oi; } }
            idx[k] = bi; val[k] = bv; if (l == bi) mine = -3.4e38f;
        }
        if (l == 0) {
            float ex[4], sum = 0.f;
#pragma unroll
            for (int k = 0; k < 4; ++k) { ex[k] = __expf(val[k] - val[0]); sum += ex[k]; }
#pragma unroll
            for (int k = 0; k < 4; ++k) { gates[t * 4 + k] = ex[k] / sum; pair_e[t * 4 + k] = idx[k];
                const unsigned pos = atomicAdd(&ctrl[CT_CNT + idx[k]], 1u); pair_p[t * 4 + k] = (int)pos; list[(size_t)idx[k] * kT + pos] = t; }
        }
    }
}
__global__ void k_moe_plan(unsigned* ctrl) {
    if (threadIdx.x == 0) { unsigned base = 0; for (int e = 0; e < kE; ++e) { ctrl[CT_ROWBASE + e] = base; base += ((ctrl[CT_CNT + e] + 255u) / 256u) * 256u; } ctrl[CT_ROWBASE + kE] = base; }
}

__global__ void __launch_bounds__(256) k_moe1_naive(const bf16_t* __restrict__ h2, const float* __restrict__ w_in, const float* __restrict__ b_in, const int* __restrict__ list,
                                                    const unsigned* __restrict__ ctrl, bf16_t* __restrict__ act) {
    __shared__ float As[16][68], Bg[16][64], Bl[16][64];
    const int e = blockIdx.z; const int mrows = (int)ctrl[CT_CNT + e];
    const int m0 = blockIdx.y * 64, n0 = blockIdx.x * 64;
    if (m0 >= mrows) return;
    const int rowbase = (int)ctrl[CT_ROWBASE + e];
    const int tid = threadIdx.x, ty = tid >> 4, tx = tid & 15;
    const int ar = tid >> 2, ak = (tid & 3) * 4, bk = tid >> 4, bn = (tid & 15) * 4;
    const int tok = list[(size_t)e * kT + min(m0 + ar, mrows - 1)];
    const bf16_t* ap = h2 + (size_t)tok * kD + ak;
    const float* bp = w_in + (size_t)e * kD * 2 * kDFF + (size_t)bk * (2 * kDFF) + n0 + bn;
    float ag[4][4] = {}, al[4][4] = {};
    for (int k0 = 0; k0 < kD; k0 += 16) {
        const uint2 av = *(const uint2*)(ap + k0);
        const float4 g4 = *(const float4*)(bp + (size_t)k0 * (2 * kDFF)); const float4 l4 = *(const float4*)(bp + (size_t)k0 * (2 * kDFF) + kDFF);
        __syncthreads();
        As[ak + 0][ar] = __uint_as_float(av.x << 16); As[ak + 1][ar] = __uint_as_float(av.x & 0xFFFF0000u);
        As[ak + 2][ar] = __uint_as_float(av.y << 16); As[ak + 3][ar] = __uint_as_float(av.y & 0xFFFF0000u);
        *(float4*)&Bg[bk][bn] = g4; *(float4*)&Bl[bk][bn] = l4;
        __syncthreads();
#pragma unroll
        for (int k = 0; k < 16; ++k) {
            const float4 a4 = *(const float4*)&As[k][ty * 4]; const float4 g44 = *(const float4*)&Bg[k][tx * 4]; const float4 l44 = *(const float4*)&Bl[k][tx * 4];
            const float a[4] = {a4.x, a4.y, a4.z, a4.w}, gg[4] = {g44.x, g44.y, g44.z, g44.w}, ll[4] = {l44.x, l44.y, l44.z, l44.w};
#pragma unroll
            for (int i = 0; i < 4; ++i)
#pragma unroll
                for (int j = 0; j < 4; ++j) { ag[i][j] += a[i] * gg[j]; al[i][j] += a[i] * ll[j]; }
        }
    }
    for (int i = 0; i < 4; ++i) { const int r = m0 + ty * 4 + i; if (r >= mrows) continue;
        for (int j = 0; j < 4; ++j) { const int c = n0 + tx * 4 + j;
            float gv = ag[i][j] + b_in[(size_t)e * 2 * kDFF + c], lv = al[i][j] + b_in[(size_t)e * 2 * kDFF + kDFF + c];
            gv = fminf(gv, 7.f); lv = fminf(fmaxf(lv, -7.f), 7.f);
            const float a = gv / (1.f + __expf(-1.702f * gv)) * (lv + 1.f);
            act[(size_t)(rowbase + r) * kDFF + c] = f2bf(a); } }
}
struct RowMoe2 { const unsigned* ctrl; const float* w;
    __device__ bool setup(int z, const GemmArgs& g, int& mrows, const bf16_t*& A, const float*& B) const { mrows = (int)ctrl[CT_CNT + z]; A = g.A + (size_t)ctrl[CT_ROWBASE + z] * kDFF; B = w + (size_t)z * kDFF * kD; return mrows > 0; }
    __device__ long row(int, int r, int mrows) const { return r < mrows ? r : mrows - 1; } };
struct EpiMoe2 { const unsigned* ctrl; const float* b_out; bf16_t* yp;
    __device__ void operator()(int z, int r, int c, float v, int mrows) const { if (r < mrows) yp[(size_t)(ctrl[CT_ROWBASE + z] + r) * kD + c] = f2bf(v + b_out[(size_t)z * kD + c]); } };

__global__ void k_final(const float* __restrict__ x1, const float* __restrict__ mod, const float* __restrict__ gates, const int* __restrict__ pair_e, const int* __restrict__ pair_p,
                        const unsigned* __restrict__ ctrl, const bf16_t* __restrict__ yp, float* __restrict__ out) {
    const int t = blockIdx.x, b = t / kS;
    float gk[4]; size_t rows[4];
#pragma unroll
    for (int k = 0; k < 4; ++k) { gk[k] = gates[t * 4 + k]; rows[k] = (size_t)(ctrl[CT_ROWBASE + pair_e[t * 4 + k]] + (unsigned)pair_p[t * 4 + k]); }
    for (int n = threadIdx.x; n < kD; n += blockDim.x) {
        float y = 0.f;
#pragma unroll
        for (int k = 0; k < 4; ++k) y += gk[k] * bf2f(yp[rows[k] * kD + n]);
        out[(size_t)t * kD + n] = x1[(size_t)t * kD + n] + mod[b * 6 * kD + 5 * kD + n] * y;
    }
}


#define LAS __attribute__((address_space(3)))
typedef short bf16x8 __attribute__((ext_vector_type(8)));
typedef short s16x4 __attribute__((ext_vector_type(4)));
typedef float f32x4 __attribute__((ext_vector_type(4)));
typedef float f32x2 __attribute__((ext_vector_type(2)));
typedef __bf16 bf16v2 __attribute__((ext_vector_type(2)));
typedef unsigned u32x2 __attribute__((ext_vector_type(2)));
typedef unsigned u32x4 __attribute__((ext_vector_type(4)));
typedef int i32x4 __attribute__((ext_vector_type(4)));
typedef int i32x8 __attribute__((ext_vector_type(8)));
__device__ __forceinline__ unsigned pk_bf16(float a, float b) { f32x2 v = {a, b}; bf16v2 r = __builtin_convertvector(v, bf16v2); return __builtin_bit_cast(unsigned, r); }

constexpr size_t WS_WIN  = WS_END;
constexpr size_t WS_WO   = WS_WIN + (size_t)kD * kNPROJ * 2;
constexpr size_t WS_WPL  = WS_WO + (size_t)kD * kD * 2;
constexpr size_t WS_WE1  = WS_WPL + (size_t)4 * kPG * kPG * 2;
constexpr size_t WS_WE2  = WS_WE1 + (size_t)kE * kD * 2 * kDFF * 2;
constexpr size_t WS_END2 = WS_WE2 + (size_t)kE * kDFF * kD * 2;

namespace fg {
constexpr int BM = 256, BK = 64, HALF = 128, HTB = 16384, STAGE_BYTES = 131072, NXCD = 8, WGM = 8;
constexpr int TAB_OFF = STAGE_BYTES;
constexpr int MISC_OFF = STAGE_BYTES + 2048;
constexpr int LDS_BYTES = STAGE_BYTES + 4096;
__device__ __forceinline__ int lds_byte(int r, int c) { const int st = (r >> 4) * 2 + (c >> 5), rr = r & 15, cc = c & 31, ob = rr * 64 + cc * 2; return st * 1024 + (ob ^ (((ob >> 9) & 1) << 5)); }
__device__ __forceinline__ void stage_rc(int b, int& R, int& C) { const int st = b / 1024, sb = b % 1024, swz = sb ^ (((sb >> 9) & 1) << 5); R = (st >> 1) * 16 + swz / 64; C = (st & 1) * 32 + (swz % 64) / 2; }

struct Unit { const char* bBase; int arow0; int nvalid; int e; int orow0; int ocol0; int acol2; };

struct StaticOrder {
    int nM, nN, nwg, G, c;
    __device__ void init(int M, int N, int G_, int c_) { nM = M / BM; nN = N / BM; nwg = nM * nN; G = G_; c = c_; }
    __device__ bool next(int i, int& pm, int& pn) const {
        const long L = (long)i * G + c; if (L >= nwg) return false;
        int wgid = (int)L; { const int q = nwg / NXCD, r = nwg % NXCD, xcd = wgid % NXCD, off = wgid / NXCD; wgid = (xcd < r ? xcd * (q + 1) : r * (q + 1) + (xcd - r) * q) + off; }
        const int nig = WGM * nN, gid = wgid / nig, fm = gid * WGM, gsz = (nM - fm) < WGM ? (nM - fm) : WGM;
        pm = fm + ((wgid % nig) % gsz); pn = (wgid % nig) / gsz; return true;
    }
};

template <int OFF> __device__ __forceinline__ s16x4 tr_read(unsigned addr) { s16x4 r; asm volatile("ds_read_b64_tr_b16 %0, %1 offset:%2" : "=&v"(r) : "v"(addr), "i"(OFF) : "memory"); return r; }
template <class Job>
__device__ __forceinline__ void gemm_phase(LAS unsigned char* lds, const Job& J) {
    const int tid = threadIdx.x, wid = __builtin_amdgcn_readfirstlane(tid >> 6), lane = tid & 63, wr = wid >> 2, wc = wid & 3, fr = lane & 15, fq = lane >> 4;
    const int nt = J.K / BK;
    unsigned voffB[2];
#pragma unroll
    for (int i = 0; i < 2; ++i) { int R, C; stage_rc(tid * 16 + i * 8192, R, C);
        const int b = tid * 16 + i * 8192, row = b >> 8, slot = (b >> 4) & 15, ch = slot ^ (((row & 3) << 2) | ((row >> 2) & 3)); voffB[i] = (unsigned)row * J.ldb2 + (unsigned)ch * 16u; }
    const size_t kstepB = (size_t)BK * J.ldb2;
    const unsigned ldsw = (unsigned)wid * 1024u;
    const int aoff = lds_byte(wr * 64 + fr, fq * 8);
    const int tq = (lane & 15) >> 2, tp = lane & 3;
    unsigned ba[2][2];
#pragma unroll
    for (int n = 0; n < 2; ++n)
#pragma unroll
        for (int t = 0; t < 2; ++t) ba[n][t] = (unsigned)(uintptr_t)lds + 256u * (8 * fq + 4 * t + tq) + 16u * ((4 * wc + 2 * n + (tp >> 1)) ^ ((tq << 2) | ((2 * fq + t) & 3))) + 8u * (tp & 1);
#define FG_SA(b, h) (65536 + ((b) * 2 + (h)) * HTB)
#define FG_SB(b, h) (((b) * 2 + (h)) * HTB)
#define FG_STAGE_A(bufoff, gk, vo) do { _Pragma("unroll") for (int _i = 0; _i < 2; ++_i) \
        __builtin_amdgcn_global_load_lds((const unsigned*)((gk) + (vo)[_i]), (LAS unsigned*)(lds + (bufoff) + ldsw + _i * 8192), 16, 0, 0); } while (0)
#define FG_STAGE_B(bufoff, gk) do { _Pragma("unroll") for (int _i = 0; _i < 2; ++_i) \
        __builtin_amdgcn_global_load_lds((const unsigned*)((gk) + voffB[_i]), (LAS unsigned*)(lds + (bufoff) + ldsw + _i * 8192), 16, 0, 0); } while (0)
#define FG_LDA(dst, b, h) do { _Pragma("unroll") for (int m = 0; m < 4; ++m) _Pragma("unroll") for (int k = 0; k < 2; ++k) dst[m][k] = *(const LAS bf16x8*)(lds + FG_SA(b, h) + aoff + m * 2048 + k * 1024); } while (0)
#define FG_LDB(dst, b, h) do { \
        dst##lo[0][0] = tr_read<FG_SB(b, h)>(ba[0][0]);        dst##hi[0][0] = tr_read<FG_SB(b, h)>(ba[0][1]); \
        dst##lo[0][1] = tr_read<FG_SB(b, h) + 8192>(ba[0][0]); dst##hi[0][1] = tr_read<FG_SB(b, h) + 8192>(ba[0][1]); \
        dst##lo[1][0] = tr_read<FG_SB(b, h)>(ba[1][0]);        dst##hi[1][0] = tr_read<FG_SB(b, h)>(ba[1][1]); \
        dst##lo[1][1] = tr_read<FG_SB(b, h) + 8192>(ba[1][0]); dst##hi[1][1] = tr_read<FG_SB(b, h) + 8192>(ba[1][1]); } while (0)
#define FG_PK(L, H) (bf16x8){L[0], L[1], L[2], L[3], H[0], H[1], H[2], H[3]}
#define FG_MMA(ai, bj, At, Bt) do { __builtin_amdgcn_s_setprio(1); _Pragma("unroll") for (int m = 0; m < 4; ++m) _Pragma("unroll") for (int n = 0; n < 2; ++n) _Pragma("unroll") for (int k = 0; k < 2; ++k) \
        acc[ai][bj][m][n] = __builtin_amdgcn_mfma_f32_16x16x32_bf16(FG_PK(Bt##lo[n][k], Bt##hi[n][k]), At[m][k], acc[ai][bj][m][n], 0, 0, 0); __builtin_amdgcn_s_setprio(0); } while (0)
#define FG_WAIT_V(n) asm volatile("s_waitcnt vmcnt(" #n ")" ::: "memory")
#define FG_WAIT_L(n) asm volatile("s_waitcnt lgkmcnt(" #n ")" ::: "memory")
#define FG_BAR __builtin_amdgcn_s_barrier()
#define FG_SCHED __builtin_amdgcn_sched_barrier(0)
#define FG_AOFF(dst, u, tabp) do { int _tz = threadIdx.x; asm volatile("" : "+v"(_tz)); _Pragma("unroll") for (int _i = 0; _i < 2; ++_i) { int _R, _C; stage_rc(_tz * 16 + _i * 8192, _R, _C); \
        _Pragma("unroll") for (int _h = 0; _h < 2; ++_h) { const int _r = _h * 128 + _R; \
        if (Job::GATHER) { const int _tok = (tabp)[_r < (u).nvalid ? _r : 0]; dst[_h][_i] = (unsigned)_tok * J.lda2 + (unsigned)(_C * 2); } \
        else dst[_h][_i] = (unsigned)((u).arow0 + _r) * J.lda2 + (unsigned)((u).acol2 + _C * 2); } } } while (0)
    Unit cur, nxt; int ui = 0;
    if (!J.next(0, cur)) return;
    LAS const int* tab0 = (LAS const int*)(lds + TAB_OFF);
    if (Job::GATHER) {
        if (wid == 0) __builtin_amdgcn_global_load_lds((const unsigned*)(J.list + cur.arow0 + lane * 4), (LAS unsigned*)(lds + TAB_OFF), 16, 0, 0);
        FG_WAIT_V(0); __syncthreads();
    }
    f32x4 acc[2][2][4][2];
#pragma unroll
    for (int a = 0; a < 2; ++a)
#pragma unroll
        for (int b = 0; b < 2; ++b)
#pragma unroll
            for (int m = 0; m < 4; ++m)
#pragma unroll
                for (int n = 0; n < 2; ++n) acc[a][b][m][n] = (f32x4){0.f, 0.f, 0.f, 0.f};
    bf16x8 At[4][2]; s16x4 B0lo[2][2], B0hi[2][2], B1lo[2][2], B1hi[2][2];
    unsigned vc[2][2];
    FG_AOFF(vc, cur, tab0);
    const char* const gA = J.A;
    const char* cB = cur.bBase;
    const unsigned bh2 = J.bhalf2;
    FG_STAGE_B(FG_SB(0, 0), cB); FG_STAGE_A(FG_SA(0, 0), gA, vc[0]); FG_STAGE_B(FG_SB(0, 1), cB + bh2); FG_STAGE_A(FG_SA(0, 1), gA, vc[1]);
    if (wr == 1) FG_BAR;
    FG_WAIT_V(4); FG_BAR;
    FG_STAGE_B(FG_SB(1, 0), cB + kstepB); FG_STAGE_A(FG_SA(1, 0), gA + 128, vc[0]); FG_STAGE_B(FG_SB(1, 1), cB + kstepB + bh2);
    FG_WAIT_V(6); FG_BAR;
    for (;;) {
        const bool has_next = J.next(ui + 1, nxt);
        if (!has_next) nxt = cur;
        if (Job::GATHER && has_next && wid == 0)
            __builtin_amdgcn_global_load_lds((const unsigned*)(J.list + nxt.arow0 + lane * 4), (LAS unsigned*)(lds + TAB_OFF + ((ui + 1) & 1) * 1024), 16, 0, 0);
        const char* nB = nxt.bBase;
        for (int t = 0; t < nt; t += 2) {
            const bool last = (t == nt - 2);
            const char* a1 = gA + (size_t)(t + 1) * 128;
            const char* a2 = last ? gA : gA + (size_t)(t + 2) * 128; const char* b2 = last ? nB : cB + (size_t)(t + 2) * kstepB;
            const char* a3 = a2 + 128; const char* b3 = b2 + kstepB;
            FG_LDB(B0, 0, 0); FG_SCHED; FG_LDA(At, 0, 0); FG_STAGE_A(FG_SA(1, 1), a1, vc[1]);
            if (last && has_next) { LAS const int* tabn = (LAS const int*)(lds + TAB_OFF + ((ui + 1) & 1) * 1024); FG_AOFF(vc, nxt, tabn); }
            FG_WAIT_L(8); FG_BAR; FG_WAIT_L(0); FG_SCHED; FG_MMA(0, 0, At, B0); FG_BAR; FG_SCHED;
            FG_LDB(B1, 0, 1); FG_STAGE_B(FG_SB(0, 0), b2);
            FG_BAR; FG_WAIT_L(0); FG_SCHED; FG_MMA(0, 1, At, B1); FG_BAR;
            FG_LDA(At, 0, 1); FG_STAGE_A(FG_SA(0, 0), a2, vc[0]);
            FG_BAR; FG_WAIT_L(0); FG_MMA(1, 0, At, B0); FG_BAR; FG_SCHED;
            FG_STAGE_B(FG_SB(0, 1), b2 + bh2);
            FG_WAIT_V(6); FG_BAR; FG_MMA(1, 1, At, B1); FG_BAR;
            FG_LDB(B0, 1, 0); FG_SCHED; FG_LDA(At, 1, 0); FG_STAGE_A(FG_SA(0, 1), a2, vc[1]);
            FG_WAIT_L(8); FG_BAR; FG_WAIT_L(0); FG_SCHED; FG_MMA(0, 0, At, B0); FG_BAR; FG_SCHED;
            FG_LDB(B1, 1, 1); FG_STAGE_B(FG_SB(1, 0), b3);
            FG_BAR; FG_WAIT_L(0); FG_SCHED; FG_MMA(0, 1, At, B1); FG_BAR;
            FG_LDA(At, 1, 1); FG_STAGE_A(FG_SA(1, 0), a3, vc[0]);
            FG_BAR; FG_WAIT_L(0); FG_MMA(1, 0, At, B0); FG_BAR; FG_SCHED;
            FG_STAGE_B(FG_SB(1, 1), b3 + bh2);
            FG_WAIT_V(6); FG_BAR; FG_MMA(1, 1, At, B1); FG_BAR;
        }
        J.epi(acc, cur, wr, wc, fr, fq);
        if (!has_next) break;
#pragma unroll
        for (int a = 0; a < 2; ++a)
#pragma unroll
            for (int b = 0; b < 2; ++b)
#pragma unroll
                for (int m = 0; m < 4; ++m)
#pragma unroll
                    for (int n = 0; n < 2; ++n) acc[a][b][m][n] = (f32x4){0.f, 0.f, 0.f, 0.f};
        cur = nxt; cB = nB; ++ui;
    }
    FG_WAIT_V(0);
    if (wr == 0) FG_BAR;
    FG_BAR;
}

#undef FG_SA
#undef FG_SB
#undef FG_STAGE_A
#undef FG_STAGE_B
#undef FG_LDA
#undef FG_LDB
#undef FG_MMA
#undef FG_WAIT_V
#undef FG_WAIT_L
#undef FG_BAR
#undef FG_SCHED
#undef FG_AOFF
template <class Job>
__device__ __forceinline__ void gemm_phase_f8(LAS unsigned char* lds, const Job& J) {
    const int tid = threadIdx.x, wid = __builtin_amdgcn_readfirstlane(tid >> 6), lane = tid & 63, wr = wid >> 2, wc = wid & 3, fr = lane & 15, fq = lane >> 4;
    const int nt = J.K / 128;
    unsigned voffB[2];
#pragma unroll
    for (int i = 0; i < 2; ++i) { int R, C; stage_rc(tid * 16 + i * 8192, R, C);
        voffB[i] = (unsigned)R * J.ldb2 + (unsigned)(C * 2); }
    const size_t kstepB = 128;
    const unsigned ldsw = (unsigned)wid * 1024u;
    const int aoff = lds_byte(wr * 64 + fr, fq * 8);
    const int boff = lds_byte(wc * 32 + fr, fq * 8);
#define FG_SA(b, h) (65536 + ((b) * 2 + (h)) * HTB)
#define FG_SB(b, h) (((b) * 2 + (h)) * HTB)
#define FG_STAGE_A(bufoff, gk, vo) do { _Pragma("unroll") for (int _i = 0; _i < 2; ++_i) \
        __builtin_amdgcn_global_load_lds((const unsigned*)((gk) + (vo)[_i]), (LAS unsigned*)(lds + (bufoff) + ldsw + _i * 8192), 16, 0, 0); } while (0)
#define FG_STAGE_B(bufoff, gk) do { _Pragma("unroll") for (int _i = 0; _i < 2; ++_i) \
        __builtin_amdgcn_global_load_lds((const unsigned*)((gk) + voffB[_i]), (LAS unsigned*)(lds + (bufoff) + ldsw + _i * 8192), 16, 0, 0); } while (0)
#define FG_LDA(dst, b, h) do { _Pragma("unroll") for (int m = 0; m < 4; ++m) _Pragma("unroll") for (int k = 0; k < 2; ++k) dst[m][k] = *(const LAS i32x4*)(lds + FG_SA(b, h) + aoff + m * 2048 + k * 1024); } while (0)
#define FG_LDB(dst, b, h) do { _Pragma("unroll") for (int n = 0; n < 2; ++n) _Pragma("unroll") for (int k = 0; k < 2; ++k) dst[n][k] = *(const LAS i32x4*)(lds + FG_SB(b, h) + boff + n * 2048 + k * 1024); } while (0)
#define FG_CAT8(X, Y) __builtin_shufflevector(X, Y, 0, 1, 2, 3, 4, 5, 6, 7)
#define FG_MMA(ai, bj, At, Bt) do { __builtin_amdgcn_s_setprio(1); _Pragma("unroll") for (int m = 0; m < 4; ++m) _Pragma("unroll") for (int n = 0; n < 2; ++n) \
        acc[ai][bj][m][n] = __builtin_amdgcn_mfma_scale_f32_16x16x128_f8f6f4(FG_CAT8(Bt[n][0], Bt[n][1]), FG_CAT8(At[m][0], At[m][1]), acc[ai][bj][m][n], 0, 0, 0, 0x79797979, 0, 0x7F7F7F7F); __builtin_amdgcn_s_setprio(0); } while (0)
#define FG_WAIT_V(n) asm volatile("s_waitcnt vmcnt(" #n ")" ::: "memory")
#define FG_WAIT_L(n) asm volatile("s_waitcnt lgkmcnt(" #n ")" ::: "memory")
#define FG_BAR __builtin_amdgcn_s_barrier()
#define FG_SCHED __builtin_amdgcn_sched_barrier(0)
#define FG_AOFF(dst, u, tabp) do { int _tz = threadIdx.x; asm volatile("" : "+v"(_tz)); _Pragma("unroll") for (int _i = 0; _i < 2; ++_i) { int _R, _C; stage_rc(_tz * 16 + _i * 8192, _R, _C); \
        _Pragma("unroll") for (int _h = 0; _h < 2; ++_h) { const int _r = _h * 128 + _R; \
        if (Job::GATHER) { const int _tok = (tabp)[_r < (u).nvalid ? _r : 0]; dst[_h][_i] = (unsigned)_tok * J.lda2 + (unsigned)(_C * 2); } \
        else dst[_h][_i] = (unsigned)((u).arow0 + _r) * J.lda2 + (unsigned)((u).acol2 + _C * 2); } } } while (0)
    Unit cur, nxt; int ui = 0;
    if (!J.next(0, cur)) return;
    LAS const int* tab0 = (LAS const int*)(lds + TAB_OFF);
    if (Job::GATHER) {
        if (wid == 0) __builtin_amdgcn_global_load_lds((const unsigned*)(J.list + cur.arow0 + lane * 4), (LAS unsigned*)(lds + TAB_OFF), 16, 0, 0);
        FG_WAIT_V(0); __syncthreads();
    }
    f32x4 acc[2][2][4][2];
#pragma unroll
    for (int a = 0; a < 2; ++a)
#pragma unroll
        for (int b = 0; b < 2; ++b)
#pragma unroll
            for (int m = 0; m < 4; ++m)
#pragma unroll
                for (int n = 0; n < 2; ++n) acc[a][b][m][n] = (f32x4){0.f, 0.f, 0.f, 0.f};
    i32x4 At[4][2], B0[2][2], B1[2][2];
    unsigned vc[2][2];
    FG_AOFF(vc, cur, tab0);
    const char* const gA = J.A;
    const char* cB = cur.bBase;
    const unsigned bh2 = J.bhalf2;
    FG_STAGE_B(FG_SB(0, 0), cB); FG_STAGE_A(FG_SA(0, 0), gA, vc[0]); FG_STAGE_B(FG_SB(0, 1), cB + bh2); FG_STAGE_A(FG_SA(0, 1), gA, vc[1]);
    if (wr == 1) FG_BAR;
    FG_WAIT_V(4); FG_BAR;
    FG_STAGE_B(FG_SB(1, 0), cB + kstepB); FG_STAGE_A(FG_SA(1, 0), gA + 128, vc[0]); FG_STAGE_B(FG_SB(1, 1), cB + kstepB + bh2);
    FG_WAIT_V(6); FG_BAR;
    for (;;) {
        const bool has_next = J.next(ui + 1, nxt);
        if (!has_next) nxt = cur;
        if (Job::GATHER && has_next && wid == 0)
            __builtin_amdgcn_global_load_lds((const unsigned*)(J.list + nxt.arow0 + lane * 4), (LAS unsigned*)(lds + TAB_OFF + ((ui + 1) & 1) * 1024), 16, 0, 0);
        const char* nB = nxt.bBase;
        for (int t = 0; t < nt; t += 2) {
            const bool last = (t == nt - 2);
            const char* a1 = gA + (size_t)(t + 1) * 128;
            const char* a2 = last ? gA : gA + (size_t)(t + 2) * 128; const char* b2 = last ? nB : cB + (size_t)(t + 2) * kstepB;
            const char* a3 = a2 + 128; const char* b3 = b2 + kstepB;
            FG_LDB(B0, 0, 0); FG_SCHED; FG_LDA(At, 0, 0); FG_STAGE_A(FG_SA(1, 1), a1, vc[1]);
            if (last && has_next) { LAS const int* tabn = (LAS const int*)(lds + TAB_OFF + ((ui + 1) & 1) * 1024); FG_AOFF(vc, nxt, tabn); }
            FG_WAIT_L(8); FG_BAR; FG_WAIT_L(0); FG_SCHED; FG_MMA(0, 0, At, B0); FG_BAR; FG_SCHED;
            FG_LDB(B1, 0, 1); FG_STAGE_B(FG_SB(0, 0), b2);
            FG_BAR; FG_WAIT_L(0); FG_SCHED; FG_MMA(0, 1, At, B1); FG_BAR;
            FG_LDA(At, 0, 1); FG_STAGE_A(FG_SA(0, 0), a2, vc[0]);
            FG_BAR; FG_WAIT_L(0); FG_MMA(1, 0, At, B0); FG_BAR; FG_SCHED;
            FG_STAGE_B(FG_SB(0, 1), b2 + bh2);
            FG_WAIT_V(6); FG_BAR; FG_MMA(1, 1, At, B1); FG_BAR;
            FG_LDB(B0, 1, 0); FG_SCHED; FG_LDA(At, 1, 0); FG_STAGE_A(FG_SA(0, 1), a2, vc[1]);
            FG_WAIT_L(8); FG_BAR; FG_WAIT_L(0); FG_SCHED; FG_MMA(0, 0, At, B0); FG_BAR; FG_SCHED;
            FG_LDB(B1, 1, 1); FG_STAGE_B(FG_SB(1, 0), b3);
            FG_BAR; FG_WAIT_L(0); FG_SCHED; FG_MMA(0, 1, At, B1); FG_BAR;
            FG_LDA(At, 1, 1); FG_STAGE_A(FG_SA(1, 0), a3, vc[0]);
            FG_BAR; FG_WAIT_L(0); FG_MMA(1, 0, At, B0); FG_BAR; FG_SCHED;
            FG_STAGE_B(FG_SB(1, 1), b3 + bh2);
            FG_WAIT_V(6); FG_BAR; FG_MMA(1, 1, At, B1); FG_BAR;
        }
        J.epi(acc, cur, wr, wc, fr, fq);
        if (!has_next) break;
#pragma unroll
        for (int a = 0; a < 2; ++a)
#pragma unroll
            for (int b = 0; b < 2; ++b)
#pragma unroll
                for (int m = 0; m < 4; ++m)
#pragma unroll
                    for (int n = 0; n < 2; ++n) acc[a][b][m][n] = (f32x4){0.f, 0.f, 0.f, 0.f};
        cur = nxt; cB = nB; ++ui;
    }
    FG_WAIT_V(0);
    if (wr == 0) FG_BAR;
    FG_BAR;
}
}

#define FG_FOR_ROWS for (int ai = 0; ai < 2; ++ai) _Pragma("unroll") for (int m = 0; m < 4; ++m)
struct JobInProj {
    static constexpr bool GATHER = false;
    const char* A; unsigned lda2, ldb2, bhalf2; int K; const int* list;
    const char* B; bf16_t* out; fg::StaticOrder S;
    __device__ __forceinline__ bool next(int i, fg::Unit& u) const { int pm, pn; if (!S.next(i, pm, pn)) return false;
        u.bBase = B + (size_t)pn * 512; u.arow0 = pm * 256; u.nvalid = 256; u.e = 0; u.orow0 = pm * 256; u.ocol0 = pn * 256; u.acol2 = 0; return true; }
    __device__ __forceinline__ void epi(const f32x4 (&acc)[2][2][4][2], const fg::Unit& u, int wr, int wc, int fr, int fq) const {
#pragma unroll
        FG_FOR_ROWS { bf16_t* rowp = out + (size_t)(u.orow0 + ai * 128 + wr * 64 + m * 16 + fr) * kNPROJ + u.ocol0 + wc * 32 + fq * 4;
#pragma unroll
            for (int bj = 0; bj < 2; ++bj)
#pragma unroll
                for (int n = 0; n < 2; ++n) { const f32x4 v = acc[ai][bj][m][n]; u32x2 w; w.x = pk_bf16(v[0], v[1]); w.y = pk_bf16(v[2], v[3]); *(u32x2*)(rowp + bj * 128 + n * 16) = w; } }
    }
};
struct JobPool {
    static constexpr bool GATHER = false;
    const char* A; unsigned lda2, ldb2, bhalf2; int K; const int* list;
    const char* B; bf16_t* cat; int G, c;
    __device__ __forceinline__ bool next(int i, fg::Unit& u) const { const int L = i * G + c; if (L >= 128) return false; const int g = L >> 5, pm = L & 31;
        u.bBase = B + (size_t)g * kPG * kPG * 2; u.arow0 = pm * 256; u.nvalid = 256; u.e = g; u.orow0 = pm * 256; u.ocol0 = kSB + g * kPG; u.acol2 = g * kPG * 2; return true; }
    __device__ __forceinline__ void epi(const f32x4 (&acc)[2][2][4][2], const fg::Unit& u, int wr, int wc, int fr, int fq) const {
#pragma unroll
        FG_FOR_ROWS { bf16_t* rowp = cat + (size_t)(u.orow0 + ai * 128 + wr * 64 + m * 16 + fr) * kD + u.ocol0 + wc * 32 + fq * 4;
#pragma unroll
            for (int bj = 0; bj < 2; ++bj)
#pragma unroll
                for (int n = 0; n < 2; ++n) { const f32x4 v = acc[ai][bj][m][n]; u32x2 w; w.x = pk_bf16(v[0], v[1]); w.y = pk_bf16(v[2], v[3]); *(u32x2*)(rowp + bj * 128 + n * 16) = w; } }
    }
};
struct JobOutProj {
    static constexpr bool GATHER = false;
    const char* A; unsigned lda2, ldb2, bhalf2; int K; const int* list;
    const char* B; const float* x; const float* mod; float* x1; fg::StaticOrder S;
    __device__ __forceinline__ bool next(int i, fg::Unit& u) const { int pm, pn; if (!S.next(i, pm, pn)) return false;
        u.bBase = B + (size_t)pn * 512; u.arow0 = pm * 256; u.nvalid = 256; u.e = 0; u.orow0 = pm * 256; u.ocol0 = pn * 256; u.acol2 = 0; return true; }
    __device__ __forceinline__ void epi(const f32x4 (&acc)[2][2][4][2], const fg::Unit& u, int wr, int wc, int fr, int fq) const {
        const int b = u.orow0 / kS; f32x4 gt[2][2];
#pragma unroll
        for (int bj = 0; bj < 2; ++bj)
#pragma unroll
            for (int n = 0; n < 2; ++n) gt[bj][n] = *(const f32x4*)(mod + b * 6 * kD + 2 * kD + u.ocol0 + bj * 128 + wc * 32 + n * 16 + fq * 4);
#pragma unroll
        FG_FOR_ROWS { const size_t ro = (size_t)(u.orow0 + ai * 128 + wr * 64 + m * 16 + fr) * kD + u.ocol0 + wc * 32 + fq * 4;
#pragma unroll
            for (int bj = 0; bj < 2; ++bj)
#pragma unroll
                for (int n = 0; n < 2; ++n) { const f32x4 xv = *(const f32x4*)(x + ro + bj * 128 + n * 16); *(f32x4*)(x1 + ro + bj * 128 + n * 16) = xv + gt[bj][n] * acc[ai][bj][m][n]; } }
    }
};
struct MoeTab { LAS const int* t; int total;
    __device__ __forceinline__ bool decode(int i, int G, int c, int& e, int& jcol, int& rb, int& cnt, int& rowbase) const {
        const int L = (G % 8 == 0) ? i * G + (c % 8) * (G / 8) + c / 8 : i * G + c; if (L >= total) return false;
        int ee = 0; while (ee < kE - 1 && t[64 + ee + 1] <= L) ++ee;
        const int local = L - t[64 + ee], nrb = t[100 + ee]; jcol = local / nrb; rb = local - jcol * nrb; e = ee; cnt = t[ee]; rowbase = t[32 + ee]; return true; }
};
__device__ __forceinline__ MoeTab moe_tables(LAS unsigned char* lds, const unsigned* ctrl, int ncol) {
    LAS int* t = (LAS int*)(lds + fg::MISC_OFF + 64);
    __syncthreads();
    if (threadIdx.x == 0) { int base = 0, us = 0; for (int e = 0; e < kE; ++e) { const int cn = (int)ctrl[CT_CNT + e], nrb = (cn + 255) >> 8; t[e] = cn; t[32 + e] = base; t[64 + e] = us; t[100 + e] = nrb; base += nrb * 256; us += nrb * ncol; } t[64 + kE] = us; }
    __syncthreads();
    MoeTab M; M.t = t; M.total = t[64 + kE]; return M;
}
struct JobMoe1 {
    static constexpr bool GATHER = true;
    const char* A; unsigned lda2, ldb2, bhalf2; int K; const int* list;
    const char* B; const float* b_in; bf16_t* act; MoeTab M; int G, c;
    __device__ __forceinline__ bool next(int i, fg::Unit& u) const { int e, j, rb, cnt, rowbase; if (!M.decode(i, G, c, e, j, rb, cnt, rowbase)) return false;
        e = __builtin_amdgcn_readfirstlane(e); j = __builtin_amdgcn_readfirstlane(j); rb = __builtin_amdgcn_readfirstlane(rb); cnt = __builtin_amdgcn_readfirstlane(cnt); rowbase = __builtin_amdgcn_readfirstlane(rowbase);
        u.bBase = B + (size_t)e * ((size_t)kD * 2 * kDFF * 2) + (size_t)j * 256; u.arow0 = e * kT + rb * 256; u.nvalid = min(256, cnt - rb * 256); u.e = e; u.orow0 = rowbase + rb * 256; u.ocol0 = j * 128; u.acol2 = 0; return true; }
    __device__ __forceinline__ void epi(const f32x4 (&acc)[2][2][4][2], const fg::Unit& u, int wr, int wc, int fr, int fq) const {
        f32x4 bg[2], bl[2];
#pragma unroll
        for (int n = 0; n < 2; ++n) { const float* bp = b_in + (size_t)u.e * 2 * kDFF + u.ocol0 + wc * 32 + n * 16 + fq * 4; bg[n] = *(const f32x4*)bp; bl[n] = *(const f32x4*)(bp + kDFF); }
#pragma unroll
        FG_FOR_ROWS { bf16_t* rowp = act + (size_t)(u.orow0 + ai * 128 + wr * 64 + m * 16 + fr) * kDFF + u.ocol0 + wc * 32 + fq * 4;
#pragma unroll
            for (int n = 0; n < 2; ++n) { const f32x4 gv = acc[ai][0][m][n] + bg[n], lv = acc[ai][1][m][n] + bl[n]; float o[4];
#pragma unroll
                for (int j = 0; j < 4; ++j) { const float g = fminf(gv[j], 7.f), l = fminf(fmaxf(lv[j], -7.f), 7.f); o[j] = g * __builtin_amdgcn_rcpf(1.f + __expf(-1.702f * g)) * (l + 1.f); }
                u32x2 w; w.x = pk_bf16(o[0], o[1]); w.y = pk_bf16(o[2], o[3]); *(u32x2*)(rowp + n * 16) = w; } }
    }
};
struct JobMoe2 {
    static constexpr bool GATHER = false;
    const char* A; unsigned lda2, ldb2, bhalf2; int K; const int* list;
    const char* B; const float* b_out; bf16_t* yp; MoeTab M; int G, c;
    __device__ __forceinline__ bool next(int i, fg::Unit& u) const { int e, j, rb, cnt, rowbase; if (!M.decode(i, G, c, e, j, rb, cnt, rowbase)) return false;
        e = __builtin_amdgcn_readfirstlane(e); j = __builtin_amdgcn_readfirstlane(j); rb = __builtin_amdgcn_readfirstlane(rb); rowbase = __builtin_amdgcn_readfirstlane(rowbase);
        u.bBase = B + (size_t)e * ((size_t)kDFF * kD * 2) + (size_t)j * 512; u.arow0 = rowbase + rb * 256; u.nvalid = 256; u.e = e; u.orow0 = rowbase + rb * 256; u.ocol0 = j * 256; u.acol2 = 0; return true; }
    __device__ __forceinline__ void epi(const f32x4 (&acc)[2][2][4][2], const fg::Unit& u, int wr, int wc, int fr, int fq) const {
        f32x4 bo[2][2];
#pragma unroll
        for (int bj = 0; bj < 2; ++bj)
#pragma unroll
            for (int n = 0; n < 2; ++n) bo[bj][n] = *(const f32x4*)(b_out + (size_t)u.e * kD + u.ocol0 + bj * 128 + wc * 32 + n * 16 + fq * 4);
#pragma unroll
        FG_FOR_ROWS { bf16_t* rowp = yp + (size_t)(u.orow0 + ai * 128 + wr * 64 + m * 16 + fr) * kD + u.ocol0 + wc * 32 + fq * 4;
#pragma unroll
            for (int bj = 0; bj < 2; ++bj)
#pragma unroll
                for (int n = 0; n < 2; ++n) { const f32x4 v = acc[ai][bj][m][n] + bo[bj][n]; u32x2 w; w.x = pk_bf16(v[0], v[1]); w.y = pk_bf16(v[2], v[3]); *(u32x2*)(rowp + bj * 128 + n * 16) = w; } }
    }
};


__device__ __forceinline__ float wave_sum(float v) {
#pragma unroll
    for (int o = 32; o > 0; o >>= 1) v += __shfl_xor(v, o);
    return v; }
__device__ __forceinline__ float bflo(unsigned u) { return __uint_as_float(u << 16); }
__device__ __forceinline__ float bfhi(unsigned u) { return __uint_as_float(u & 0xFFFF0000u); }

namespace at {
typedef float f32x16 __attribute__((ext_vector_type(16)));
__device__ __forceinline__ unsigned off_b(unsigned row, unsigned ch) { return 256u * row + 16u * (ch ^ (((row & 3) << 2) | ((row >> 2) & 3))); }
constexpr float kC2 = 0.08838834764831845f * 1.4426950408889634f;
constexpr float kDoneThresh = 160.f;

__device__ __forceinline__ void attn_phase(LAS unsigned char* lds, const bf16_t* __restrict__ proj, const float* __restrict__ qw, const float* __restrict__ kw,
                                           bf16_t* __restrict__ cat, int G, int c) {
    const int tid = threadIdx.x, wid = __builtin_amdgcn_readfirstlane(tid >> 6), lane = tid & 63, ql = lane & 31, hf = lane >> 5;
    const unsigned ldsb = (unsigned)(uintptr_t)lds;
    const int skey = tid >> 4, sch = tid & 15;
    const unsigned X = ((ql & 3) << 2) | ((ql >> 2) & 3);
    const unsigned krow = 256u * ql, kY = 16u * (X ^ (unsigned)hf);
    const int tq = (lane & 15) >> 2, tp = lane & 3, blk = (lane >> 4) & 1;
    unsigned va[4][2];
#pragma unroll
    for (int cc = 0; cc < 4; ++cc)
#pragma unroll
        for (int t = 0; t < 2; ++t) va[cc][t] = 256u * (8 * t + 4 * hf + tq) + 16u * ((4 * cc + 2 * blk + (tp >> 1)) ^ ((tq << 2) | ((2 * t + hf) & 3))) + 8u * (tp & 1);
    for (int unit = c; unit < kB * kNH * 8; unit += G) {
        const int qb = unit & 7, bh = unit >> 3, h = bh & 7, b = bh >> 3;
        const int q0 = qb * 256, r0 = q0 + wid * 32;
        const bf16_t* base = proj + (size_t)(b * kS) * kNPROJ + h * kHD;
        LAS unsigned char* qlds = lds + 65536 + wid * 8192 + lane * 16;
        { u32x4 qr[8]; float ss = 0.f;
#pragma unroll
          for (int s = 0; s < 8; ++s) { qr[s] = *(const u32x4*)(base + (size_t)(r0 + ql) * kNPROJ + 16 * s + 8 * hf);
              const unsigned u[4] = {qr[s].x, qr[s].y, qr[s].z, qr[s].w};
#pragma unroll
              for (int e = 0; e < 4; ++e) { const float a = bflo(u[e]), bb = bfhi(u[e]); ss += a * a + bb * bb; } }
          ss += __shfl_xor(ss, 32);
          const float rq = rsqrtf(ss * (1.f / kHD) + kEPS) * kC2;
#pragma unroll
          for (int s = 0; s < 8; ++s) { const int d0 = 16 * s + 8 * hf;
              const f32x4 w0 = *(const f32x4*)(qw + d0) * *(const f32x4*)(kw + d0), w1 = *(const f32x4*)(qw + d0 + 4) * *(const f32x4*)(kw + d0 + 4);
              const unsigned u[4] = {qr[s].x, qr[s].y, qr[s].z, qr[s].w};
              u32x4 pk; pk.x = pk_bf16(bflo(u[0]) * rq * w0[0], bfhi(u[0]) * rq * w0[1]); pk.y = pk_bf16(bflo(u[1]) * rq * w0[2], bfhi(u[1]) * rq * w0[3]);
              pk.z = pk_bf16(bflo(u[2]) * rq * w1[0], bfhi(u[2]) * rq * w1[1]); pk.w = pk_bf16(bflo(u[3]) * rq * w1[2], bfhi(u[3]) * rq * w1[3]);
              *(LAS u32x4*)(qlds + 1024 * s) = pk; } }
        f32x16 o[4];
#pragma unroll
        for (int cc = 0; cc < 4; ++cc)
#pragma unroll
            for (int r = 0; r < 16; ++r) o[cc][r] = 0.f;
        float carry = 0.f; bool wactive = true;
        int jt = (q0 + 255) >> 6, cur = 0;
        u32x4 kr[2], vr[2];
#define AT_LOAD(jt_) do { _Pragma("unroll") for (int i = 0; i < 2; ++i) { const bf16_t* rp = base + (size_t)(64 * (jt_) + skey + 32 * i) * kNPROJ + sch * 8; \
            kr[i] = *(const u32x4*)(rp + kSB); vr[i] = *(const u32x4*)(rp + 2 * kSB); } } while (0)
        AT_LOAD(jt);
        for (;;) {
            LAS unsigned char* kbuf = lds + cur * 32768; LAS unsigned char* vbuf = kbuf + 16384;
#pragma unroll
            for (int i = 0; i < 2; ++i) { const unsigned u[4] = {kr[i].x, kr[i].y, kr[i].z, kr[i].w}; float f[8]; float ss = 0.f;
#pragma unroll
                for (int e = 0; e < 4; ++e) { f[2 * e] = bflo(u[e]); f[2 * e + 1] = bfhi(u[e]); ss += f[2 * e] * f[2 * e] + f[2 * e + 1] * f[2 * e + 1]; }
                ss += __shfl_xor(ss, 1); ss += __shfl_xor(ss, 2); ss += __shfl_xor(ss, 4); ss += __shfl_xor(ss, 8);
                const float rk = rsqrtf(ss * (1.f / kHD) + kEPS);
                u32x4 pk; pk.x = pk_bf16(f[0] * rk, f[1] * rk); pk.y = pk_bf16(f[2] * rk, f[3] * rk); pk.z = pk_bf16(f[4] * rk, f[5] * rk); pk.w = pk_bf16(f[6] * rk, f[7] * rk);
                const unsigned a = off_b(skey + 32 * i, sch);
                *(LAS u32x4*)(kbuf + a) = pk; *(LAS u32x4*)(vbuf + a) = vr[i]; }
            const int any = __syncthreads_or(wactive ? 1 : 0);
            if (!any) break;
            const int jtc = jt;
            if (jt > 0) AT_LOAD(jt - 1);
            if (wactive && 64 * jtc < r0 + 31) {
                f32x16 s0, s1;
#pragma unroll
                for (int r = 0; r < 16; ++r) { s0[r] = 0.f; s1[r] = 0.f; }
#pragma unroll
                for (int s = 0; s < 8; ++s) { const unsigned a = krow + ((32u * s) ^ kY);
                    const bf16x8 k0 = *(const LAS bf16x8*)(kbuf + a), k1 = *(const LAS bf16x8*)(kbuf + 8192 + a), qv = *(const LAS bf16x8*)(qlds + 1024 * s);
                    s0 = __builtin_amdgcn_mfma_f32_32x32x16_bf16(k0, qv, s0, 0, 0, 0); s1 = __builtin_amdgcn_mfma_f32_32x32x16_bf16(k1, qv, s1, 0, 0, 0); }
                const int tabs = r0 + ql, kbase0 = 64 * jtc + 4 * hf;
                float run = carry; u32x4 pfr[2][2];
#pragma unroll
                for (int kb = 1; kb >= 0; --kb) {
                    float sp[16], gp[4], T[4];
#pragma unroll
                    for (int r = 0; r < 16; ++r) { const float z = kb ? s1[r] : s0[r]; const int key = kbase0 + 32 * kb + 8 * (r >> 2) + (r & 3);
                        const float v = __builtin_amdgcn_logf(1.f + __builtin_amdgcn_exp2f(z)); sp[r] = key < tabs ? v : 0.f; }
#pragma unroll
                    for (int g = 0; g < 4; ++g) { const float gsum = (sp[4 * g] + sp[4 * g + 1]) + (sp[4 * g + 2] + sp[4 * g + 3]);
                        const auto sw = __builtin_amdgcn_permlane32_swap(__float_as_uint(gsum), __float_as_uint(gsum), false, false);
                        const float lo = __uint_as_float(sw[0]), hi = __uint_as_float(sw[1]);
                        T[g] = lo + hi; gp[g] = hf ? 0.f : hi; }
#pragma unroll
                    for (int g = 3; g >= 0; --g) { const float offs = run + gp[g];
                        const float c3 = offs + sp[4 * g + 3], c2 = c3 + sp[4 * g + 2], c1 = c2 + sp[4 * g + 1], c0 = c1 + sp[4 * g];
                        const float cs[4] = {c0, c1, c2, c3};
#pragma unroll
                        for (int i = 0; i < 4; ++i) { const int r = 4 * g + i; const float z = kb ? s1[r] : s0[r]; const int key = kbase0 + 32 * kb + 8 * g + i;
                            const float e = __builtin_amdgcn_exp2f(z - cs[i]); sp[r] = key < tabs ? e : 0.f; }
                        run += T[g]; }
#pragma unroll
                    for (int s2 = 0; s2 < 2; ++s2) { u32x4 pk; pk.x = pk_bf16(sp[8 * s2], sp[8 * s2 + 1]); pk.y = pk_bf16(sp[8 * s2 + 2], sp[8 * s2 + 3]);
                        pk.z = pk_bf16(sp[8 * s2 + 4], sp[8 * s2 + 5]); pk.w = pk_bf16(sp[8 * s2 + 6], sp[8 * s2 + 7]); pfr[kb][s2] = pk; }
                }
                carry = run;
                const unsigned vb0 = ldsb + (unsigned)cur * 32768u + 16384u;
#define AT_PV(cc) do { const unsigned a0 = vb0 + va[cc][0], a1 = vb0 + va[cc][1]; \
                    const s16x4 l00 = fg::tr_read<0>(a0), h00 = fg::tr_read<0>(a1), l01 = fg::tr_read<4096>(a0), h01 = fg::tr_read<4096>(a1); \
                    const s16x4 l10 = fg::tr_read<8192>(a0), h10 = fg::tr_read<8192>(a1), l11 = fg::tr_read<12288>(a0), h11 = fg::tr_read<12288>(a1); \
                    asm volatile("s_waitcnt lgkmcnt(0)" ::: "memory"); __builtin_amdgcn_sched_barrier(0); \
                    o[cc] = __builtin_amdgcn_mfma_f32_32x32x16_bf16(FG_PK(l00, h00), __builtin_bit_cast(bf16x8, pfr[0][0]), o[cc], 0, 0, 0); \
                    o[cc] = __builtin_amdgcn_mfma_f32_32x32x16_bf16(FG_PK(l01, h01), __builtin_bit_cast(bf16x8, pfr[0][1]), o[cc], 0, 0, 0); \
                    o[cc] = __builtin_amdgcn_mfma_f32_32x32x16_bf16(FG_PK(l10, h10), __builtin_bit_cast(bf16x8, pfr[1][0]), o[cc], 0, 0, 0); \
                    o[cc] = __builtin_amdgcn_mfma_f32_32x32x16_bf16(FG_PK(l11, h11), __builtin_bit_cast(bf16x8, pfr[1][1]), o[cc], 0, 0, 0); } while (0)
                AT_PV(0); AT_PV(1); AT_PV(2); AT_PV(3);
#undef AT_PV
                wactive = __any(carry <= kDoneThresh);
            }
            if (jt == 0) break;
            --jt; cur ^= 1;
        }
#undef AT_LOAD
        bf16_t* orow = cat + (size_t)(b * kS + r0 + ql) * kD + h * kHD + 4 * hf;
#pragma unroll
        for (int cc = 0; cc < 4; ++cc)
#pragma unroll
            for (int g = 0; g < 4; ++g) { u32x2 w; w.x = pk_bf16(o[cc][4 * g], o[cc][4 * g + 1]); w.y = pk_bf16(o[cc][4 * g + 2], o[cc][4 * g + 3]); *(u32x2*)(orow + 32 * cc + 8 * g) = w; }
        __syncthreads();
    }
}
}

__device__ __forceinline__ void pool_p_phase(const bf16_t* __restrict__ proj, bf16_t* __restrict__ p, int G, int c) {
    for (int idx = c * 512 + threadIdx.x; idx < kT * (kPW / 8); idx += G * 512) {
        const int c8 = idx & 127, t = idx >> 7, s = t & (kS - 1), g = c8 >> 5, w = 2 << g, cnt = min(s + 1, w);
        const bf16_t* up = proj + (size_t)t * kNPROJ + 3 * kSB + c8 * 8;
        float acc[8], u0[8];
#pragma unroll
        for (int e = 0; e < 8; ++e) acc[e] = 0.f;
        for (int i = 0; i < cnt; ++i) { const uint4 v = *(const uint4*)(up - (size_t)i * kNPROJ); const unsigned u[4] = {v.x, v.y, v.z, v.w};
#pragma unroll
            for (int e = 0; e < 4; ++e) { const float a = bflo(u[e]), bb = bfhi(u[e]); acc[2 * e] += a; acc[2 * e + 1] += bb; if (i == 0) { u0[2 * e] = a; u0[2 * e + 1] = bb; } } }
        const float inv = 1.f / (float)cnt;
        u32x4 pk; pk.x = pk_bf16(acc[0] * inv - u0[0], acc[1] * inv - u0[1]); pk.y = pk_bf16(acc[2] * inv - u0[2], acc[3] * inv - u0[3]);
        pk.z = pk_bf16(acc[4] * inv - u0[4], acc[5] * inv - u0[5]); pk.w = pk_bf16(acc[6] * inv - u0[6], acc[7] * inv - u0[7]);
        *(u32x4*)(p + (size_t)t * kPW + c8 * 8) = pk;
    }
}


__device__ __forceinline__ unsigned pk4_fp8(float a, float b, float c, float d) { int p = __builtin_amdgcn_cvt_pk_fp8_f32(a, b, 0, false); p = __builtin_amdgcn_cvt_pk_fp8_f32(c, d, p, true); return (unsigned)p; }
__device__ __forceinline__ float clamp448(float v) { return __builtin_amdgcn_fmed3f(v, -448.f, 448.f); }
constexpr float kWScale = 64.f;

struct JobMoe1F8 {
    static constexpr bool GATHER = true;
    const char* A; unsigned lda2, ldb2, bhalf2; int K; const int* list;
    const char* B; const float* b_in; unsigned char* act; MoeTab M; int G, c;
    __device__ __forceinline__ bool next(int i, fg::Unit& u) const { int e, j, rb, cnt, rowbase; if (!M.decode(i, G, c, e, j, rb, cnt, rowbase)) return false;
        e = __builtin_amdgcn_readfirstlane(e); j = __builtin_amdgcn_readfirstlane(j); rb = __builtin_amdgcn_readfirstlane(rb); cnt = __builtin_amdgcn_readfirstlane(cnt); rowbase = __builtin_amdgcn_readfirstlane(rowbase);
        u.bBase = B + (size_t)e * ((size_t)2 * kDFF * kD) + (size_t)j * 128 * kD; u.arow0 = e * kT + rb * 256; u.nvalid = min(256, cnt - rb * 256); u.e = e; u.orow0 = rowbase + rb * 256; u.ocol0 = j * 128; u.acol2 = 0; return true; }
    __device__ __forceinline__ void epi(const f32x4 (&acc)[2][2][4][2], const fg::Unit& u, int wr, int wc, int fr, int fq) const {
        f32x4 bg[2], bl[2];
#pragma unroll
        for (int n = 0; n < 2; ++n) { const float* bp = b_in + (size_t)u.e * 2 * kDFF + u.ocol0 + wc * 32 + n * 16 + fq * 4; bg[n] = *(const f32x4*)bp; bl[n] = *(const f32x4*)(bp + kDFF); }
#pragma unroll
        FG_FOR_ROWS { unsigned char* rowp = act + (size_t)(u.orow0 + ai * 128 + wr * 64 + m * 16 + fr) * kDFF + u.ocol0 + wc * 32 + fq * 4;
#pragma unroll
            for (int n = 0; n < 2; ++n) { const f32x4 gv = acc[ai][0][m][n] + bg[n], lv = acc[ai][1][m][n] + bl[n]; float o[4];
#pragma unroll
                for (int j = 0; j < 4; ++j) { const float g = fminf(gv[j], 7.f), l = fminf(fmaxf(lv[j], -7.f), 7.f); o[j] = clamp448(g * __builtin_amdgcn_rcpf(1.f + __expf(-1.702f * g)) * (l + 1.f)); }
                *(unsigned*)(rowp + n * 16) = pk4_fp8(o[0], o[1], o[2], o[3]); } }
    }
};
struct JobMoe2F8 {
    static constexpr bool GATHER = false;
    const char* A; unsigned lda2, ldb2, bhalf2; int K; const int* list;
    const char* B; const float* b_out; bf16_t* yp; MoeTab M; int G, c;
    __device__ __forceinline__ bool next(int i, fg::Unit& u) const { int e, j, rb, cnt, rowbase; if (!M.decode(i, G, c, e, j, rb, cnt, rowbase)) return false;
        e = __builtin_amdgcn_readfirstlane(e); j = __builtin_amdgcn_readfirstlane(j); rb = __builtin_amdgcn_readfirstlane(rb); rowbase = __builtin_amdgcn_readfirstlane(rowbase);
        u.bBase = B + (size_t)e * ((size_t)kDFF * kD) + (size_t)j * 256 * kDFF; u.arow0 = rowbase + rb * 256; u.nvalid = 256; u.e = e; u.orow0 = rowbase + rb * 256; u.ocol0 = j * 256; u.acol2 = 0; return true; }
    __device__ __forceinline__ void epi(const f32x4 (&acc)[2][2][4][2], const fg::Unit& u, int wr, int wc, int fr, int fq) const {
        f32x4 bo[2][2];
#pragma unroll
        for (int bj = 0; bj < 2; ++bj)
#pragma unroll
            for (int n = 0; n < 2; ++n) bo[bj][n] = *(const f32x4*)(b_out + (size_t)u.e * kD + u.ocol0 + bj * 128 + wc * 32 + n * 16 + fq * 4);
#pragma unroll
        FG_FOR_ROWS { bf16_t* rowp = yp + (size_t)(u.orow0 + ai * 128 + wr * 64 + m * 16 + fr) * kD + u.ocol0 + wc * 32 + fq * 4;
#pragma unroll
            for (int bj = 0; bj < 2; ++bj)
#pragma unroll
                for (int n = 0; n < 2; ++n) { const f32x4 v = acc[ai][bj][m][n] + bo[bj][n]; u32x2 w; w.x = pk_bf16(v[0], v[1]); w.y = pk_bf16(v[2], v[3]); *(u32x2*)(rowp + bj * 128 + n * 16) = w; } }
    }
};

struct CvtT { const float* src; unsigned char* dst; int K, N, tn, per; };
__device__ __forceinline__ CvtT cvt_make(const float* src, unsigned char* dst, int K, int N) { CvtT c; c.src = src; c.dst = dst; c.K = K; c.N = N; c.tn = N / 64; c.per = (K / 128) * (N / 64); return c; }
__device__ __forceinline__ void cvt_load(const CvtT& C, int t, int kq, int nc, f32x4 (&v)[4]) {
    const int mat = t / C.per, r = t - mat * C.per, kt = r / C.tn, nt_ = r - kt * C.tn;
    const float* sp = C.src + (size_t)mat * C.K * C.N + (size_t)(kt * 128 + 4 * kq) * C.N + nt_ * 64 + 4 * nc;
#pragma unroll
    for (int i = 0; i < 4; ++i) v[i] = __builtin_nontemporal_load((const f32x4*)(sp + (size_t)i * C.N));
}
__device__ __forceinline__ void cvt_emit(const CvtT& C, int t, LAS unsigned* L, const f32x4 (&v)[4], int kq, int nc, int rn, int rc) {
#pragma unroll
    for (int j = 0; j < 4; ++j) L[(4 * nc + j) * 33 + kq] = pk4_fp8(v[0][j] * kWScale, v[1][j] * kWScale, v[2][j] * kWScale, v[3][j] * kWScale);
    __syncthreads();
    const int mat = t / C.per, r = t - mat * C.per, kt = r / C.tn, nt_ = r - kt * C.tn;
    u32x4 o; o.x = L[rn * 33 + 4 * rc]; o.y = L[rn * 33 + 4 * rc + 1]; o.z = L[rn * 33 + 4 * rc + 2]; o.w = L[rn * 33 + 4 * rc + 3];
    *(u32x4*)(C.dst + (size_t)mat * C.K * C.N + (size_t)(nt_ * 64 + rn) * C.K + kt * 128 + rc * 16) = o;
}
__device__ __forceinline__ void convert_t_f8(LAS unsigned char* lds, const CvtT C, int t0, int t1, int stride) {
    const int tid = threadIdx.x, kq = tid >> 4, nc = tid & 15, rn = tid >> 3, rc = tid & 7;
    LAS unsigned* L0 = (LAS unsigned*)lds; LAS unsigned* L1 = L0 + 64 * 33 + 16;
    f32x4 va[4], vb[4], vc[4];
    int t = t0;
    __syncthreads();
    if (t < t1) cvt_load(C, t, kq, nc, va);
    if (t + stride < t1) cvt_load(C, t + stride, kq, nc, vb);
    for (; t < t1; t += 3 * stride) {
        if (t + 2 * stride < t1) cvt_load(C, t + 2 * stride, kq, nc, vc);
        cvt_emit(C, t, L0, va, kq, nc, rn, rc);
        if (t + stride >= t1) break;
        if (t + 3 * stride < t1) cvt_load(C, t + 3 * stride, kq, nc, va);
        cvt_emit(C, t + stride, L1, vb, kq, nc, rn, rc);
        if (t + 2 * stride >= t1) break;
        if (t + 4 * stride < t1) cvt_load(C, t + 4 * stride, kq, nc, vb);
        cvt_emit(C, t + 2 * stride, L0, vc, kq, nc, rn, rc);
        if (t + 3 * stride < t1) { __syncthreads(); }
    }
    __syncthreads();
}

__device__ __forceinline__ void convert_seg(const float* __restrict__ src, bf16_t* __restrict__ dst, size_t n8, size_t gtid, size_t gstride) {
    const f32x4* s4 = (const f32x4*)src; u32x4* d4 = (u32x4*)dst;
#pragma unroll 4
    for (size_t i = gtid; i < n8; i += gstride) { const f32x4 a = __builtin_nontemporal_load(s4 + 2 * i), b = __builtin_nontemporal_load(s4 + 2 * i + 1);
        u32x4 w; w.x = pk_bf16(a[0], a[1]); w.y = pk_bf16(a[2], a[3]); w.z = pk_bf16(b[0], b[1]); w.w = pk_bf16(b[2], b[3]); d4[i] = w; }
}


#define XB_TMO      128
#define XB_XCNT(j)  (256  + 64 * (j))
#define XB_XSUB(j)  (1280 + 64 * (j))
#define XB_XGEN(j)  (2304 + 64 * (j))
#define XB_TOP      3328
#define XB_TOPGEN   3392
#define XCD_BAR_WORDS 3456
#define XB_SPIN_CAP (1u << 18)
__device__ __forceinline__ unsigned xb_ld(unsigned* p)              { return __hip_atomic_load(p, __ATOMIC_RELAXED, __HIP_MEMORY_SCOPE_AGENT); }
__device__ __forceinline__ unsigned xb_add(unsigned* p, unsigned v) { return __hip_atomic_fetch_add(p, v, __ATOMIC_RELAXED, __HIP_MEMORY_SCOPE_AGENT); }
__device__ __forceinline__ unsigned xb_xcc_id() { return (unsigned)__builtin_amdgcn_s_getreg((3 << 11) | 20) & 0xFu; }
#define XB_SPIN(cond, bar) do { unsigned _sp = 0; while (cond) { __builtin_amdgcn_s_sleep(1); \
    if ((++_sp & 255u) == 0u) { if (xb_ld(&(bar)[XB_TMO])) break; if (_sp > XB_SPIN_CAP) { atomicAdd(&(bar)[XB_TMO], 1u); break; } } } } while (0)
struct XcdBarrier { unsigned* bar; unsigned x; volatile LAS unsigned* st; };
__device__ __forceinline__ XcdBarrier xcd_barrier_post(unsigned* bar, volatile LAS unsigned* st) {
    XcdBarrier b; b.bar = bar; b.x = xb_xcc_id(); b.st = st;
    if (threadIdx.x == 0) (void)xb_add(&bar[XB_XCNT(b.x)], 1u);
    return b;
}
__device__ __forceinline__ void xcd_barrier_complete(unsigned* bar, unsigned x, unsigned& nloc, unsigned& nx) {
    const unsigned G = gridDim.x * gridDim.y * gridDim.z;
    unsigned sum, cnt, mine, sp = 0u;
    for (;;) {
        sum = 0u; cnt = 0u; mine = 0u;
#pragma unroll
        for (unsigned j = 0; j < 16; ++j) { const unsigned c = xb_ld(&bar[XB_XCNT(j)]); sum += c; cnt += (c > 0u) ? 1u : 0u; mine = (j == x) ? c : mine; }
        if (sum == G) break;
        __builtin_amdgcn_s_sleep(1);
        if ((++sp & 255u) == 0u) { if (xb_ld(&bar[XB_TMO])) break; if (sp > XB_SPIN_CAP) { atomicAdd(&bar[XB_TMO], 1u); break; } }
    }
    nloc = mine > 0u ? mine : 1u; nx = cnt > 0u ? cnt : 1u;
}
__device__ __forceinline__ void xcd_barrier(const XcdBarrier& b) {
    asm volatile("s_waitcnt vmcnt(0)" ::: "memory");
    __syncthreads();
    if (threadIdx.x == 0) {
        unsigned* bar = b.bar;
        __builtin_amdgcn_s_waitcnt(0);
        unsigned nloc = b.st[0], nx = b.st[1];
        if (nloc == 0u) { xcd_barrier_complete(bar, b.x, nloc, nx); b.st[0] = nloc; b.st[1] = nx; }
        const unsigned old = xb_add(&bar[XB_XSUB(b.x)], 1u);
        const unsigned gen = old / nloc;
        if (old + 1u == (gen + 1u) * nloc) {
            __builtin_amdgcn_fence(__ATOMIC_RELEASE, "agent");
            asm volatile("s_waitcnt vmcnt(0)" ::: "memory");
            const unsigned og = xb_add(&bar[XB_TOP], 1u);
            const unsigned tg = og / nx;
            if (og + 1u == (tg + 1u) * nx) xb_add(&bar[XB_TOPGEN], 1u);
            else XB_SPIN(xb_ld(&bar[XB_TOPGEN]) == tg, bar);
            __builtin_amdgcn_fence(__ATOMIC_ACQUIRE, "agent");
            xb_add(&bar[XB_XGEN(b.x)], 1u);
            asm volatile("s_waitcnt vmcnt(0)" ::: "memory");
        } else {
            XB_SPIN(xb_ld(&bar[XB_XGEN(b.x)]) == gen, bar);
            __builtin_amdgcn_fence(__ATOMIC_ACQUIRE, "agent");
            asm volatile("s_waitcnt vmcnt(0)" ::: "memory");
        }
    }
    __syncthreads();
}

__device__ __forceinline__ void ada_phase(LAS unsigned char* lds, const float* __restrict__ cvec, const float* __restrict__ w_ada, const float* __restrict__ b_ada, float* __restrict__ mod, int G, int c) {
    LAS float* ca = (LAS float*)lds;
    LAS float* part = (LAS float*)(lds + 32768);
    const int tid = threadIdx.x;
    __syncthreads();
    for (int i = tid; i < kB * kD; i += 512) { const float v = cvec[i]; ca[i] = v / (1.f + __expf(-v)); }
    __syncthreads();
    for (int cb = c; cb < 6 * kD / 48; cb += G) {
        const int n0 = cb * 48, cg = tid % 12, kr = tid / 12;
        if (tid < 504) {
            f32x4 a0 = {0.f, 0.f, 0.f, 0.f}, a1 = a0, a2 = a0, a3 = a0;
#pragma unroll 8
            for (int k = kr; k < kD; k += 42) { const f32x4 w = __builtin_nontemporal_load((const f32x4*)(w_ada + (size_t)k * (6 * kD) + n0 + cg * 4));
                a0 += ca[k] * w; a1 += ca[kD + k] * w; a2 += ca[2 * kD + k] * w; a3 += ca[3 * kD + k] * w; }
            LAS f32x4* pp = (LAS f32x4*)(part + (kr * 12 + cg) * 16); pp[0] = a0; pp[1] = a1; pp[2] = a2; pp[3] = a3;
        }
        __syncthreads();
        if (tid < 192) { const int col = tid % 48, b = tid / 48; float sum = 0.f;
            for (int r = 0; r < 42; ++r) sum += part[(r * 12 + (col >> 2)) * 16 + b * 4 + (col & 3)];
            mod[b * 6 * kD + n0 + col] = sum + b_ada[n0 + col]; }
        __syncthreads();
    }
}

__device__ __forceinline__ void norm1_phase(const float* __restrict__ x, const float* __restrict__ nw, const float* __restrict__ mod, bf16_t* __restrict__ out, int G, int c) {
    const int wid = threadIdx.x >> 6, lane = threadIdx.x & 63;
    for (int t = c * 8 + wid; t < kT; t += G * 8) {
        const int b = t / kS; const float* xr = x + (size_t)t * kD + lane * 4; const float* mb = mod + b * 6 * kD + lane * 4;
        f32x4 v[8]; float ss = 0.f;
#pragma unroll
        for (int j = 0; j < 8; ++j) { v[j] = *(const f32x4*)(xr + 256 * j); ss += v[j][0] * v[j][0] + v[j][1] * v[j][1] + v[j][2] * v[j][2] + v[j][3] * v[j][3]; }
        ss = wave_sum(ss);
        const float r = rsqrtf(ss * (1.f / kD) + kEPS);
#pragma unroll
        for (int j = 0; j < 8; ++j) { const f32x4 w = *(const f32x4*)(nw + lane * 4 + 256 * j), sh = *(const f32x4*)(mb + 256 * j), sc = *(const f32x4*)(mb + kD + 256 * j);
            const f32x4 y = v[j] * r * w * (1.f + sc) + sh; u32x2 o; o.x = pk_bf16(y[0], y[1]); o.y = pk_bf16(y[2], y[3]);
            *(u32x2*)(out + (size_t)t * kD + lane * 4 + 256 * j) = o; }
    }
}

constexpr int RT_STRIDE = 144;
__device__ __forceinline__ void norm2_router_phase(LAS unsigned char* lds, const float* __restrict__ x1, const float* __restrict__ nw, const float* __restrict__ mod,
                                                   const float* __restrict__ w_router, const float* __restrict__ b_router, unsigned char* __restrict__ h2,
                                                   float* __restrict__ gates, int* __restrict__ pair_e, int* __restrict__ pair_p, int* __restrict__ list, unsigned* __restrict__ ctrl, int G, int c) {
    const int tid = threadIdx.x, wid = tid >> 6, lane = tid & 63;
    for (int blk = c; blk < kT / 32; blk += G) {
#pragma unroll 1
        for (int pass = 0; pass < 2; ++pass) {
            const int t0 = blk * 32 + wid * 4 + pass * 2, b = t0 / kS;
            float rs[2];
#pragma unroll
            for (int rr = 0; rr < 2; ++rr) { const float* xr = x1 + (size_t)(t0 + rr) * kD + 2 * lane; float ss = 0.f;
#pragma unroll
                for (int i = 0; i < 16; ++i) { const f32x2 v = *(const f32x2*)(xr + 128 * i); ss += v[0] * v[0] + v[1] * v[1]; }
                ss = wave_sum(ss); rs[rr] = rsqrtf(ss * (1.f / kD) + kEPS); }
            f32x4 acc[2][8];
#pragma unroll
            for (int rr = 0; rr < 2; ++rr)
#pragma unroll
                for (int q = 0; q < 8; ++q) acc[rr][q] = (f32x4){0.f, 0.f, 0.f, 0.f};
#pragma unroll 1
            for (int q = 0; q < 4; ++q) {
                __syncthreads();
#pragma unroll
                for (int j = 0; j < 8; ++j) { const int idx = tid + 512 * j, row = idx >> 3, ch = idx & 7;
                    *(LAS f32x4*)(lds + row * RT_STRIDE + ch * 16) = *(const f32x4*)(w_router + (size_t)(512 * q + row) * kE + ch * 4); }
                f32x2 yq[2][4];
#pragma unroll
                for (int ii = 0; ii < 4; ++ii) { const int n = 2 * lane + 128 * (4 * q + ii);
                    const f32x2 w = *(const f32x2*)(nw + n), sh = *(const f32x2*)(mod + b * 6 * kD + 3 * kD + n), sc = *(const f32x2*)(mod + b * 6 * kD + 4 * kD + n);
#pragma unroll
                    for (int rr = 0; rr < 2; ++rr) { const f32x2 v = *(const f32x2*)(x1 + (size_t)(t0 + rr) * kD + n); yq[rr][ii] = v * rs[rr] * w * (1.f + sc) + sh;
                        *(unsigned short*)(h2 + (size_t)(t0 + rr) * kD + n) = (unsigned short)__builtin_amdgcn_cvt_pk_fp8_f32(clamp448(yq[rr][ii][0]), clamp448(yq[rr][ii][1]), 0, false); } }
                __syncthreads();
#pragma unroll
                for (int ii = 0; ii < 4; ++ii)
#pragma unroll
                    for (int e = 0; e < 2; ++e) { const LAS unsigned char* wp = lds + (2 * lane + 128 * ii + e) * RT_STRIDE;
#pragma unroll
                        for (int ch = 0; ch < 8; ++ch) { const f32x4 wv = *(const LAS f32x4*)(wp + ch * 16);
                            acc[0][ch] += yq[0][ii][e] * wv; acc[1][ch] += yq[1][ii][e] * wv; } }
            }
#pragma unroll
            for (int rr = 0; rr < 2; ++rr) {
                float v16[16], v8[8], v4[4], v2[2], v1;
                { const bool up = lane & 32;
#pragma unroll
                  for (int j = 0; j < 16; ++j) { const float lo = acc[rr][j >> 2][j & 3], hi = acc[rr][4 + (j >> 2)][j & 3]; const float send = up ? lo : hi, keep = up ? hi : lo; v16[j] = keep + __shfl_xor(send, 32); } }
                { const bool up = lane & 16;
#pragma unroll
                  for (int j = 0; j < 8; ++j) { const float send = up ? v16[j] : v16[j + 8], keep = up ? v16[j + 8] : v16[j]; v8[j] = keep + __shfl_xor(send, 16); } }
                { const bool up = lane & 8;
#pragma unroll
                  for (int j = 0; j < 4; ++j) { const float send = up ? v8[j] : v8[j + 4], keep = up ? v8[j + 4] : v8[j]; v4[j] = keep + __shfl_xor(send, 8); } }
                { const bool up = lane & 4;
#pragma unroll
                  for (int j = 0; j < 2; ++j) { const float send = up ? v4[j] : v4[j + 2], keep = up ? v4[j + 2] : v4[j]; v2[j] = keep + __shfl_xor(send, 4); } }
                { const bool up = lane & 2; const float send = up ? v2[0] : v2[1], keep = up ? v2[1] : v2[0]; v1 = keep + __shfl_xor(send, 2); }
                v1 += __shfl_xor(v1, 1);
                const int e_mine = (lane >> 1) & 31;
                float mine = (lane & 1) ? -3.4e38f : v1 + b_router[e_mine];
                int idx[4]; float val[4];
#pragma unroll
                for (int k = 0; k < 4; ++k) { float bv = mine; int bi = e_mine + ((lane & 1) << 6);
#pragma unroll
                    for (int o = 32; o > 0; o >>= 1) { const float ov = __shfl_xor(bv, o); const int oi = __shfl_xor(bi, o); if (ov > bv || (ov == bv && oi < bi)) { bv = ov; bi = oi; } }
                    idx[k] = bi; val[k] = bv; if (!(lane & 1) && e_mine == bi) mine = -3.4e38f; }
                if (lane == 0) { const int t = t0 + rr; float ex[4], sum = 0.f;
#pragma unroll
                    for (int k = 0; k < 4; ++k) { ex[k] = __expf(val[k] - val[0]); sum += ex[k]; }
                    const float inv = 1.f / sum;
#pragma unroll
                    for (int k = 0; k < 4; ++k) { gates[t * 4 + k] = ex[k] * inv; pair_e[t * 4 + k] = idx[k];
                        const unsigned pos = atomicAdd(&ctrl[CT_CNT + idx[k]], 1u); pair_p[t * 4 + k] = (int)pos; list[(size_t)idx[k] * kT + pos] = t; } }
            }
        }
    }
}

__device__ __forceinline__ void final_phase(const float* __restrict__ x1, const float* __restrict__ mod, const float* __restrict__ gates, const int* __restrict__ pair_e, const int* __restrict__ pair_p,
                                            const MoeTab M, const bf16_t* __restrict__ yp, float* __restrict__ out, int G, int c) {
    const int wid = threadIdx.x >> 6, lane = threadIdx.x & 63;
    for (int t = c * 8 + wid; t < kT; t += G * 8) {
        const int b = t / kS; float gk[4]; const bf16_t* rp[4];
#pragma unroll
        for (int k = 0; k < 4; ++k) { gk[k] = gates[t * 4 + k]; const int e = pair_e[t * 4 + k];
            rp[k] = yp + (size_t)(M.t[32 + e] + pair_p[t * 4 + k]) * kD + lane * 8; }
#pragma unroll
        for (int j = 0; j < 4; ++j) { f32x4 y0 = {0.f, 0.f, 0.f, 0.f}, y1 = y0;
#pragma unroll
            for (int k = 0; k < 4; ++k) { const u32x4 v = *(const u32x4*)(rp[k] + 512 * j);
                y0 += gk[k] * (f32x4){bflo(v.x), bfhi(v.x), bflo(v.y), bfhi(v.y)}; y1 += gk[k] * (f32x4){bflo(v.z), bfhi(v.z), bflo(v.w), bfhi(v.w)}; }
            const size_t o = (size_t)t * kD + lane * 8 + 512 * j; const float* gp = mod + b * 6 * kD + 5 * kD + lane * 8 + 512 * j;
            *(f32x4*)(out + o) = *(const f32x4*)(x1 + o) + *(const f32x4*)gp * y0; *(f32x4*)(out + o + 4) = *(const f32x4*)(x1 + o + 4) + *(const f32x4*)(gp + 4) * y1; }
    }
}

struct MegaArgs { const float* in[18]; float* out; unsigned char* ws; int ph_lo, ph_hi; };
constexpr int NPHASE = 10;
__global__ void __launch_bounds__(512, 2) mega(MegaArgs a) {
    extern __shared__ __attribute__((aligned(16))) unsigned char lds_raw[];
    LAS unsigned char* lds = (LAS unsigned char*)lds_raw;
    unsigned char* ws = a.ws;
    const int lo = a.ph_lo, hi = a.ph_hi;
#ifndef DUP_PHASE
#define DUP_PHASE -1
#endif
#define IN(k) (lo <= (k) && (k) < hi)
#define REP(k)
#define DUPQ(k) ((k) == DUP_PHASE)
#define SEAM(k) do { if (IN(k) && IN((k) + 1)) xcd_barrier(bar); } while (0)
    const int G = gridDim.x, c = blockIdx.x;
    unsigned* ctrl = (unsigned*)(ws + WS_CTRL);
    const int grp = (c >> 3) & 1;
    const CvtT C1 = cvt_make(a.in[14], (unsigned char*)(ws + WS_WE1), kD, 2 * kDFF);
    const CvtT C2 = cvt_make(a.in[16], (unsigned char*)(ws + WS_WE2), kDFF, kD);
    const int c1_split = (kE * C1.per / G) * 5 / 8 * G;
    if (threadIdx.x == 0) *(LAS u32x4*)(lds + fg::MISC_OFF) = (u32x4){0u, 0u, 0u, 0u};
    __syncthreads();
    XcdBarrier bar; bar.bar = ctrl; bar.x = 0; bar.st = (volatile LAS unsigned*)(lds + fg::MISC_OFF);
    if (hi - lo > 1) bar = xcd_barrier_post(ctrl, (volatile LAS unsigned*)(lds + fg::MISC_OFF));
    float* mod = (float*)(ws + WS_MOD);
    if (IN(0)) REP(0) {
        ada_phase(lds, a.in[1], a.in[4], a.in[5], mod, G, c);
        const size_t gtid = (size_t)blockIdx.x * 512 + threadIdx.x, gstride = (size_t)G * 512;
        convert_seg(a.in[6], (bf16_t*)(ws + WS_WIN), (size_t)kD * kNPROJ / 8, gtid, gstride);
        convert_seg(a.in[11], (bf16_t*)(ws + WS_WO), (size_t)kD * kD / 8, gtid, gstride);
        { const f32x4* s4 = (const f32x4*)a.in[9]; const f32x4* sc4 = (const f32x4*)a.in[10]; u32x4* d4 = (u32x4*)(ws + WS_WPL);
          for (size_t i = gtid; i < (size_t)4 * kPG * kPG / 8; i += gstride) { const int g = (int)(i >> 13), n8 = (int)(i & 31);
              const f32x4 sa = sc4[g * 64 + n8 * 2], sb = sc4[g * 64 + n8 * 2 + 1]; const f32x4 a0 = s4[2 * i] * sa, b0 = s4[2 * i + 1] * sb;
              u32x4 w; w.x = pk_bf16(a0[0], a0[1]); w.y = pk_bf16(a0[2], a0[3]); w.z = pk_bf16(b0[0], b0[1]); w.w = pk_bf16(b0[2], b0[3]); d4[i] = w; } }
    }
    SEAM(0);
    if (IN(1)) REP(1) norm1_phase(a.in[0], a.in[2], mod, (bf16_t*)(ws + WS_H), G, c);
    if (IN(1) && DUPQ(1)) norm1_phase(a.in[0], a.in[2], mod, (bf16_t*)(ws + WS_H), G, c);
    SEAM(1);
    if (IN(2) && grp == 0) convert_t_f8(lds, C1, c, c1_split, G);
    if (IN(2)) REP(2) { JobInProj J; J.A = (const char*)(ws + WS_H); J.lda2 = kD * 2; J.ldb2 = kNPROJ * 2; J.bhalf2 = 256; J.K = kD; J.list = nullptr;
        J.B = (const char*)(ws + WS_WIN); J.out = (bf16_t*)(ws + WS_PROJ); J.S.init(kT, kNPROJ, G, c); fg::gemm_phase(lds, J); }
    if (IN(2) && DUPQ(2)) { JobInProj J; J.A = (const char*)(ws + WS_H); J.lda2 = kD * 2; J.ldb2 = kNPROJ * 2; J.bhalf2 = 256; J.K = kD; J.list = nullptr;
        J.B = (const char*)(ws + WS_WIN); J.out = (bf16_t*)(ws + WS_PROJ); J.S.init(kT, kNPROJ, G, c); fg::gemm_phase(lds, J); }
    if (IN(2) && grp == 1) convert_t_f8(lds, C1, c, c1_split, G);
    SEAM(2);
    if (IN(3)) REP(3) { at::attn_phase(lds, (const bf16_t*)(ws + WS_PROJ), a.in[7], a.in[8], (bf16_t*)(ws + WS_CAT), G, c);
        pool_p_phase((const bf16_t*)(ws + WS_PROJ), (bf16_t*)(ws + WS_P), G, c); }
    if (IN(3) && DUPQ(3)) { at::attn_phase(lds, (const bf16_t*)(ws + WS_PROJ), a.in[7], a.in[8], (bf16_t*)(ws + WS_CAT), G, c);
        pool_p_phase((const bf16_t*)(ws + WS_PROJ), (bf16_t*)(ws + WS_P), G, c); }
    SEAM(3);
    if (IN(4)) REP(4) { JobPool J; J.A = (const char*)(ws + WS_P); J.lda2 = kPW * 2; J.ldb2 = kPG * 2; J.bhalf2 = 256; J.K = kPG; J.list = nullptr;
        J.B = (const char*)(ws + WS_WPL); J.cat = (bf16_t*)(ws + WS_CAT); J.G = G; J.c = c; fg::gemm_phase(lds, J); }
    if (IN(4) && DUPQ(4)) { JobPool J; J.A = (const char*)(ws + WS_P); J.lda2 = kPW * 2; J.ldb2 = kPG * 2; J.bhalf2 = 256; J.K = kPG; J.list = nullptr;
        J.B = (const char*)(ws + WS_WPL); J.cat = (bf16_t*)(ws + WS_CAT); J.G = G; J.c = c; fg::gemm_phase(lds, J); }
    SEAM(4);
    if (IN(5) && grp == 0) convert_t_f8(lds, C1, c1_split + c, kE * C1.per, G);
    if (IN(5)) REP(5) { JobOutProj J; J.A = (const char*)(ws + WS_CAT); J.lda2 = kD * 2; J.ldb2 = kD * 2; J.bhalf2 = 256; J.K = kD; J.list = nullptr;
        J.B = (const char*)(ws + WS_WO); J.x = a.in[0]; J.mod = mod; J.x1 = (float*)(ws + WS_X1); J.S.init(kT, kD, G, c); fg::gemm_phase(lds, J); }
    if (IN(5) && DUPQ(5)) { JobOutProj J; J.A = (const char*)(ws + WS_CAT); J.lda2 = kD * 2; J.ldb2 = kD * 2; J.bhalf2 = 256; J.K = kD; J.list = nullptr;
        J.B = (const char*)(ws + WS_WO); J.x = a.in[0]; J.mod = mod; J.x1 = (float*)(ws + WS_X1); J.S.init(kT, kD, G, c); fg::gemm_phase(lds, J); }
    if (IN(5) && grp == 1) convert_t_f8(lds, C1, c1_split + c, kE * C1.per, G);
    SEAM(5);
    if (IN(6)) REP(6) norm2_router_phase(lds, (const float*)(ws + WS_X1), a.in[3], mod, a.in[12], a.in[13], (unsigned char*)(ws + WS_H2), (float*)(ws + WS_GATES), (int*)(ws + WS_PAIRE), (int*)(ws + WS_PAIRP),
                                  (int*)(ws + WS_LIST), ctrl, G, c);
    SEAM(6);
    if (IN(7) && grp == 0) convert_t_f8(lds, C2, c, kE * C2.per, G);
    if (IN(7)) REP(7) { JobMoe1F8 J; J.A = (const char*)(ws + WS_H2); J.lda2 = kD; J.ldb2 = kD; J.bhalf2 = (unsigned)kDFF * kD; J.K = kD; J.list = (const int*)(ws + WS_LIST);
        J.B = (const char*)(ws + WS_WE1); J.b_in = a.in[15]; J.act = (unsigned char*)(ws + WS_ACT); J.M = moe_tables(lds, ctrl, kDFF / 128); J.G = G; J.c = c; fg::gemm_phase_f8(lds, J); }
    if (IN(7) && DUPQ(7)) { JobMoe1F8 J; J.A = (const char*)(ws + WS_H2); J.lda2 = kD; J.ldb2 = kD; J.bhalf2 = (unsigned)kDFF * kD; J.K = kD; J.list = (const int*)(ws + WS_LIST);
        J.B = (const char*)(ws + WS_WE1); J.b_in = a.in[15]; J.act = (unsigned char*)(ws + WS_ACT); J.M = moe_tables(lds, ctrl, kDFF / 128); J.G = G; J.c = c; fg::gemm_phase_f8(lds, J); }
    if (IN(7) && grp == 1) convert_t_f8(lds, C2, c, kE * C2.per, G);
    SEAM(7);
    if (IN(8)) REP(8) { JobMoe2F8 J; J.A = (const char*)(ws + WS_ACT); J.lda2 = kDFF; J.ldb2 = kDFF; J.bhalf2 = 128u * kDFF; J.K = kDFF; J.list = nullptr;
        J.B = (const char*)(ws + WS_WE2); J.b_out = a.in[17]; J.yp = (bf16_t*)(ws + WS_YP); J.M = moe_tables(lds, ctrl, kD / 256); J.G = G; J.c = c; fg::gemm_phase_f8(lds, J); }
    if (IN(8) && DUPQ(8)) { JobMoe2F8 J; J.A = (const char*)(ws + WS_ACT); J.lda2 = kDFF; J.ldb2 = kDFF; J.bhalf2 = 128u * kDFF; J.K = kDFF; J.list = nullptr;
        J.B = (const char*)(ws + WS_WE2); J.b_out = a.in[17]; J.yp = (bf16_t*)(ws + WS_YP); J.M = moe_tables(lds, ctrl, kD / 256); J.G = G; J.c = c; fg::gemm_phase_f8(lds, J); }
    SEAM(8);
    if (IN(9)) REP(9) final_phase((const float*)(ws + WS_X1), mod, (const float*)(ws + WS_GATES), (const int*)(ws + WS_PAIRE), (const int*)(ws + WS_PAIRP), moe_tables(lds, ctrl, 1), (const bf16_t*)(ws + WS_YP), a.out, G, c);
    if (IN(9) && DUPQ(9)) final_phase((const float*)(ws + WS_X1), mod, (const float*)(ws + WS_GATES), (const int*)(ws + WS_PAIRE), (const int*)(ws + WS_PAIRP), moe_tables(lds, ctrl, 1), (const bf16_t*)(ws + WS_YP), a.out, G, c);
#undef IN
#undef SEAM
}

#ifndef N_LAUNCHES
#define N_LAUNCHES 1
#endif
extern "C" void kernel_launch(void* const* d_in, const int* in_sizes, int n_in, void* d_out, int out_size, void* d_ws, size_t ws_size, hipStream_t stream) {
    static int grid = 0;
    if (grid == 0) {
        int dev = 0, cus = 0;
        (void)hipGetDevice(&dev); (void)hipDeviceGetAttribute(&cus, hipDeviceAttributeMultiprocessorCount, dev);
        (void)hipFuncSetAttribute((const void*)mega, hipFuncAttributeMaxDynamicSharedMemorySize, fg::LDS_BYTES);
        grid = cus > 0 ? cus : 256;
    }
    MegaArgs a{}; for (int i = 0; i < 18; ++i) a.in[i] = (const float*)d_in[i]; a.out = (float*)d_out; a.ws = (unsigned char*)d_ws;
    (void)hipMemsetAsync((char*)d_ws + WS_CTRL, 0, 65536, stream);
    if (N_LAUNCHES == 1) { a.ph_lo = 0; a.ph_hi = NPHASE; hipLaunchKernelGGL(mega, dim3(grid), dim3(512), fg::LDS_BYTES, stream, a); }
    else for (int p = 0; p < NPHASE; ++p) { a.ph_lo = p; a.ph_hi = p + 1; hipLaunchKernelGGL(mega, dim3(grid), dim3(512), fg::LDS_BYTES, stream, a); }
}
```

```cpp
#include <hip/hip_runtime.h>
#include <stdint.h>

constexpr int kB = 4, kS = 2048, kD = 2048, kT = kB * kS;
constexpr int kHD = 128, kNH = 8, kSB = 1024, kPW = 1024, kPG = 256;
constexpr int kNPROJ = 4096, kE = 32, kTOPK = 4, kDFF = 2048;
constexpr float kEPS = 1e-6f;
constexpr int kMaxSlots = 160 * 256;

typedef unsigned short bf16_t;
__device__ __forceinline__ bf16_t f2bf(float f) { unsigned u = __float_as_uint(f); u += 0x7FFFu + ((u >> 16) & 1u); return (bf16_t)(u >> 16); }
__device__ __forceinline__ float bf2f(bf16_t b) { return __uint_as_float(((unsigned)b) << 16); }

constexpr size_t WS_CTRL   = 0;
constexpr size_t WS_MOD    = 65536;
constexpr size_t WS_H      = WS_MOD + (size_t)4 * 12288 * 4;
constexpr size_t WS_PROJ   = WS_H + (size_t)kT * kD * 2;
constexpr size_t WS_CAT    = WS_PROJ + (size_t)kT * kNPROJ * 2;
constexpr size_t WS_P      = WS_CAT + (size_t)kT * kD * 2;
constexpr size_t WS_X1     = WS_P + (size_t)kT * kPW * 2;
constexpr size_t WS_H2     = WS_X1 + (size_t)kT * kD * 4;
constexpr size_t WS_GATES  = WS_H2 + (size_t)kT * kD * 2;
constexpr size_t WS_PAIRE  = WS_GATES + (size_t)kT * 4 * 4;
constexpr size_t WS_PAIRP  = WS_PAIRE + (size_t)kT * 4 * 4;
constexpr size_t WS_LIST   = WS_PAIRP + (size_t)kT * 4 * 4;
constexpr size_t WS_ACT    = WS_LIST + (size_t)kE * kT * 4;
constexpr size_t WS_YP     = WS_ACT + (size_t)kMaxSlots * kDFF * 2;
constexpr size_t WS_END    = WS_YP + (size_t)kMaxSlots * kD * 2;
constexpr int CT_CNT = 4096;
constexpr int CT_ROWBASE = 4160;

__global__ void k_ada(const float* __restrict__ c, const float* __restrict__ w_ada, const float* __restrict__ b_ada, float* __restrict__ mod) {
    __shared__ float ca[kB][kD];
    for (int i = threadIdx.x; i < kB * kD; i += blockDim.x) { const float v = c[i]; ca[i / kD][i % kD] = v / (1.f + __expf(-v)); }
    __syncthreads();
    const int n = blockIdx.x * blockDim.x + threadIdx.x;
    float a0 = 0.f, a1 = 0.f, a2 = 0.f, a3 = 0.f;
    for (int k = 0; k < kD; ++k) { const float w = w_ada[(size_t)k * (6 * kD) + n]; a0 += ca[0][k] * w; a1 += ca[1][k] * w; a2 += ca[2][k] * w; a3 += ca[3][k] * w; }
    const float bb = b_ada[n];
    mod[0 * 6 * kD + n] = a0 + bb; mod[1 * 6 * kD + n] = a1 + bb; mod[2 * 6 * kD + n] = a2 + bb; mod[3 * 6 * kD + n] = a3 + bb;
}

__device__ __forceinline__ float block_sum_256(float v, float* red) {
    for (int o = 32; o > 0; o >>= 1) v += __shfl_down(v, o);
    const int w = threadIdx.x >> 6, l = threadIdx.x & 63;
    __syncthreads();
    if (l == 0) red[w] = v;
    __syncthreads();
    return red[0] + red[1] + red[2] + red[3];
}
__global__ void k_norm_mod(const float* __restrict__ x, const float* __restrict__ nw, const float* __restrict__ mod, int shift_off, int scale_off, bf16_t* __restrict__ out) {
    __shared__ float red[4];
    const int t = blockIdx.x, b = t / kS;
    const float* xr = x + (size_t)t * kD;
    float v[8]; float ss = 0.f;
    for (int i = 0; i < 8; ++i) { v[i] = xr[threadIdx.x + 256 * i]; ss += v[i] * v[i]; }
    ss = block_sum_256(ss, red);
    const float r = rsqrtf(ss / kD + kEPS);
    for (int i = 0; i < 8; ++i) { const int n = threadIdx.x + 256 * i;
        const float y = v[i] * r * nw[n] * (1.f + mod[b * 6 * kD + scale_off + n]) + mod[b * 6 * kD + shift_off + n];
        out[(size_t)t * kD + n] = f2bf(y); }
}

struct GemmArgs { const bf16_t* A; const float* B; int lda; int ldb; int K; int pad; };
template <class RowFn, class Epi>
__global__ void __launch_bounds__(256) k_gemm_naive(GemmArgs g, RowFn rowfn, Epi epi) {
    __shared__ float As[16][68], Bs[16][64];
    const int z = blockIdx.z;
    int mrows; const bf16_t* Abase; const float* Bbase;
    if (!rowfn.setup(z, g, mrows, Abase, Bbase)) return;
    const int m0 = blockIdx.y * 64, n0 = blockIdx.x * 64;
    if (m0 >= mrows) return;
    const int tid = threadIdx.x, ty = tid >> 4, tx = tid & 15;
    const int ar = tid >> 2, ak = (tid & 3) * 4;
    const int bk = tid >> 4, bn = (tid & 15) * 4;
    const long arow = rowfn.row(z, m0 + ar, mrows);
    const bf16_t* ap = Abase + arow * (long)g.lda + ak;
    const float* bp = Bbase + (size_t)bk * g.ldb + n0 + bn;
    float acc[4][4] = {};
    for (int k0 = 0; k0 < g.K; k0 += 16) {
        const uint2 av = *(const uint2*)(ap + k0);
        const float4 bv = *(const float4*)(bp + (size_t)k0 * g.ldb);
        __syncthreads();
        As[ak + 0][ar] = __uint_as_float(av.x << 16); As[ak + 1][ar] = __uint_as_float(av.x & 0xFFFF0000u);
        As[ak + 2][ar] = __uint_as_float(av.y << 16); As[ak + 3][ar] = __uint_as_float(av.y & 0xFFFF0000u);
        *(float4*)&Bs[bk][bn] = bv;
        __syncthreads();
#pragma unroll
        for (int k = 0; k < 16; ++k) {
            const float4 a4 = *(const float4*)&As[k][ty * 4]; const float4 b4 = *(const float4*)&Bs[k][tx * 4];
            const float a[4] = {a4.x, a4.y, a4.z, a4.w}, b[4] = {b4.x, b4.y, b4.z, b4.w};
#pragma unroll
            for (int i = 0; i < 4; ++i)
#pragma unroll
                for (int j = 0; j < 4; ++j) acc[i][j] += a[i] * b[j];
        }
    }
#pragma unroll
    for (int i = 0; i < 4; ++i)
#pragma unroll
        for (int j = 0; j < 4; ++j) epi(z, m0 + ty * 4 + i, n0 + tx * 4 + j, acc[i][j], mrows);
}
struct RowDense { int M;
    __device__ bool setup(int, const GemmArgs& g, int& mrows, const bf16_t*& A, const float*& B) const { mrows = M; A = g.A; B = g.B; return true; }
    __device__ long row(int, int r, int) const { return r; } };
struct EpiStoreBf16 { bf16_t* C; int ldc; int pad;
    __device__ void operator()(int, int r, int c, float v, int) const { C[(size_t)r * ldc + c] = f2bf(v); } };
struct EpiOutProj { const float* x; const float* mod; float* x1;
    __device__ void operator()(int, int r, int c, float v, int) const { const int b = r / kS; x1[(size_t)r * kD + c] = x[(size_t)r * kD + c] + mod[b * 6 * kD + 2 * kD + c] * v; } };
struct RowPool { int pad; __device__ bool setup(int z, const GemmArgs& g, int& mrows, const bf16_t*& A, const float*& B) const { mrows = kT; A = g.A + z * kPG; B = g.B + (size_t)z * kPG * kPG; return true; }
    __device__ long row(int, int r, int) const { return r; } };
struct EpiPool { const float* pool_scale; bf16_t* cat;
    __device__ void operator()(int z, int r, int c, float v, int) const { cat[(size_t)r * kD + kSB + z * kPG + c] = f2bf(v * pool_scale[z * kPG + c]); } };

__global__ void __launch_bounds__(256) k_attn_naive(const bf16_t* __restrict__ proj, const float* __restrict__ qw, const float* __restrict__ kw, bf16_t* __restrict__ cat) {
    __shared__ float qs[4][kHD];
    const int w = threadIdx.x >> 6, lane = threadIdx.x & 63;
    const int rowid = blockIdx.x * 4 + w;
    const int t = rowid % kS, bh = rowid / kS, h = bh % kNH, b = bh / kNH;
    const bf16_t* qrow = proj + (size_t)(b * kS + t) * kNPROJ + h * kHD;
    float q0 = bf2f(qrow[lane]), q1 = bf2f(qrow[lane + 64]);
    float ss = q0 * q0 + q1 * q1;
    for (int o = 32; o > 0; o >>= 1) ss += __shfl_xor(ss, o);
    const float rq = rsqrtf(ss / kHD + kEPS) * 0.08838834764831845f;
    qs[w][lane] = q0 * rq * qw[lane] * kw[lane]; qs[w][lane + 64] = q1 * rq * qw[lane + 64] * kw[lane + 64];
    __syncthreads();
    float o0 = 0.f, o1 = 0.f, carry = 0.f;
    for (int jb = ((t - 1) >> 6) << 6; jb >= 0 && t > 0; jb -= 64) {
        const int j = jb + lane; const bool valid = j < t;
        float z = 0.f, sp = 0.f;
        if (valid) {
            const bf16_t* krow = proj + (size_t)(b * kS + j) * kNPROJ + kSB + h * kHD;
            float dot = 0.f, kss = 0.f;
            for (int d = 0; d < kHD; d += 8) { const uint4 kv = *(const uint4*)(krow + d); const unsigned u[4] = {kv.x, kv.y, kv.z, kv.w};
#pragma unroll
                for (int e = 0; e < 4; ++e) { const float k0 = __uint_as_float(u[e] << 16), k1 = __uint_as_float(u[e] & 0xFFFF0000u);
                    dot += qs[w][d + 2 * e] * k0 + qs[w][d + 2 * e + 1] * k1; kss += k0 * k0 + k1 * k1; } }
            z = dot * rsqrtf(kss / kHD + kEPS);
            sp = (z > 15.f) ? z : log1pf(__expf(z));
        }
        float s = sp;
        for (int o = 1; o < 64; o <<= 1) { const float v = __shfl_down(s, o); if (lane + o < 64) s += v; }
        const float a = valid ? __expf(z - (carry + s)) : 0.f;
        carry += __shfl(s, 0);
        const int jmax = min(64, t - jb);
        const bf16_t* vb = proj + (size_t)(b * kS + jb) * kNPROJ + 2 * kSB + h * kHD;
        for (int l = 0; l < jmax; ++l) { const float al = __shfl(a, l); o0 += al * bf2f(vb[(size_t)l * kNPROJ + lane]); o1 += al * bf2f(vb[(size_t)l * kNPROJ + lane + 64]); }
    }
    bf16_t* orow = cat + (size_t)(b * kS + t) * kD + h * kHD;
    orow[lane] = f2bf(o0); orow[lane + 64] = f2bf(o1);
}

__global__ void k_pool_p(const bf16_t* __restrict__ proj, bf16_t* __restrict__ p) {
    const int idx = blockIdx.x * blockDim.x + threadIdx.x;
    const int c = idx & (kPW - 1), t = idx >> 10, s = t % kS, g = c >> 8;
    const int w = 2 << g;
    const int cnt = min(s + 1, w);
    float sum = 0.f;
    for (int i = 0; i < cnt; ++i) sum += bf2f(proj[(size_t)(t - i) * kNPROJ + 3 * kSB + c]);
    const float u = bf2f(proj[(size_t)t * kNPROJ + 3 * kSB + c]);
    p[(size_t)t * kPW + c] = f2bf(sum / (float)cnt - u);
}

__global__ void __launch_bounds__(256) k_norm2_router(const float* __restrict__ x1, const float* __restrict__ nw, const float* __restrict__ mod,
                               const float* __restrict__ w_router, const float* __restrict__ b_router, unsigned char* __restrict__ h2,
                               float* __restrict__ gates, int* __restrict__ pair_e, int* __restrict__ pair_p, int* __restrict__ list, unsigned* __restrict__ ctrl) {
    __shared__ float red[4]; __shared__ float lg[4][kE];
    const int t = blockIdx.x, b = t / kS;
    const float* xr = x1 + (size_t)t * kD;
    float v[8]; float ss = 0.f;
    for (int i = 0; i < 8; ++i) { v[i] = xr[threadIdx.x + 256 * i]; ss += v[i] * v[i]; }
    ss = block_sum_256(ss, red);
    const float r = rsqrtf(ss / kD + kEPS);
    float part[kE];
#pragma unroll
    for (int e = 0; e < kE; ++e) part[e] = 0.f;
    for (int i = 0; i < 8; ++i) { const int n = threadIdx.x + 256 * i;
        const float y = v[i] * r * nw[n] * (1.f + mod[b * 6 * kD + 4 * kD + n]) + mod[b * 6 * kD + 3 * kD + n];
        h2[(size_t)t * kD + n] = f2bf(y);
        const float4* wr = (const float4*)(w_router + (size_t)n * kE);
#pragma unroll
        for (int e4 = 0; e4 < 8; ++e4) { const float4 w4 = wr[e4]; part[e4 * 4] += y * w4.x; part[e4 * 4 + 1] += y * w4.y; part[e4 * 4 + 2] += y * w4.z; part[e4 * 4 + 3] += y * w4.w; } }
    const int wv = threadIdx.x >> 6, l = threadIdx.x & 63;
#pragma unroll
    for (int e = 0; e < kE; ++e) { float s = part[e]; for (int o = 32; o > 0; o >>= 1) s += __shfl_down(s, o); if (l == 0) lg[wv][e] = s; }
    __syncthreads();
    if (threadIdx.x < 64) {
        const int e = l & 31;
        float mine = lg[0][e] + lg[1][e] + lg[2][e] + lg[3][e] + b_router[e];
        if (l >= 32) mine = -3.4e38f;
        int idx[4]; float val[4];
#pragma unroll
        for (int k = 0; k < 4; ++k) {
            float bv = mine; int bi = l;
            for (int o = 32; o > 0; o >>= 1) { const float ov = __shfl_xor(bv, o); const int oi = __shfl_xor(bi, o); if (ov > bv || (ov == bv && oi < bi)) { bv = ov; bi = oi; } }
            idx[k] = bi; val[k] = bv; if (l == bi) mine = -3.4e38f;
        }
        if (l == 0) {
            float ex[4], sum = 0.f;
#pragma unroll
            for (int k = 0; k < 4; ++k) { ex[k] = __expf(val[k] - val[0]); sum += ex[k]; }
#pragma unroll
            for (int k = 0; k < 4; ++k) { gates[t * 4 + k] = ex[k] / sum; pair_e[t * 4 + k] = idx[k];
                const unsigned pos = atomicAdd(&ctrl[CT_CNT + idx[k]], 1u); pair_p[t * 4 + k] = (int)pos; list[(size_t)idx[k] * kT + pos] = t; }
        }
    }
}
__global__ void k_moe_plan(unsigned* ctrl) {
    if (threadIdx.x == 0) { unsigned base = 0; for (int e = 0; e < kE; ++e) { ctrl[CT_ROWBASE + e] = base; base += ((ctrl[CT_CNT + e] + 255u) / 256u) * 256u; } ctrl[CT_ROWBASE + kE] = base; }
}

__global__ void __launch_bounds__(256) k_moe1_naive(const bf16_t* __restrict__ h2, const float* __restrict__ w_in, const float* __restrict__ b_in, const int* __restrict__ list,
                                                    const unsigned* __restrict__ ctrl, bf16_t* __restrict__ act) {
    __shared__ float As[16][68], Bg[16][64], Bl[16][64];
    const int e = blockIdx.z; const int mrows = (int)ctrl[CT_CNT + e];
    const int m0 = blockIdx.y * 64, n0 = blockIdx.x * 64;
    if (m0 >= mrows) return;
    const int rowbase = (int)ctrl[CT_ROWBASE + e];
    const int tid = threadIdx.x, ty = tid >> 4, tx = tid & 15;
    const int ar = tid >> 2, ak = (tid & 3) * 4, bk = tid >> 4, bn = (tid & 15) * 4;
    const int tok = list[(size_t)e * kT + min(m0 + ar, mrows - 1)];
    const bf16_t* ap = h2 + (size_t)tok * kD + ak;
    const float* bp = w_in + (size_t)e * kD * 2 * kDFF + (size_t)bk * (2 * kDFF) + n0 + bn;
    float ag[4][4] = {}, al[4][4] = {};
    for (int k0 = 0; k0 < kD; k0 += 16) {
        const uint2 av = *(const uint2*)(ap + k0);
        const float4 g4 = *(const float4*)(bp + (size_t)k0 * (2 * kDFF)); const float4 l4 = *(const float4*)(bp + (size_t)k0 * (2 * kDFF) + kDFF);
        __syncthreads();
        As[ak + 0][ar] = __uint_as_float(av.x << 16); As[ak + 1][ar] = __uint_as_float(av.x & 0xFFFF0000u);
        As[ak + 2][ar] = __uint_as_float(av.y << 16); As[ak + 3][ar] = __uint_as_float(av.y & 0xFFFF0000u);
        *(float4*)&Bg[bk][bn] = g4; *(float4*)&Bl[bk][bn] = l4;
        __syncthreads();
#pragma unroll
        for (int k = 0; k < 16; ++k) {
            const float4 a4 = *(const float4*)&As[k][ty * 4]; const float4 g44 = *(const float4*)&Bg[k][tx * 4]; const float4 l44 = *(const float4*)&Bl[k][tx * 4];
            const float a[4] = {a4.x, a4.y, a4.z, a4.w}, gg[4] = {g44.x, g44.y, g44.z, g44.w}, ll[4] = {l44.x, l44.y, l44.z, l44.w};
#pragma unroll
            for (int i = 0; i < 4; ++i)
#pragma unroll
                for (int j = 0; j < 4; ++j) { ag[i][j] += a[i] * gg[j]; al[i][j] += a[i] * ll[j]; }
        }
    }
    for (int i = 0; i < 4; ++i) { const int r = m0 + ty * 4 + i; if (r >= mrows) continue;
        for (int j = 0; j < 4; ++j) { const int c = n0 + tx * 4 + j;
            float gv = ag[i][j] + b_in[(size_t)e * 2 * kDFF + c], lv = al[i][j] + b_in[(size_t)e * 2 * kDFF + kDFF + c];
            gv = fminf(gv, 7.f); lv = fminf(fmaxf(lv, -7.f), 7.f);
            const float a = gv / (1.f + __expf(-1.702f * gv)) * (lv + 1.f);
            act[(size_t)(rowbase + r) * kDFF + c] = f2bf(a); } }
}
struct RowMoe2 { const unsigned* ctrl; const float* w;
    __device__ bool setup(int z, const GemmArgs& g, int& mrows, const bf16_t*& A, const float*& B) const { mrows = (int)ctrl[CT_CNT + z]; A = g.A + (size_t)ctrl[CT_ROWBASE + z] * kDFF; B = w + (size_t)z * kDFF * kD; return mrows > 0; }
    __device__ long row(int, int r, int mrows) const { return r < mrows ? r : mrows - 1; } };
struct EpiMoe2 { const unsigned* ctrl; const float* b_out; bf16_t* yp;
    __device__ void operator()(int z, int r, int c, float v, int mrows) const { if (r < mrows) yp[(size_t)(ctrl[CT_ROWBASE + z] + r) * kD + c] = f2bf(v + b_out[(size_t)z * kD + c]); } };

__global__ void k_final(const float* __restrict__ x1, const float* __restrict__ mod, const float* __restrict__ gates, const int* __restrict__ pair_e, const int* __restrict__ pair_p,
                        const unsigned* __restrict__ ctrl, const bf16_t* __restrict__ yp, float* __restrict__ out) {
    const int t = blockIdx.x, b = t / kS;
    float gk[4]; size_t rows[4];
#pragma unroll
    for (int k = 0; k < 4; ++k) { gk[k] = gates[t * 4 + k]; rows[k] = (size_t)(ctrl[CT_ROWBASE + pair_e[t * 4 + k]] + (unsigned)pair_p[t * 4 + k]); }
    for (int n = threadIdx.x; n < kD; n += blockDim.x) {
        float y = 0.f;
#pragma unroll
        for (int k = 0; k < 4; ++k) y += gk[k] * bf2f(yp[rows[k] * kD + n]);
        out[(size_t)t * kD + n] = x1[(size_t)t * kD + n] + mod[b * 6 * kD + 5 * kD + n] * y;
    }
}


#define LAS __attribute__((address_space(3)))
typedef short bf16x8 __attribute__((ext_vector_type(8)));
typedef short s16x4 __attribute__((ext_vector_type(4)));
typedef float f32x4 __attribute__((ext_vector_type(4)));
typedef float f32x2 __attribute__((ext_vector_type(2)));
typedef __bf16 bf16v2 __attribute__((ext_vector_type(2)));
typedef unsigned u32x2 __attribute__((ext_vector_type(2)));
typedef unsigned u32x4 __attribute__((ext_vector_type(4)));
typedef int i32x4 __attribute__((ext_vector_type(4)));
typedef int i32x8 __attribute__((ext_vector_type(8)));
__device__ __forceinline__ unsigned pk_bf16(float a, float b) { f32x2 v = {a, b}; bf16v2 r = __builtin_convertvector(v, bf16v2); return __builtin_bit_cast(unsigned, r); }

constexpr size_t WS_WIN  = WS_END;
constexpr size_t WS_WO   = WS_WIN + (size_t)kD * kNPROJ * 2;
constexpr size_t WS_WPL  = WS_WO + (size_t)kD * kD * 2;
constexpr size_t WS_WE1  = WS_WPL + (size_t)4 * kPG * kPG * 2;
constexpr size_t WS_WE2  = WS_WE1 + (size_t)kE * kD * 2 * kDFF * 2;
constexpr size_t WS_END2 = WS_WE2 + (size_t)kE * kDFF * kD * 2;

namespace fg {
constexpr int BM = 256, BK = 64, HALF = 128, HTB = 16384, STAGE_BYTES = 131072, NXCD = 8, WGM = 8;
constexpr int TAB_OFF = STAGE_BYTES;
constexpr int MISC_OFF = STAGE_BYTES + 2048;
constexpr int LDS_BYTES = STAGE_BYTES + 4096;
__device__ __forceinline__ int lds_byte(int r, int c) { const int st = (r >> 4) * 2 + (c >> 5), rr = r & 15, cc = c & 31, ob = rr * 64 + cc * 2; return st * 1024 + (ob ^ (((ob >> 9) & 1) << 5)); }
__device__ __forceinline__ void stage_rc(int b, int& R, int& C) { const int st = b / 1024, sb = b % 1024, swz = sb ^ (((sb >> 9) & 1) << 5); R = (st >> 1) * 16 + swz / 64; C = (st & 1) * 32 + (swz % 64) / 2; }

struct Unit { const char* bBase; int arow0; int nvalid; int e; int orow0; int ocol0; int acol2; };

struct StaticOrder {
    int nM, nN, nwg, G, c;
    __device__ void init(int M, int N, int G_, int c_) { nM = M / BM; nN = N / BM; nwg = nM * nN; G = G_; c = c_; }
    __device__ bool next(int i, int& pm, int& pn) const {
        const long L = (long)i * G + c; if (L >= nwg) return false;
        int wgid = (int)L; { const int q = nwg / NXCD, r = nwg % NXCD, xcd = wgid % NXCD, off = wgid / NXCD; wgid = (xcd < r ? xcd * (q + 1) : r * (q + 1) + (xcd - r) * q) + off; }
        const int nig = WGM * nN, gid = wgid / nig, fm = gid * WGM, gsz = (nM - fm) < WGM ? (nM - fm) : WGM;
        pm = fm + ((wgid % nig) % gsz); pn = (wgid % nig) / gsz; return true;
    }
};

template <int OFF> __device__ __forceinline__ s16x4 tr_read(unsigned addr) { s16x4 r; asm volatile("ds_read_b64_tr_b16 %0, %1 offset:%2" : "=&v"(r) : "v"(addr), "i"(OFF) : "memory"); return r; }
template <class Job>
__device__ __forceinline__ void gemm_phase(LAS unsigned char* lds, const Job& J) {
    const int tid = threadIdx.x, wid = __builtin_amdgcn_readfirstlane(tid >> 6), lane = tid & 63, wr = wid >> 2, wc = wid & 3, fr = lane & 15, fq = lane >> 4;
    const int nt = J.K / BK;
    unsigned voffB[2];
#pragma unroll
    for (int i = 0; i < 2; ++i) { int R, C; stage_rc(tid * 16 + i * 8192, R, C);
        const int b = tid * 16 + i * 8192, row = b >> 8, slot = (b >> 4) & 15, ch = slot ^ (((row & 3) << 2) | ((row >> 2) & 3)); voffB[i] = (unsigned)row * J.ldb2 + (unsigned)ch * 16u; }
    const size_t kstepB = (size_t)BK * J.ldb2;
    const unsigned ldsw = (unsigned)wid * 1024u;
    const int aoff = lds_byte(wr * 64 + fr, fq * 8);
    const int tq = (lane & 15) >> 2, tp = lane & 3;
    unsigned ba[2][2];
#pragma unroll
    for (int n = 0; n < 2; ++n)
#pragma unroll
        for (int t = 0; t < 2; ++t) ba[n][t] = (unsigned)(uintptr_t)lds + 256u * (8 * fq + 4 * t + tq) + 16u * ((4 * wc + 2 * n + (tp >> 1)) ^ ((tq << 2) | ((2 * fq + t) & 3))) + 8u * (tp & 1);
#define FG_SA(b, h) (65536 + ((b) * 2 + (h)) * HTB)
#define FG_SB(b, h) (((b) * 2 + (h)) * HTB)
#define FG_STAGE_A(bufoff, gk, vo) do { _Pragma("unroll") for (int _i = 0; _i < 2; ++_i) \
        __builtin_amdgcn_global_load_lds((const unsigned*)((gk) + (vo)[_i]), (LAS unsigned*)(lds + (bufoff) + ldsw + _i * 8192), 16, 0, 0); } while (0)
#define FG_STAGE_B(bufoff, gk) do { _Pragma("unroll") for (int _i = 0; _i < 2; ++_i) \
        __builtin_amdgcn_global_load_lds((const unsigned*)((gk) + voffB[_i]), (LAS unsigned*)(lds + (bufoff) + ldsw + _i * 8192), 16, 0, 0); } while (0)
#define FG_LDA(dst, b, h) do { _Pragma("unroll") for (int m = 0; m < 4; ++m) _Pragma("unroll") for (int k = 0; k < 2; ++k) dst[m][k] = *(const LAS bf16x8*)(lds + FG_SA(b, h) + aoff + m * 2048 + k * 1024); } while (0)
#define FG_LDB(dst, b, h) do { \
        dst##lo[0][0] = tr_read<FG_SB(b, h)>(ba[0][0]);        dst##hi[0][0] = tr_read<FG_SB(b, h)>(ba[0][1]); \
        dst##lo[0][1] = tr_read<FG_SB(b, h) + 8192>(ba[0][0]); dst##hi[0][1] = tr_read<FG_SB(b, h) + 8192>(ba[0][1]); \
        dst##lo[1][0] = tr_read<FG_SB(b, h)>(ba[1][0]);        dst##hi[1][0] = tr_read<FG_SB(b, h)>(ba[1][1]); \
        dst##lo[1][1] = tr_read<FG_SB(b, h) + 8192>(ba[1][0]); dst##hi[1][1] = tr_read<FG_SB(b, h) + 8192>(ba[1][1]); } while (0)
#define FG_PK(L, H) (bf16x8){L[0], L[1], L[2], L[3], H[0], H[1], H[2], H[3]}
#define FG_MMA(ai, bj, At, Bt) do { __builtin_amdgcn_s_setprio(1); _Pragma("unroll") for (int m = 0; m < 4; ++m) _Pragma("unroll") for (int n = 0; n < 2; ++n) _Pragma("unroll") for (int k = 0; k < 2; ++k) \
        acc[ai][bj][m][n] = __builtin_amdgcn_mfma_f32_16x16x32_bf16(FG_PK(Bt##lo[n][k], Bt##hi[n][k]), At[m][k], acc[ai][bj][m][n], 0, 0, 0); __builtin_amdgcn_s_setprio(0); } while (0)
#define FG_WAIT_V(n) asm volatile("s_waitcnt vmcnt(" #n ")" ::: "memory")
#define FG_WAIT_L(n) asm volatile("s_waitcnt lgkmcnt(" #n ")" ::: "memory")
#define FG_BAR __builtin_amdgcn_s_barrier()
#define FG_SCHED __builtin_amdgcn_sched_barrier(0)
#define FG_AOFF(dst, u, tabp) do { int _tz = threadIdx.x; asm volatile("" : "+v"(_tz)); _Pragma("unroll") for (int _i = 0; _i < 2; ++_i) { int _R, _C; stage_rc(_tz * 16 + _i * 8192, _R, _C); \
        _Pragma("unroll") for (int _h = 0; _h < 2; ++_h) { const int _r = _h * 128 + _R; \
        if (Job::GATHER) { const int _tok = (tabp)[_r < (u).nvalid ? _r : 0]; dst[_h][_i] = (unsigned)_tok * J.lda2 + (unsigned)(_C * 2); } \
        else dst[_h][_i] = (unsigned)((u).arow0 + _r) * J.lda2 + (unsigned)((u).acol2 + _C * 2); } } } while (0)
    Unit cur, nxt; int ui = 0;
    if (!J.next(0, cur)) return;
    LAS const int* tab0 = (LAS const int*)(lds + TAB_OFF);
    if (Job::GATHER) {
        if (wid == 0) __builtin_amdgcn_global_load_lds((const unsigned*)(J.list + cur.arow0 + lane * 4), (LAS unsigned*)(lds + TAB_OFF), 16, 0, 0);
        FG_WAIT_V(0); __syncthreads();
    }
    f32x4 acc[2][2][4][2];
#pragma unroll
    for (int a = 0; a < 2; ++a)
#pragma unroll
        for (int b = 0; b < 2; ++b)
#pragma unroll
            for (int m = 0; m < 4; ++m)
#pragma unroll
                for (int n = 0; n < 2; ++n) acc[a][b][m][n] = (f32x4){0.f, 0.f, 0.f, 0.f};
    bf16x8 At[4][2]; s16x4 B0lo[2][2], B0hi[2][2], B1lo[2][2], B1hi[2][2];
    unsigned vc[2][2];
    FG_AOFF(vc, cur, tab0);
    const char* const gA = J.A;
    const char* cB = cur.bBase;
    const unsigned bh2 = J.bhalf2;
    FG_STAGE_B(FG_SB(0, 0), cB); FG_STAGE_A(FG_SA(0, 0), gA, vc[0]); FG_STAGE_B(FG_SB(0, 1), cB + bh2); FG_STAGE_A(FG_SA(0, 1), gA, vc[1]);
    if (wr == 1) FG_BAR;
    FG_WAIT_V(4); FG_BAR;
    FG_STAGE_B(FG_SB(1, 0), cB + kstepB); FG_STAGE_A(FG_SA(1, 0), gA + 128, vc[0]); FG_STAGE_B(FG_SB(1, 1), cB + kstepB + bh2);
    FG_WAIT_V(6); FG_BAR;
    for (;;) {
        const bool has_next = J.next(ui + 1, nxt);
        if (!has_next) nxt = cur;
        if (Job::GATHER && has_next && wid == 0)
            __builtin_amdgcn_global_load_lds((const unsigned*)(J.list + nxt.arow0 + lane * 4), (LAS unsigned*)(lds + TAB_OFF + ((ui + 1) & 1) * 1024), 16, 0, 0);
        const char* nB = nxt.bBase;
        for (int t = 0; t < nt; t += 2) {
            const bool last = (t == nt - 2);
            const char* a1 = gA + (size_t)(t + 1) * 128;
            const char* a2 = last ? gA : gA + (size_t)(t + 2) * 128; const char* b2 = last ? nB : cB + (size_t)(t + 2) * kstepB;
            const char* a3 = a2 + 128; const char* b3 = b2 + kstepB;
            FG_LDB(B0, 0, 0); FG_SCHED; FG_LDA(At, 0, 0); FG_STAGE_A(FG_SA(1, 1), a1, vc[1]);
            if (last && has_next) { LAS const int* tabn = (LAS const int*)(lds + TAB_OFF + ((ui + 1) & 1) * 1024); FG_AOFF(vc, nxt, tabn); }
            FG_WAIT_L(8); FG_BAR; FG_WAIT_L(0); FG_SCHED; FG_MMA(0, 0, At, B0); FG_BAR; FG_SCHED;
            FG_LDB(B1, 0, 1); FG_STAGE_B(FG_SB(0, 0), b2);
            FG_BAR; FG_WAIT_L(0); FG_SCHED; FG_MMA(0, 1, At, B1); FG_BAR;
            FG_LDA(At, 0, 1); FG_STAGE_A(FG_SA(0, 0), a2, vc[0]);
            FG_BAR; FG_WAIT_L(0); FG_MMA(1, 0, At, B0); FG_BAR; FG_SCHED;
            FG_STAGE_B(FG_SB(0, 1), b2 + bh2);
            FG_WAIT_V(6); FG_BAR; FG_MMA(1, 1, At, B1); FG_BAR;
            FG_LDB(B0, 1, 0); FG_SCHED; FG_LDA(At, 1, 0); FG_STAGE_A(FG_SA(0, 1), a2, vc[1]);
            FG_WAIT_L(8); FG_BAR; FG_WAIT_L(0); FG_SCHED; FG_MMA(0, 0, At, B0); FG_BAR; FG_SCHED;
            FG_LDB(B1, 1, 1); FG_STAGE_B(FG_SB(1, 0), b3);
            FG_BAR; FG_WAIT_L(0); FG_SCHED; FG_MMA(0, 1, At, B1); FG_BAR;
            FG_LDA(At, 1, 1); FG_STAGE_A(FG_SA(1, 0), a3, vc[0]);
            FG_BAR; FG_WAIT_L(0); FG_MMA(1, 0, At, B0); FG_BAR; FG_SCHED;
            FG_STAGE_B(FG_SB(1, 1), b3 + bh2);
            FG_WAIT_V(6); FG_BAR; FG_MMA(1, 1, At, B1); FG_BAR;
        }
        J.epi(acc, cur, wr, wc, fr, fq);
        if (!has_next) break;
#pragma unroll
        for (int a = 0; a < 2; ++a)
#pragma unroll
            for (int b = 0; b < 2; ++b)
#pragma unroll
                for (int m = 0; m < 4; ++m)
#pragma unroll
                    for (int n = 0; n < 2; ++n) acc[a][b][m][n] = (f32x4){0.f, 0.f, 0.f, 0.f};
        cur = nxt; cB = nB; ++ui;
    }
    FG_WAIT_V(0);
    if (wr == 0) FG_BAR;
    FG_BAR;
}

#undef FG_SA
#undef FG_SB
#undef FG_STAGE_A
#undef FG_STAGE_B
#undef FG_LDA
#undef FG_LDB
#undef FG_MMA
#undef FG_WAIT_V
#undef FG_WAIT_L
#undef FG_BAR
#undef FG_SCHED
#undef FG_AOFF
template <class Job>
__device__ __forceinline__ void gemm_phase_f8(LAS unsigned char* lds, const Job& J) {
    const int tid = threadIdx.x, wid = __builtin_amdgcn_readfirstlane(tid >> 6), lane = tid & 63, wr = wid >> 2, wc = wid & 3, fr = lane & 15, fq = lane >> 4;
    const int nt = J.K / 128;
    unsigned voffB[2];
#pragma unroll
    for (int i = 0; i < 2; ++i) { int R, C; stage_rc(tid * 16 + i * 8192, R, C);
        voffB[i] = (unsigned)R * J.ldb2 + (unsigned)(C * 2); }
    const size_t kstepB = 128;
    const unsigned ldsw = (unsigned)wid * 1024u;
    const int aoff = lds_byte(wr * 64 + fr, fq * 8);
    const int boff = lds_byte(wc * 32 + fr, fq * 8);
#define FG_SA(b, h) (65536 + ((b) * 2 + (h)) * HTB)
#define FG_SB(b, h) (((b) * 2 + (h)) * HTB)
#define FG_STAGE_A(bufoff, gk, vo) do { _Pragma("unroll") for (int _i = 0; _i < 2; ++_i) \
        __builtin_amdgcn_global_load_lds((const unsigned*)((gk) + (vo)[_i]), (LAS unsigned*)(lds + (bufoff) + ldsw + _i * 8192), 16, 0, 0); } while (0)
#define FG_STAGE_B(bufoff, gk) do { _Pragma("unroll") for (int _i = 0; _i < 2; ++_i) \
        __builtin_amdgcn_global_load_lds((const unsigned*)((gk) + voffB[_i]), (LAS unsigned*)(lds + (bufoff) + ldsw + _i * 8192), 16, 0, 0); } while (0)
#define FG_LDA(dst, b, h) do { _Pragma("unroll") for (int m = 0; m < 4; ++m) _Pragma("unroll") for (int k = 0; k < 2; ++k) dst[m][k] = *(const LAS i32x4*)(lds + FG_SA(b, h) + aoff + m * 2048 + k * 1024); } while (0)
#define FG_LDB(dst, b, h) do { _Pragma("unroll") for (int n = 0; n < 2; ++n) _Pragma("unroll") for (int k = 0; k < 2; ++k) dst[n][k] = *(const LAS i32x4*)(lds + FG_SB(b, h) + boff + n * 2048 + k * 1024); } while (0)
#define FG_CAT8(X, Y) __builtin_shufflevector(X, Y, 0, 1, 2, 3, 4, 5, 6, 7)
#define FG_MMA(ai, bj, At, Bt) do { __builtin_amdgcn_s_setprio(1); _Pragma("unroll") for (int m = 0; m < 4; ++m) _Pragma("unroll") for (int n = 0; n < 2; ++n) \
        acc[ai][bj][m][n] = __builtin_amdgcn_mfma_scale_f32_16x16x128_f8f6f4(FG_CAT8(Bt[n][0], Bt[n][1]), FG_CAT8(At[m][0], At[m][1]), acc[ai][bj][m][n], 0, 0, 0, 0x79797979, 0, 0x7F7F7F7F); __builtin_amdgcn_s_setprio(0); } while (0)
#define FG_WAIT_V(n) asm volatile("s_waitcnt vmcnt(" #n ")" ::: "memory")
#define FG_WAIT_L(n) asm volatile("s_waitcnt lgkmcnt(" #n ")" ::: "memory")
#define FG_BAR __builtin_amdgcn_s_barrier()
#define FG_SCHED __builtin_amdgcn_sched_barrier(0)
#define FG_AOFF(dst, u, tabp) do { int _tz = threadIdx.x; asm volatile("" : "+v"(_tz)); _Pragma("unroll") for (int _i = 0; _i < 2; ++_i) { int _R, _C; stage_rc(_tz * 16 + _i * 8192, _R, _C); \
        _Pragma("unroll") for (int _h = 0; _h < 2; ++_h) { const int _r = _h * 128 + _R; \
        if (Job::GATHER) { const int _tok = (tabp)[_r < (u).nvalid ? _r : 0]; dst[_h][_i] = (unsigned)_tok * J.lda2 + (unsigned)(_C * 2); } \
        else dst[_h][_i] = (unsigned)((u).arow0 + _r) * J.lda2 + (unsigned)((u).acol2 + _C * 2); } } } while (0)
    Unit cur, nxt; int ui = 0;
    if (!J.next(0, cur)) return;
    LAS const int* tab0 = (LAS const int*)(lds + TAB_OFF);
    if (Job::GATHER) {
        if (wid == 0) __builtin_amdgcn_global_load_lds((const unsigned*)(J.list + cur.arow0 + lane * 4), (LAS unsigned*)(lds + TAB_OFF), 16, 0, 0);
        FG_WAIT_V(0); __syncthreads();
    }
    f32x4 acc[2][2][4][2];
#pragma unroll
    for (int a = 0; a < 2; ++a)
#pragma unroll
        for (int b = 0; b < 2; ++b)
#pragma unroll
            for (int m = 0; m < 4; ++m)
#pragma unroll
                for (int n = 0; n < 2; ++n) acc[a][b][m][n] = (f32x4){0.f, 0.f, 0.f, 0.f};
    i32x4 At[4][2], B0[2][2], B1[2][2];
    unsigned vc[2][2];
    FG_AOFF(vc, cur, tab0);
    const char* const gA = J.A;
    const char* cB = cur.bBase;
    const unsigned bh2 = J.bhalf2;
    FG_STAGE_B(FG_SB(0, 0), cB); FG_STAGE_A(FG_SA(0, 0), gA, vc[0]); FG_STAGE_B(FG_SB(0, 1), cB + bh2); FG_STAGE_A(FG_SA(0, 1), gA, vc[1]);
    if (wr == 1) FG_BAR;
    FG_WAIT_V(4); FG_BAR;
    FG_STAGE_B(FG_SB(1, 0), cB + kstepB); FG_STAGE_A(FG_SA(1, 0), gA + 128, vc[0]); FG_STAGE_B(FG_SB(1, 1), cB + kstepB + bh2);
    FG_WAIT_V(6); FG_BAR;
    for (;;) {
        const bool has_next = J.next(ui + 1, nxt);
        if (!has_next) nxt = cur;
        if (Job::GATHER && has_next && wid == 0)
            __builtin_amdgcn_global_load_lds((const unsigned*)(J.list + nxt.arow0 + lane * 4), (LAS unsigned*)(lds + TAB_OFF + ((ui + 1) & 1) * 1024), 16, 0, 0);
        const char* nB = nxt.bBase;
        for (int t = 0; t < nt; t += 2) {
            const bool last = (t == nt - 2);
            const char* a1 = gA + (size_t)(t + 1) * 128;
            const char* a2 = last ? gA : gA + (size_t)(t + 2) * 128; const char* b2 = last ? nB : cB + (size_t)(t + 2) * kstepB;
            const char* a3 = a2 + 128; const char* b3 = b2 + kstepB;
            FG_LDB(B0, 0, 0); FG_SCHED; FG_LDA(At, 0, 0); FG_STAGE_A(FG_SA(1, 1), a1, vc[1]);
            if (last && has_next) { LAS const int* tabn = (LAS const int*)(lds + TAB_OFF + ((ui + 1) & 1) * 1024); FG_AOFF(vc, nxt, tabn); }
            FG_WAIT_L(8); FG_BAR; FG_WAIT_L(0); FG_SCHED; FG_MMA(0, 0, At, B0); FG_BAR; FG_SCHED;
            FG_LDB(B1, 0, 1); FG_STAGE_B(FG_SB(0, 0), b2);
            FG_BAR; FG_WAIT_L(0); FG_SCHED; FG_MMA(0, 1, At, B1); FG_BAR;
            FG_LDA(At, 0, 1); FG_STAGE_A(FG_SA(0, 0), a2, vc[0]);
            FG_BAR; FG_WAIT_L(0); FG_MMA(1, 0, At, B0); FG_BAR; FG_SCHED;
            FG_STAGE_B(FG_SB(0, 1), b2 + bh2);
            FG_WAIT_V(6); FG_BAR; FG_MMA(1, 1, At, B1); FG_BAR;
            FG_LDB(B0, 1, 0); FG_SCHED; FG_LDA(At, 1, 0); FG_STAGE_A(FG_SA(0, 1), a2, vc[1]);
            FG_WAIT_L(8); FG_BAR; FG_WAIT_L(0); FG_SCHED; FG_MMA(0, 0, At, B0); FG_BAR; FG_SCHED;
            FG_LDB(B1, 1, 1); FG_STAGE_B(FG_SB(1, 0), b3);
            FG_BAR; FG_WAIT_L(0); FG_SCHED; FG_MMA(0, 1, At, B1); FG_BAR;
            FG_LDA(At, 1, 1); FG_STAGE_A(FG_SA(1, 0), a3, vc[0]);
            FG_BAR; FG_WAIT_L(0); FG_MMA(1, 0, At, B0); FG_BAR; FG_SCHED;
            FG_STAGE_B(FG_SB(1, 1), b3 + bh2);
            FG_WAIT_V(6); FG_BAR; FG_MMA(1, 1, At, B1); FG_BAR;
        }
        J.epi(acc, cur, wr, wc, fr, fq);
        if (!has_next) break;
#pragma unroll
        for (int a = 0; a < 2; ++a)
#pragma unroll
            for (int b = 0; b < 2; ++b)
#pragma unroll
                for (int m = 0; m < 4; ++m)
#pragma unroll
                    for (int n = 0; n < 2; ++n) acc[a][b][m][n] = (f32x4){0.f, 0.f, 0.f, 0.f};
        cur = nxt; cB = nB; ++ui;
    }
    FG_WAIT_V(0);
    if (wr == 0) FG_BAR;
    FG_BAR;
}
}

#define FG_FOR_ROWS for (int ai = 0; ai < 2; ++ai) _Pragma("unroll") for (int m = 0; m < 4; ++m)
struct JobInProj {
    static constexpr bool GATHER = false;
    const char* A; unsigned lda2, ldb2, bhalf2; int K; const int* list;
    const char* B; bf16_t* out; fg::StaticOrder S;
    __device__ __forceinline__ bool next(int i, fg::Unit& u) const { int pm, pn; if (!S.next(i, pm, pn)) return false;
        u.bBase = B + (size_t)pn * 512; u.arow0 = pm * 256; u.nvalid = 256; u.e = 0; u.orow0 = pm * 256; u.ocol0 = pn * 256; u.acol2 = 0; return true; }
    __device__ __forceinline__ void epi(const f32x4 (&acc)[2][2][4][2], const fg::Unit& u, int wr, int wc, int fr, int fq) const {
#pragma unroll
        FG_FOR_ROWS { bf16_t* rowp = out + (size_t)(u.orow0 + ai * 128 + wr * 64 + m * 16 + fr) * kNPROJ + u.ocol0 + wc * 32 + fq * 4;
#pragma unroll
            for (int bj = 0; bj < 2; ++bj)
#pragma unroll
                for (int n = 0; n < 2; ++n) { const f32x4 v = acc[ai][bj][m][n]; u32x2 w; w.x = pk_bf16(v[0], v[1]); w.y = pk_bf16(v[2], v[3]); *(u32x2*)(rowp + bj * 128 + n * 16) = w; } }
    }
};
struct JobPool {
    static constexpr bool GATHER = false;
    const char* A; unsigned lda2, ldb2, bhalf2; int K; const int* list;
    const char* B; bf16_t* cat; int G, c;
    __device__ __forceinline__ bool next(int i, fg::Unit& u) const { const int L = i * G + c; if (L >= 128) return false; const int g = L >> 5, pm = L & 31;
        u.bBase = B + (size_t)g * kPG * kPG * 2; u.arow0 = pm * 256; u.nvalid = 256; u.e = g; u.orow0 = pm * 256; u.ocol0 = kSB + g * kPG; u.acol2 = g * kPG * 2; return true; }
    __device__ __forceinline__ void epi(const f32x4 (&acc)[2][2][4][2], const fg::Unit& u, int wr, int wc, int fr, int fq) const {
#pragma unroll
        FG_FOR_ROWS { bf16_t* rowp = cat + (size_t)(u.orow0 + ai * 128 + wr * 64 + m * 16 + fr) * kD + u.ocol0 + wc * 32 + fq * 4;
#pragma unroll
            for (int bj = 0; bj < 2; ++bj)
#pragma unroll
                for (int n = 0; n < 2; ++n) { const f32x4 v = acc[ai][bj][m][n]; u32x2 w; w.x = pk_bf16(v[0], v[1]); w.y = pk_bf16(v[2], v[3]); *(u32x2*)(rowp + bj * 128 + n * 16) = w; } }
    }
};
struct JobOutProj {
    static constexpr bool GATHER = false;
    const char* A; unsigned lda2, ldb2, bhalf2; int K; const int* list;
    const char* B; const float* x; const float* mod; float* x1; fg::StaticOrder S;
    __device__ __forceinline__ bool next(int i, fg::Unit& u) const { int pm, pn; if (!S.next(i, pm, pn)) return false;
        u.bBase = B + (size_t)pn * 512; u.arow0 = pm * 256; u.nvalid = 256; u.e = 0; u.orow0 = pm * 256; u.ocol0 = pn * 256; u.acol2 = 0; return true; }
    __device__ __forceinline__ void epi(const f32x4 (&acc)[2][2][4][2], const fg::Unit& u, int wr, int wc, int fr, int fq) const {
        const int b = u.orow0 / kS; f32x4 gt[2][2];
#pragma unroll
        for (int bj = 0; bj < 2; ++bj)
#pragma unroll
            for (int n = 0; n < 2; ++n) gt[bj][n] = *(const f32x4*)(mod + b * 6 * kD + 2 * kD + u.ocol0 + bj * 128 + wc * 32 + n * 16 + fq * 4);
#pragma unroll
        FG_FOR_ROWS { const size_t ro = (size_t)(u.orow0 + ai * 128 + wr * 64 + m * 16 + fr) * kD + u.ocol0 + wc * 32 + fq * 4;
#pragma unroll
            for (int bj = 0; bj < 2; ++bj)
#pragma unroll
                for (int n = 0; n < 2; ++n) { const f32x4 xv = *(const f32x4*)(x + ro + bj * 128 + n * 16); *(f32x4*)(x1 + ro + bj * 128 + n * 16) = xv + gt[bj][n] * acc[ai][bj][m][n]; } }
    }
};
struct MoeTab { LAS const int* t; int total;
    __device__ __forceinline__ bool decode(int i, int G, int c, int& e, int& jcol, int& rb, int& cnt, int& rowbase) const {
        const int L = (G % 8 == 0) ? i * G + (c % 8) * (G / 8) + c / 8 : i * G + c; if (L >= total) return false;
        int ee = 0; while (ee < kE - 1 && t[64 + ee + 1] <= L) ++ee;
        const int local = L - t[64 + ee], nrb = t[100 + ee]; jcol = local / nrb; rb = local - jcol * nrb; e = ee; cnt = t[ee]; rowbase = t[32 + ee]; return true; }
};
__device__ __forceinline__ MoeTab moe_tables(LAS unsigned char* lds, const unsigned* ctrl, int ncol) {
    LAS int* t = (LAS int*)(lds + fg::MISC_OFF + 64);
    __syncthreads();
    if (threadIdx.x == 0) { int base = 0, us = 0; for (int e = 0; e < kE; ++e) { const int cn = (int)ctrl[CT_CNT + e], nrb = (cn + 255) >> 8; t[e] = cn; t[32 + e] = base; t[64 + e] = us; t[100 + e] = nrb; base += nrb * 256; us += nrb * ncol; } t[64 + kE] = us; }
    __syncthreads();
    MoeTab M; M.t = t; M.total = t[64 + kE]; return M;
}
struct JobMoe1 {
    static constexpr bool GATHER = true;
    const char* A; unsigned lda2, ldb2, bhalf2; int K; const int* list;
    const char* B; const float* b_in; bf16_t* act; MoeTab M; int G, c;
    __device__ __forceinline__ bool next(int i, fg::Unit& u) const { int e, j, rb, cnt, rowbase; if (!M.decode(i, G, c, e, j, rb, cnt, rowbase)) return false;
        e = __builtin_amdgcn_readfirstlane(e); j = __builtin_amdgcn_readfirstlane(j); rb = __builtin_amdgcn_readfirstlane(rb); cnt = __builtin_amdgcn_readfirstlane(cnt); rowbase = __builtin_amdgcn_readfirstlane(rowbase);
        u.bBase = B + (size_t)e * ((size_t)kD * 2 * kDFF * 2) + (size_t)j * 256; u.arow0 = e * kT + rb * 256; u.nvalid = min(256, cnt - rb * 256); u.e = e; u.orow0 = rowbase + rb * 256; u.ocol0 = j * 128; u.acol2 = 0; return true; }
    __device__ __forceinline__ void epi(const f32x4 (&acc)[2][2][4][2], const fg::Unit& u, int wr, int wc, int fr, int fq) const {
        f32x4 bg[2], bl[2];
#pragma unroll
        for (int n = 0; n < 2; ++n) { const float* bp = b_in + (size_t)u.e * 2 * kDFF + u.ocol0 + wc * 32 + n * 16 + fq * 4; bg[n] = *(const f32x4*)bp; bl[n] = *(const f32x4*)(bp + kDFF); }
#pragma unroll
        FG_FOR_ROWS { bf16_t* rowp = act + (size_t)(u.orow0 + ai * 128 + wr * 64 + m * 16 + fr) * kDFF + u.ocol0 + wc * 32 + fq * 4;
#pragma unroll
            for (int n = 0; n < 2; ++n) { const f32x4 gv = acc[ai][0][m][n] + bg[n], lv = acc[ai][1][m][n] + bl[n]; float o[4];
#pragma unroll
                for (int j = 0; j < 4; ++j) { const float g = fminf(gv[j], 7.f), l = fminf(fmaxf(lv[j], -7.f), 7.f); o[j] = g * __builtin_amdgcn_rcpf(1.f + __expf(-1.702f * g)) * (l + 1.f); }
                u32x2 w; w.x = pk_bf16(o[0], o[1]); w.y = pk_bf16(o[2], o[3]); *(u32x2*)(rowp + n * 16) = w; } }
    }
};
struct JobMoe2 {
    static constexpr bool GATHER = false;
    const char* A; unsigned lda2, ldb2, bhalf2; int K; const int* list;
    const char* B; const float* b_out; bf16_t* yp; MoeTab M; int G, c;
    __device__ __forceinline__ bool next(int i, fg::Unit& u) const { int e, j, rb, cnt, rowbase; if (!M.decode(i, G, c, e, j, rb, cnt, rowbase)) return false;
        e = __builtin_amdgcn_readfirstlane(e); j = __builtin_amdgcn_readfirstlane(j); rb = __builtin_amdgcn_readfirstlane(rb); rowbase = __builtin_amdgcn_readfirstlane(rowbase);
        u.bBase = B + (size_t)e * ((size_t)kDFF * kD * 2) + (size_t)j * 512; u.arow0 = rowbase + rb * 256; u.nvalid = 256; u.e = e; u.orow0 = rowbase + rb * 256; u.ocol0 = j * 256; u.acol2 = 0; return true; }
    __device__ __forceinline__ void epi(const f32x4 (&acc)[2][2][4][2], const fg::Unit& u, int wr, int wc, int fr, int fq) const {
        f32x4 bo[2][2];
#pragma unroll
        for (int bj = 0; bj < 2; ++bj)
#pragma unroll
            for (int n = 0; n < 2; ++n) bo[bj][n] = *(const f32x4*)(b_out + (size_t)u.e * kD + u.ocol0 + bj * 128 + wc * 32 + n * 16 + fq * 4);
#pragma unroll
        FG_FOR_ROWS { bf16_t* rowp = yp + (size_t)(u.orow0 + ai * 128 + wr * 64 + m * 16 + fr) * kD + u.ocol0 + wc * 32 + fq * 4;
#pragma unroll
            for (int bj = 0; bj < 2; ++bj)
#pragma unroll
                for (int n = 0; n < 2; ++n) { const f32x4 v = acc[ai][bj][m][n] + bo[bj][n]; u32x2 w; w.x = pk_bf16(v[0], v[1]); w.y = pk_bf16(v[2], v[3]); *(u32x2*)(rowp + bj * 128 + n * 16) = w; } }
    }
};


__device__ __forceinline__ float wave_sum(float v) {
#pragma unroll
    for (int o = 32; o > 0; o >>= 1) v += __shfl_xor(v, o);
    return v; }
__device__ __forceinline__ float bflo(unsigned u) { return __uint_as_float(u << 16); }
__device__ __forceinline__ float bfhi(unsigned u) { return __uint_as_float(u & 0xFFFF0000u); }

namespace at {
typedef float f32x16 __attribute__((ext_vector_type(16)));
__device__ __forceinline__ unsigned off_b(unsigned row, unsigned ch) { return 256u * row + 16u * (ch ^ (((row & 3) << 2) | ((row >> 2) & 3))); }
constexpr float kC2 = 0.08838834764831845f * 1.4426950408889634f;
constexpr float kDoneThresh = 140.f;

__device__ __forceinline__ void attn_phase(LAS unsigned char* lds, const bf16_t* __restrict__ proj, const float* __restrict__ qw, const float* __restrict__ kw,
                                           bf16_t* __restrict__ cat, int G, int c) {
    const int tid = threadIdx.x, wid = __builtin_amdgcn_readfirstlane(tid >> 6), lane = tid & 63, ql = lane & 31, hf = lane >> 5;
    const unsigned ldsb = (unsigned)(uintptr_t)lds;
    const int skey = tid >> 4, sch = tid & 15;
    const unsigned X = ((ql & 3) << 2) | ((ql >> 2) & 3);
    const unsigned krow = 256u * ql, kY = 16u * (X ^ (unsigned)hf);
    const int tq = (lane & 15) >> 2, tp = lane & 3, blk = (lane >> 4) & 1;
    unsigned va[4][2];
#pragma unroll
    for (int cc = 0; cc < 4; ++cc)
#pragma unroll
        for (int t = 0; t < 2; ++t) va[cc][t] = 256u * (8 * t + 4 * hf + tq) + 16u * ((4 * cc + 2 * blk + (tp >> 1)) ^ ((tq << 2) | ((2 * t + hf) & 3))) + 8u * (tp & 1);
    for (int unit = c; unit < kB * kNH * 8; unit += G) {
        const int qb = unit & 7, bh = unit >> 3, h = bh & 7, b = bh >> 3;
        const int q0 = qb * 256, r0 = q0 + wid * 32;
        const bf16_t* base = proj + (size_t)(b * kS) * kNPROJ + h * kHD;
        LAS unsigned char* qlds = lds + 65536 + wid * 8192 + lane * 16;
        { u32x4 qr[8]; float ss = 0.f;
#pragma unroll
          for (int s = 0; s < 8; ++s) { qr[s] = *(const u32x4*)(base + (size_t)(r0 + ql) * kNPROJ + 16 * s + 8 * hf);
              const unsigned u[4] = {qr[s].x, qr[s].y, qr[s].z, qr[s].w};
#pragma unroll
              for (int e = 0; e < 4; ++e) { const float a = bflo(u[e]), bb = bfhi(u[e]); ss += a * a + bb * bb; } }
          ss += __shfl_xor(ss, 32);
          const float rq = rsqrtf(ss * (1.f / kHD) + kEPS) * kC2;
#pragma unroll
          for (int s = 0; s < 8; ++s) { const int d0 = 16 * s + 8 * hf;
              const f32x4 w0 = *(const f32x4*)(qw + d0) * *(const f32x4*)(kw + d0), w1 = *(const f32x4*)(qw + d0 + 4) * *(const f32x4*)(kw + d0 + 4);
              const unsigned u[4] = {qr[s].x, qr[s].y, qr[s].z, qr[s].w};
              u32x4 pk; pk.x = pk_bf16(bflo(u[0]) * rq * w0[0], bfhi(u[0]) * rq * w0[1]); pk.y = pk_bf16(bflo(u[1]) * rq * w0[2], bfhi(u[1]) * rq * w0[3]);
              pk.z = pk_bf16(bflo(u[2]) * rq * w1[0], bfhi(u[2]) * rq * w1[1]); pk.w = pk_bf16(bflo(u[3]) * rq * w1[2], bfhi(u[3]) * rq * w1[3]);
              *(LAS u32x4*)(qlds + 1024 * s) = pk; } }
        f32x16 o[4];
#pragma unroll
        for (int cc = 0; cc < 4; ++cc)
#pragma unroll
            for (int r = 0; r < 16; ++r) o[cc][r] = 0.f;
        float carry = 0.f; bool wactive = true;
        int jt = (q0 + 255) >> 6, cur = 0;
        u32x4 kr[2], vr[2];
#define AT_LOAD(jt_) do { _Pragma("unroll") for (int i = 0; i < 2; ++i) { const bf16_t* rp = base + (size_t)(64 * (jt_) + skey + 32 * i) * kNPROJ + sch * 8; \
            kr[i] = *(const u32x4*)(rp + kSB); vr[i] = *(const u32x4*)(rp + 2 * kSB); } } while (0)
        AT_LOAD(jt);
        for (;;) {
            LAS unsigned char* kbuf = lds + cur * 32768; LAS unsigned char* vbuf = kbuf + 16384;
#pragma unroll
            for (int i = 0; i < 2; ++i) { const unsigned u[4] = {kr[i].x, kr[i].y, kr[i].z, kr[i].w}; float f[8]; float ss = 0.f;
#pragma unroll
                for (int e = 0; e < 4; ++e) { f[2 * e] = bflo(u[e]); f[2 * e + 1] = bfhi(u[e]); ss += f[2 * e] * f[2 * e] + f[2 * e + 1] * f[2 * e + 1]; }
                ss += __shfl_xor(ss, 1); ss += __shfl_xor(ss, 2); ss += __shfl_xor(ss, 4); ss += __shfl_xor(ss, 8);
                const float rk = rsqrtf(ss * (1.f / kHD) + kEPS);
                u32x4 pk; pk.x = pk_bf16(f[0] * rk, f[1] * rk); pk.y = pk_bf16(f[2] * rk, f[3] * rk); pk.z = pk_bf16(f[4] * rk, f[5] * rk); pk.w = pk_bf16(f[6] * rk, f[7] * rk);
                const unsigned a = off_b(skey + 32 * i, sch);
                *(LAS u32x4*)(kbuf + a) = pk; *(LAS u32x4*)(vbuf + a) = vr[i]; }
            const int any = __syncthreads_or(wactive ? 1 : 0);
            if (!any) break;
            const int jtc = jt;
            if (jt > 0) AT_LOAD(jt - 1);
            if (wactive && 64 * jtc < r0 + 31) {
                f32x16 s0, s1;
#pragma unroll
                for (int r = 0; r < 16; ++r) { s0[r] = 0.f; s1[r] = 0.f; }
#pragma unroll
                for (int s = 0; s < 8; ++s) { const unsigned a = krow + ((32u * s) ^ kY);
                    const bf16x8 k0 = *(const LAS bf16x8*)(kbuf + a), k1 = *(const LAS bf16x8*)(kbuf + 8192 + a), qv = *(const LAS bf16x8*)(qlds + 1024 * s);
                    s0 = __builtin_amdgcn_mfma_f32_32x32x16_bf16(k0, qv, s0, 0, 0, 0); s1 = __builtin_amdgcn_mfma_f32_32x32x16_bf16(k1, qv, s1, 0, 0, 0); }
                const int tabs = r0 + ql, kbase0 = 64 * jtc + 4 * hf;
                float run = carry; u32x4 pfr[2][2];
#pragma unroll
                for (int kb = 1; kb >= 0; --kb) {
                    float sp[16], gp[4], T[4];
#pragma unroll
                    for (int r = 0; r < 16; ++r) { const float z = kb ? s1[r] : s0[r]; const int key = kbase0 + 32 * kb + 8 * (r >> 2) + (r & 3);
                        const float v = __builtin_amdgcn_logf(1.f + __builtin_amdgcn_exp2f(z)); sp[r] = key < tabs ? v : 0.f; }
#pragma unroll
                    for (int g = 0; g < 4; ++g) { const float gsum = (sp[4 * g] + sp[4 * g + 1]) + (sp[4 * g + 2] + sp[4 * g + 3]);
                        const auto sw = __builtin_amdgcn_permlane32_swap(__float_as_uint(gsum), __float_as_uint(gsum), false, false);
                        const float lo = __uint_as_float(sw[0]), hi = __uint_as_float(sw[1]);
                        T[g] = lo + hi; gp[g] = hf ? 0.f : hi; }
#pragma unroll
                    for (int g = 3; g >= 0; --g) { const float offs = run + gp[g];
                        const float c3 = offs + sp[4 * g + 3], c2 = c3 + sp[4 * g + 2], c1 = c2 + sp[4 * g + 1], c0 = c1 + sp[4 * g];
                        const float cs[4] = {c0, c1, c2, c3};
#pragma unroll
                        for (int i = 0; i < 4; ++i) { const int r = 4 * g + i; const float z = kb ? s1[r] : s0[r]; const int key = kbase0 + 32 * kb + 8 * g + i;
                            const float e = __builtin_amdgcn_exp2f(z - cs[i]); sp[r] = key < tabs ? e : 0.f; }
                        run += T[g]; }
#pragma unroll
                    for (int s2 = 0; s2 < 2; ++s2) { u32x4 pk; pk.x = pk_bf16(sp[8 * s2], sp[8 * s2 + 1]); pk.y = pk_bf16(sp[8 * s2 + 2], sp[8 * s2 + 3]);
                        pk.z = pk_bf16(sp[8 * s2 + 4], sp[8 * s2 + 5]); pk.w = pk_bf16(sp[8 * s2 + 6], sp[8 * s2 + 7]); pfr[kb][s2] = pk; }
                }
                carry = run;
                const unsigned vb0 = ldsb + (unsigned)cur * 32768u + 16384u;
#define AT_PV(cc) do { const unsigned a0 = vb0 + va[cc][0], a1 = vb0 + va[cc][1]; \
                    const s16x4 l00 = fg::tr_read<0>(a0), h00 = fg::tr_read<0>(a1), l01 = fg::tr_read<4096>(a0), h01 = fg::tr_read<4096>(a1); \
                    const s16x4 l10 = fg::tr_read<8192>(a0), h10 = fg::tr_read<8192>(a1), l11 = fg::tr_read<12288>(a0), h11 = fg::tr_read<12288>(a1); \
                    asm volatile("s_waitcnt lgkmcnt(0)" ::: "memory"); __builtin_amdgcn_sched_barrier(0); \
                    o[cc] = __builtin_amdgcn_mfma_f32_32x32x16_bf16(FG_PK(l00, h00), __builtin_bit_cast(bf16x8, pfr[0][0]), o[cc], 0, 0, 0); \
                    o[cc] = __builtin_amdgcn_mfma_f32_32x32x16_bf16(FG_PK(l01, h01), __builtin_bit_cast(bf16x8, pfr[0][1]), o[cc], 0, 0, 0); \
                    o[cc] = __builtin_amdgcn_mfma_f32_32x32x16_bf16(FG_PK(l10, h10), __builtin_bit_cast(bf16x8, pfr[1][0]), o[cc], 0, 0, 0); \
                    o[cc] = __builtin_amdgcn_mfma_f32_32x32x16_bf16(FG_PK(l11, h11), __builtin_bit_cast(bf16x8, pfr[1][1]), o[cc], 0, 0, 0); } while (0)
                AT_PV(0); AT_PV(1); AT_PV(2); AT_PV(3);
#undef AT_PV
                wactive = __any(carry <= kDoneThresh);
            }
            if (jt == 0) break;
            --jt; cur ^= 1;
        }
#undef AT_LOAD
        bf16_t* orow = cat + (size_t)(b * kS + r0 + ql) * kD + h * kHD + 4 * hf;
#pragma unroll
        for (int cc = 0; cc < 4; ++cc)
#pragma unroll
            for (int g = 0; g < 4; ++g) { u32x2 w; w.x = pk_bf16(o[cc][4 * g], o[cc][4 * g + 1]); w.y = pk_bf16(o[cc][4 * g + 2], o[cc][4 * g + 3]); *(u32x2*)(orow + 32 * cc + 8 * g) = w; }
        __syncthreads();
    }
}
}

__device__ __forceinline__ void pool_p_phase(const bf16_t* __restrict__ proj, bf16_t* __restrict__ p, int G, int c) {
    for (int idx = c * 512 + threadIdx.x; idx < kT * (kPW / 8); idx += G * 512) {
        const int c8 = idx & 127, t = idx >> 7, s = t & (kS - 1), g = c8 >> 5, w = 2 << g, cnt = min(s + 1, w);
        const bf16_t* up = proj + (size_t)t * kNPROJ + 3 * kSB + c8 * 8;
        float acc[8], u0[8];
#pragma unroll
        for (int e = 0; e < 8; ++e) acc[e] = 0.f;
        for (int i = 0; i < cnt; ++i) { const uint4 v = *(const uint4*)(up - (size_t)i * kNPROJ); const unsigned u[4] = {v.x, v.y, v.z, v.w};
#pragma unroll
            for (int e = 0; e < 4; ++e) { const float a = bflo(u[e]), bb = bfhi(u[e]); acc[2 * e] += a; acc[2 * e + 1] += bb; if (i == 0) { u0[2 * e] = a; u0[2 * e + 1] = bb; } } }
        const float inv = 1.f / (float)cnt;
        u32x4 pk; pk.x = pk_bf16(acc[0] * inv - u0[0], acc[1] * inv - u0[1]); pk.y = pk_bf16(acc[2] * inv - u0[2], acc[3] * inv - u0[3]);
        pk.z = pk_bf16(acc[4] * inv - u0[4], acc[5] * inv - u0[5]); pk.w = pk_bf16(acc[6] * inv - u0[6], acc[7] * inv - u0[7]);
        *(u32x4*)(p + (size_t)t * kPW + c8 * 8) = pk;
    }
}


__device__ __forceinline__ unsigned pk4_fp8(float a, float b, float c, float d) { int p = __builtin_amdgcn_cvt_pk_fp8_f32(a, b, 0, false); p = __builtin_amdgcn_cvt_pk_fp8_f32(c, d, p, true); return (unsigned)p; }
__device__ __forceinline__ float clamp448(float v) { return __builtin_amdgcn_fmed3f(v, -448.f, 448.f); }
constexpr float kWScale = 64.f;

struct JobMoe1F8 {
    static constexpr bool GATHER = true;
    const char* A; unsigned lda2, ldb2, bhalf2; int K; const int* list;
    const char* B; const float* b_in; unsigned char* act; MoeTab M; int G, c;
    __device__ __forceinline__ bool next(int i, fg::Unit& u) const { int e, j, rb, cnt, rowbase; if (!M.decode(i, G, c, e, j, rb, cnt, rowbase)) return false;
        e = __builtin_amdgcn_readfirstlane(e); j = __builtin_amdgcn_readfirstlane(j); rb = __builtin_amdgcn_readfirstlane(rb); cnt = __builtin_amdgcn_readfirstlane(cnt); rowbase = __builtin_amdgcn_readfirstlane(rowbase);
        u.bBase = B + (size_t)e * ((size_t)2 * kDFF * kD) + (size_t)j * 128 * kD; u.arow0 = e * kT + rb * 256; u.nvalid = min(256, cnt - rb * 256); u.e = e; u.orow0 = rowbase + rb * 256; u.ocol0 = j * 128; u.acol2 = 0; return true; }
    __device__ __forceinline__ void epi(const f32x4 (&acc)[2][2][4][2], const fg::Unit& u, int wr, int wc, int fr, int fq) const {
        f32x4 bg[2], bl[2];
#pragma unroll
        for (int n = 0; n < 2; ++n) { const float* bp = b_in + (size_t)u.e * 2 * kDFF + u.ocol0 + wc * 32 + n * 16 + fq * 4; bg[n] = *(const f32x4*)bp; bl[n] = *(const f32x4*)(bp + kDFF); }
#pragma unroll
        FG_FOR_ROWS { unsigned char* rowp = act + (size_t)(u.orow0 + ai * 128 + wr * 64 + m * 16 + fr) * kDFF + u.ocol0 + wc * 32 + fq * 4;
#pragma unroll
            for (int n = 0; n < 2; ++n) { const f32x4 gv = acc[ai][0][m][n] + bg[n], lv = acc[ai][1][m][n] + bl[n]; float o[4];
#pragma unroll
                for (int j = 0; j < 4; ++j) { const float g = fminf(gv[j], 7.f), l = fminf(fmaxf(lv[j], -7.f), 7.f); o[j] = clamp448(g * __builtin_amdgcn_rcpf(1.f + __expf(-1.702f * g)) * (l + 1.f)); }
                *(unsigned*)(rowp + n * 16) = pk4_fp8(o[0], o[1], o[2], o[3]); } }
    }
};
struct JobMoe2F8 {
    static constexpr bool GATHER = false;
    const char* A; unsigned lda2, ldb2, bhalf2; int K; const int* list;
    const char* B; const float* b_out; bf16_t* yp; MoeTab M; int G, c;
    __device__ __forceinline__ bool next(int i, fg::Unit& u) const { int e, j, rb, cnt, rowbase; if (!M.decode(i, G, c, e, j, rb, cnt, rowbase)) return false;
        e = __builtin_amdgcn_readfirstlane(e); j = __builtin_amdgcn_readfirstlane(j); rb = __builtin_amdgcn_readfirstlane(rb); rowbase = __builtin_amdgcn_readfirstlane(rowbase);
        u.bBase = B + (size_t)e * ((size_t)kDFF * kD) + (size_t)j * 256 * kDFF; u.arow0 = rowbase + rb * 256; u.nvalid = 256; u.e = e; u.orow0 = rowbase + rb * 256; u.ocol0 = j * 256; u.acol2 = 0; return true; }
    __device__ __forceinline__ void epi(const f32x4 (&acc)[2][2][4][2], const fg::Unit& u, int wr, int wc, int fr, int fq) const {
        f32x4 bo[2][2];
#pragma unroll
        for (int bj = 0; bj < 2; ++bj)
#pragma unroll
            for (int n = 0; n < 2; ++n) bo[bj][n] = *(const f32x4*)(b_out + (size_t)u.e * kD + u.ocol0 + bj * 128 + wc * 32 + n * 16 + fq * 4);
#pragma unroll
        FG_FOR_ROWS { bf16_t* rowp = yp + (size_t)(u.orow0 + ai * 128 + wr * 64 + m * 16 + fr) * kD + u.ocol0 + wc * 32 + fq * 4;
#pragma unroll
            for (int bj = 0; bj < 2; ++bj)
#pragma unroll
                for (int n = 0; n < 2; ++n) { const f32x4 v = acc[ai][bj][m][n] + bo[bj][n]; u32x2 w; w.x = pk_bf16(v[0], v[1]); w.y = pk_bf16(v[2], v[3]); *(u32x2*)(rowp + bj * 128 + n * 16) = w; } }
    }
};

struct CvtT { const float* src; unsigned char* dst; int K, N, tn, per; };
__device__ __forceinline__ CvtT cvt_make(const float* src, unsigned char* dst, int K, int N) { CvtT c; c.src = src; c.dst = dst; c.K = K; c.N = N; c.tn = N / 64; c.per = (K / 128) * (N / 64); return c; }
__device__ __forceinline__ void cvt_load(const CvtT& C, int t, int kq, int nc, f32x4 (&v)[4]) {
    const int mat = t / C.per, r = t - mat * C.per, kt = r / C.tn, nt_ = r - kt * C.tn;
    const float* sp = C.src + (size_t)mat * C.K * C.N + (size_t)(kt * 128 + 4 * kq) * C.N + nt_ * 64 + 4 * nc;
#pragma unroll
    for (int i = 0; i < 4; ++i) v[i] = __builtin_nontemporal_load((const f32x4*)(sp + (size_t)i * C.N));
}
__device__ __forceinline__ void cvt_emit(const CvtT& C, int t, LAS unsigned* L, const f32x4 (&v)[4], int kq, int nc, int rn, int rc) {
#pragma unroll
    for (int j = 0; j < 4; ++j) L[(4 * nc + j) * 33 + kq] = pk4_fp8(v[0][j] * kWScale, v[1][j] * kWScale, v[2][j] * kWScale, v[3][j] * kWScale);
    __syncthreads();
    const int mat = t / C.per, r = t - mat * C.per, kt = r / C.tn, nt_ = r - kt * C.tn;
    u32x4 o; o.x = L[rn * 33 + 4 * rc]; o.y = L[rn * 33 + 4 * rc + 1]; o.z = L[rn * 33 + 4 * rc + 2]; o.w = L[rn * 33 + 4 * rc + 3];
    __builtin_nontemporal_store(o, (u32x4*)(C.dst + (size_t)mat * C.K * C.N + (size_t)(nt_ * 64 + rn) * C.K + kt * 128 + rc * 16));
}
__device__ __forceinline__ void convert_t_f8(LAS unsigned char* lds, const CvtT C, int t0, int t1, int stride) {
    const int tid = threadIdx.x, kq = tid >> 4, nc = tid & 15, rn = tid >> 3, rc = tid & 7;
    LAS unsigned* L0 = (LAS unsigned*)lds; LAS unsigned* L1 = L0 + 64 * 33 + 16;
    f32x4 va[4], vb[4], vc[4];
    int t = t0;
    __syncthreads();
    if (t < t1) cvt_load(C, t, kq, nc, va);
    if (t + stride < t1) cvt_load(C, t + stride, kq, nc, vb);
    for (; t < t1; t += 3 * stride) {
        if (t + 2 * stride < t1) cvt_load(C, t + 2 * stride, kq, nc, vc);
        cvt_emit(C, t, L0, va, kq, nc, rn, rc);
        if (t + stride >= t1) break;
        if (t + 3 * stride < t1) cvt_load(C, t + 3 * stride, kq, nc, va);
        cvt_emit(C, t + stride, L1, vb, kq, nc, rn, rc);
        if (t + 2 * stride >= t1) break;
        if (t + 4 * stride < t1) cvt_load(C, t + 4 * stride, kq, nc, vb);
        cvt_emit(C, t + 2 * stride, L0, vc, kq, nc, rn, rc);
        if (t + 3 * stride < t1) { __syncthreads(); }
    }
    __syncthreads();
}

__device__ __forceinline__ void convert_seg(const float* __restrict__ src, bf16_t* __restrict__ dst, size_t n8, size_t gtid, size_t gstride) {
    const f32x4* s4 = (const f32x4*)src; u32x4* d4 = (u32x4*)dst;
#pragma unroll 4
    for (size_t i = gtid; i < n8; i += gstride) { const f32x4 a = __builtin_nontemporal_load(s4 + 2 * i), b = __builtin_nontemporal_load(s4 + 2 * i + 1);
        u32x4 w; w.x = pk_bf16(a[0], a[1]); w.y = pk_bf16(a[2], a[3]); w.z = pk_bf16(b[0], b[1]); w.w = pk_bf16(b[2], b[3]); d4[i] = w; }
}


#define XB_TMO      128
#define XB_XCNT(j)  (256  + 64 * (j))
#define XB_XSUB(j)  (1280 + 64 * (j))
#define XB_XGEN(j)  (2304 + 64 * (j))
#define XB_TOP      3328
#define XB_TOPGEN   3392
#define XCD_BAR_WORDS 3456
#define XB_SPIN_CAP (1u << 18)
__device__ __forceinline__ unsigned xb_ld(unsigned* p)              { return __hip_atomic_load(p, __ATOMIC_RELAXED, __HIP_MEMORY_SCOPE_AGENT); }
__device__ __forceinline__ unsigned xb_add(unsigned* p, unsigned v) { return __hip_atomic_fetch_add(p, v, __ATOMIC_RELAXED, __HIP_MEMORY_SCOPE_AGENT); }
__device__ __forceinline__ unsigned xb_xcc_id() { return (unsigned)__builtin_amdgcn_s_getreg((3 << 11) | 20) & 0xFu; }
#define XB_SPIN(cond, bar) do { unsigned _sp = 0; while (cond) { __builtin_amdgcn_s_sleep(1); \
    if ((++_sp & 255u) == 0u) { if (xb_ld(&(bar)[XB_TMO])) break; if (_sp > XB_SPIN_CAP) { atomicAdd(&(bar)[XB_TMO], 1u); break; } } } } while (0)
struct XcdBarrier { unsigned* bar; unsigned x; volatile LAS unsigned* st; };
__device__ __forceinline__ XcdBarrier xcd_barrier_post(unsigned* bar, volatile LAS unsigned* st) {
    XcdBarrier b; b.bar = bar; b.x = xb_xcc_id(); b.st = st;
    if (threadIdx.x == 0) (void)xb_add(&bar[XB_XCNT(b.x)], 1u);
    return b;
}
__device__ __forceinline__ void xcd_barrier_complete(unsigned* bar, unsigned x, unsigned& nloc, unsigned& nx) {
    const unsigned G = gridDim.x * gridDim.y * gridDim.z;
    unsigned sum, cnt, mine, sp = 0u;
    for (;;) {
        sum = 0u; cnt = 0u; mine = 0u;
#pragma unroll
        for (unsigned j = 0; j < 16; ++j) { const unsigned c = xb_ld(&bar[XB_XCNT(j)]); sum += c; cnt += (c > 0u) ? 1u : 0u; mine = (j == x) ? c : mine; }
        if (sum == G) break;
        __builtin_amdgcn_s_sleep(1);
        if ((++sp & 255u) == 0u) { if (xb_ld(&bar[XB_TMO])) break; if (sp > XB_SPIN_CAP) { atomicAdd(&bar[XB_TMO], 1u); break; } }
    }
    nloc = mine > 0u ? mine : 1u; nx = cnt > 0u ? cnt : 1u;
}
__device__ __forceinline__ void xcd_barrier(const XcdBarrier& b) {
    asm volatile("s_waitcnt vmcnt(0)" ::: "memory");
    __syncthreads();
    if (threadIdx.x == 0) {
        unsigned* bar = b.bar;
        __builtin_amdgcn_s_waitcnt(0);
        unsigned nloc = b.st[0], nx = b.st[1];
        if (nloc == 0u) { xcd_barrier_complete(bar, b.x, nloc, nx); b.st[0] = nloc; b.st[1] = nx; }
        const unsigned old = xb_add(&bar[XB_XSUB(b.x)], 1u);
        const unsigned gen = old / nloc;
        if (old + 1u == (gen + 1u) * nloc) {
            __builtin_amdgcn_fence(__ATOMIC_RELEASE, "agent");
            asm volatile("s_waitcnt vmcnt(0)" ::: "memory");
            const unsigned og = xb_add(&bar[XB_TOP], 1u);
            const unsigned tg = og / nx;
            if (og + 1u == (tg + 1u) * nx) xb_add(&bar[XB_TOPGEN], 1u);
            else XB_SPIN(xb_ld(&bar[XB_TOPGEN]) == tg, bar);
            __builtin_amdgcn_fence(__ATOMIC_ACQUIRE, "agent");
            xb_add(&bar[XB_XGEN(b.x)], 1u);
            asm volatile("s_waitcnt vmcnt(0)" ::: "memory");
        } else {
            XB_SPIN(xb_ld(&bar[XB_XGEN(b.x)]) == gen, bar);
            __builtin_amdgcn_fence(__ATOMIC_ACQUIRE, "agent");
            asm volatile("s_waitcnt vmcnt(0)" ::: "memory");
        }
    }
    __syncthreads();
}

__device__ __forceinline__ void ada_phase(LAS unsigned char* lds, const float* __restrict__ cvec, const float* __restrict__ w_ada, const float* __restrict__ b_ada, float* __restrict__ mod, int G, int c) {
    LAS float* ca = (LAS float*)lds;
    LAS float* part = (LAS float*)(lds + 32768);
    const int tid = threadIdx.x;
    __syncthreads();
    for (int i = tid; i < kB * kD; i += 512) { const float v = cvec[i]; ca[i] = v / (1.f + __expf(-v)); }
    __syncthreads();
    for (int cb = c; cb < 6 * kD / 48; cb += G) {
        const int n0 = cb * 48, cg = tid % 12, kr = tid / 12;
        if (tid < 504) {
            f32x4 a0 = {0.f, 0.f, 0.f, 0.f}, a1 = a0, a2 = a0, a3 = a0;
#pragma unroll 8
            for (int k = kr; k < kD; k += 42) { const f32x4 w = __builtin_nontemporal_load((const f32x4*)(w_ada + (size_t)k * (6 * kD) + n0 + cg * 4));
                a0 += ca[k] * w; a1 += ca[kD + k] * w; a2 += ca[2 * kD + k] * w; a3 += ca[3 * kD + k] * w; }
            LAS f32x4* pp = (LAS f32x4*)(part + (kr * 12 + cg) * 16); pp[0] = a0; pp[1] = a1; pp[2] = a2; pp[3] = a3;
        }
        __syncthreads();
        if (tid < 192) { const int col = tid % 48, b = tid / 48; float sum = 0.f;
            for (int r = 0; r < 42; ++r) sum += part[(r * 12 + (col >> 2)) * 16 + b * 4 + (col & 3)];
            mod[b * 6 * kD + n0 + col] = sum + b_ada[n0 + col]; }
        __syncthreads();
    }
}

__device__ __forceinline__ void norm1_phase(const float* __restrict__ x, const float* __restrict__ nw, const float* __restrict__ mod, bf16_t* __restrict__ out, int G, int c) {
    const int wid = threadIdx.x >> 6, lane = threadIdx.x & 63;
    for (int t = c * 8 + wid; t < kT; t += G * 8) {
        const int b = t / kS; const float* xr = x + (size_t)t * kD + lane * 4; const float* mb = mod + b * 6 * kD + lane * 4;
        f32x4 v[8]; float ss = 0.f;
#pragma unroll
        for (int j = 0; j < 8; ++j) { v[j] = *(const f32x4*)(xr + 256 * j); ss += v[j][0] * v[j][0] + v[j][1] * v[j][1] + v[j][2] * v[j][2] + v[j][3] * v[j][3]; }
        ss = wave_sum(ss);
        const float r = rsqrtf(ss * (1.f / kD) + kEPS);
#pragma unroll
        for (int j = 0; j < 8; ++j) { const f32x4 w = *(const f32x4*)(nw + lane * 4 + 256 * j), sh = *(const f32x4*)(mb + 256 * j), sc = *(const f32x4*)(mb + kD + 256 * j);
            const f32x4 y = v[j] * r * w * (1.f + sc) + sh; u32x2 o; o.x = pk_bf16(y[0], y[1]); o.y = pk_bf16(y[2], y[3]);
            *(u32x2*)(out + (size_t)t * kD + lane * 4 + 256 * j) = o; }
    }
}

constexpr int RT_STRIDE = 144;
__device__ __forceinline__ void norm2_router_phase(LAS unsigned char* lds, const float* __restrict__ x1, const float* __restrict__ nw, const float* __restrict__ mod,
                                                   const float* __restrict__ w_router, const float* __restrict__ b_router, unsigned char* __restrict__ h2,
                                                   float* __restrict__ gates, int* __restrict__ pair_e, int* __restrict__ pair_p, int* __restrict__ list, unsigned* __restrict__ ctrl, int G, int c) {
    const int tid = threadIdx.x, wid = tid >> 6, lane = tid & 63;
    for (int blk = c; blk < kT / 32; blk += G) {
#pragma unroll 1
        for (int pass = 0; pass < 2; ++pass) {
            const int t0 = blk * 32 + wid * 4 + pass * 2, b = t0 / kS;
            float rs[2];
#pragma unroll
            for (int rr = 0; rr < 2; ++rr) { const float* xr = x1 + (size_t)(t0 + rr) * kD + 2 * lane; float ss = 0.f;
#pragma unroll
                for (int i = 0; i < 16; ++i) { const f32x2 v = *(const f32x2*)(xr + 128 * i); ss += v[0] * v[0] + v[1] * v[1]; }
                ss = wave_sum(ss); rs[rr] = rsqrtf(ss * (1.f / kD) + kEPS); }
            f32x4 acc[2][8];
#pragma unroll
            for (int rr = 0; rr < 2; ++rr)
#pragma unroll
                for (int q = 0; q < 8; ++q) acc[rr][q] = (f32x4){0.f, 0.f, 0.f, 0.f};
#pragma unroll 1
            for (int q = 0; q < 4; ++q) {
                __syncthreads();
#pragma unroll
                for (int j = 0; j < 8; ++j) { const int idx = tid + 512 * j, row = idx >> 3, ch = idx & 7;
                    *(LAS f32x4*)(lds + row * RT_STRIDE + ch * 16) = *(const f32x4*)(w_router + (size_t)(512 * q + row) * kE + ch * 4); }
                f32x2 yq[2][4];
#pragma unroll
                for (int ii = 0; ii < 4; ++ii) { const int n = 2 * lane + 128 * (4 * q + ii);
                    const f32x2 w = *(const f32x2*)(nw + n), sh = *(const f32x2*)(mod + b * 6 * kD + 3 * kD + n), sc = *(const f32x2*)(mod + b * 6 * kD + 4 * kD + n);
#pragma unroll
                    for (int rr = 0; rr < 2; ++rr) { const f32x2 v = *(const f32x2*)(x1 + (size_t)(t0 + rr) * kD + n); yq[rr][ii] = v * rs[rr] * w * (1.f + sc) + sh;
                        *(unsigned short*)(h2 + (size_t)(t0 + rr) * kD + n) = (unsigned short)__builtin_amdgcn_cvt_pk_fp8_f32(clamp448(yq[rr][ii][0]), clamp448(yq[rr][ii][1]), 0, false); } }
                __syncthreads();
#pragma unroll
                for (int ii = 0; ii < 4; ++ii)
#pragma unroll
                    for (int e = 0; e < 2; ++e) { const LAS unsigned char* wp = lds + (2 * lane + 128 * ii + e) * RT_STRIDE;
#pragma unroll
                        for (int ch = 0; ch < 8; ++ch) { const f32x4 wv = *(const LAS f32x4*)(wp + ch * 16);
                            acc[0][ch] += yq[0][ii][e] * wv; acc[1][ch] += yq[1][ii][e] * wv; } }
            }
#pragma unroll
            for (int rr = 0; rr < 2; ++rr) {
                float v16[16], v8[8], v4[4], v2[2], v1;
                { const bool up = lane & 32;
#pragma unroll
                  for (int j = 0; j < 16; ++j) { const float lo = acc[rr][j >> 2][j & 3], hi = acc[rr][4 + (j >> 2)][j & 3]; const float send = up ? lo : hi, keep = up ? hi : lo; v16[j] = keep + __shfl_xor(send, 32); } }
                { const bool up = lane & 16;
#pragma unroll
                  for (int j = 0; j < 8; ++j) { const float send = up ? v16[j] : v16[j + 8], keep = up ? v16[j + 8] : v16[j]; v8[j] = keep + __shfl_xor(send, 16); } }
                { const bool up = lane & 8;
#pragma unroll
                  for (int j = 0; j < 4; ++j) { const float send = up ? v8[j] : v8[j + 4], keep = up ? v8[j + 4] : v8[j]; v4[j] = keep + __shfl_xor(send, 8); } }
                { const bool up = lane & 4;
#pragma unroll
                  for (int j = 0; j < 2; ++j) { const float send = up ? v4[j] : v4[j + 2], keep = up ? v4[j + 2] : v4[j]; v2[j] = keep + __shfl_xor(send, 4); } }
                { const bool up = lane & 2; const float send = up ? v2[0] : v2[1], keep = up ? v2[1] : v2[0]; v1 = keep + __shfl_xor(send, 2); }
                v1 += __shfl_xor(v1, 1);
                const int e_mine = (lane >> 1) & 31;
                float mine = (lane & 1) ? -3.4e38f : v1 + b_router[e_mine];
                int idx[4]; float val[4];
#pragma unroll
                for (int k = 0; k < 4; ++k) { float bv = mine; int bi = e_mine + ((lane & 1) << 6);
#pragma unroll
                    for (int o = 32; o > 0; o >>= 1) { const float ov = __shfl_xor(bv, o); const int oi = __shfl_xor(bi, o); if (ov > bv || (ov == bv && oi < bi)) { bv = ov; bi = oi; } }
                    idx[k] = bi; val[k] = bv; if (!(lane & 1) && e_mine == bi) mine = -3.4e38f; }
                if (lane == 0) { const int t = t0 + rr; float ex[4], sum = 0.f;
#pragma unroll
                    for (int k = 0; k < 4; ++k) { ex[k] = __expf(val[k] - val[0]); sum += ex[k]; }
                    const float inv = 1.f / sum;
#pragma unroll
                    for (int k = 0; k < 4; ++k) { gates[t * 4 + k] = ex[k] * inv; pair_e[t * 4 + k] = idx[k];
                        const unsigned pos = atomicAdd(&ctrl[CT_CNT + idx[k]], 1u); pair_p[t * 4 + k] = (int)pos; list[(size_t)idx[k] * kT + pos] = t; } }
            }
        }
    }
}

__device__ __forceinline__ void final_phase(const float* __restrict__ x1, const float* __restrict__ mod, const float* __restrict__ gates, const int* __restrict__ pair_e, const int* __restrict__ pair_p,
                                            const MoeTab M, const bf16_t* __restrict__ yp, float* __restrict__ out, int G, int c) {
    const int wid = threadIdx.x >> 6, lane = threadIdx.x & 63;
    for (int t = c * 8 + wid; t < kT; t += G * 8) {
        const int b = t / kS; float gk[4]; const bf16_t* rp[4];
#pragma unroll
        for (int k = 0; k < 4; ++k) { gk[k] = gates[t * 4 + k]; const int e = pair_e[t * 4 + k];
            rp[k] = yp + (size_t)(M.t[32 + e] + pair_p[t * 4 + k]) * kD + lane * 8; }
#pragma unroll
        for (int j = 0; j < 4; ++j) { f32x4 y0 = {0.f, 0.f, 0.f, 0.f}, y1 = y0;
#pragma unroll
            for (int k = 0; k < 4; ++k) { const u32x4 v = *(const u32x4*)(rp[k] + 512 * j);
                y0 += gk[k] * (f32x4){bflo(v.x), bfhi(v.x), bflo(v.y), bfhi(v.y)}; y1 += gk[k] * (f32x4){bflo(v.z), bfhi(v.z), bflo(v.w), bfhi(v.w)}; }
            const size_t o = (size_t)t * kD + lane * 8 + 512 * j; const float* gp = mod + b * 6 * kD + 5 * kD + lane * 8 + 512 * j;
            *(f32x4*)(out + o) = *(const f32x4*)(x1 + o) + *(const f32x4*)gp * y0; *(f32x4*)(out + o + 4) = *(const f32x4*)(x1 + o + 4) + *(const f32x4*)(gp + 4) * y1; }
    }
}

struct MegaArgs { const float* in[18]; float* out; unsigned char* ws; int ph_lo, ph_hi; };
constexpr int NPHASE = 10;
__global__ void __launch_bounds__(512, 2) mega(MegaArgs a) {
    extern __shared__ __attribute__((aligned(16))) unsigned char lds_raw[];
    LAS unsigned char* lds = (LAS unsigned char*)lds_raw;
    unsigned char* ws = a.ws;
    const int lo = a.ph_lo, hi = a.ph_hi;
#ifndef DUP_PHASE
#define DUP_PHASE -1
#endif
#define IN(k) (lo <= (k) && (k) < hi)
#define REP(k)
#define DUPQ(k) ((k) == DUP_PHASE)
#define SEAM(k) do { if (IN(k) && IN((k) + 1)) xcd_barrier(bar); } while (0)
    const int G = gridDim.x, c = blockIdx.x;
    unsigned* ctrl = (unsigned*)(ws + WS_CTRL);
    const int grp = (c >> 3) & 1;
    const CvtT C1 = cvt_make(a.in[14], (unsigned char*)(ws + WS_WE1), kD, 2 * kDFF);
    const CvtT C2 = cvt_make(a.in[16], (unsigned char*)(ws + WS_WE2), kDFF, kD);
    const int c1_a = 64 * G, c1_b = 88 * G;
    if (threadIdx.x == 0) *(LAS u32x4*)(lds + fg::MISC_OFF) = (u32x4){0u, 0u, 0u, 0u};
    __syncthreads();
    XcdBarrier bar; bar.bar = ctrl; bar.x = 0; bar.st = (volatile LAS unsigned*)(lds + fg::MISC_OFF);
    if (hi - lo > 1) bar = xcd_barrier_post(ctrl, (volatile LAS unsigned*)(lds + fg::MISC_OFF));
    float* mod = (float*)(ws + WS_MOD);
    if (IN(0)) REP(0) {
        ada_phase(lds, a.in[1], a.in[4], a.in[5], mod, G, c);
        const size_t gtid = (size_t)blockIdx.x * 512 + threadIdx.x, gstride = (size_t)G * 512;
        convert_seg(a.in[6], (bf16_t*)(ws + WS_WIN), (size_t)kD * kNPROJ / 8, gtid, gstride);
        convert_seg(a.in[11], (bf16_t*)(ws + WS_WO), (size_t)kD * kD / 8, gtid, gstride);
        { const f32x4* s4 = (const f32x4*)a.in[9]; const f32x4* sc4 = (const f32x4*)a.in[10]; u32x4* d4 = (u32x4*)(ws + WS_WPL);
          for (size_t i = gtid; i < (size_t)4 * kPG * kPG / 8; i += gstride) { const int g = (int)(i >> 13), n8 = (int)(i & 31);
              const f32x4 sa = sc4[g * 64 + n8 * 2], sb = sc4[g * 64 + n8 * 2 + 1]; const f32x4 a0 = s4[2 * i] * sa, b0 = s4[2 * i + 1] * sb;
              u32x4 w; w.x = pk_bf16(a0[0], a0[1]); w.y = pk_bf16(a0[2], a0[3]); w.z = pk_bf16(b0[0], b0[1]); w.w = pk_bf16(b0[2], b0[3]); d4[i] = w; } }
    }
    SEAM(0);
    if (IN(1)) REP(1) norm1_phase(a.in[0], a.in[2], mod, (bf16_t*)(ws + WS_H), G, c);
    if (IN(1) && DUPQ(1)) norm1_phase(a.in[0], a.in[2], mod, (bf16_t*)(ws + WS_H), G, c);
    SEAM(1);
    if (IN(2) && grp == 0) convert_t_f8(lds, C1, c, c1_a, G);
    if (IN(2)) REP(2) { JobInProj J; J.A = (const char*)(ws + WS_H); J.lda2 = kD * 2; J.ldb2 = kNPROJ * 2; J.bhalf2 = 256; J.K = kD; J.list = nullptr;
        J.B = (const char*)(ws + WS_WIN); J.out = (bf16_t*)(ws + WS_PROJ); J.S.init(kT, kNPROJ, G, c); fg::gemm_phase(lds, J); }
    if (IN(2) && DUPQ(2)) { JobInProj J; J.A = (const char*)(ws + WS_H); J.lda2 = kD * 2; J.ldb2 = kNPROJ * 2; J.bhalf2 = 256; J.K = kD; J.list = nullptr;
        J.B = (const char*)(ws + WS_WIN); J.out = (bf16_t*)(ws + WS_PROJ); J.S.init(kT, kNPROJ, G, c); fg::gemm_phase(lds, J); }
    if (IN(2) && grp == 1) convert_t_f8(lds, C1, c, c1_a, G);
    SEAM(2);
    if (IN(3) && grp == 0) convert_t_f8(lds, C1, c1_a + c, c1_b, G);
    if (IN(3)) REP(3) { at::attn_phase(lds, (const bf16_t*)(ws + WS_PROJ), a.in[7], a.in[8], (bf16_t*)(ws + WS_CAT), G, c);
        pool_p_phase((const bf16_t*)(ws + WS_PROJ), (bf16_t*)(ws + WS_P), G, c); }
    if (IN(3) && DUPQ(3)) { at::attn_phase(lds, (const bf16_t*)(ws + WS_PROJ), a.in[7], a.in[8], (bf16_t*)(ws + WS_CAT), G, c);
        pool_p_phase((const bf16_t*)(ws + WS_PROJ), (bf16_t*)(ws + WS_P), G, c); }
    if (IN(3) && grp == 1) convert_t_f8(lds, C1, c1_a + c, c1_b, G);
    SEAM(3);
    if (IN(4)) REP(4) { JobPool J; J.A = (const char*)(ws + WS_P); J.lda2 = kPW * 2; J.ldb2 = kPG * 2; J.bhalf2 = 256; J.K = kPG; J.list = nullptr;
        J.B = (const char*)(ws + WS_WPL); J.cat = (bf16_t*)(ws + WS_CAT); J.G = G; J.c = c; fg::gemm_phase(lds, J); }
    if (IN(4) && DUPQ(4)) { JobPool J; J.A = (const char*)(ws + WS_P); J.lda2 = kPW * 2; J.ldb2 = kPG * 2; J.bhalf2 = 256; J.K = kPG; J.list = nullptr;
        J.B = (const char*)(ws + WS_WPL); J.cat = (bf16_t*)(ws + WS_CAT); J.G = G; J.c = c; fg::gemm_phase(lds, J); }
    SEAM(4);
    if (IN(5) && grp == 0) convert_t_f8(lds, C1, c1_b + c, kE * C1.per, G);
    if (IN(5)) REP(5) { JobOutProj J; J.A = (const char*)(ws + WS_CAT); J.lda2 = kD * 2; J.ldb2 = kD * 2; J.bhalf2 = 256; J.K = kD; J.list = nullptr;
        J.B = (const char*)(ws + WS_WO); J.x = a.in[0]; J.mod = mod; J.x1 = (float*)(ws + WS_X1); J.S.init(kT, kD, G, c); fg::gemm_phase(lds, J); }
    if (IN(5) && DUPQ(5)) { JobOutProj J; J.A = (const char*)(ws + WS_CAT); J.lda2 = kD * 2; J.ldb2 = kD * 2; J.bhalf2 = 256; J.K = kD; J.list = nullptr;
        J.B = (const char*)(ws + WS_WO); J.x = a.in[0]; J.mod = mod; J.x1 = (float*)(ws + WS_X1); J.S.init(kT, kD, G, c); fg::gemm_phase(lds, J); }
    if (IN(5) && grp == 1) convert_t_f8(lds, C1, c1_b + c, kE * C1.per, G);
    SEAM(5);
    if (IN(6)) REP(6) norm2_router_phase(lds, (const float*)(ws + WS_X1), a.in[3], mod, a.in[12], a.in[13], (unsigned char*)(ws + WS_H2), (float*)(ws + WS_GATES), (int*)(ws + WS_PAIRE), (int*)(ws + WS_PAIRP),
                                  (int*)(ws + WS_LIST), ctrl, G, c);
    SEAM(6);
    if (IN(7) && grp == 0) convert_t_f8(lds, C2, c, kE * C2.per, G);
    if (IN(7)) REP(7) { JobMoe1F8 J; J.A = (const char*)(ws + WS_H2); J.lda2 = kD; J.ldb2 = kD; J.bhalf2 = (unsigned)kDFF * kD; J.K = kD; J.list = (const int*)(ws + WS_LIST);
        J.B = (const char*)(ws + WS_WE1); J.b_in = a.in[15]; J.act = (unsigned char*)(ws + WS_ACT); J.M = moe_tables(lds, ctrl, kDFF / 128); J.G = G; J.c = c; fg::gemm_phase_f8(lds, J); }
    if (IN(7) && DUPQ(7)) { JobMoe1F8 J; J.A = (const char*)(ws + WS_H2); J.lda2 = kD; J.ldb2 = kD; J.bhalf2 = (unsigned)kDFF * kD; J.K = kD; J.list = (const int*)(ws + WS_LIST);
        J.B = (const char*)(ws + WS_WE1); J.b_in = a.in[15]; J.act = (unsigned char*)(ws + WS_ACT); J.M = moe_tables(lds, ctrl, kDFF / 128); J.G = G; J.c = c; fg::gemm_phase_f8(lds, J); }
    if (IN(7) && grp == 1) convert_t_f8(lds, C2, c, kE * C2.per, G);
    SEAM(7);
    if (IN(8)) REP(8) { JobMoe2F8 J; J.A = (const char*)(ws + WS_ACT); J.lda2 = kDFF; J.ldb2 = kDFF; J.bhalf2 = 128u * kDFF; J.K = kDFF; J.list = nullptr;
        J.B = (const char*)(ws + WS_WE2); J.b_out = a.in[17]; J.yp = (bf16_t*)(ws + WS_YP); J.M = moe_tables(lds, ctrl, kD / 256); J.G = G; J.c = c; fg::gemm_phase_f8(lds, J); }
    if (IN(8) && DUPQ(8)) { JobMoe2F8 J; J.A = (const char*)(ws + WS_ACT); J.lda2 = kDFF; J.ldb2 = kDFF; J.bhalf2 = 128u * kDFF; J.K = kDFF; J.list = nullptr;
        J.B = (const char*)(ws + WS_WE2); J.b_out = a.in[17]; J.yp = (bf16_t*)(ws + WS_YP); J.M = moe_tables(lds, ctrl, kD / 256); J.G = G; J.c = c; fg::gemm_phase_f8(lds, J); }
    SEAM(8);
    if (IN(9)) REP(9) final_phase((const float*)(ws + WS_X1), mod, (const float*)(ws + WS_GATES), (const int*)(ws + WS_PAIRE), (const int*)(ws + WS_PAIRP), moe_tables(lds, ctrl, 1), (const bf16_t*)(ws + WS_YP), a.out, G, c);
    if (IN(9) && DUPQ(9)) final_phase((const float*)(ws + WS_X1), mod, (const float*)(ws + WS_GATES), (const int*)(ws + WS_PAIRE), (const int*)(ws + WS_PAIRP), moe_tables(lds, ctrl, 1), (const bf16_t*)(ws + WS_YP), a.out, G, c);
#undef IN
#undef SEAM
}

#ifndef N_LAUNCHES
#define N_LAUNCHES 1
#endif
extern "C" void kernel_launch(void* const* d_in, const int* in_sizes, int n_in, void* d_out, int out_size, void* d_ws, size_t ws_size, hipStream_t stream) {
    static int grid = 0;
    if (grid == 0) {
        int dev = 0, cus = 0;
        (void)hipGetDevice(&dev); (void)hipDeviceGetAttribute(&cus, hipDeviceAttributeMultiprocessorCount, dev);
        (void)hipFuncSetAttribute((const void*)mega, hipFuncAttributeMaxDynamicSharedMemorySize, fg::LDS_BYTES);
        grid = cus > 0 ? cus : 256;
    }
    MegaArgs a{}; for (int i = 0; i < 18; ++i) a.in[i] = (const float*)d_in[i]; a.out = (float*)d_out; a.ws = (unsigned char*)d_ws;
    (void)hipMemsetAsync((char*)d_ws + WS_CTRL, 0, 65536, stream);
    if (N_LAUNCHES == 1) { a.ph_lo = 0; a.ph_hi = NPHASE; hipLaunchKernelGGL(mega, dim3(grid), dim3(512), fg::LDS_BYTES, stream, a); }
    else for (int p = 0; p < NPHASE; ++p) { a.ph_lo = p; a.ph_hi = p + 1; hipLaunchKernelGGL(mega, dim3(grid), dim3(512), fg::LDS_BYTES, stream, a); }
}
```

```cpp
#include <hip/hip_runtime.h>
#include <stdint.h>

constexpr int kB = 4, kS = 2048, kD = 2048, kT = kB * kS;
constexpr int kHD = 128, kNH = 8, kSB = 1024, kPW = 1024, kPG = 256;
constexpr int kNPROJ = 4096, kE = 32, kTOPK = 4, kDFF = 2048;
constexpr float kEPS = 1e-6f;
constexpr int kMaxSlots = 160 * 256;

typedef unsigned short bf16_t;
__device__ __forceinline__ bf16_t f2bf(float f) { unsigned u = __float_as_uint(f); u += 0x7FFFu + ((u >> 16) & 1u); return (bf16_t)(u >> 16); }
__device__ __forceinline__ float bf2f(bf16_t b) { return __uint_as_float(((unsigned)b) << 16); }

constexpr size_t WS_CTRL   = 0;
constexpr size_t WS_MOD    = 65536;
constexpr size_t WS_H      = WS_MOD + (size_t)4 * 12288 * 4;
constexpr size_t WS_PROJ   = WS_H + (size_t)kT * kD * 2;
constexpr size_t WS_CAT    = WS_PROJ + (size_t)kT * kNPROJ * 2;
constexpr size_t WS_P      = WS_CAT + (size_t)kT * kD * 2;
constexpr size_t WS_X1     = WS_P + (size_t)kT * kPW * 2;
constexpr size_t WS_H2     = WS_X1 + (size_t)kT * kD * 4;
constexpr size_t WS_GATES  = WS_H2 + (size_t)kT * kD * 2;
constexpr size_t WS_PAIRE  = WS_GATES + (size_t)kT * 4 * 4;
constexpr size_t WS_PAIRP  = WS_PAIRE + (size_t)kT * 4 * 4;
constexpr size_t WS_LIST   = WS_PAIRP + (size_t)kT * 4 * 4;
constexpr size_t WS_ACT    = WS_LIST + (size_t)kE * kT * 4;
constexpr size_t WS_YP     = WS_ACT + (size_t)kMaxSlots * kDFF * 2;
constexpr size_t WS_END    = WS_YP + (size_t)kMaxSlots * kD * 2;
constexpr int CT_CNT = 4096;
constexpr int CT_ROWBASE = 4160;

#define LAS __attribute__((address_space(3)))
typedef short bf16x8 __attribute__((ext_vector_type(8)));
typedef short s16x4 __attribute__((ext_vector_type(4)));
typedef float f32x4 __attribute__((ext_vector_type(4)));
typedef float f32x2 __attribute__((ext_vector_type(2)));
typedef __bf16 bf16v2 __attribute__((ext_vector_type(2)));
typedef unsigned u32x2 __attribute__((ext_vector_type(2)));
typedef unsigned u32x4 __attribute__((ext_vector_type(4)));
typedef int i32x4 __attribute__((ext_vector_type(4)));
typedef int i32x8 __attribute__((ext_vector_type(8)));
__device__ __forceinline__ unsigned pk_bf16(float a, float b) { f32x2 v = {a, b}; bf16v2 r = __builtin_convertvector(v, bf16v2); return __builtin_bit_cast(unsigned, r); }

constexpr size_t WS_WIN  = WS_END;
constexpr size_t WS_WO   = WS_WIN + (size_t)kD * kNPROJ * 2;
constexpr size_t WS_WPL  = WS_WO + (size_t)kD * kD * 2;
constexpr size_t WS_WE1  = WS_WPL + (size_t)4 * kPG * kPG * 2;
constexpr size_t WS_WE2  = WS_WE1 + (size_t)kE * kD * 2 * kDFF * 2;
constexpr size_t WS_END2 = WS_WE2 + (size_t)kE * kDFF * kD * 2;

namespace fg {
constexpr int BM = 256, BK = 64, HALF = 128, HTB = 16384, STAGE_BYTES = 131072, NXCD = 8, WGM = 8;
constexpr int TAB_OFF = STAGE_BYTES;
constexpr int MISC_OFF = STAGE_BYTES + 2048;
constexpr int LDS_BYTES = STAGE_BYTES + 4096;
__device__ __forceinline__ int lds_byte(int r, int c) { const int st = (r >> 4) * 2 + (c >> 5), rr = r & 15, cc = c & 31, ob = rr * 64 + cc * 2; return st * 1024 + (ob ^ (((ob >> 9) & 1) << 5)); }
__device__ __forceinline__ void stage_rc(int b, int& R, int& C) { const int st = b / 1024, sb = b % 1024, swz = sb ^ (((sb >> 9) & 1) << 5); R = (st >> 1) * 16 + swz / 64; C = (st & 1) * 32 + (swz % 64) / 2; }

struct Unit { const char* bBase; int arow0; int nvalid; int e; int orow0; int ocol0; int acol2; };

struct StaticOrder {
    int nM, nN, nwg, G, c;
    __device__ void init(int M, int N, int G_, int c_) { nM = M / BM; nN = N / BM; nwg = nM * nN; G = G_; c = c_; }
    __device__ bool next(int i, int& pm, int& pn) const {
        const long L = (long)i * G + c; if (L >= nwg) return false;
        int wgid = (int)L; { const int q = nwg / NXCD, r = nwg % NXCD, xcd = wgid % NXCD, off = wgid / NXCD; wgid = (xcd < r ? xcd * (q + 1) : r * (q + 1) + (xcd - r) * q) + off; }
        const int nig = WGM * nN, gid = wgid / nig, fm = gid * WGM, gsz = (nM - fm) < WGM ? (nM - fm) : WGM;
        pm = fm + ((wgid % nig) % gsz); pn = (wgid % nig) / gsz; return true;
    }
};

template <int OFF> __device__ __forceinline__ s16x4 tr_read(unsigned addr) { s16x4 r; asm volatile("ds_read_b64_tr_b16 %0, %1 offset:%2" : "=&v"(r) : "v"(addr), "i"(OFF) : "memory"); return r; }
template <class Job>
__device__ __forceinline__ void gemm_phase(LAS unsigned char* lds, const Job& J) {
    const int tid = threadIdx.x, wid = __builtin_amdgcn_readfirstlane(tid >> 6), lane = tid & 63, wr = wid >> 2, wc = wid & 3, fr = lane & 15, fq = lane >> 4;
    const int nt = J.K / BK;
    unsigned voffB[2];
#pragma unroll
    for (int i = 0; i < 2; ++i) { int R, C; stage_rc(tid * 16 + i * 8192, R, C);
        const int b = tid * 16 + i * 8192, row = b >> 8, slot = (b >> 4) & 15, ch = slot ^ (((row & 3) << 2) | ((row >> 2) & 3)); voffB[i] = (unsigned)row * J.ldb2 + (unsigned)ch * 16u; }
    const size_t kstepB = (size_t)BK * J.ldb2;
    const unsigned ldsw = (unsigned)wid * 1024u;
    const int aoff = lds_byte(wr * 64 + fr, fq * 8);
    const int tq = (lane & 15) >> 2, tp = lane & 3;
    unsigned ba[2][2];
#pragma unroll
    for (int n = 0; n < 2; ++n)
#pragma unroll
        for (int t = 0; t < 2; ++t) ba[n][t] = (unsigned)(uintptr_t)lds + 256u * (8 * fq + 4 * t + tq) + 16u * ((4 * wc + 2 * n + (tp >> 1)) ^ ((tq << 2) | ((2 * fq + t) & 3))) + 8u * (tp & 1);
#define FG_SA(b, h) (65536 + ((b) * 2 + (h)) * HTB)
#define FG_SB(b, h) (((b) * 2 + (h)) * HTB)
#define FG_STAGE_A(bufoff, gk, vo) do { _Pragma("unroll") for (int _i = 0; _i < 2; ++_i) \
        __builtin_amdgcn_global_load_lds((const unsigned*)((gk) + (vo)[_i]), (LAS unsigned*)(lds + (bufoff) + ldsw + _i * 8192), 16, 0, 0); } while (0)
#define FG_STAGE_B(bufoff, gk) do { _Pragma("unroll") for (int _i = 0; _i < 2; ++_i) \
        __builtin_amdgcn_global_load_lds((const unsigned*)((gk) + voffB[_i]), (LAS unsigned*)(lds + (bufoff) + ldsw + _i * 8192), 16, 0, 0); } while (0)
#define FG_LDA(dst, b, h) do { _Pragma("unroll") for (int m = 0; m < 4; ++m) _Pragma("unroll") for (int k = 0; k < 2; ++k) dst[m][k] = *(const LAS bf16x8*)(lds + FG_SA(b, h) + aoff + m * 2048 + k * 1024); } while (0)
#define FG_LDB(dst, b, h) do { \
        dst##lo[0][0] = tr_read<FG_SB(b, h)>(ba[0][0]);        dst##hi[0][0] = tr_read<FG_SB(b, h)>(ba[0][1]); \
        dst##lo[0][1] = tr_read<FG_SB(b, h) + 8192>(ba[0][0]); dst##hi[0][1] = tr_read<FG_SB(b, h) + 8192>(ba[0][1]); \
        dst##lo[1][0] = tr_read<FG_SB(b, h)>(ba[1][0]);        dst##hi[1][0] = tr_read<FG_SB(b, h)>(ba[1][1]); \
        dst##lo[1][1] = tr_read<FG_SB(b, h) + 8192>(ba[1][0]); dst##hi[1][1] = tr_read<FG_SB(b, h) + 8192>(ba[1][1]); } while (0)
#define FG_PK(L, H) (bf16x8){L[0], L[1], L[2], L[3], H[0], H[1], H[2], H[3]}
#define FG_MMA(ai, bj, At, Bt) do { __builtin_amdgcn_s_setprio(1); _Pragma("unroll") for (int m = 0; m < 4; ++m) _Pragma("unroll") for (int n = 0; n < 2; ++n) _Pragma("unroll") for (int k = 0; k < 2; ++k) \
        acc[ai][bj][m][n] = __builtin_amdgcn_mfma_f32_16x16x32_bf16(FG_PK(Bt##lo[n][k], Bt##hi[n][k]), At[m][k], acc[ai][bj][m][n], 0, 0, 0); __builtin_amdgcn_s_setprio(0); } while (0)
#define FG_WAIT_V(n) asm volatile("s_waitcnt vmcnt(" #n ")" ::: "memory")
#define FG_WAIT_L(n) asm volatile("s_waitcnt lgkmcnt(" #n ")" ::: "memory")
#define FG_BAR __builtin_amdgcn_s_barrier()
#define FG_SCHED __builtin_amdgcn_sched_barrier(0)
#define FG_AOFF(dst, u, tabp) do { int _tz = threadIdx.x; asm volatile("" : "+v"(_tz)); _Pragma("unroll") for (int _i = 0; _i < 2; ++_i) { int _R, _C; stage_rc(_tz * 16 + _i * 8192, _R, _C); \
        _Pragma("unroll") for (int _h = 0; _h < 2; ++_h) { const int _r = _h * 128 + _R; \
        if (Job::GATHER) { const int _tok = (tabp)[_r < (u).nvalid ? _r : 0]; dst[_h][_i] = (unsigned)_tok * J.lda2 + (unsigned)(_C * 2); } \
        else dst[_h][_i] = (unsigned)((u).arow0 + _r) * J.lda2 + (unsigned)((u).acol2 + _C * 2); } } } while (0)
    Unit cur, nxt; int ui = 0;
    if (!J.next(0, cur)) return;
    LAS const int* tab0 = (LAS const int*)(lds + TAB_OFF);
    if (Job::GATHER) {
        if (wid == 0) __builtin_amdgcn_global_load_lds((const unsigned*)(J.list + cur.arow0 + lane * 4), (LAS unsigned*)(lds + TAB_OFF), 16, 0, 0);
        FG_WAIT_V(0); __syncthreads();
    }
    f32x4 acc[2][2][4][2];
#pragma unroll
    for (int a = 0; a < 2; ++a)
#pragma unroll
        for (int b = 0; b < 2; ++b)
#pragma unroll
            for (int m = 0; m < 4; ++m)
#pragma unroll
                for (int n = 0; n < 2; ++n) acc[a][b][m][n] = (f32x4){0.f, 0.f, 0.f, 0.f};
    bf16x8 At[4][2]; s16x4 B0lo[2][2], B0hi[2][2], B1lo[2][2], B1hi[2][2];
    unsigned vc[2][2];
    FG_AOFF(vc, cur, tab0);
    const char* const gA = J.A;
    const char* cB = cur.bBase;
    const unsigned bh2 = J.bhalf2;
    FG_STAGE_B(FG_SB(0, 0), cB); FG_STAGE_A(FG_SA(0, 0), gA, vc[0]); FG_STAGE_B(FG_SB(0, 1), cB + bh2); FG_STAGE_A(FG_SA(0, 1), gA, vc[1]);
    if (wr == 1) FG_BAR;
    FG_WAIT_V(4); FG_BAR;
    FG_STAGE_B(FG_SB(1, 0), cB + kstepB); FG_STAGE_A(FG_SA(1, 0), gA + 128, vc[0]); FG_STAGE_B(FG_SB(1, 1), cB + kstepB + bh2);
    FG_WAIT_V(6); FG_BAR;
    for (;;) {
        const bool has_next = J.next(ui + 1, nxt);
        if (!has_next) nxt = cur;
        if (Job::GATHER && has_next && wid == 0)
            __builtin_amdgcn_global_load_lds((const unsigned*)(J.list + nxt.arow0 + lane * 4), (LAS unsigned*)(lds + TAB_OFF + ((ui + 1) & 1) * 1024), 16, 0, 0);
        const char* nB = nxt.bBase;
        for (int t = 0; t < nt; t += 2) {
            const bool last = (t == nt - 2);
            const char* a1 = gA + (size_t)(t + 1) * 128;
            const char* a2 = last ? gA : gA + (size_t)(t + 2) * 128; const char* b2 = last ? nB : cB + (size_t)(t + 2) * kstepB;
            const char* a3 = a2 + 128; const char* b3 = b2 + kstepB;
            FG_LDB(B0, 0, 0); FG_SCHED; FG_LDA(At, 0, 0); FG_STAGE_A(FG_SA(1, 1), a1, vc[1]);
            if (last && has_next) { LAS const int* tabn = (LAS const int*)(lds + TAB_OFF + ((ui + 1) & 1) * 1024); FG_AOFF(vc, nxt, tabn); }
            FG_WAIT_L(8); FG_BAR; FG_WAIT_L(0); FG_SCHED; FG_MMA(0, 0, At, B0); FG_BAR; FG_SCHED;
            FG_LDB(B1, 0, 1); FG_STAGE_B(FG_SB(0, 0), b2);
            FG_BAR; FG_WAIT_L(0); FG_SCHED; FG_MMA(0, 1, At, B1); FG_BAR;
            FG_LDA(At, 0, 1); FG_STAGE_A(FG_SA(0, 0), a2, vc[0]);
            FG_BAR; FG_WAIT_L(0); FG_MMA(1, 0, At, B0); FG_BAR; FG_SCHED;
            FG_STAGE_B(FG_SB(0, 1), b2 + bh2);
            FG_WAIT_V(6); FG_BAR; FG_MMA(1, 1, At, B1); FG_BAR;
            FG_LDB(B0, 1, 0); FG_SCHED; FG_LDA(At, 1, 0); FG_STAGE_A(FG_SA(0, 1), a2, vc[1]);
            FG_WAIT_L(8); FG_BAR; FG_WAIT_L(0); FG_SCHED; FG_MMA(0, 0, At, B0); FG_BAR; FG_SCHED;
            FG_LDB(B1, 1, 1); FG_STAGE_B(FG_SB(1, 0), b3);
            FG_BAR; FG_WAIT_L(0); FG_SCHED; FG_MMA(0, 1, At, B1); FG_BAR;
            FG_LDA(At, 1, 1); FG_STAGE_A(FG_SA(1, 0), a3, vc[0]);
            FG_BAR; FG_WAIT_L(0); FG_MMA(1, 0, At, B0); FG_BAR; FG_SCHED;
            FG_STAGE_B(FG_SB(1, 1), b3 + bh2);
            FG_WAIT_V(6); FG_BAR; FG_MMA(1, 1, At, B1); FG_BAR;
        }
        J.epi(acc, cur, wr, wc, fr, fq);
        if (!has_next) break;
#pragma unroll
        for (int a = 0; a < 2; ++a)
#pragma unroll
            for (int b = 0; b < 2; ++b)
#pragma unroll
                for (int m = 0; m < 4; ++m)
#pragma unroll
                    for (int n = 0; n < 2; ++n) acc[a][b][m][n] = (f32x4){0.f, 0.f, 0.f, 0.f};
        cur = nxt; cB = nB; ++ui;
    }
    FG_WAIT_V(0);
    if (wr == 0) FG_BAR;
    FG_BAR;
}

#undef FG_SA
#undef FG_SB
#undef FG_STAGE_A
#undef FG_STAGE_B
#undef FG_LDA
#undef FG_LDB
#undef FG_MMA
#undef FG_WAIT_V
#undef FG_WAIT_L
#undef FG_BAR
#undef FG_SCHED
#undef FG_AOFF
template <class Job>
__device__ __forceinline__ void gemm_phase_f8(LAS unsigned char* lds, const Job& J) {
    const int tid = threadIdx.x, wid = __builtin_amdgcn_readfirstlane(tid >> 6), lane = tid & 63, wr = wid >> 2, wc = wid & 3, fr = lane & 15, fq = lane >> 4;
    const int nt = J.K / 128;
    unsigned voffB[2];
#pragma unroll
    for (int i = 0; i < 2; ++i) { int R, C; stage_rc(tid * 16 + i * 8192, R, C);
        voffB[i] = (unsigned)R * J.ldb2 + (unsigned)(C * 2); }
    const size_t kstepB = 128;
    const unsigned ldsw = (unsigned)wid * 1024u;
    const int aoff = lds_byte(wr * 64 + fr, fq * 8);
    const int boff = lds_byte(wc * 32 + fr, fq * 8);
#define FG_SA(b, h) (65536 + ((b) * 2 + (h)) * HTB)
#define FG_SB(b, h) (((b) * 2 + (h)) * HTB)
#define FG_STAGE_A(bufoff, gk, vo) do { _Pragma("unroll") for (int _i = 0; _i < 2; ++_i) \
        __builtin_amdgcn_global_load_lds((const unsigned*)((gk) + (vo)[_i]), (LAS unsigned*)(lds + (bufoff) + ldsw + _i * 8192), 16, 0, 0); } while (0)
#define FG_STAGE_B(bufoff, gk) do { _Pragma("unroll") for (int _i = 0; _i < 2; ++_i) \
        __builtin_amdgcn_global_load_lds((const unsigned*)((gk) + voffB[_i]), (LAS unsigned*)(lds + (bufoff) + ldsw + _i * 8192), 16, 0, 0); } while (0)
#define FG_LDA(dst, b, h) do { _Pragma("unroll") for (int m = 0; m < 4; ++m) _Pragma("unroll") for (int k = 0; k < 2; ++k) dst[m][k] = *(const LAS i32x4*)(lds + FG_SA(b, h) + aoff + m * 2048 + k * 1024); } while (0)
#define FG_LDB(dst, b, h) do { _Pragma("unroll") for (int n = 0; n < 2; ++n) _Pragma("unroll") for (int k = 0; k < 2; ++k) dst[n][k] = *(const LAS i32x4*)(lds + FG_SB(b, h) + boff + n * 2048 + k * 1024); } while (0)
#define FG_CAT8(X, Y) __builtin_shufflevector(X, Y, 0, 1, 2, 3, 4, 5, 6, 7)
#define FG_MMA(ai, bj, At, Bt) do { __builtin_amdgcn_s_setprio(1); _Pragma("unroll") for (int m = 0; m < 4; ++m) _Pragma("unroll") for (int n = 0; n < 2; ++n) \
        acc[ai][bj][m][n] = __builtin_amdgcn_mfma_scale_f32_16x16x128_f8f6f4(FG_CAT8(Bt[n][0], Bt[n][1]), FG_CAT8(At[m][0], At[m][1]), acc[ai][bj][m][n], 0, 0, 0, 0x79797979, 0, 0x7F7F7F7F); __builtin_amdgcn_s_setprio(0); } while (0)
#define FG_WAIT_V(n) asm volatile("s_waitcnt vmcnt(" #n ")" ::: "memory")
#define FG_WAIT_L(n) asm volatile("s_waitcnt lgkmcnt(" #n ")" ::: "memory")
#define FG_BAR __builtin_amdgcn_s_barrier()
#define FG_SCHED __builtin_amdgcn_sched_barrier(0)
#define FG_AOFF(dst, u, tabp) do { int _tz = threadIdx.x; asm volatile("" : "+v"(_tz)); _Pragma("unroll") for (int _i = 0; _i < 2; ++_i) { int _R, _C; stage_rc(_tz * 16 + _i * 8192, _R, _C); \
        _Pragma("unroll") for (int _h = 0; _h < 2; ++_h) { const int _r = _h * 128 + _R; \
        if (Job::GATHER) { const int _tok = (tabp)[_r < (u).nvalid ? _r : 0]; dst[_h][_i] = (unsigned)_tok * J.lda2 + (unsigned)(_C * 2); } \
        else dst[_h][_i] = (unsigned)((u).arow0 + _r) * J.lda2 + (unsigned)((u).acol2 + _C * 2); } } } while (0)
    Unit cur, nxt; int ui = 0;
    if (!J.next(0, cur)) return;
    LAS const int* tab0 = (LAS const int*)(lds + TAB_OFF);
    if (Job::GATHER) {
        if (wid == 0) __builtin_amdgcn_global_load_lds((const unsigned*)(J.list + cur.arow0 + lane * 4), (LAS unsigned*)(lds + TAB_OFF), 16, 0, 0);
        FG_WAIT_V(0); __syncthreads();
    }
    f32x4 acc[2][2][4][2];
#pragma unroll
    for (int a = 0; a < 2; ++a)
#pragma unroll
        for (int b = 0; b < 2; ++b)
#pragma unroll
            for (int m = 0; m < 4; ++m)
#pragma unroll
                for (int n = 0; n < 2; ++n) acc[a][b][m][n] = (f32x4){0.f, 0.f, 0.f, 0.f};
    i32x4 At[4][2], B0[2][2], B1[2][2];
    unsigned vc[2][2];
    FG_AOFF(vc, cur, tab0);
    const char* const gA = J.A;
    const char* cB = cur.bBase;
    const unsigned bh2 = J.bhalf2;
    FG_STAGE_B(FG_SB(0, 0), cB); FG_STAGE_A(FG_SA(0, 0), gA, vc[0]); FG_STAGE_B(FG_SB(0, 1), cB + bh2); FG_STAGE_A(FG_SA(0, 1), gA, vc[1]);
    if (wr == 1) FG_BAR;
    FG_WAIT_V(4); FG_BAR;
    FG_STAGE_B(FG_SB(1, 0), cB + kstepB); FG_STAGE_A(FG_SA(1, 0), gA + 128, vc[0]); FG_STAGE_B(FG_SB(1, 1), cB + kstepB + bh2);
    FG_WAIT_V(6); FG_BAR;
    for (;;) {
        const bool has_next = J.next(ui + 1, nxt);
        if (!has_next) nxt = cur;
        if (Job::GATHER && has_next && wid == 0)
            __builtin_amdgcn_global_load_lds((const unsigned*)(J.list + nxt.arow0 + lane * 4), (LAS unsigned*)(lds + TAB_OFF + ((ui + 1) & 1) * 1024), 16, 0, 0);
        const char* nB = nxt.bBase;
        for (int t = 0; t < nt; t += 2) {
            const bool last = (t == nt - 2);
            const char* a1 = gA + (size_t)(t + 1) * 128;
            const char* a2 = last ? gA : gA + (size_t)(t + 2) * 128; const char* b2 = last ? nB : cB + (size_t)(t + 2) * kstepB;
            const char* a3 = a2 + 128; const char* b3 = b2 + kstepB;
            FG_LDB(B0, 0, 0); FG_SCHED; FG_LDA(At, 0, 0); FG_STAGE_A(FG_SA(1, 1), a1, vc[1]);
            if (last && has_next) { LAS const int* tabn = (LAS const int*)(lds + TAB_OFF + ((ui + 1) & 1) * 1024); FG_AOFF(vc, nxt, tabn); }
            FG_WAIT_L(8); FG_BAR; FG_WAIT_L(0); FG_SCHED; FG_MMA(0, 0, At, B0); FG_BAR; FG_SCHED;
            FG_LDB(B1, 0, 1); FG_STAGE_B(FG_SB(0, 0), b2);
            FG_BAR; FG_WAIT_L(0); FG_SCHED; FG_MMA(0, 1, At, B1); FG_BAR;
            FG_LDA(At, 0, 1); FG_STAGE_A(FG_SA(0, 0), a2, vc[0]);
            FG_BAR; FG_WAIT_L(0); FG_MMA(1, 0, At, B0); FG_BAR; FG_SCHED;
            FG_STAGE_B(FG_SB(0, 1), b2 + bh2);
            FG_WAIT_V(6); FG_BAR; FG_MMA(1, 1, At, B1); FG_BAR;
            FG_LDB(B0, 1, 0); FG_SCHED; FG_LDA(At, 1, 0); FG_STAGE_A(FG_SA(0, 1), a2, vc[1]);
            FG_WAIT_L(8); FG_BAR; FG_WAIT_L(0); FG_SCHED; FG_MMA(0, 0, At, B0); FG_BAR; FG_SCHED;
            FG_LDB(B1, 1, 1); FG_STAGE_B(FG_SB(1, 0), b3);
            FG_BAR; FG_WAIT_L(0); FG_SCHED; FG_MMA(0, 1, At, B1); FG_BAR;
            FG_LDA(At, 1, 1); FG_STAGE_A(FG_SA(1, 0), a3, vc[0]);
            FG_BAR; FG_WAIT_L(0); FG_MMA(1, 0, At, B0); FG_BAR; FG_SCHED;
            FG_STAGE_B(FG_SB(1, 1), b3 + bh2);
            FG_WAIT_V(6); FG_BAR; FG_MMA(1, 1, At, B1); FG_BAR;
        }
        J.epi(acc, cur, wr, wc, fr, fq);
        if (!has_next) break;
#pragma unroll
        for (int a = 0; a < 2; ++a)
#pragma unroll
            for (int b = 0; b < 2; ++b)
#pragma unroll
                for (int m = 0; m < 4; ++m)
#pragma unroll
                    for (int n = 0; n < 2; ++n) acc[a][b][m][n] = (f32x4){0.f, 0.f, 0.f, 0.f};
        cur = nxt; cB = nB; ++ui;
    }
    FG_WAIT_V(0);
    if (wr == 0) FG_BAR;
    FG_BAR;
}
}

#define FG_FOR_ROWS for (int ai = 0; ai < 2; ++ai) _Pragma("unroll") for (int m = 0; m < 4; ++m)
struct JobInProj {
    static constexpr bool GATHER = false;
    const char* A; unsigned lda2, ldb2, bhalf2; int K; const int* list;
    const char* B; bf16_t* out; fg::StaticOrder S;
    __device__ __forceinline__ bool next(int i, fg::Unit& u) const { int pm, pn; if (!S.next(i, pm, pn)) return false;
        u.bBase = B + (size_t)pn * 512; u.arow0 = pm * 256; u.nvalid = 256; u.e = 0; u.orow0 = pm * 256; u.ocol0 = pn * 256; u.acol2 = 0; return true; }
    __device__ __forceinline__ void epi(const f32x4 (&acc)[2][2][4][2], const fg::Unit& u, int wr, int wc, int fr, int fq) const {
#pragma unroll
        FG_FOR_ROWS { bf16_t* rowp = out + (size_t)(u.orow0 + ai * 128 + wr * 64 + m * 16 + fr) * kNPROJ + u.ocol0 + wc * 32 + fq * 4;
#pragma unroll
            for (int bj = 0; bj < 2; ++bj)
#pragma unroll
                for (int n = 0; n < 2; ++n) { const f32x4 v = acc[ai][bj][m][n]; u32x2 w; w.x = pk_bf16(v[0], v[1]); w.y = pk_bf16(v[2], v[3]); *(u32x2*)(rowp + bj * 128 + n * 16) = w; } }
    }
};
struct JobPool {
    static constexpr bool GATHER = false;
    const char* A; unsigned lda2, ldb2, bhalf2; int K; const int* list;
    const char* B; bf16_t* cat; int G, c;
    __device__ __forceinline__ bool next(int i, fg::Unit& u) const { const int L = i * G + c; if (L >= 128) return false; const int g = L >> 5, pm = L & 31;
        u.bBase = B + (size_t)g * kPG * kPG * 2; u.arow0 = pm * 256; u.nvalid = 256; u.e = g; u.orow0 = pm * 256; u.ocol0 = kSB + g * kPG; u.acol2 = g * kPG * 2; return true; }
    __device__ __forceinline__ void epi(const f32x4 (&acc)[2][2][4][2], const fg::Unit& u, int wr, int wc, int fr, int fq) const {
#pragma unroll
        FG_FOR_ROWS { bf16_t* rowp = cat + (size_t)(u.orow0 + ai * 128 + wr * 64 + m * 16 + fr) * kD + u.ocol0 + wc * 32 + fq * 4;
#pragma unroll
            for (int bj = 0; bj < 2; ++bj)
#pragma unroll
                for (int n = 0; n < 2; ++n) { const f32x4 v = acc[ai][bj][m][n]; u32x2 w; w.x = pk_bf16(v[0], v[1]); w.y = pk_bf16(v[2], v[3]); *(u32x2*)(rowp + bj * 128 + n * 16) = w; } }
    }
};
struct JobOutProj {
    static constexpr bool GATHER = false;
    const char* A; unsigned lda2, ldb2, bhalf2; int K; const int* list;
    const char* B; const float* x; const float* mod; float* x1; fg::StaticOrder S;
    __device__ __forceinline__ bool next(int i, fg::Unit& u) const { int pm, pn; if (!S.next(i, pm, pn)) return false;
        u.bBase = B + (size_t)pn * 512; u.arow0 = pm * 256; u.nvalid = 256; u.e = 0; u.orow0 = pm * 256; u.ocol0 = pn * 256; u.acol2 = 0; return true; }
    __device__ __forceinline__ void epi(const f32x4 (&acc)[2][2][4][2], const fg::Unit& u, int wr, int wc, int fr, int fq) const {
        const int b = u.orow0 / kS; f32x4 gt[2][2];
#pragma unroll
        for (int bj = 0; bj < 2; ++bj)
#pragma unroll
            for (int n = 0; n < 2; ++n) gt[bj][n] = *(const f32x4*)(mod + b * 6 * kD + 2 * kD + u.ocol0 + bj * 128 + wc * 32 + n * 16 + fq * 4);
#pragma unroll
        FG_FOR_ROWS { const size_t ro = (size_t)(u.orow0 + ai * 128 + wr * 64 + m * 16 + fr) * kD + u.ocol0 + wc * 32 + fq * 4;
#pragma unroll
            for (int bj = 0; bj < 2; ++bj)
#pragma unroll
                for (int n = 0; n < 2; ++n) { const f32x4 xv = *(const f32x4*)(x + ro + bj * 128 + n * 16); *(f32x4*)(x1 + ro + bj * 128 + n * 16) = xv + gt[bj][n] * acc[ai][bj][m][n]; } }
    }
};
struct MoeTab { LAS const int* t; int total;
    __device__ __forceinline__ bool decode(int i, int G, int c, int& e, int& jcol, int& rb, int& cnt, int& rowbase) const {
        const int L = (G % 8 == 0) ? i * G + (c % 8) * (G / 8) + c / 8 : i * G + c; if (L >= total) return false;
        int ee = 0; while (ee < kE - 1 && t[64 + ee + 1] <= L) ++ee;
        const int local = L - t[64 + ee], nrb = t[100 + ee]; jcol = local / nrb; rb = local - jcol * nrb; e = ee; cnt = t[ee]; rowbase = t[32 + ee]; return true; }
};
__device__ __forceinline__ MoeTab moe_tables(LAS unsigned char* lds, const unsigned* ctrl, int ncol) {
    LAS int* t = (LAS int*)(lds + fg::MISC_OFF + 64);
    __syncthreads();
    if (threadIdx.x == 0) { int base = 0, us = 0; for (int e = 0; e < kE; ++e) { const int cn = (int)ctrl[CT_CNT + 64 * e], nrb = (cn + 255) >> 8; t[e] = cn; t[32 + e] = base; t[64 + e] = us; t[100 + e] = nrb; base += nrb * 256; us += nrb * ncol; } t[64 + kE] = us; }
    __syncthreads();
    MoeTab M; M.t = t; M.total = t[64 + kE]; return M;
}
struct JobMoe1 {
    static constexpr bool GATHER = true;
    const char* A; unsigned lda2, ldb2, bhalf2; int K; const int* list;
    const char* B; const float* b_in; bf16_t* act; MoeTab M; int G, c;
    __device__ __forceinline__ bool next(int i, fg::Unit& u) const { int e, j, rb, cnt, rowbase; if (!M.decode(i, G, c, e, j, rb, cnt, rowbase)) return false;
        e = __builtin_amdgcn_readfirstlane(e); j = __builtin_amdgcn_readfirstlane(j); rb = __builtin_amdgcn_readfirstlane(rb); cnt = __builtin_amdgcn_readfirstlane(cnt); rowbase = __builtin_amdgcn_readfirstlane(rowbase);
        u.bBase = B + (size_t)e * ((size_t)kD * 2 * kDFF * 2) + (size_t)j * 256; u.arow0 = e * kT + rb * 256; u.nvalid = min(256, cnt - rb * 256); u.e = e; u.orow0 = rowbase + rb * 256; u.ocol0 = j * 128; u.acol2 = 0; return true; }
    __device__ __forceinline__ void epi(const f32x4 (&acc)[2][2][4][2], const fg::Unit& u, int wr, int wc, int fr, int fq) const {
        f32x4 bg[2], bl[2];
#pragma unroll
        for (int n = 0; n < 2; ++n) { const float* bp = b_in + (size_t)u.e * 2 * kDFF + u.ocol0 + wc * 32 + n * 16 + fq * 4; bg[n] = *(const f32x4*)bp; bl[n] = *(const f32x4*)(bp + kDFF); }
#pragma unroll
        FG_FOR_ROWS { bf16_t* rowp = act + (size_t)(u.orow0 + ai * 128 + wr * 64 + m * 16 + fr) * kDFF + u.ocol0 + wc * 32 + fq * 4;
#pragma unroll
            for (int n = 0; n < 2; ++n) { const f32x4 gv = acc[ai][0][m][n] + bg[n], lv = acc[ai][1][m][n] + bl[n]; float o[4];
#pragma unroll
                for (int j = 0; j < 4; ++j) { const float g = fminf(gv[j], 7.f), l = fminf(fmaxf(lv[j], -7.f), 7.f); o[j] = g * __builtin_amdgcn_rcpf(1.f + __expf(-1.702f * g)) * (l + 1.f); }
                u32x2 w; w.x = pk_bf16(o[0], o[1]); w.y = pk_bf16(o[2], o[3]); *(u32x2*)(rowp + n * 16) = w; } }
    }
};
struct JobMoe2 {
    static constexpr bool GATHER = false;
    const char* A; unsigned lda2, ldb2, bhalf2; int K; const int* list;
    const char* B; const float* b_out; bf16_t* yp; MoeTab M; int G, c;
    __device__ __forceinline__ bool next(int i, fg::Unit& u) const { int e, j, rb, cnt, rowbase; if (!M.decode(i, G, c, e, j, rb, cnt, rowbase)) return false;
        e = __builtin_amdgcn_readfirstlane(e); j = __builtin_amdgcn_readfirstlane(j); rb = __builtin_amdgcn_readfirstlane(rb); rowbase = __builtin_amdgcn_readfirstlane(rowbase);
        u.bBase = B + (size_t)e * ((size_t)kDFF * kD * 2) + (size_t)j * 512; u.arow0 = rowbase + rb * 256; u.nvalid = 256; u.e = e; u.orow0 = rowbase + rb * 256; u.ocol0 = j * 256; u.acol2 = 0; return true; }
    __device__ __forceinline__ void epi(const f32x4 (&acc)[2][2][4][2], const fg::Unit& u, int wr, int wc, int fr, int fq) const {
        f32x4 bo[2][2];
#pragma unroll
        for (int bj = 0; bj < 2; ++bj)
#pragma unroll
            for (int n = 0; n < 2; ++n) bo[bj][n] = *(const f32x4*)(b_out + (size_t)u.e * kD + u.ocol0 + bj * 128 + wc * 32 + n * 16 + fq * 4);
#pragma unroll
        FG_FOR_ROWS { bf16_t* rowp = yp + (size_t)(u.orow0 + ai * 128 + wr * 64 + m * 16 + fr) * kD + u.ocol0 + wc * 32 + fq * 4;
#pragma unroll
            for (int bj = 0; bj < 2; ++bj)
#pragma unroll
                for (int n = 0; n < 2; ++n) { const f32x4 v = acc[ai][bj][m][n] + bo[bj][n]; u32x2 w; w.x = pk_bf16(v[0], v[1]); w.y = pk_bf16(v[2], v[3]); *(u32x2*)(rowp + bj * 128 + n * 16) = w; } }
    }
};


__device__ __forceinline__ float wave_sum(float v) {
#pragma unroll
    for (int o = 32; o > 0; o >>= 1) v += __shfl_xor(v, o);
    return v; }
__device__ __forceinline__ float bflo(unsigned u) { return __uint_as_float(u << 16); }
__device__ __forceinline__ float bfhi(unsigned u) { return __uint_as_float(u & 0xFFFF0000u); }

namespace at {
typedef float f32x16 __attribute__((ext_vector_type(16)));
__device__ __forceinline__ unsigned off_b(unsigned row, unsigned ch) { return 256u * row + 16u * (ch ^ (((row & 3) << 2) | ((row >> 2) & 3))); }
constexpr float kC2 = 0.08838834764831845f * 1.4426950408889634f;
constexpr float kDoneThresh = 140.f;

__device__ __forceinline__ void attn_phase(LAS unsigned char* lds, const bf16_t* __restrict__ proj, const float* __restrict__ qw, const float* __restrict__ kw,
                                           bf16_t* __restrict__ cat, int G, int c) {
    const int tid = threadIdx.x, wid = __builtin_amdgcn_readfirstlane(tid >> 6), lane = tid & 63, ql = lane & 31, hf = lane >> 5;
    const unsigned ldsb = (unsigned)(uintptr_t)lds;
    const int skey = tid >> 4, sch = tid & 15;
    const unsigned X = ((ql & 3) << 2) | ((ql >> 2) & 3);
    const unsigned krow = 256u * ql, kY = 16u * (X ^ (unsigned)hf);
    const int tq = (lane & 15) >> 2, tp = lane & 3, blk = (lane >> 4) & 1;
    unsigned va[4][2];
#pragma unroll
    for (int cc = 0; cc < 4; ++cc)
#pragma unroll
        for (int t = 0; t < 2; ++t) va[cc][t] = 256u * (8 * t + 4 * hf + tq) + 16u * ((4 * cc + 2 * blk + (tp >> 1)) ^ ((tq << 2) | ((2 * t + hf) & 3))) + 8u * (tp & 1);
    for (int unit = c; unit < kB * kNH * 8; unit += G) {
        const int qb = unit & 7, bh = unit >> 3, h = bh & 7, b = bh >> 3;
        const int q0 = qb * 256, r0 = q0 + wid * 32;
        const bf16_t* base = proj + (size_t)(b * kS) * kNPROJ + h * kHD;
        LAS unsigned char* qlds = lds + 65536 + wid * 8192 + lane * 16;
        { u32x4 qr[8]; float ss = 0.f;
#pragma unroll
          for (int s = 0; s < 8; ++s) { qr[s] = *(const u32x4*)(base + (size_t)(r0 + ql) * kNPROJ + 16 * s + 8 * hf);
              const unsigned u[4] = {qr[s].x, qr[s].y, qr[s].z, qr[s].w};
#pragma unroll
              for (int e = 0; e < 4; ++e) { const float a = bflo(u[e]), bb = bfhi(u[e]); ss += a * a + bb * bb; } }
          ss += __shfl_xor(ss, 32);
          const float rq = rsqrtf(ss * (1.f / kHD) + kEPS) * kC2;
#pragma unroll
          for (int s = 0; s < 8; ++s) { const int d0 = 16 * s + 8 * hf;
              const f32x4 w0 = *(const f32x4*)(qw + d0) * *(const f32x4*)(kw + d0), w1 = *(const f32x4*)(qw + d0 + 4) * *(const f32x4*)(kw + d0 + 4);
              const unsigned u[4] = {qr[s].x, qr[s].y, qr[s].z, qr[s].w};
              u32x4 pk; pk.x = pk_bf16(bflo(u[0]) * rq * w0[0], bfhi(u[0]) * rq * w0[1]); pk.y = pk_bf16(bflo(u[1]) * rq * w0[2], bfhi(u[1]) * rq * w0[3]);
              pk.z = pk_bf16(bflo(u[2]) * rq * w1[0], bfhi(u[2]) * rq * w1[1]); pk.w = pk_bf16(bflo(u[3]) * rq * w1[2], bfhi(u[3]) * rq * w1[3]);
              *(LAS u32x4*)(qlds + 1024 * s) = pk; } }
        f32x16 o[4];
#pragma unroll
        for (int cc = 0; cc < 4; ++cc)
#pragma unroll
            for (int r = 0; r < 16; ++r) o[cc][r] = 0.f;
        float carry = 0.f; bool wactive = true;
        int jt = (q0 + 255) >> 6, cur = 0;
        u32x4 kr[2], vr[2];
#define AT_LOAD(jt_) do { _Pragma("unroll") for (int i = 0; i < 2; ++i) { const bf16_t* rp = base + (size_t)(64 * (jt_) + skey + 32 * i) * kNPROJ + sch * 8; \
            kr[i] = *(const u32x4*)(rp + kSB); vr[i] = *(const u32x4*)(rp + 2 * kSB); } } while (0)
        AT_LOAD(jt);
        for (;;) {
            LAS unsigned char* kbuf = lds + cur * 32768; LAS unsigned char* vbuf = kbuf + 16384;
#pragma unroll
            for (int i = 0; i < 2; ++i) { const unsigned u[4] = {kr[i].x, kr[i].y, kr[i].z, kr[i].w}; float f[8]; float ss = 0.f;
#pragma unroll
                for (int e = 0; e < 4; ++e) { f[2 * e] = bflo(u[e]); f[2 * e + 1] = bfhi(u[e]); ss += f[2 * e] * f[2 * e] + f[2 * e + 1] * f[2 * e + 1]; }
                ss += __shfl_xor(ss, 1); ss += __shfl_xor(ss, 2); ss += __shfl_xor(ss, 4); ss += __shfl_xor(ss, 8);
                const float rk = rsqrtf(ss * (1.f / kHD) + kEPS);
                u32x4 pk; pk.x = pk_bf16(f[0] * rk, f[1] * rk); pk.y = pk_bf16(f[2] * rk, f[3] * rk); pk.z = pk_bf16(f[4] * rk, f[5] * rk); pk.w = pk_bf16(f[6] * rk, f[7] * rk);
                const unsigned a = off_b(skey + 32 * i, sch);
                *(LAS u32x4*)(kbuf + a) = pk; *(LAS u32x4*)(vbuf + a) = vr[i]; }
            const int any = __syncthreads_or(wactive ? 1 : 0);
            if (!any) break;
            const int jtc = jt;
            if (jt > 0) AT_LOAD(jt - 1);
            if (wactive && 64 * jtc < r0 + 31) {
                f32x16 s0, s1;
#pragma unroll
                for (int r = 0; r < 16; ++r) { s0[r] = 0.f; s1[r] = 0.f; }
#pragma unroll
                for (int s = 0; s < 8; ++s) { const unsigned a = krow + ((32u * s) ^ kY);
                    const bf16x8 k0 = *(const LAS bf16x8*)(kbuf + a), k1 = *(const LAS bf16x8*)(kbuf + 8192 + a), qv = *(const LAS bf16x8*)(qlds + 1024 * s);
                    s0 = __builtin_amdgcn_mfma_f32_32x32x16_bf16(k0, qv, s0, 0, 0, 0); s1 = __builtin_amdgcn_mfma_f32_32x32x16_bf16(k1, qv, s1, 0, 0, 0); }
                const int tabs = r0 + ql, kbase0 = 64 * jtc + 4 * hf;
                float run = carry; u32x4 pfr[2][2];
#pragma unroll
                for (int kb = 1; kb >= 0; --kb) {
                    float sp[16], gp[4], T[4];
#pragma unroll
                    for (int r = 0; r < 16; ++r) { const float z = kb ? s1[r] : s0[r]; const int key = kbase0 + 32 * kb + 8 * (r >> 2) + (r & 3);
                        const float v = __builtin_amdgcn_logf(1.f + __builtin_amdgcn_exp2f(z)); sp[r] = key < tabs ? v : 0.f; }
#pragma unroll
                    for (int g = 0; g < 4; ++g) { const float gsum = (sp[4 * g] + sp[4 * g + 1]) + (sp[4 * g + 2] + sp[4 * g + 3]);
                        const auto sw = __builtin_amdgcn_permlane32_swap(__float_as_uint(gsum), __float_as_uint(gsum), false, false);
                        const float lo = __uint_as_float(sw[0]), hi = __uint_as_float(sw[1]);
                        T[g] = lo + hi; gp[g] = hf ? 0.f : hi; }
#pragma unroll
                    for (int g = 3; g >= 0; --g) { const float offs = run + gp[g];
                        const float c3 = offs + sp[4 * g + 3], c2 = c3 + sp[4 * g + 2], c1 = c2 + sp[4 * g + 1], c0 = c1 + sp[4 * g];
                        const float cs[4] = {c0, c1, c2, c3};
#pragma unroll
                        for (int i = 0; i < 4; ++i) { const int r = 4 * g + i; const float z = kb ? s1[r] : s0[r]; const int key = kbase0 + 32 * kb + 8 * g + i;
                            const float e = __builtin_amdgcn_exp2f(z - cs[i]); sp[r] = key < tabs ? e : 0.f; }
                        run += T[g]; }
#pragma unroll
                    for (int s2 = 0; s2 < 2; ++s2) { u32x4 pk; pk.x = pk_bf16(sp[8 * s2], sp[8 * s2 + 1]); pk.y = pk_bf16(sp[8 * s2 + 2], sp[8 * s2 + 3]);
                        pk.z = pk_bf16(sp[8 * s2 + 4], sp[8 * s2 + 5]); pk.w = pk_bf16(sp[8 * s2 + 6], sp[8 * s2 + 7]); pfr[kb][s2] = pk; }
                }
                carry = run;
                const unsigned vb0 = ldsb + (unsigned)cur * 32768u + 16384u;
#define AT_PV(cc) do { const unsigned a0 = vb0 + va[cc][0], a1 = vb0 + va[cc][1]; \
                    const s16x4 l00 = fg::tr_read<0>(a0), h00 = fg::tr_read<0>(a1), l01 = fg::tr_read<4096>(a0), h01 = fg::tr_read<4096>(a1); \
                    const s16x4 l10 = fg::tr_read<8192>(a0), h10 = fg::tr_read<8192>(a1), l11 = fg::tr_read<12288>(a0), h11 = fg::tr_read<12288>(a1); \
                    asm volatile("s_waitcnt lgkmcnt(0)" ::: "memory"); __builtin_amdgcn_sched_barrier(0); \
                    o[cc] = __builtin_amdgcn_mfma_f32_32x32x16_bf16(FG_PK(l00, h00), __builtin_bit_cast(bf16x8, pfr[0][0]), o[cc], 0, 0, 0); \
                    o[cc] = __builtin_amdgcn_mfma_f32_32x32x16_bf16(FG_PK(l01, h01), __builtin_bit_cast(bf16x8, pfr[0][1]), o[cc], 0, 0, 0); \
                    o[cc] = __builtin_amdgcn_mfma_f32_32x32x16_bf16(FG_PK(l10, h10), __builtin_bit_cast(bf16x8, pfr[1][0]), o[cc], 0, 0, 0); \
                    o[cc] = __builtin_amdgcn_mfma_f32_32x32x16_bf16(FG_PK(l11, h11), __builtin_bit_cast(bf16x8, pfr[1][1]), o[cc], 0, 0, 0); } while (0)
                AT_PV(0); AT_PV(1); AT_PV(2); AT_PV(3);
#undef AT_PV
                wactive = __any(carry <= kDoneThresh);
            }
            if (jt == 0) break;
            --jt; cur ^= 1;
        }
#undef AT_LOAD
        bf16_t* orow = cat + (size_t)(b * kS + r0 + ql) * kD + h * kHD + 4 * hf;
#pragma unroll
        for (int cc = 0; cc < 4; ++cc)
#pragma unroll
            for (int g = 0; g < 4; ++g) { u32x2 w; w.x = pk_bf16(o[cc][4 * g], o[cc][4 * g + 1]); w.y = pk_bf16(o[cc][4 * g + 2], o[cc][4 * g + 3]); *(u32x2*)(orow + 32 * cc + 8 * g) = w; }
        __syncthreads();
    }
}
}

__device__ __forceinline__ void pool_p_phase(const bf16_t* __restrict__ proj, bf16_t* __restrict__ p, int G, int c) {
    for (int idx = c * 512 + threadIdx.x; idx < kT * (kPW / 8); idx += G * 512) {
        const int c8 = idx & 127, t = idx >> 7, s = t & (kS - 1), g = c8 >> 5, w = 2 << g, cnt = min(s + 1, w);
        const bf16_t* up = proj + (size_t)t * kNPROJ + 3 * kSB + c8 * 8;
        float acc[8], u0[8];
#pragma unroll
        for (int e = 0; e < 8; ++e) acc[e] = 0.f;
        for (int i = 0; i < cnt; ++i) { const uint4 v = *(const uint4*)(up - (size_t)i * kNPROJ); const unsigned u[4] = {v.x, v.y, v.z, v.w};
#pragma unroll
            for (int e = 0; e < 4; ++e) { const float a = bflo(u[e]), bb = bfhi(u[e]); acc[2 * e] += a; acc[2 * e + 1] += bb; if (i == 0) { u0[2 * e] = a; u0[2 * e + 1] = bb; } } }
        const float inv = 1.f / (float)cnt;
        u32x4 pk; pk.x = pk_bf16(acc[0] * inv - u0[0], acc[1] * inv - u0[1]); pk.y = pk_bf16(acc[2] * inv - u0[2], acc[3] * inv - u0[3]);
        pk.z = pk_bf16(acc[4] * inv - u0[4], acc[5] * inv - u0[5]); pk.w = pk_bf16(acc[6] * inv - u0[6], acc[7] * inv - u0[7]);
        *(u32x4*)(p + (size_t)t * kPW + c8 * 8) = pk;
    }
}


__device__ __forceinline__ unsigned pk4_fp8(float a, float b, float c, float d) { int p = __builtin_amdgcn_cvt_pk_fp8_f32(a, b, 0, false); p = __builtin_amdgcn_cvt_pk_fp8_f32(c, d, p, true); return (unsigned)p; }
__device__ __forceinline__ float clamp448(float v) { return __builtin_amdgcn_fmed3f(v, -448.f, 448.f); }
constexpr float kWScale = 64.f;

struct JobMoe1F8 {
    static constexpr bool GATHER = true;
    const char* A; unsigned lda2, ldb2, bhalf2; int K; const int* list;
    const char* B; const float* b_in; unsigned char* act; MoeTab M; int G, c;
    __device__ __forceinline__ bool next(int i, fg::Unit& u) const { int e, j, rb, cnt, rowbase; if (!M.decode(i, G, c, e, j, rb, cnt, rowbase)) return false;
        e = __builtin_amdgcn_readfirstlane(e); j = __builtin_amdgcn_readfirstlane(j); rb = __builtin_amdgcn_readfirstlane(rb); cnt = __builtin_amdgcn_readfirstlane(cnt); rowbase = __builtin_amdgcn_readfirstlane(rowbase);
        u.bBase = B + (size_t)e * ((size_t)2 * kDFF * kD) + (size_t)j * 128 * kD; u.arow0 = e * kT + rb * 256; u.nvalid = min(256, cnt - rb * 256); u.e = e; u.orow0 = rowbase + rb * 256; u.ocol0 = j * 128; u.acol2 = 0; return true; }
    __device__ __forceinline__ void epi(const f32x4 (&acc)[2][2][4][2], const fg::Unit& u, int wr, int wc, int fr, int fq) const {
        f32x4 bg[2], bl[2];
#pragma unroll
        for (int n = 0; n < 2; ++n) { const float* bp = b_in + (size_t)u.e * 2 * kDFF + u.ocol0 + wc * 32 + n * 16 + fq * 4; bg[n] = *(const f32x4*)bp; bl[n] = *(const f32x4*)(bp + kDFF); }
#pragma unroll
        FG_FOR_ROWS { unsigned char* rowp = act + (size_t)(u.orow0 + ai * 128 + wr * 64 + m * 16 + fr) * kDFF + u.ocol0 + wc * 32 + fq * 4;
#pragma unroll
            for (int n = 0; n < 2; ++n) { const f32x4 gv = acc[ai][0][m][n] + bg[n], lv = acc[ai][1][m][n] + bl[n]; float o[4];
#pragma unroll
                for (int j = 0; j < 4; ++j) { const float g = fminf(gv[j], 7.f), l = fminf(fmaxf(lv[j], -7.f), 7.f); o[j] = clamp448(g * __builtin_amdgcn_rcpf(1.f + __expf(-1.702f * g)) * (l + 1.f)); }
                *(unsigned*)(rowp + n * 16) = pk4_fp8(o[0], o[1], o[2], o[3]); } }
    }
};
struct JobMoe2F8 {
    static constexpr bool GATHER = false;
    const char* A; unsigned lda2, ldb2, bhalf2; int K; const int* list;
    const char* B; const float* b_out; bf16_t* yp; MoeTab M; int G, c;
    __device__ __forceinline__ bool next(int i, fg::Unit& u) const { int e, j, rb, cnt, rowbase; if (!M.decode(i, G, c, e, j, rb, cnt, rowbase)) return false;
        e = __builtin_amdgcn_readfirstlane(e); j = __builtin_amdgcn_readfirstlane(j); rb = __builtin_amdgcn_readfirstlane(rb); rowbase = __builtin_amdgcn_readfirstlane(rowbase);
        u.bBase = B + (size_t)e * ((size_t)kDFF * kD) + (size_t)j * 256 * kDFF; u.arow0 = rowbase + rb * 256; u.nvalid = 256; u.e = e; u.orow0 = rowbase + rb * 256; u.ocol0 = j * 256; u.acol2 = 0; return true; }
    __device__ __forceinline__ void epi(const f32x4 (&acc)[2][2][4][2], const fg::Unit& u, int wr, int wc, int fr, int fq) const {
        f32x4 bo[2][2];
#pragma unroll
        for (int bj = 0; bj < 2; ++bj)
#pragma unroll
            for (int n = 0; n < 2; ++n) bo[bj][n] = *(const f32x4*)(b_out + (size_t)u.e * kD + u.ocol0 + bj * 128 + wc * 32 + n * 16 + fq * 4);
#pragma unroll
        FG_FOR_ROWS { bf16_t* rowp = yp + (size_t)(u.orow0 + ai * 128 + wr * 64 + m * 16 + fr) * kD + u.ocol0 + wc * 32 + fq * 4;
#pragma unroll
            for (int bj = 0; bj < 2; ++bj)
#pragma unroll
                for (int n = 0; n < 2; ++n) { const f32x4 v = acc[ai][bj][m][n] + bo[bj][n]; u32x2 w; w.x = pk_bf16(v[0], v[1]); w.y = pk_bf16(v[2], v[3]); *(u32x2*)(rowp + bj * 128 + n * 16) = w; } }
    }
};

struct CvtT { const float* src; unsigned char* dst; int K, N, tn, per; };
__device__ __forceinline__ CvtT cvt_make(const float* src, unsigned char* dst, int K, int N) { CvtT c; c.src = src; c.dst = dst; c.K = K; c.N = N; c.tn = N / 64; c.per = (K / 128) * (N / 64); return c; }
__device__ __forceinline__ void cvt_load(const CvtT& C, int t, int kq, int nc, f32x4 (&v)[4]) {
    const int mat = t / C.per, r = t - mat * C.per, kt = r / C.tn, nt_ = r - kt * C.tn;
    const float* sp = C.src + (size_t)mat * C.K * C.N + (size_t)(kt * 128 + 4 * kq) * C.N + nt_ * 64 + 4 * nc;
#pragma unroll
    for (int i = 0; i < 4; ++i) v[i] = __builtin_nontemporal_load((const f32x4*)(sp + (size_t)i * C.N));
}
__device__ __forceinline__ void cvt_emit(const CvtT& C, int t, LAS unsigned* L, const f32x4 (&v)[4], int kq, int nc, int rn, int rc) {
#pragma unroll
    for (int j = 0; j < 4; ++j) L[(4 * nc + j) * 33 + kq] = pk4_fp8(v[0][j] * kWScale, v[1][j] * kWScale, v[2][j] * kWScale, v[3][j] * kWScale);
    __syncthreads();
    const int mat = t / C.per, r = t - mat * C.per, kt = r / C.tn, nt_ = r - kt * C.tn;
    u32x4 o; o.x = L[rn * 33 + 4 * rc]; o.y = L[rn * 33 + 4 * rc + 1]; o.z = L[rn * 33 + 4 * rc + 2]; o.w = L[rn * 33 + 4 * rc + 3];
    __builtin_nontemporal_store(o, (u32x4*)(C.dst + (size_t)mat * C.K * C.N + (size_t)(nt_ * 64 + rn) * C.K + kt * 128 + rc * 16));
}
__device__ __forceinline__ void convert_t_f8(LAS unsigned char* lds, const CvtT C, int t0, int t1, int stride) {
    const int tid = threadIdx.x, kq = tid >> 4, nc = tid & 15, rn = tid >> 3, rc = tid & 7;
    LAS unsigned* L0 = (LAS unsigned*)lds; LAS unsigned* L1 = L0 + 64 * 33 + 16;
    f32x4 v0[4], v1[4], v2[4], v3[4], v4[4], v5[4];
    int t = t0;
    __syncthreads();
#define CV_LD(V, k) do { if (t + (k) * stride < t1) cvt_load(C, t + (k) * stride, kq, nc, V); } while (0)
#define CV_EM(V, k, L) do { if (t + (k) * stride >= t1) break; cvt_emit(C, t + (k) * stride, L, V, kq, nc, rn, rc); } while (0)
    CV_LD(v0, 0); CV_LD(v1, 1); CV_LD(v2, 2); CV_LD(v3, 3); CV_LD(v4, 4);
    for (; t < t1; t += 6 * stride) {
        CV_LD(v5, 5);  CV_EM(v0, 0, L0);
        CV_LD(v0, 6);  CV_EM(v1, 1, L1);
        CV_LD(v1, 7);  CV_EM(v2, 2, L0);
        CV_LD(v2, 8);  CV_EM(v3, 3, L1);
        CV_LD(v3, 9);  CV_EM(v4, 4, L0);
        CV_LD(v4, 10); CV_EM(v5, 5, L1);
    }
#undef CV_LD
#undef CV_EM
    __syncthreads();
}

__device__ __forceinline__ void convert_seg(const float* __restrict__ src, bf16_t* __restrict__ dst, size_t n8, size_t gtid, size_t gstride) {
    const f32x4* s4 = (const f32x4*)src; u32x4* d4 = (u32x4*)dst;
#pragma unroll 4
    for (size_t i = gtid; i < n8; i += gstride) { const f32x4 a = __builtin_nontemporal_load(s4 + 2 * i), b = __builtin_nontemporal_load(s4 + 2 * i + 1);
        u32x4 w; w.x = pk_bf16(a[0], a[1]); w.y = pk_bf16(a[2], a[3]); w.z = pk_bf16(b[0], b[1]); w.w = pk_bf16(b[2], b[3]); d4[i] = w; }
}


#define XB_TMO      128
#define XB_XCNT(j)  (256  + 64 * (j))
#define XB_XSUB(j)  (1280 + 64 * (j))
#define XB_XGEN(j)  (2304 + 64 * (j))
#define XB_TOP      3328
#define XB_TOPGEN   3392
#define XCD_BAR_WORDS 3456
#define XB_SPIN_CAP (1u << 18)
__device__ __forceinline__ unsigned xb_ld(unsigned* p)              { return __hip_atomic_load(p, __ATOMIC_RELAXED, __HIP_MEMORY_SCOPE_AGENT); }
__device__ __forceinline__ unsigned xb_add(unsigned* p, unsigned v) { return __hip_atomic_fetch_add(p, v, __ATOMIC_RELAXED, __HIP_MEMORY_SCOPE_AGENT); }
__device__ __forceinline__ unsigned xb_xcc_id() { return (unsigned)__builtin_amdgcn_s_getreg((3 << 11) | 20) & 0xFu; }
#define XB_SPIN(cond, bar) do { unsigned _sp = 0; while (cond) { __builtin_amdgcn_s_sleep(1); \
    if ((++_sp & 255u) == 0u) { if (xb_ld(&(bar)[XB_TMO])) break; if (_sp > XB_SPIN_CAP) { atomicAdd(&(bar)[XB_TMO], 1u); break; } } } } while (0)
struct XcdBarrier { unsigned* bar; unsigned x; volatile LAS unsigned* st; };
__device__ __forceinline__ XcdBarrier xcd_barrier_post(unsigned* bar, volatile LAS unsigned* st) {
    XcdBarrier b; b.bar = bar; b.x = xb_xcc_id(); b.st = st;
    if (threadIdx.x == 0) (void)xb_add(&bar[XB_XCNT(b.x)], 1u);
    return b;
}
__device__ __forceinline__ void xcd_barrier_complete(unsigned* bar, unsigned x, unsigned& nloc, unsigned& nx) {
    const unsigned G = gridDim.x * gridDim.y * gridDim.z;
    unsigned sum, cnt, mine, sp = 0u;
    for (;;) {
        sum = 0u; cnt = 0u; mine = 0u;
#pragma unroll
        for (unsigned j = 0; j < 16; ++j) { const unsigned c = xb_ld(&bar[XB_XCNT(j)]); sum += c; cnt += (c > 0u) ? 1u : 0u; mine = (j == x) ? c : mine; }
        if (sum == G) break;
        __builtin_amdgcn_s_sleep(1);
        if ((++sp & 255u) == 0u) { if (xb_ld(&bar[XB_TMO])) break; if (sp > XB_SPIN_CAP) { atomicAdd(&bar[XB_TMO], 1u); break; } }
    }
    nloc = mine > 0u ? mine : 1u; nx = cnt > 0u ? cnt : 1u;
}
__device__ __forceinline__ void xcd_barrier(const XcdBarrier& b) {
    asm volatile("s_waitcnt vmcnt(0)" ::: "memory");
    __syncthreads();
    if (threadIdx.x == 0) {
        unsigned* bar = b.bar;
        __builtin_amdgcn_s_waitcnt(0);
        unsigned nloc = b.st[0], nx = b.st[1];
        if (nloc == 0u) { xcd_barrier_complete(bar, b.x, nloc, nx); b.st[0] = nloc; b.st[1] = nx; }
        const unsigned old = xb_add(&bar[XB_XSUB(b.x)], 1u);
        const unsigned gen = old / nloc;
        if (old + 1u == (gen + 1u) * nloc) {
            __builtin_amdgcn_fence(__ATOMIC_RELEASE, "agent");
            asm volatile("s_waitcnt vmcnt(0)" ::: "memory");
            const unsigned og = xb_add(&bar[XB_TOP], 1u);
            const unsigned tg = og / nx;
            if (og + 1u == (tg + 1u) * nx) xb_add(&bar[XB_TOPGEN], 1u);
            else XB_SPIN(xb_ld(&bar[XB_TOPGEN]) == tg, bar);
            __builtin_amdgcn_fence(__ATOMIC_ACQUIRE, "agent");
            xb_add(&bar[XB_XGEN(b.x)], 1u);
            asm volatile("s_waitcnt vmcnt(0)" ::: "memory");
        } else {
            XB_SPIN(xb_ld(&bar[XB_XGEN(b.x)]) == gen, bar);
            __builtin_amdgcn_fence(__ATOMIC_ACQUIRE, "agent");
            asm volatile("s_waitcnt vmcnt(0)" ::: "memory");
        }
    }
    __syncthreads();
}

__device__ __forceinline__ void ada_phase(LAS unsigned char* lds, const float* __restrict__ cvec, const float* __restrict__ w_ada, const float* __restrict__ b_ada, float* __restrict__ mod, int G, int c) {
    LAS float* ca = (LAS float*)lds;
    LAS float* part = (LAS float*)(lds + 32768);
    const int tid = threadIdx.x;
    __syncthreads();
    for (int i = tid; i < kB * kD; i += 512) { const float v = cvec[i]; ca[i] = v / (1.f + __expf(-v)); }
    __syncthreads();
    for (int cb = c; cb < 6 * kD / 48; cb += G) {
        const int n0 = cb * 48, cg = tid % 12, kr = tid / 12;
        if (tid < 504) {
            f32x4 a0 = {0.f, 0.f, 0.f, 0.f}, a1 = a0, a2 = a0, a3 = a0;
#pragma unroll 8
            for (int k = kr; k < kD; k += 42) { const f32x4 w = __builtin_nontemporal_load((const f32x4*)(w_ada + (size_t)k * (6 * kD) + n0 + cg * 4));
                a0 += ca[k] * w; a1 += ca[kD + k] * w; a2 += ca[2 * kD + k] * w; a3 += ca[3 * kD + k] * w; }
            LAS f32x4* pp = (LAS f32x4*)(part + (kr * 12 + cg) * 16); pp[0] = a0; pp[1] = a1; pp[2] = a2; pp[3] = a3;
        }
        __syncthreads();
        if (tid < 192) { const int col = tid % 48, b = tid / 48; float sum = 0.f;
            for (int r = 0; r < 42; ++r) sum += part[(r * 12 + (col >> 2)) * 16 + b * 4 + (col & 3)];
            mod[b * 6 * kD + n0 + col] = sum + b_ada[n0 + col]; }
        __syncthreads();
    }
}

__device__ __forceinline__ void norm1_phase(const float* __restrict__ x, const float* __restrict__ nw, const float* __restrict__ mod, bf16_t* __restrict__ out, int G, int c) {
    const int wid = threadIdx.x >> 6, lane = threadIdx.x & 63;
    for (int t = c * 8 + wid; t < kT; t += G * 8) {
        const int b = t / kS; const float* xr = x + (size_t)t * kD + lane * 4; const float* mb = mod + b * 6 * kD + lane * 4;
        f32x4 v[8]; float ss = 0.f;
#pragma unroll
        for (int j = 0; j < 8; ++j) { v[j] = *(const f32x4*)(xr + 256 * j); ss += v[j][0] * v[j][0] + v[j][1] * v[j][1] + v[j][2] * v[j][2] + v[j][3] * v[j][3]; }
        ss = wave_sum(ss);
        const float r = rsqrtf(ss * (1.f / kD) + kEPS);
#pragma unroll
        for (int j = 0; j < 8; ++j) { const f32x4 w = *(const f32x4*)(nw + lane * 4 + 256 * j), sh = *(const f32x4*)(mb + 256 * j), sc = *(const f32x4*)(mb + kD + 256 * j);
            const f32x4 y = v[j] * r * w * (1.f + sc) + sh; u32x2 o; o.x = pk_bf16(y[0], y[1]); o.y = pk_bf16(y[2], y[3]);
            *(u32x2*)(out + (size_t)t * kD + lane * 4 + 256 * j) = o; }
    }
}

constexpr int RT_STRIDE = 144;
__device__ __forceinline__ void norm2_router_phase(LAS unsigned char* lds, const float* __restrict__ x1, const float* __restrict__ nw, const float* __restrict__ mod,
                                                   const float* __restrict__ w_router, const float* __restrict__ b_router, unsigned char* __restrict__ h2,
                                                   float* __restrict__ gates, int* __restrict__ pair_e, int* __restrict__ pair_p, int* __restrict__ list, unsigned* __restrict__ ctrl, int G, int c) {
    const int tid = threadIdx.x, wid = tid >> 6, lane = tid & 63;
    for (int blk = c; blk < kT / 32; blk += G) {
#pragma unroll 1
        for (int pass = 0; pass < 2; ++pass) {
            const int t0 = blk * 32 + wid * 4 + pass * 2, b = t0 / kS;
            float rs[2];
#pragma unroll
            for (int rr = 0; rr < 2; ++rr) { const float* xr = x1 + (size_t)(t0 + rr) * kD + 2 * lane; float ss = 0.f;
#pragma unroll
                for (int i = 0; i < 16; ++i) { const f32x2 v = *(const f32x2*)(xr + 128 * i); ss += v[0] * v[0] + v[1] * v[1]; }
                ss = wave_sum(ss); rs[rr] = rsqrtf(ss * (1.f / kD) + kEPS); }
            f32x4 acc[2][8];
#pragma unroll
            for (int rr = 0; rr < 2; ++rr)
#pragma unroll
                for (int q = 0; q < 8; ++q) acc[rr][q] = (f32x4){0.f, 0.f, 0.f, 0.f};
#pragma unroll 1
            for (int q = 0; q < 4; ++q) {
                __syncthreads();
#pragma unroll
                for (int j = 0; j < 8; ++j) { const int idx = tid + 512 * j, row = idx >> 3, ch = idx & 7;
                    *(LAS f32x4*)(lds + row * RT_STRIDE + ch * 16) = *(const f32x4*)(w_router + (size_t)(512 * q + row) * kE + ch * 4); }
                f32x2 yq[2][4];
#pragma unroll
                for (int ii = 0; ii < 4; ++ii) { const int n = 2 * lane + 128 * (4 * q + ii);
                    const f32x2 w = *(const f32x2*)(nw + n), sh = *(const f32x2*)(mod + b * 6 * kD + 3 * kD + n), sc = *(const f32x2*)(mod + b * 6 * kD + 4 * kD + n);
#pragma unroll
                    for (int rr = 0; rr < 2; ++rr) { const f32x2 v = *(const f32x2*)(x1 + (size_t)(t0 + rr) * kD + n); yq[rr][ii] = v * rs[rr] * w * (1.f + sc) + sh;
                        *(unsigned short*)(h2 + (size_t)(t0 + rr) * kD + n) = (unsigned short)__builtin_amdgcn_cvt_pk_fp8_f32(clamp448(yq[rr][ii][0]), clamp448(yq[rr][ii][1]), 0, false); } }
                __syncthreads();
#pragma unroll
                for (int ii = 0; ii < 4; ++ii)
#pragma unroll
                    for (int e = 0; e < 2; ++e) { const LAS unsigned char* wp = lds + (2 * lane + 128 * ii + e) * RT_STRIDE;
#pragma unroll
                        for (int ch = 0; ch < 8; ++ch) { const f32x4 wv = *(const LAS f32x4*)(wp + ch * 16);
                            acc[0][ch] += yq[0][ii][e] * wv; acc[1][ch] += yq[1][ii][e] * wv; } }
            }
#pragma unroll
            for (int rr = 0; rr < 2; ++rr) {
                float v16[16], v8[8], v4[4], v2[2], v1;
                { const bool up = lane & 32;
#pragma unroll
                  for (int j = 0; j < 16; ++j) { const float lo = acc[rr][j >> 2][j & 3], hi = acc[rr][4 + (j >> 2)][j & 3]; const float send = up ? lo : hi, keep = up ? hi : lo; v16[j] = keep + __shfl_xor(send, 32); } }
                { const bool up = lane & 16;
#pragma unroll
                  for (int j = 0; j < 8; ++j) { const float send = up ? v16[j] : v16[j + 8], keep = up ? v16[j + 8] : v16[j]; v8[j] = keep + __shfl_xor(send, 16); } }
                { const bool up = lane & 8;
#pragma unroll
                  for (int j = 0; j < 4; ++j) { const float send = up ? v8[j] : v8[j + 4], keep = up ? v8[j + 4] : v8[j]; v4[j] = keep + __shfl_xor(send, 8); } }
                { const bool up = lane & 4;
#pragma unroll
                  for (int j = 0; j < 2; ++j) { const float send = up ? v4[j] : v4[j + 2], keep = up ? v4[j + 2] : v4[j]; v2[j] = keep + __shfl_xor(send, 4); } }
                { const bool up = lane & 2; const float send = up ? v2[0] : v2[1], keep = up ? v2[1] : v2[0]; v1 = keep + __shfl_xor(send, 2); }
                v1 += __shfl_xor(v1, 1);
                const int e_mine = (lane >> 1) & 31;
                float mine = (lane & 1) ? -3.4e38f : v1 + b_router[e_mine];
                int idx[4]; float val[4];
#pragma unroll
                for (int k = 0; k < 4; ++k) { float bv = mine; int bi = e_mine + ((lane & 1) << 6);
#pragma unroll
                    for (int o = 32; o > 0; o >>= 1) { const float ov = __shfl_xor(bv, o); const int oi = __shfl_xor(bi, o); if (ov > bv || (ov == bv && oi < bi)) { bv = ov; bi = oi; } }
                    idx[k] = bi; val[k] = bv; if (!(lane & 1) && e_mine == bi) mine = -3.4e38f; }
                if (lane == 0) { const int t = t0 + rr; float ex[4], sum = 0.f;
#pragma unroll
                    for (int k = 0; k < 4; ++k) { ex[k] = __expf(val[k] - val[0]); sum += ex[k]; }
                    const float inv = 1.f / sum;
#pragma unroll
                    for (int k = 0; k < 4; ++k) { gates[t * 4 + k] = ex[k] * inv; pair_e[t * 4 + k] = idx[k];
                        const unsigned pos = atomicAdd(&ctrl[CT_CNT + 64 * idx[k]], 1u); pair_p[t * 4 + k] = (int)pos; list[(size_t)idx[k] * kT + pos] = t; } }
            }
        }
    }
}

__device__ __forceinline__ void final_phase(const float* __restrict__ x1, const float* __restrict__ mod, const float* __restrict__ gates, const int* __restrict__ pair_e, const int* __restrict__ pair_p,
                                            const MoeTab M, const bf16_t* __restrict__ yp, float* __restrict__ out, int G, int c) {
    const int wid = threadIdx.x >> 6, lane = threadIdx.x & 63;
    for (int t = c * 8 + wid; t < kT; t += G * 8) {
        const int b = t / kS; float gk[4]; const bf16_t* rp[4];
#pragma unroll
        for (int k = 0; k < 4; ++k) { gk[k] = gates[t * 4 + k]; const int e = pair_e[t * 4 + k];
            rp[k] = yp + (size_t)(M.t[32 + e] + pair_p[t * 4 + k]) * kD + lane * 8; }
#pragma unroll
        for (int j = 0; j < 4; ++j) { f32x4 y0 = {0.f, 0.f, 0.f, 0.f}, y1 = y0;
#pragma unroll
            for (int k = 0; k < 4; ++k) { const u32x4 v = *(const u32x4*)(rp[k] + 512 * j);
                y0 += gk[k] * (f32x4){bflo(v.x), bfhi(v.x), bflo(v.y), bfhi(v.y)}; y1 += gk[k] * (f32x4){bflo(v.z), bfhi(v.z), bflo(v.w), bfhi(v.w)}; }
            const size_t o = (size_t)t * kD + lane * 8 + 512 * j; const float* gp = mod + b * 6 * kD + 5 * kD + lane * 8 + 512 * j;
            *(f32x4*)(out + o) = *(const f32x4*)(x1 + o) + *(const f32x4*)gp * y0; *(f32x4*)(out + o + 4) = *(const f32x4*)(x1 + o + 4) + *(const f32x4*)(gp + 4) * y1; }
    }
}

struct MegaArgs { const float* in[18]; float* out; unsigned char* ws; int ph_lo, ph_hi; };
constexpr int NPHASE = 10;
__global__ void __launch_bounds__(512, 2) mega(MegaArgs a) {
    extern __shared__ __attribute__((aligned(16))) unsigned char lds_raw[];
    LAS unsigned char* lds = (LAS unsigned char*)lds_raw;
    unsigned char* ws = a.ws;
    const int lo = a.ph_lo, hi = a.ph_hi;
#ifndef DUP_PHASE
#define DUP_PHASE -1
#endif
#define IN(k) (lo <= (k) && (k) < hi)
#define REP(k)
#define DUPQ(k) ((k) == DUP_PHASE)
#define SEAM(k) do { if (IN(k) && IN((k) + 1)) xcd_barrier(bar); } while (0)
    const int G = gridDim.x, c = blockIdx.x;
    unsigned* ctrl = (unsigned*)(ws + WS_CTRL);
    const int grp = (c >> 3) & 1;
    const CvtT C1 = cvt_make(a.in[14], (unsigned char*)(ws + WS_WE1), kD, 2 * kDFF);
    const CvtT C2 = cvt_make(a.in[16], (unsigned char*)(ws + WS_WE2), kDFF, kD);
    const int c1_a = 64 * G, c1_b = 88 * G;
    if (threadIdx.x == 0) *(LAS u32x4*)(lds + fg::MISC_OFF) = (u32x4){0u, 0u, 0u, 0u};
    __syncthreads();
    XcdBarrier bar; bar.bar = ctrl; bar.x = 0; bar.st = (volatile LAS unsigned*)(lds + fg::MISC_OFF);
    if (hi - lo > 1) bar = xcd_barrier_post(ctrl, (volatile LAS unsigned*)(lds + fg::MISC_OFF));
    float* mod = (float*)(ws + WS_MOD);
    if (IN(0)) REP(0) {
        ada_phase(lds, a.in[1], a.in[4], a.in[5], mod, G, c);
        const size_t gtid = (size_t)blockIdx.x * 512 + threadIdx.x, gstride = (size_t)G * 512;
        convert_seg(a.in[6], (bf16_t*)(ws + WS_WIN), (size_t)kD * kNPROJ / 8, gtid, gstride);
        convert_seg(a.in[11], (bf16_t*)(ws + WS_WO), (size_t)kD * kD / 8, gtid, gstride);
        { const f32x4* s4 = (const f32x4*)a.in[9]; const f32x4* sc4 = (const f32x4*)a.in[10]; u32x4* d4 = (u32x4*)(ws + WS_WPL);
          for (size_t i = gtid; i < (size_t)4 * kPG * kPG / 8; i += gstride) { const int g = (int)(i >> 13), n8 = (int)(i & 31);
              const f32x4 sa = sc4[g * 64 + n8 * 2], sb = sc4[g * 64 + n8 * 2 + 1]; const f32x4 a0 = s4[2 * i] * sa, b0 = s4[2 * i + 1] * sb;
              u32x4 w; w.x = pk_bf16(a0[0], a0[1]); w.y = pk_bf16(a0[2], a0[3]); w.z = pk_bf16(b0[0], b0[1]); w.w = pk_bf16(b0[2], b0[3]); d4[i] = w; } }
    }
    SEAM(0);
    if (IN(1)) REP(1) norm1_phase(a.in[0], a.in[2], mod, (bf16_t*)(ws + WS_H), G, c);
    if (IN(1) && DUPQ(1)) norm1_phase(a.in[0], a.in[2], mod, (bf16_t*)(ws + WS_H), G, c);
    SEAM(1);
    if (IN(2) && grp == 0) convert_t_f8(lds, C1, c, c1_a, G);
    if (IN(2)) REP(2) { JobInProj J; J.A = (const char*)(ws + WS_H); J.lda2 = kD * 2; J.ldb2 = kNPROJ * 2; J.bhalf2 = 256; J.K = kD; J.list = nullptr;
        J.B = (const char*)(ws + WS_WIN); J.out = (bf16_t*)(ws + WS_PROJ); J.S.init(kT, kNPROJ, G, c); fg::gemm_phase(lds, J); }
    if (IN(2) && DUPQ(2)) { JobInProj J; J.A = (const char*)(ws + WS_H); J.lda2 = kD * 2; J.ldb2 = kNPROJ * 2; J.bhalf2 = 256; J.K = kD; J.list = nullptr;
        J.B = (const char*)(ws + WS_WIN); J.out = (bf16_t*)(ws + WS_PROJ); J.S.init(kT, kNPROJ, G, c); fg::gemm_phase(lds, J); }
    if (IN(2) && grp == 1) convert_t_f8(lds, C1, c, c1_a, G);
    SEAM(2);
    if (IN(3) && grp == 0) convert_t_f8(lds, C1, c1_a + c, c1_b, G);
    if (IN(3)) REP(3) { at::attn_phase(lds, (const bf16_t*)(ws + WS_PROJ), a.in[7], a.in[8], (bf16_t*)(ws + WS_CAT), G, c);
        pool_p_phase((const bf16_t*)(ws + WS_PROJ), (bf16_t*)(ws + WS_P), G, c); }
    if (IN(3) && DUPQ(3)) { at::attn_phase(lds, (const bf16_t*)(ws + WS_PROJ), a.in[7], a.in[8], (bf16_t*)(ws + WS_CAT), G, c);
        pool_p_phase((const bf16_t*)(ws + WS_PROJ), (bf16_t*)(ws + WS_P), G, c); }
    if (IN(3) && grp == 1) convert_t_f8(lds, C1, c1_a + c, c1_b, G);
    SEAM(3);
    if (IN(4)) REP(4) { JobPool J; J.A = (const char*)(ws + WS_P); J.lda2 = kPW * 2; J.ldb2 = kPG * 2; J.bhalf2 = 256; J.K = kPG; J.list = nullptr;
        J.B = (const char*)(ws + WS_WPL); J.cat = (bf16_t*)(ws + WS_CAT); J.G = G; J.c = c; fg::gemm_phase(lds, J); }
    if (IN(4) && DUPQ(4)) { JobPool J; J.A = (const char*)(ws + WS_P); J.lda2 = kPW * 2; J.ldb2 = kPG * 2; J.bhalf2 = 256; J.K = kPG; J.list = nullptr;
        J.B = (const char*)(ws + WS_WPL); J.cat = (bf16_t*)(ws + WS_CAT); J.G = G; J.c = c; fg::gemm_phase(lds, J); }
    SEAM(4);
    if (IN(5) && grp == 0) convert_t_f8(lds, C1, c1_b + c, kE * C1.per, G);
    if (IN(5)) REP(5) { JobOutProj J; J.A = (const char*)(ws + WS_CAT); J.lda2 = kD * 2; J.ldb2 = kD * 2; J.bhalf2 = 256; J.K = kD; J.list = nullptr;
        J.B = (const char*)(ws + WS_WO); J.x = a.in[0]; J.mod = mod; J.x1 = (float*)(ws + WS_X1); J.S.init(kT, kD, G, c); fg::gemm_phase(lds, J); }
    if (IN(5) && DUPQ(5)) { JobOutProj J; J.A = (const char*)(ws + WS_CAT); J.lda2 = kD * 2; J.ldb2 = kD * 2; J.bhalf2 = 256; J.K = kD; J.list = nullptr;
        J.B = (const char*)(ws + WS_WO); J.x = a.in[0]; J.mod = mod; J.x1 = (float*)(ws + WS_X1); J.S.init(kT, kD, G, c); fg::gemm_phase(lds, J); }
    if (IN(5) && grp == 1) convert_t_f8(lds, C1, c1_b + c, kE * C1.per, G);
    SEAM(5);
    if (IN(6)) REP(6) norm2_router_phase(lds, (const float*)(ws + WS_X1), a.in[3], mod, a.in[12], a.in[13], (unsigned char*)(ws + WS_H2), (float*)(ws + WS_GATES), (int*)(ws + WS_PAIRE), (int*)(ws + WS_PAIRP),
                                  (int*)(ws + WS_LIST), ctrl, G, c);
    SEAM(6);
    if (IN(7) && grp == 0) convert_t_f8(lds, C2, c, kE * C2.per, G);
    if (IN(7)) REP(7) { JobMoe1F8 J; J.A = (const char*)(ws + WS_H2); J.lda2 = kD; J.ldb2 = kD; J.bhalf2 = (unsigned)kDFF * kD; J.K = kD; J.list = (const int*)(ws + WS_LIST);
        J.B = (const char*)(ws + WS_WE1); J.b_in = a.in[15]; J.act = (unsigned char*)(ws + WS_ACT); J.M = moe_tables(lds, ctrl, kDFF / 128); J.G = G; J.c = c; fg::gemm_phase_f8(lds, J); }
    if (IN(7) && DUPQ(7)) { JobMoe1F8 J; J.A = (const char*)(ws + WS_H2); J.lda2 = kD; J.ldb2 = kD; J.bhalf2 = (unsigned)kDFF * kD; J.K = kD; J.list = (const int*)(ws + WS_LIST);
        J.B = (const char*)(ws + WS_WE1); J.b_in = a.in[15]; J.act = (unsigned char*)(ws + WS_ACT); J.M = moe_tables(lds, ctrl, kDFF / 128); J.G = G; J.c = c; fg::gemm_phase_f8(lds, J); }
    if (IN(7) && grp == 1) convert_t_f8(lds, C2, c, kE * C2.per, G);
    SEAM(7);
    if (IN(8)) REP(8) { JobMoe2F8 J; J.A = (const char*)(ws + WS_ACT); J.lda2 = kDFF; J.ldb2 = kDFF; J.bhalf2 = 128u * kDFF; J.K = kDFF; J.list = nullptr;
        J.B = (const char*)(ws + WS_WE2); J.b_out = a.in[17]; J.yp = (bf16_t*)(ws + WS_YP); J.M = moe_tables(lds, ctrl, kD / 256); J.G = G; J.c = c; fg::gemm_phase_f8(lds, J); }
    if (IN(8) && DUPQ(8)) { JobMoe2F8 J; J.A = (const char*)(ws + WS_ACT); J.lda2 = kDFF; J.ldb2 = kDFF; J.bhalf2 = 128u * kDFF; J.K = kDFF; J.list = nullptr;
        J.B = (const char*)(ws + WS_WE2); J.b_out = a.in[17]; J.yp = (bf16_t*)(ws + WS_YP); J.M = moe_tables(lds, ctrl, kD / 256); J.G = G; J.c = c; fg::gemm_phase_f8(lds, J); }
    SEAM(8);
    if (IN(9)) REP(9) final_phase((const float*)(ws + WS_X1), mod, (const float*)(ws + WS_GATES), (const int*)(ws + WS_PAIRE), (const int*)(ws + WS_PAIRP), moe_tables(lds, ctrl, 1), (const bf16_t*)(ws + WS_YP), a.out, G, c);
    if (IN(9) && DUPQ(9)) final_phase((const float*)(ws + WS_X1), mod, (const float*)(ws + WS_GATES), (const int*)(ws + WS_PAIRE), (const int*)(ws + WS_PAIRP), moe_tables(lds, ctrl, 1), (const bf16_t*)(ws + WS_YP), a.out, G, c);
#undef IN
#undef SEAM
}

#ifndef N_LAUNCHES
#define N_LAUNCHES 1
#endif
extern "C" void kernel_launch(void* const* d_in, const int* in_sizes, int n_in, void* d_out, int out_size, void* d_ws, size_t ws_size, hipStream_t stream) {
    static int grid = 0;
    if (grid == 0) {
        int dev = 0, cus = 0;
        (void)hipGetDevice(&dev); (void)hipDeviceGetAttribute(&cus, hipDeviceAttributeMultiprocessorCount, dev);
        (void)hipFuncSetAttribute((const void*)mega, hipFuncAttributeMaxDynamicSharedMemorySize, fg::LDS_BYTES);
        grid = cus > 0 ? cus : 256;
    }
    MegaArgs a{}; for (int i = 0; i < 18; ++i) a.in[i] = (const float*)d_in[i]; a.out = (float*)d_out; a.ws = (unsigned char*)d_ws;
    (void)hipMemsetAsync((char*)d_ws + WS_CTRL, 0, 65536, stream);
    if (N_LAUNCHES == 1) { a.ph_lo = 0; a.ph_hi = NPHASE; hipLaunchKernelGGL(mega, dim3(grid), dim3(512), fg::LDS_BYTES, stream, a); }
    else for (int p = 0; p < NPHASE; ++p) { a.ph_lo = p; a.ph_hi = p + 1; hipLaunchKernelGGL(mega, dim3(grid), dim3(512), fg::LDS_BYTES, stream, a); }
}
```

```cpp
#include <hip/hip_runtime.h>
#include <stdint.h>

constexpr int kB = 4, kS = 2048, kD = 2048, kT = kB * kS;
constexpr int kHD = 128, kNH = 8, kSB = 1024, kPW = 1024, kPG = 256;
constexpr int kNPROJ = 4096, kE = 32, kTOPK = 4, kDFF = 2048;
constexpr float kEPS = 1e-6f;
constexpr int kMaxSlots = 160 * 256;

typedef unsigned short bf16_t;
__device__ __forceinline__ bf16_t f2bf(float f) { unsigned u = __float_as_uint(f); u += 0x7FFFu + ((u >> 16) & 1u); return (bf16_t)(u >> 16); }
__device__ __forceinline__ float bf2f(bf16_t b) { return __uint_as_float(((unsigned)b) << 16); }

constexpr size_t WS_CTRL   = 0;
constexpr size_t WS_MOD    = 65536;
constexpr size_t WS_H      = WS_MOD + (size_t)4 * 12288 * 4;
constexpr size_t WS_PROJ   = WS_H + (size_t)kT * kD * 2;
constexpr size_t WS_CAT    = WS_PROJ + (size_t)kT * kNPROJ * 2;
constexpr size_t WS_P      = WS_CAT + (size_t)kT * kD * 2;
constexpr size_t WS_X1     = WS_P + (size_t)kT * kPW * 2;
constexpr size_t WS_H2     = WS_X1 + (size_t)kT * kD * 4;
constexpr size_t WS_GATES  = WS_H2 + (size_t)kT * kD * 2;
constexpr size_t WS_PAIRE  = WS_GATES + (size_t)kT * 4 * 4;
constexpr size_t WS_PAIRP  = WS_PAIRE + (size_t)kT * 4 * 4;
constexpr size_t WS_LIST   = WS_PAIRP + (size_t)kT * 4 * 4;
constexpr size_t WS_ACT    = WS_LIST + (size_t)kE * kT * 4;
constexpr size_t WS_YP     = WS_ACT + (size_t)kMaxSlots * kDFF * 2;
constexpr size_t WS_END    = WS_YP + (size_t)kMaxSlots * kD * 2;
constexpr int CT_CNT = 4096;
constexpr int CT_ROWBASE = 4160;
constexpr int CT_Q = 8192;

#define LAS __attribute__((address_space(3)))
typedef short bf16x8 __attribute__((ext_vector_type(8)));
typedef short s16x4 __attribute__((ext_vector_type(4)));
typedef float f32x4 __attribute__((ext_vector_type(4)));
typedef float f32x2 __attribute__((ext_vector_type(2)));
typedef __bf16 bf16v2 __attribute__((ext_vector_type(2)));
typedef unsigned u32x2 __attribute__((ext_vector_type(2)));
typedef unsigned u32x4 __attribute__((ext_vector_type(4)));
typedef int i32x4 __attribute__((ext_vector_type(4)));
typedef int i32x8 __attribute__((ext_vector_type(8)));
__device__ __forceinline__ unsigned pk_bf16(float a, float b) { f32x2 v = {a, b}; bf16v2 r = __builtin_convertvector(v, bf16v2); return __builtin_bit_cast(unsigned, r); }

constexpr size_t WS_WIN  = WS_END;
constexpr size_t WS_WO   = WS_WIN + (size_t)kD * kNPROJ * 2;
constexpr size_t WS_WPL  = WS_WO + (size_t)kD * kD * 2;
constexpr size_t WS_WE1  = WS_WPL + (size_t)4 * kPG * kPG * 2;
constexpr size_t WS_WE2  = WS_WE1 + (size_t)kE * kD * 2 * kDFF * 2;
constexpr size_t WS_END2 = WS_WE2 + (size_t)kE * kDFF * kD * 2;

namespace fg {
constexpr int BM = 256, BK = 64, HALF = 128, HTB = 16384, STAGE_BYTES = 131072, NXCD = 8, WGM = 8;
constexpr int TAB_OFF = STAGE_BYTES;
constexpr int MISC_OFF = STAGE_BYTES + 2048;
constexpr int LDS_BYTES = STAGE_BYTES + 4096;
__device__ __forceinline__ int lds_byte(int r, int c) { const int st = (r >> 4) * 2 + (c >> 5), rr = r & 15, cc = c & 31, ob = rr * 64 + cc * 2; return st * 1024 + (ob ^ (((ob >> 9) & 1) << 5)); }
__device__ __forceinline__ void stage_rc(int b, int& R, int& C) { const int st = b / 1024, sb = b % 1024, swz = sb ^ (((sb >> 9) & 1) << 5); R = (st >> 1) * 16 + swz / 64; C = (st & 1) * 32 + (swz % 64) / 2; }

struct Unit { const char* bBase; int arow0; int nvalid; int e; int orow0; int ocol0; int acol2; };

struct StaticOrder {
    int nM, nN, nwg, G, c;
    __device__ void init(int M, int N, int G_, int c_) { nM = M / BM; nN = N / BM; nwg = nM * nN; G = G_; c = c_; }
    __device__ bool next(int i, int& pm, int& pn) const {
        const long L = (long)i * G + c; if (L >= nwg) return false;
        int wgid = (int)L; { const int q = nwg / NXCD, r = nwg % NXCD, xcd = wgid % NXCD, off = wgid / NXCD; wgid = (xcd < r ? xcd * (q + 1) : r * (q + 1) + (xcd - r) * q) + off; }
        const int nig = WGM * nN, gid = wgid / nig, fm = gid * WGM, gsz = (nM - fm) < WGM ? (nM - fm) : WGM;
        pm = fm + ((wgid % nig) % gsz); pn = (wgid % nig) / gsz; return true;
    }
};

template <int OFF> __device__ __forceinline__ s16x4 tr_read(unsigned addr) { s16x4 r; asm volatile("ds_read_b64_tr_b16 %0, %1 offset:%2" : "=&v"(r) : "v"(addr), "i"(OFF) : "memory"); return r; }
template <class Job>
__device__ __forceinline__ void gemm_phase(LAS unsigned char* lds, const Job& J) {
    const int tid = threadIdx.x, wid = __builtin_amdgcn_readfirstlane(tid >> 6), lane = tid & 63, wr = wid >> 2, wc = wid & 3, fr = lane & 15, fq = lane >> 4;
    const int nt = J.K / BK;
    unsigned voffB[2];
#pragma unroll
    for (int i = 0; i < 2; ++i) { int R, C; stage_rc(tid * 16 + i * 8192, R, C);
        const int b = tid * 16 + i * 8192, row = b >> 8, slot = (b >> 4) & 15, ch = slot ^ (((row & 3) << 2) | ((row >> 2) & 3)); voffB[i] = (unsigned)row * J.ldb2 + (unsigned)ch * 16u; }
    const size_t kstepB = (size_t)BK * J.ldb2;
    const unsigned ldsw = (unsigned)wid * 1024u;
    const int aoff = lds_byte(wr * 64 + fr, fq * 8);
    const int tq = (lane & 15) >> 2, tp = lane & 3;
    unsigned ba[2][2];
#pragma unroll
    for (int n = 0; n < 2; ++n)
#pragma unroll
        for (int t = 0; t < 2; ++t) ba[n][t] = (unsigned)(uintptr_t)lds + 256u * (8 * fq + 4 * t + tq) + 16u * ((4 * wc + 2 * n + (tp >> 1)) ^ ((tq << 2) | ((2 * fq + t) & 3))) + 8u * (tp & 1);
#define FG_SA(b, h) (65536 + ((b) * 2 + (h)) * HTB)
#define FG_SB(b, h) (((b) * 2 + (h)) * HTB)
#define FG_STAGE_A(bufoff, gk, vo) do { _Pragma("unroll") for (int _i = 0; _i < 2; ++_i) \
        __builtin_amdgcn_global_load_lds((const unsigned*)((gk) + (vo)[_i]), (LAS unsigned*)(lds + (bufoff) + ldsw + _i * 8192), 16, 0, 0); } while (0)
#define FG_STAGE_B(bufoff, gk) do { _Pragma("unroll") for (int _i = 0; _i < 2; ++_i) \
        __builtin_amdgcn_global_load_lds((const unsigned*)((gk) + voffB[_i]), (LAS unsigned*)(lds + (bufoff) + ldsw + _i * 8192), 16, 0, 0); } while (0)
#define FG_LDA(dst, b, h) do { _Pragma("unroll") for (int m = 0; m < 4; ++m) _Pragma("unroll") for (int k = 0; k < 2; ++k) dst[m][k] = *(const LAS bf16x8*)(lds + FG_SA(b, h) + aoff + m * 2048 + k * 1024); } while (0)
#define FG_LDB(dst, b, h) do { \
        dst##lo[0][0] = tr_read<FG_SB(b, h)>(ba[0][0]);        dst##hi[0][0] = tr_read<FG_SB(b, h)>(ba[0][1]); \
        dst##lo[0][1] = tr_read<FG_SB(b, h) + 8192>(ba[0][0]); dst##hi[0][1] = tr_read<FG_SB(b, h) + 8192>(ba[0][1]); \
        dst##lo[1][0] = tr_read<FG_SB(b, h)>(ba[1][0]);        dst##hi[1][0] = tr_read<FG_SB(b, h)>(ba[1][1]); \
        dst##lo[1][1] = tr_read<FG_SB(b, h) + 8192>(ba[1][0]); dst##hi[1][1] = tr_read<FG_SB(b, h) + 8192>(ba[1][1]); } while (0)
#define FG_PK(L, H) (bf16x8){L[0], L[1], L[2], L[3], H[0], H[1], H[2], H[3]}
#define FG_MMA(ai, bj, At, Bt) do { __builtin_amdgcn_s_setprio(1); _Pragma("unroll") for (int m = 0; m < 4; ++m) _Pragma("unroll") for (int n = 0; n < 2; ++n) _Pragma("unroll") for (int k = 0; k < 2; ++k) \
        acc[ai][bj][m][n] = __builtin_amdgcn_mfma_f32_16x16x32_bf16(FG_PK(Bt##lo[n][k], Bt##hi[n][k]), At[m][k], acc[ai][bj][m][n], 0, 0, 0); __builtin_amdgcn_s_setprio(0); } while (0)
#define FG_WAIT_V(n) asm volatile("s_waitcnt vmcnt(" #n ")" ::: "memory")
#define FG_WAIT_L(n) asm volatile("s_waitcnt lgkmcnt(" #n ")" ::: "memory")
#define FG_BAR __builtin_amdgcn_s_barrier()
#define FG_SCHED __builtin_amdgcn_sched_barrier(0)
#define FG_AOFF(dst, u, tabp) do { int _tz = threadIdx.x; asm volatile("" : "+v"(_tz)); _Pragma("unroll") for (int _i = 0; _i < 2; ++_i) { int _R, _C; stage_rc(_tz * 16 + _i * 8192, _R, _C); \
        _Pragma("unroll") for (int _h = 0; _h < 2; ++_h) { const int _r = _h * 128 + _R; \
        if (Job::GATHER) { const int _tok = (tabp)[_r < (u).nvalid ? _r : 0]; dst[_h][_i] = (unsigned)_tok * J.lda2 + (unsigned)(_C * 2); } \
        else dst[_h][_i] = (unsigned)((u).arow0 + _r) * J.lda2 + (unsigned)((u).acol2 + _C * 2); } } } while (0)
    Unit cur, nxt; int ui = 0;
    if (!J.next(0, cur)) return;
    LAS const int* tab0 = (LAS const int*)(lds + TAB_OFF);
    if (Job::GATHER) {
        if (wid == 0) __builtin_amdgcn_global_load_lds((const unsigned*)(J.list + cur.arow0 + lane * 4), (LAS unsigned*)(lds + TAB_OFF), 16, 0, 0);
        FG_WAIT_V(0); __syncthreads();
    }
    f32x4 acc[2][2][4][2];
#pragma unroll
    for (int a = 0; a < 2; ++a)
#pragma unroll
        for (int b = 0; b < 2; ++b)
#pragma unroll
            for (int m = 0; m < 4; ++m)
#pragma unroll
                for (int n = 0; n < 2; ++n) acc[a][b][m][n] = (f32x4){0.f, 0.f, 0.f, 0.f};
    bf16x8 At[4][2]; s16x4 B0lo[2][2], B0hi[2][2], B1lo[2][2], B1hi[2][2];
    unsigned vc[2][2];
    FG_AOFF(vc, cur, tab0);
    const char* const gA = J.A;
    const char* cB = cur.bBase;
    const unsigned bh2 = J.bhalf2;
    FG_STAGE_B(FG_SB(0, 0), cB); FG_STAGE_A(FG_SA(0, 0), gA, vc[0]); FG_STAGE_B(FG_SB(0, 1), cB + bh2); FG_STAGE_A(FG_SA(0, 1), gA, vc[1]);
    if (wr == 1) FG_BAR;
    FG_WAIT_V(4); FG_BAR;
    FG_STAGE_B(FG_SB(1, 0), cB + kstepB); FG_STAGE_A(FG_SA(1, 0), gA + 128, vc[0]); FG_STAGE_B(FG_SB(1, 1), cB + kstepB + bh2);
    FG_WAIT_V(6); FG_BAR;
    for (;;) {
        const bool has_next = J.next(ui + 1, nxt);
        if (!has_next) nxt = cur;
        if (Job::GATHER && has_next && wid == 0)
            __builtin_amdgcn_global_load_lds((const unsigned*)(J.list + nxt.arow0 + lane * 4), (LAS unsigned*)(lds + TAB_OFF + ((ui + 1) & 1) * 1024), 16, 0, 0);
        const char* nB = nxt.bBase;
        for (int t = 0; t < nt; t += 2) {
            const bool last = (t == nt - 2);
            const char* a1 = gA + (size_t)(t + 1) * 128;
            const char* a2 = last ? gA : gA + (size_t)(t + 2) * 128; const char* b2 = last ? nB : cB + (size_t)(t + 2) * kstepB;
            const char* a3 = a2 + 128; const char* b3 = b2 + kstepB;
            FG_LDB(B0, 0, 0); FG_SCHED; FG_LDA(At, 0, 0); FG_STAGE_A(FG_SA(1, 1), a1, vc[1]);
            if (last && has_next) { LAS const int* tabn = (LAS const int*)(lds + TAB_OFF + ((ui + 1) & 1) * 1024); FG_AOFF(vc, nxt, tabn); }
            FG_WAIT_L(8); FG_BAR; FG_WAIT_L(0); FG_SCHED; FG_MMA(0, 0, At, B0); FG_BAR; FG_SCHED;
            FG_LDB(B1, 0, 1); FG_STAGE_B(FG_SB(0, 0), b2);
            FG_BAR; FG_WAIT_L(0); FG_SCHED; FG_MMA(0, 1, At, B1); FG_BAR;
            FG_LDA(At, 0, 1); FG_STAGE_A(FG_SA(0, 0), a2, vc[0]);
            FG_BAR; FG_WAIT_L(0); FG_MMA(1, 0, At, B0); FG_BAR; FG_SCHED;
            FG_STAGE_B(FG_SB(0, 1), b2 + bh2);
            FG_WAIT_V(6); FG_BAR; FG_MMA(1, 1, At, B1); FG_BAR;
            FG_LDB(B0, 1, 0); FG_SCHED; FG_LDA(At, 1, 0); FG_STAGE_A(FG_SA(0, 1), a2, vc[1]);
            FG_WAIT_L(8); FG_BAR; FG_WAIT_L(0); FG_SCHED; FG_MMA(0, 0, At, B0); FG_BAR; FG_SCHED;
            FG_LDB(B1, 1, 1); FG_STAGE_B(FG_SB(1, 0), b3);
            FG_BAR; FG_WAIT_L(0); FG_SCHED; FG_MMA(0, 1, At, B1); FG_BAR;
            FG_LDA(At, 1, 1); FG_STAGE_A(FG_SA(1, 0), a3, vc[0]);
            FG_BAR; FG_WAIT_L(0); FG_MMA(1, 0, At, B0); FG_BAR; FG_SCHED;
            FG_STAGE_B(FG_SB(1, 1), b3 + bh2);
            FG_WAIT_V(6); FG_BAR; FG_MMA(1, 1, At, B1); FG_BAR;
        }
        J.epi(acc, cur, wr, wc, fr, fq);
        if (!has_next) break;
#pragma unroll
        for (int a = 0; a < 2; ++a)
#pragma unroll
            for (int b = 0; b < 2; ++b)
#pragma unroll
                for (int m = 0; m < 4; ++m)
#pragma unroll
                    for (int n = 0; n < 2; ++n) acc[a][b][m][n] = (f32x4){0.f, 0.f, 0.f, 0.f};
        cur = nxt; cB = nB; ++ui;
    }
    FG_WAIT_V(0);
    if (wr == 0) FG_BAR;
    FG_BAR;
}

#undef FG_SA
#undef FG_SB
#undef FG_STAGE_A
#undef FG_STAGE_B
#undef FG_LDA
#undef FG_LDB
#undef FG_MMA
#undef FG_WAIT_V
#undef FG_WAIT_L
#undef FG_BAR
#undef FG_SCHED
#undef FG_AOFF
template <class Job>
__device__ __forceinline__ void gemm_phase_f8(LAS unsigned char* lds, const Job& J) {
    const int tid = threadIdx.x, wid = __builtin_amdgcn_readfirstlane(tid >> 6), lane = tid & 63, wr = wid >> 2, wc = wid & 3, fr = lane & 15, fq = lane >> 4;
    const int nt = J.K / 128;
    unsigned voffB[2];
#pragma unroll
    for (int i = 0; i < 2; ++i) { int R, C; stage_rc(tid * 16 + i * 8192, R, C);
        voffB[i] = (unsigned)R * J.ldb2 + (unsigned)(C * 2); }
    const size_t kstepB = 128;
    const unsigned ldsw = (unsigned)wid * 1024u;
    const int aoff = lds_byte(wr * 64 + fr, fq * 8);
    const int boff = lds_byte(wc * 32 + fr, fq * 8);
#define FG_SA(b, h) (65536 + ((b) * 2 + (h)) * HTB)
#define FG_SB(b, h) (((b) * 2 + (h)) * HTB)
#define FG_STAGE_A(bufoff, gk, vo) do { _Pragma("unroll") for (int _i = 0; _i < 2; ++_i) \
        __builtin_amdgcn_global_load_lds((const unsigned*)((gk) + (vo)[_i]), (LAS unsigned*)(lds + (bufoff) + ldsw + _i * 8192), 16, 0, 0); } while (0)
#define FG_STAGE_B(bufoff, gk) do { _Pragma("unroll") for (int _i = 0; _i < 2; ++_i) \
        __builtin_amdgcn_global_load_lds((const unsigned*)((gk) + voffB[_i]), (LAS unsigned*)(lds + (bufoff) + ldsw + _i * 8192), 16, 0, 0); } while (0)
#define FG_LDA(dst, b, h) do { _Pragma("unroll") for (int m = 0; m < 4; ++m) _Pragma("unroll") for (int k = 0; k < 2; ++k) dst[m][k] = *(const LAS i32x4*)(lds + FG_SA(b, h) + aoff + m * 2048 + k * 1024); } while (0)
#define FG_LDB(dst, b, h) do { _Pragma("unroll") for (int n = 0; n < 2; ++n) _Pragma("unroll") for (int k = 0; k < 2; ++k) dst[n][k] = *(const LAS i32x4*)(lds + FG_SB(b, h) + boff + n * 2048 + k * 1024); } while (0)
#define FG_CAT8(X, Y) __builtin_shufflevector(X, Y, 0, 1, 2, 3, 4, 5, 6, 7)
#define FG_MMA(ai, bj, At, Bt) do { __builtin_amdgcn_s_setprio(1); _Pragma("unroll") for (int m = 0; m < 4; ++m) _Pragma("unroll") for (int n = 0; n < 2; ++n) \
        acc[ai][bj][m][n] = __builtin_amdgcn_mfma_scale_f32_16x16x128_f8f6f4(FG_CAT8(Bt[n][0], Bt[n][1]), FG_CAT8(At[m][0], At[m][1]), acc[ai][bj][m][n], 0, 0, 0, 0x79797979, 0, 0x7F7F7F7F); __builtin_amdgcn_s_setprio(0); } while (0)
#define FG_WAIT_V(n) asm volatile("s_waitcnt vmcnt(" #n ")" ::: "memory")
#define FG_WAIT_L(n) asm volatile("s_waitcnt lgkmcnt(" #n ")" ::: "memory")
#define FG_BAR __builtin_amdgcn_s_barrier()
#define FG_SCHED __builtin_amdgcn_sched_barrier(0)
#define FG_AOFF(dst, u, tabp) do { int _tz = threadIdx.x; asm volatile("" : "+v"(_tz)); _Pragma("unroll") for (int _i = 0; _i < 2; ++_i) { int _R, _C; stage_rc(_tz * 16 + _i * 8192, _R, _C); \
        _Pragma("unroll") for (int _h = 0; _h < 2; ++_h) { const int _r = _h * 128 + _R; \
        if (Job::GATHER) { const int _tok = (tabp)[_r < (u).nvalid ? _r : 0]; dst[_h][_i] = (unsigned)_tok * J.lda2 + (unsigned)(_C * 2); } \
        else dst[_h][_i] = (unsigned)((u).arow0 + _r) * J.lda2 + (unsigned)((u).acol2 + _C * 2); } } } while (0)
    Unit cur, nxt; int ui = 0;
    if (!J.next(0, cur)) return;
    LAS const int* tab0 = (LAS const int*)(lds + TAB_OFF);
    if (Job::GATHER) {
        if (wid == 0) __builtin_amdgcn_global_load_lds((const unsigned*)(J.list + cur.arow0 + lane * 4), (LAS unsigned*)(lds + TAB_OFF), 16, 0, 0);
        FG_WAIT_V(0); __syncthreads();
    }
    f32x4 acc[2][2][4][2];
#pragma unroll
    for (int a = 0; a < 2; ++a)
#pragma unroll
        for (int b = 0; b < 2; ++b)
#pragma unroll
            for (int m = 0; m < 4; ++m)
#pragma unroll
                for (int n = 0; n < 2; ++n) acc[a][b][m][n] = (f32x4){0.f, 0.f, 0.f, 0.f};
    i32x4 At[4][2], B0[2][2], B1[2][2];
    unsigned vc[2][2];
    FG_AOFF(vc, cur, tab0);
    const char* const gA = J.A;
    const char* cB = cur.bBase;
    const unsigned bh2 = J.bhalf2;
    FG_STAGE_B(FG_SB(0, 0), cB); FG_STAGE_A(FG_SA(0, 0), gA, vc[0]); FG_STAGE_B(FG_SB(0, 1), cB + bh2); FG_STAGE_A(FG_SA(0, 1), gA, vc[1]);
    if (wr == 1) FG_BAR;
    FG_WAIT_V(4); FG_BAR;
    FG_STAGE_B(FG_SB(1, 0), cB + kstepB); FG_STAGE_A(FG_SA(1, 0), gA + 128, vc[0]); FG_STAGE_B(FG_SB(1, 1), cB + kstepB + bh2);
    FG_WAIT_V(6); FG_BAR;
    for (;;) {
        const bool has_next = J.next(ui + 1, nxt);
        if (!has_next) nxt = cur;
        if (Job::GATHER && has_next && wid == 0)
            __builtin_amdgcn_global_load_lds((const unsigned*)(J.list + nxt.arow0 + lane * 4), (LAS unsigned*)(lds + TAB_OFF + ((ui + 1) & 1) * 1024), 16, 0, 0);
        const char* nB = nxt.bBase;
        for (int t = 0; t < nt; t += 2) {
            const bool last = (t == nt - 2);
            const char* a1 = gA + (size_t)(t + 1) * 128;
            const char* a2 = last ? gA : gA + (size_t)(t + 2) * 128; const char* b2 = last ? nB : cB + (size_t)(t + 2) * kstepB;
            const char* a3 = a2 + 128; const char* b3 = b2 + kstepB;
            FG_LDB(B0, 0, 0); FG_SCHED; FG_LDA(At, 0, 0); FG_STAGE_A(FG_SA(1, 1), a1, vc[1]);
            if (last && has_next) { LAS const int* tabn = (LAS const int*)(lds + TAB_OFF + ((ui + 1) & 1) * 1024); FG_AOFF(vc, nxt, tabn); }
            FG_WAIT_L(8); FG_BAR; FG_WAIT_L(0); FG_SCHED; FG_MMA(0, 0, At, B0); FG_BAR; FG_SCHED;
            FG_LDB(B1, 0, 1); FG_STAGE_B(FG_SB(0, 0), b2);
            FG_BAR; FG_WAIT_L(0); FG_SCHED; FG_MMA(0, 1, At, B1); FG_BAR;
            FG_LDA(At, 0, 1); FG_STAGE_A(FG_SA(0, 0), a2, vc[0]);
            FG_BAR; FG_WAIT_L(0); FG_MMA(1, 0, At, B0); FG_BAR; FG_SCHED;
            FG_STAGE_B(FG_SB(0, 1), b2 + bh2);
            FG_WAIT_V(6); FG_BAR; FG_MMA(1, 1, At, B1); FG_BAR;
            FG_LDB(B0, 1, 0); FG_SCHED; FG_LDA(At, 1, 0); FG_STAGE_A(FG_SA(0, 1), a2, vc[1]);
            FG_WAIT_L(8); FG_BAR; FG_WAIT_L(0); FG_SCHED; FG_MMA(0, 0, At, B0); FG_BAR; FG_SCHED;
            FG_LDB(B1, 1, 1); FG_STAGE_B(FG_SB(1, 0), b3);
            FG_BAR; FG_WAIT_L(0); FG_SCHED; FG_MMA(0, 1, At, B1); FG_BAR;
            FG_LDA(At, 1, 1); FG_STAGE_A(FG_SA(1, 0), a3, vc[0]);
            FG_BAR; FG_WAIT_L(0); FG_MMA(1, 0, At, B0); FG_BAR; FG_SCHED;
            FG_STAGE_B(FG_SB(1, 1), b3 + bh2);
            FG_WAIT_V(6); FG_BAR; FG_MMA(1, 1, At, B1); FG_BAR;
        }
        J.epi(acc, cur, wr, wc, fr, fq);
        if (!has_next) break;
#pragma unroll
        for (int a = 0; a < 2; ++a)
#pragma unroll
            for (int b = 0; b < 2; ++b)
#pragma unroll
                for (int m = 0; m < 4; ++m)
#pragma unroll
                    for (int n = 0; n < 2; ++n) acc[a][b][m][n] = (f32x4){0.f, 0.f, 0.f, 0.f};
        cur = nxt; cB = nB; ++ui;
    }
    FG_WAIT_V(0);
    if (wr == 0) FG_BAR;
    FG_BAR;
}
}

#define FG_FOR_ROWS for (int ai = 0; ai < 2; ++ai) _Pragma("unroll") for (int m = 0; m < 4; ++m)
struct JobInProj {
    static constexpr bool GATHER = false;
    const char* A; unsigned lda2, ldb2, bhalf2; int K; const int* list;
    const char* B; bf16_t* out; fg::StaticOrder S;
    __device__ __forceinline__ bool next(int i, fg::Unit& u) const { int pm, pn; if (!S.next(i, pm, pn)) return false;
        u.bBase = B + (size_t)pn * 512; u.arow0 = pm * 256; u.nvalid = 256; u.e = 0; u.orow0 = pm * 256; u.ocol0 = pn * 256; u.acol2 = 0; return true; }
    __device__ __forceinline__ void epi(const f32x4 (&acc)[2][2][4][2], const fg::Unit& u, int wr, int wc, int fr, int fq) const {
#pragma unroll
        FG_FOR_ROWS { bf16_t* rowp = out + (size_t)(u.orow0 + ai * 128 + wr * 64 + m * 16 + fr) * kNPROJ + u.ocol0 + wc * 32 + fq * 4;
#pragma unroll
            for (int bj = 0; bj < 2; ++bj)
#pragma unroll
                for (int n = 0; n < 2; ++n) { const f32x4 v = acc[ai][bj][m][n]; u32x2 w; w.x = pk_bf16(v[0], v[1]); w.y = pk_bf16(v[2], v[3]); *(u32x2*)(rowp + bj * 128 + n * 16) = w; } }
    }
};
struct JobPool {
    static constexpr bool GATHER = false;
    const char* A; unsigned lda2, ldb2, bhalf2; int K; const int* list;
    const char* B; bf16_t* cat; int G, c;
    __device__ __forceinline__ bool next(int i, fg::Unit& u) const { const int L = i * G + c; if (L >= 128) return false; const int g = L >> 5, pm = L & 31;
        u.bBase = B + (size_t)g * kPG * kPG * 2; u.arow0 = pm * 256; u.nvalid = 256; u.e = g; u.orow0 = pm * 256; u.ocol0 = kSB + g * kPG; u.acol2 = g * kPG * 2; return true; }
    __device__ __forceinline__ void epi(const f32x4 (&acc)[2][2][4][2], const fg::Unit& u, int wr, int wc, int fr, int fq) const {
#pragma unroll
        FG_FOR_ROWS { bf16_t* rowp = cat + (size_t)(u.orow0 + ai * 128 + wr * 64 + m * 16 + fr) * kD + u.ocol0 + wc * 32 + fq * 4;
#pragma unroll
            for (int bj = 0; bj < 2; ++bj)
#pragma unroll
                for (int n = 0; n < 2; ++n) { const f32x4 v = acc[ai][bj][m][n]; u32x2 w; w.x = pk_bf16(v[0], v[1]); w.y = pk_bf16(v[2], v[3]); *(u32x2*)(rowp + bj * 128 + n * 16) = w; } }
    }
};
struct JobOutProj {
    static constexpr bool GATHER = false;
    const char* A; unsigned lda2, ldb2, bhalf2; int K; const int* list;
    const char* B; const float* x; const float* mod; float* x1; fg::StaticOrder S;
    __device__ __forceinline__ bool next(int i, fg::Unit& u) const { int pm, pn; if (!S.next(i, pm, pn)) return false;
        u.bBase = B + (size_t)pn * 512; u.arow0 = pm * 256; u.nvalid = 256; u.e = 0; u.orow0 = pm * 256; u.ocol0 = pn * 256; u.acol2 = 0; return true; }
    __device__ __forceinline__ void epi(const f32x4 (&acc)[2][2][4][2], const fg::Unit& u, int wr, int wc, int fr, int fq) const {
        const int b = u.orow0 / kS; f32x4 gt[2][2];
#pragma unroll
        for (int bj = 0; bj < 2; ++bj)
#pragma unroll
            for (int n = 0; n < 2; ++n) gt[bj][n] = *(const f32x4*)(mod + b * 6 * kD + 2 * kD + u.ocol0 + bj * 128 + wc * 32 + n * 16 + fq * 4);
#pragma unroll
        FG_FOR_ROWS { const size_t ro = (size_t)(u.orow0 + ai * 128 + wr * 64 + m * 16 + fr) * kD + u.ocol0 + wc * 32 + fq * 4;
#pragma unroll
            for (int bj = 0; bj < 2; ++bj)
#pragma unroll
                for (int n = 0; n < 2; ++n) { const f32x4 xv = *(const f32x4*)(x + ro + bj * 128 + n * 16); *(f32x4*)(x1 + ro + bj * 128 + n * 16) = xv + gt[bj][n] * acc[ai][bj][m][n]; } }
    }
};
struct MoeTab { LAS const int* t; int total;
    __device__ __forceinline__ bool decode(int i, int G, int c, int& e, int& jcol, int& rb, int& cnt, int& rowbase) const {
        const int L = (G % 8 == 0) ? i * G + (c % 8) * (G / 8) + c / 8 : i * G + c; if (L >= total) return false;
        int ee = 0; while (ee < kE - 1 && t[64 + ee + 1] <= L) ++ee;
        const int local = L - t[64 + ee], nrb = t[100 + ee]; jcol = local / nrb; rb = local - jcol * nrb; e = ee; cnt = t[ee]; rowbase = t[32 + ee]; return true; }
};
__device__ __forceinline__ MoeTab moe_tables(LAS unsigned char* lds, const unsigned* ctrl, int ncol) {
    LAS int* t = (LAS int*)(lds + fg::MISC_OFF + 64);
    __syncthreads();
    if (threadIdx.x == 0) { int base = 0, us = 0; for (int e = 0; e < kE; ++e) { const int cn = (int)ctrl[CT_CNT + 64 * e], nrb = (cn + 255) >> 8; t[e] = cn; t[32 + e] = base; t[64 + e] = us; t[100 + e] = nrb; base += nrb * 256; us += nrb * ncol; } t[64 + kE] = us; }
    __syncthreads();
    MoeTab M; M.t = t; M.total = t[64 + kE]; return M;
}
struct JobMoe1 {
    static constexpr bool GATHER = true;
    const char* A; unsigned lda2, ldb2, bhalf2; int K; const int* list;
    const char* B; const float* b_in; bf16_t* act; MoeTab M; int G, c;
    __device__ __forceinline__ bool next(int i, fg::Unit& u) const { int e, j, rb, cnt, rowbase; if (!M.decode(i, G, c, e, j, rb, cnt, rowbase)) return false;
        e = __builtin_amdgcn_readfirstlane(e); j = __builtin_amdgcn_readfirstlane(j); rb = __builtin_amdgcn_readfirstlane(rb); cnt = __builtin_amdgcn_readfirstlane(cnt); rowbase = __builtin_amdgcn_readfirstlane(rowbase);
        u.bBase = B + (size_t)e * ((size_t)kD * 2 * kDFF * 2) + (size_t)j * 256; u.arow0 = e * kT + rb * 256; u.nvalid = min(256, cnt - rb * 256); u.e = e; u.orow0 = rowbase + rb * 256; u.ocol0 = j * 128; u.acol2 = 0; return true; }
    __device__ __forceinline__ void epi(const f32x4 (&acc)[2][2][4][2], const fg::Unit& u, int wr, int wc, int fr, int fq) const {
        f32x4 bg[2], bl[2];
#pragma unroll
        for (int n = 0; n < 2; ++n) { const float* bp = b_in + (size_t)u.e * 2 * kDFF + u.ocol0 + wc * 32 + n * 16 + fq * 4; bg[n] = *(const f32x4*)bp; bl[n] = *(const f32x4*)(bp + kDFF); }
#pragma unroll
        FG_FOR_ROWS { bf16_t* rowp = act + (size_t)(u.orow0 + ai * 128 + wr * 64 + m * 16 + fr) * kDFF + u.ocol0 + wc * 32 + fq * 4;
#pragma unroll
            for (int n = 0; n < 2; ++n) { const f32x4 gv = acc[ai][0][m][n] + bg[n], lv = acc[ai][1][m][n] + bl[n]; float o[4];
#pragma unroll
                for (int j = 0; j < 4; ++j) { const float g = fminf(gv[j], 7.f), l = fminf(fmaxf(lv[j], -7.f), 7.f); o[j] = g * __builtin_amdgcn_rcpf(1.f + __expf(-1.702f * g)) * (l + 1.f); }
                u32x2 w; w.x = pk_bf16(o[0], o[1]); w.y = pk_bf16(o[2], o[3]); *(u32x2*)(rowp + n * 16) = w; } }
    }
};
struct JobMoe2 {
    static constexpr bool GATHER = false;
    const char* A; unsigned lda2, ldb2, bhalf2; int K; const int* list;
    const char* B; const float* b_out; bf16_t* yp; MoeTab M; int G, c;
    __device__ __forceinline__ bool next(int i, fg::Unit& u) const { int e, j, rb, cnt, rowbase; if (!M.decode(i, G, c, e, j, rb, cnt, rowbase)) return false;
        e = __builtin_amdgcn_readfirstlane(e); j = __builtin_amdgcn_readfirstlane(j); rb = __builtin_amdgcn_readfirstlane(rb); rowbase = __builtin_amdgcn_readfirstlane(rowbase);
        u.bBase = B + (size_t)e * ((size_t)kDFF * kD * 2) + (size_t)j * 512; u.arow0 = rowbase + rb * 256; u.nvalid = 256; u.e = e; u.orow0 = rowbase + rb * 256; u.ocol0 = j * 256; u.acol2 = 0; return true; }
    __device__ __forceinline__ void epi(const f32x4 (&acc)[2][2][4][2], const fg::Unit& u, int wr, int wc, int fr, int fq) const {
        f32x4 bo[2][2];
#pragma unroll
        for (int bj = 0; bj < 2; ++bj)
#pragma unroll
            for (int n = 0; n < 2; ++n) bo[bj][n] = *(const f32x4*)(b_out + (size_t)u.e * kD + u.ocol0 + bj * 128 + wc * 32 + n * 16 + fq * 4);
#pragma unroll
        FG_FOR_ROWS { bf16_t* rowp = yp + (size_t)(u.orow0 + ai * 128 + wr * 64 + m * 16 + fr) * kD + u.ocol0 + wc * 32 + fq * 4;
#pragma unroll
            for (int bj = 0; bj < 2; ++bj)
#pragma unroll
                for (int n = 0; n < 2; ++n) { const f32x4 v = acc[ai][bj][m][n] + bo[bj][n]; u32x2 w; w.x = pk_bf16(v[0], v[1]); w.y = pk_bf16(v[2], v[3]); *(u32x2*)(rowp + bj * 128 + n * 16) = w; } }
    }
};


__device__ __forceinline__ float wave_sum(float v) {
#pragma unroll
    for (int o = 32; o > 0; o >>= 1) v += __shfl_xor(v, o);
    return v; }
__device__ __forceinline__ float bflo(unsigned u) { return __uint_as_float(u << 16); }
__device__ __forceinline__ float bfhi(unsigned u) { return __uint_as_float(u & 0xFFFF0000u); }

namespace at {
typedef float f32x16 __attribute__((ext_vector_type(16)));
__device__ __forceinline__ unsigned off_b(unsigned row, unsigned ch) { return 256u * row + 16u * (ch ^ (((row & 3) << 2) | ((row >> 2) & 3))); }
constexpr float kC2 = 0.08838834764831845f * 1.4426950408889634f;
constexpr float kDoneThresh = 140.f;

__device__ __forceinline__ void attn_phase(LAS unsigned char* lds, const bf16_t* __restrict__ proj, const float* __restrict__ qw, const float* __restrict__ kw,
                                           bf16_t* __restrict__ cat, int G, int c) {
    const int tid = threadIdx.x, wid = __builtin_amdgcn_readfirstlane(tid >> 6), lane = tid & 63, ql = lane & 31, hf = lane >> 5;
    const unsigned ldsb = (unsigned)(uintptr_t)lds;
    const int skey = tid >> 4, sch = tid & 15;
    const unsigned X = ((ql & 3) << 2) | ((ql >> 2) & 3);
    const unsigned krow = 256u * ql, kY = 16u * (X ^ (unsigned)hf);
    const int tq = (lane & 15) >> 2, tp = lane & 3, blk = (lane >> 4) & 1;
    unsigned va[4][2];
#pragma unroll
    for (int cc = 0; cc < 4; ++cc)
#pragma unroll
        for (int t = 0; t < 2; ++t) va[cc][t] = 256u * (8 * t + 4 * hf + tq) + 16u * ((4 * cc + 2 * blk + (tp >> 1)) ^ ((tq << 2) | ((2 * t + hf) & 3))) + 8u * (tp & 1);
    for (int unit = c; unit < kB * kNH * 8; unit += G) {
        const int qb = unit & 7, bh = unit >> 3, h = bh & 7, b = bh >> 3;
        const int q0 = qb * 256, r0 = q0 + wid * 32;
        const bf16_t* base = proj + (size_t)(b * kS) * kNPROJ + h * kHD;
        LAS unsigned char* qlds = lds + 65536 + wid * 8192 + lane * 16;
        { u32x4 qr[8]; float ss = 0.f;
#pragma unroll
          for (int s = 0; s < 8; ++s) { qr[s] = *(const u32x4*)(base + (size_t)(r0 + ql) * kNPROJ + 16 * s + 8 * hf);
              const unsigned u[4] = {qr[s].x, qr[s].y, qr[s].z, qr[s].w};
#pragma unroll
              for (int e = 0; e < 4; ++e) { const float a = bflo(u[e]), bb = bfhi(u[e]); ss += a * a + bb * bb; } }
          ss += __shfl_xor(ss, 32);
          const float rq = rsqrtf(ss * (1.f / kHD) + kEPS) * kC2;
#pragma unroll
          for (int s = 0; s < 8; ++s) { const int d0 = 16 * s + 8 * hf;
              const f32x4 w0 = *(const f32x4*)(qw + d0) * *(const f32x4*)(kw + d0), w1 = *(const f32x4*)(qw + d0 + 4) * *(const f32x4*)(kw + d0 + 4);
              const unsigned u[4] = {qr[s].x, qr[s].y, qr[s].z, qr[s].w};
              u32x4 pk; pk.x = pk_bf16(bflo(u[0]) * rq * w0[0], bfhi(u[0]) * rq * w0[1]); pk.y = pk_bf16(bflo(u[1]) * rq * w0[2], bfhi(u[1]) * rq * w0[3]);
              pk.z = pk_bf16(bflo(u[2]) * rq * w1[0], bfhi(u[2]) * rq * w1[1]); pk.w = pk_bf16(bflo(u[3]) * rq * w1[2], bfhi(u[3]) * rq * w1[3]);
              *(LAS u32x4*)(qlds + 1024 * s) = pk; } }
        f32x16 o[4];
#pragma unroll
        for (int cc = 0; cc < 4; ++cc)
#pragma unroll
            for (int r = 0; r < 16; ++r) o[cc][r] = 0.f;
        float carry = 0.f; bool wactive = true;
        int jt = (q0 + 255) >> 6, cur = 0;
        u32x4 kr[2], vr[2];
#define AT_LOAD(jt_) do { _Pragma("unroll") for (int i = 0; i < 2; ++i) { const bf16_t* rp = base + (size_t)(64 * (jt_) + skey + 32 * i) * kNPROJ + sch * 8; \
            kr[i] = *(const u32x4*)(rp + kSB); vr[i] = *(const u32x4*)(rp + 2 * kSB); } } while (0)
        AT_LOAD(jt);
        for (;;) {
            LAS unsigned char* kbuf = lds + cur * 32768; LAS unsigned char* vbuf = kbuf + 16384;
#pragma unroll
            for (int i = 0; i < 2; ++i) { const unsigned u[4] = {kr[i].x, kr[i].y, kr[i].z, kr[i].w}; float f[8]; float ss = 0.f;
#pragma unroll
                for (int e = 0; e < 4; ++e) { f[2 * e] = bflo(u[e]); f[2 * e + 1] = bfhi(u[e]); ss += f[2 * e] * f[2 * e] + f[2 * e + 1] * f[2 * e + 1]; }
                ss += __shfl_xor(ss, 1); ss += __shfl_xor(ss, 2); ss += __shfl_xor(ss, 4); ss += __shfl_xor(ss, 8);
                const float rk = rsqrtf(ss * (1.f / kHD) + kEPS);
                u32x4 pk; pk.x = pk_bf16(f[0] * rk, f[1] * rk); pk.y = pk_bf16(f[2] * rk, f[3] * rk); pk.z = pk_bf16(f[4] * rk, f[5] * rk); pk.w = pk_bf16(f[6] * rk, f[7] * rk);
                const unsigned a = off_b(skey + 32 * i, sch);
                *(LAS u32x4*)(kbuf + a) = pk; *(LAS u32x4*)(vbuf + a) = vr[i]; }
            const int any = __syncthreads_or(wactive ? 1 : 0);
            if (!any) break;
            const int jtc = jt;
            if (jt > 0) AT_LOAD(jt - 1);
            if (wactive && 64 * jtc < r0 + 31) {
                f32x16 s0, s1;
#pragma unroll
                for (int r = 0; r < 16; ++r) { s0[r] = 0.f; s1[r] = 0.f; }
#pragma unroll
                for (int s = 0; s < 8; ++s) { const unsigned a = krow + ((32u * s) ^ kY);
                    const bf16x8 k0 = *(const LAS bf16x8*)(kbuf + a), k1 = *(const LAS bf16x8*)(kbuf + 8192 + a), qv = *(const LAS bf16x8*)(qlds + 1024 * s);
                    s0 = __builtin_amdgcn_mfma_f32_32x32x16_bf16(k0, qv, s0, 0, 0, 0); s1 = __builtin_amdgcn_mfma_f32_32x32x16_bf16(k1, qv, s1, 0, 0, 0); }
                const int tabs = r0 + ql, kbase0 = 64 * jtc + 4 * hf;
                float run = carry; u32x4 pfr[2][2];
#pragma unroll
                for (int kb = 1; kb >= 0; --kb) {
                    float sp[16], gp[4], T[4];
#pragma unroll
                    for (int r = 0; r < 16; ++r) { const float z = kb ? s1[r] : s0[r]; const int key = kbase0 + 32 * kb + 8 * (r >> 2) + (r & 3);
                        const float v = __builtin_amdgcn_logf(1.f + __builtin_amdgcn_exp2f(z)); sp[r] = key < tabs ? v : 0.f; }
#pragma unroll
                    for (int g = 0; g < 4; ++g) { const float gsum = (sp[4 * g] + sp[4 * g + 1]) + (sp[4 * g + 2] + sp[4 * g + 3]);
                        const auto sw = __builtin_amdgcn_permlane32_swap(__float_as_uint(gsum), __float_as_uint(gsum), false, false);
                        const float lo = __uint_as_float(sw[0]), hi = __uint_as_float(sw[1]);
                        T[g] = lo + hi; gp[g] = hf ? 0.f : hi; }
#pragma unroll
                    for (int g = 3; g >= 0; --g) { const float offs = run + gp[g];
                        const float c3 = offs + sp[4 * g + 3], c2 = c3 + sp[4 * g + 2], c1 = c2 + sp[4 * g + 1], c0 = c1 + sp[4 * g];
                        const float cs[4] = {c0, c1, c2, c3};
#pragma unroll
                        for (int i = 0; i < 4; ++i) { const int r = 4 * g + i; const float z = kb ? s1[r] : s0[r]; const int key = kbase0 + 32 * kb + 8 * g + i;
                            const float e = __builtin_amdgcn_exp2f(z - cs[i]); sp[r] = key < tabs ? e : 0.f; }
                        run += T[g]; }
#pragma unroll
                    for (int s2 = 0; s2 < 2; ++s2) { u32x4 pk; pk.x = pk_bf16(sp[8 * s2], sp[8 * s2 + 1]); pk.y = pk_bf16(sp[8 * s2 + 2], sp[8 * s2 + 3]);
                        pk.z = pk_bf16(sp[8 * s2 + 4], sp[8 * s2 + 5]); pk.w = pk_bf16(sp[8 * s2 + 6], sp[8 * s2 + 7]); pfr[kb][s2] = pk; }
                }
                carry = run;
                const unsigned vb0 = ldsb + (unsigned)cur * 32768u + 16384u;
#define AT_PV(cc) do { const unsigned a0 = vb0 + va[cc][0], a1 = vb0 + va[cc][1]; \
                    const s16x4 l00 = fg::tr_read<0>(a0), h00 = fg::tr_read<0>(a1), l01 = fg::tr_read<4096>(a0), h01 = fg::tr_read<4096>(a1); \
                    const s16x4 l10 = fg::tr_read<8192>(a0), h10 = fg::tr_read<8192>(a1), l11 = fg::tr_read<12288>(a0), h11 = fg::tr_read<12288>(a1); \
                    asm volatile("s_waitcnt lgkmcnt(0)" ::: "memory"); __builtin_amdgcn_sched_barrier(0); \
                    o[cc] = __builtin_amdgcn_mfma_f32_32x32x16_bf16(FG_PK(l00, h00), __builtin_bit_cast(bf16x8, pfr[0][0]), o[cc], 0, 0, 0); \
                    o[cc] = __builtin_amdgcn_mfma_f32_32x32x16_bf16(FG_PK(l01, h01), __builtin_bit_cast(bf16x8, pfr[0][1]), o[cc], 0, 0, 0); \
                    o[cc] = __builtin_amdgcn_mfma_f32_32x32x16_bf16(FG_PK(l10, h10), __builtin_bit_cast(bf16x8, pfr[1][0]), o[cc], 0, 0, 0); \
                    o[cc] = __builtin_amdgcn_mfma_f32_32x32x16_bf16(FG_PK(l11, h11), __builtin_bit_cast(bf16x8, pfr[1][1]), o[cc], 0, 0, 0); } while (0)
                AT_PV(0); AT_PV(1); AT_PV(2); AT_PV(3);
#undef AT_PV
                wactive = __any(carry <= kDoneThresh);
            }
            if (jt == 0) break;
            --jt; cur ^= 1;
        }
#undef AT_LOAD
        bf16_t* orow = cat + (size_t)(b * kS + r0 + ql) * kD + h * kHD + 4 * hf;
#pragma unroll
        for (int cc = 0; cc < 4; ++cc)
#pragma unroll
            for (int g = 0; g < 4; ++g) { u32x2 w; w.x = pk_bf16(o[cc][4 * g], o[cc][4 * g + 1]); w.y = pk_bf16(o[cc][4 * g + 2], o[cc][4 * g + 3]); *(u32x2*)(orow + 32 * cc + 8 * g) = w; }
        __syncthreads();
    }
}
}

__device__ __forceinline__ void pool_p_phase(const bf16_t* __restrict__ proj, bf16_t* __restrict__ p, int G, int c) {
    for (int idx = c * 512 + threadIdx.x; idx < kT * (kPW / 8); idx += G * 512) {
        const int c8 = idx & 127, t = idx >> 7, s = t & (kS - 1), g = c8 >> 5, w = 2 << g, cnt = min(s + 1, w);
        const bf16_t* up = proj + (size_t)t * kNPROJ + 3 * kSB + c8 * 8;
        float acc[8], u0[8];
#pragma unroll
        for (int e = 0; e < 8; ++e) acc[e] = 0.f;
        for (int i = 0; i < cnt; ++i) { const uint4 v = *(const uint4*)(up - (size_t)i * kNPROJ); const unsigned u[4] = {v.x, v.y, v.z, v.w};
#pragma unroll
            for (int e = 0; e < 4; ++e) { const float a = bflo(u[e]), bb = bfhi(u[e]); acc[2 * e] += a; acc[2 * e + 1] += bb; if (i == 0) { u0[2 * e] = a; u0[2 * e + 1] = bb; } } }
        const float inv = 1.f / (float)cnt;
        u32x4 pk; pk.x = pk_bf16(acc[0] * inv - u0[0], acc[1] * inv - u0[1]); pk.y = pk_bf16(acc[2] * inv - u0[2], acc[3] * inv - u0[3]);
        pk.z = pk_bf16(acc[4] * inv - u0[4], acc[5] * inv - u0[5]); pk.w = pk_bf16(acc[6] * inv - u0[6], acc[7] * inv - u0[7]);
        *(u32x4*)(p + (size_t)t * kPW + c8 * 8) = pk;
    }
}


__device__ __forceinline__ unsigned pk4_fp8(float a, float b, float c, float d) { int p = __builtin_amdgcn_cvt_pk_fp8_f32(a, b, 0, false); p = __builtin_amdgcn_cvt_pk_fp8_f32(c, d, p, true); return (unsigned)p; }
__device__ __forceinline__ float clamp448(float v) { return __builtin_amdgcn_fmed3f(v, -448.f, 448.f); }
constexpr float kWScale = 64.f;

struct JobMoe1F8 {
    static constexpr bool GATHER = true;
    const char* A; unsigned lda2, ldb2, bhalf2; int K; const int* list;
    const char* B; const float* b_in; unsigned char* act; MoeTab M; int G, c;
    __device__ __forceinline__ bool next(int i, fg::Unit& u) const { int e, j, rb, cnt, rowbase; if (!M.decode(i, G, c, e, j, rb, cnt, rowbase)) return false;
        e = __builtin_amdgcn_readfirstlane(e); j = __builtin_amdgcn_readfirstlane(j); rb = __builtin_amdgcn_readfirstlane(rb); cnt = __builtin_amdgcn_readfirstlane(cnt); rowbase = __builtin_amdgcn_readfirstlane(rowbase);
        u.bBase = B + (size_t)e * ((size_t)2 * kDFF * kD) + (size_t)j * 128 * kD; u.arow0 = e * kT + rb * 256; u.nvalid = min(256, cnt - rb * 256); u.e = e; u.orow0 = rowbase + rb * 256; u.ocol0 = j * 128; u.acol2 = 0; return true; }
    __device__ __forceinline__ void epi(const f32x4 (&acc)[2][2][4][2], const fg::Unit& u, int wr, int wc, int fr, int fq) const {
        f32x4 bg[2], bl[2];
#pragma unroll
        for (int n = 0; n < 2; ++n) { const float* bp = b_in + (size_t)u.e * 2 * kDFF + u.ocol0 + wc * 32 + n * 16 + fq * 4; bg[n] = *(const f32x4*)bp; bl[n] = *(const f32x4*)(bp + kDFF); }
#pragma unroll
        FG_FOR_ROWS { unsigned char* rowp = act + (size_t)(u.orow0 + ai * 128 + wr * 64 + m * 16 + fr) * kDFF + u.ocol0 + wc * 32 + fq * 4;
#pragma unroll
            for (int n = 0; n < 2; ++n) { const f32x4 gv = acc[ai][0][m][n] + bg[n], lv = acc[ai][1][m][n] + bl[n]; float o[4];
#pragma unroll
                for (int j = 0; j < 4; ++j) { const float g = fminf(gv[j], 7.f), l = fminf(fmaxf(lv[j], -7.f), 7.f); o[j] = clamp448(g * __builtin_amdgcn_rcpf(1.f + __expf(-1.702f * g)) * (l + 1.f)); }
                *(unsigned*)(rowp + n * 16) = pk4_fp8(o[0], o[1], o[2], o[3]); } }
    }
};
struct JobMoe2F8 {
    static constexpr bool GATHER = false;
    const char* A; unsigned lda2, ldb2, bhalf2; int K; const int* list;
    const char* B; const float* b_out; bf16_t* yp; MoeTab M; int G, c;
    __device__ __forceinline__ bool next(int i, fg::Unit& u) const { int e, j, rb, cnt, rowbase; if (!M.decode(i, G, c, e, j, rb, cnt, rowbase)) return false;
        e = __builtin_amdgcn_readfirstlane(e); j = __builtin_amdgcn_readfirstlane(j); rb = __builtin_amdgcn_readfirstlane(rb); rowbase = __builtin_amdgcn_readfirstlane(rowbase);
        u.bBase = B + (size_t)e * ((size_t)kDFF * kD) + (size_t)j * 256 * kDFF; u.arow0 = rowbase + rb * 256; u.nvalid = 256; u.e = e; u.orow0 = rowbase + rb * 256; u.ocol0 = j * 256; u.acol2 = 0; return true; }
    __device__ __forceinline__ void epi(const f32x4 (&acc)[2][2][4][2], const fg::Unit& u, int wr, int wc, int fr, int fq) const {
        f32x4 bo[2][2];
#pragma unroll
        for (int bj = 0; bj < 2; ++bj)
#pragma unroll
            for (int n = 0; n < 2; ++n) bo[bj][n] = *(const f32x4*)(b_out + (size_t)u.e * kD + u.ocol0 + bj * 128 + wc * 32 + n * 16 + fq * 4);
#pragma unroll
        FG_FOR_ROWS { bf16_t* rowp = yp + (size_t)(u.orow0 + ai * 128 + wr * 64 + m * 16 + fr) * kD + u.ocol0 + wc * 32 + fq * 4;
#pragma unroll
            for (int bj = 0; bj < 2; ++bj)
#pragma unroll
                for (int n = 0; n < 2; ++n) { const f32x4 v = acc[ai][bj][m][n] + bo[bj][n]; u32x2 w; w.x = pk_bf16(v[0], v[1]); w.y = pk_bf16(v[2], v[3]); *(u32x2*)(rowp + bj * 128 + n * 16) = w; } }
    }
};

struct CvtT { const float* src; unsigned char* dst; int K, N, tn, per; };
__device__ __forceinline__ CvtT cvt_make(const float* src, unsigned char* dst, int K, int N) { CvtT c; c.src = src; c.dst = dst; c.K = K; c.N = N; c.tn = N / 64; c.per = (K / 128) * (N / 64); return c; }
__device__ __forceinline__ void cvt_load(const CvtT& C, int t, int kq, int nc, f32x4 (&v)[4]) {
    const int mat = t / C.per, r = t - mat * C.per, kt = r / C.tn, nt_ = r - kt * C.tn;
    const float* sp = C.src + (size_t)mat * C.K * C.N + (size_t)(kt * 128 + 4 * kq) * C.N + nt_ * 64 + 4 * nc;
#pragma unroll
    for (int i = 0; i < 4; ++i) v[i] = __builtin_nontemporal_load((const f32x4*)(sp + (size_t)i * C.N));
}
__device__ __forceinline__ void cvt_emit(const CvtT& C, int t, LAS unsigned* L, const f32x4 (&v)[4], int kq, int nc, int rn, int rc) {
#pragma unroll
    for (int j = 0; j < 4; ++j) L[(4 * nc + j) * 33 + kq] = pk4_fp8(v[0][j] * kWScale, v[1][j] * kWScale, v[2][j] * kWScale, v[3][j] * kWScale);
    __syncthreads();
    const int mat = t / C.per, r = t - mat * C.per, kt = r / C.tn, nt_ = r - kt * C.tn;
    u32x4 o; o.x = L[rn * 33 + 4 * rc]; o.y = L[rn * 33 + 4 * rc + 1]; o.z = L[rn * 33 + 4 * rc + 2]; o.w = L[rn * 33 + 4 * rc + 3];
    __builtin_nontemporal_store(o, (u32x4*)(C.dst + (size_t)mat * C.K * C.N + (size_t)(nt_ * 64 + rn) * C.K + kt * 128 + rc * 16));
}
__device__ __forceinline__ void convert_t_f8(LAS unsigned char* lds, const CvtT C, int t0, int t1, int stride) {
    const int tid = threadIdx.x, kq = tid >> 4, nc = tid & 15, rn = tid >> 3, rc = tid & 7;
    f32x4 v0[4], v1[4], vn[4];
    __syncthreads();
    if (t0 < t1) cvt_load(C, t0, kq, nc, v0);
    if (t0 + stride < t1) cvt_load(C, t0 + stride, kq, nc, v1);
    int i = 0;
#pragma unroll 1
    for (int t = t0; t < t1; t += stride, ++i) {
        if (t + 2 * stride < t1) cvt_load(C, t + 2 * stride, kq, nc, vn);
        cvt_emit(C, t, (LAS unsigned*)(lds + (i & 1) * 8704), v0, kq, nc, rn, rc);
#pragma unroll
        for (int j = 0; j < 4; ++j) { v0[j] = v1[j]; v1[j] = vn[j]; }
    }
    __syncthreads();
}
__device__ __forceinline__ void convert_dyn(LAS unsigned char* lds, const CvtT C, unsigned* qctr, int dbase, int dend) {
    LAS int* bx = (LAS int*)(lds + 2 * 8704);
#pragma unroll 1
    for (;;) {
        __syncthreads();
        if (threadIdx.x == 0) bx[0] = dbase + (int)atomicAdd(qctr, 8u);
        __syncthreads();
        const int t0 = bx[0];
        if (t0 >= dend) break;
        convert_t_f8(lds, C, t0, min(t0 + 8, dend), 1);
    }
}

__device__ __forceinline__ void convert_seg(const float* __restrict__ src, bf16_t* __restrict__ dst, size_t n8, size_t gtid, size_t gstride) {
    const f32x4* s4 = (const f32x4*)src; u32x4* d4 = (u32x4*)dst;
#pragma unroll 4
    for (size_t i = gtid; i < n8; i += gstride) { const f32x4 a = __builtin_nontemporal_load(s4 + 2 * i), b = __builtin_nontemporal_load(s4 + 2 * i + 1);
        u32x4 w; w.x = pk_bf16(a[0], a[1]); w.y = pk_bf16(a[2], a[3]); w.z = pk_bf16(b[0], b[1]); w.w = pk_bf16(b[2], b[3]); d4[i] = w; }
}


#define XB_TMO      128
#define XB_XCNT(j)  (256  + 64 * (j))
#define XB_XSUB(j)  (1280 + 64 * (j))
#define XB_XGEN(j)  (2304 + 64 * (j))
#define XB_TOP      3328
#define XB_TOPGEN   3392
#define XCD_BAR_WORDS 3456
#define XB_SPIN_CAP (1u << 18)
__device__ __forceinline__ unsigned xb_ld(unsigned* p)              { return __hip_atomic_load(p, __ATOMIC_RELAXED, __HIP_MEMORY_SCOPE_AGENT); }
__device__ __forceinline__ unsigned xb_add(unsigned* p, unsigned v) { return __hip_atomic_fetch_add(p, v, __ATOMIC_RELAXED, __HIP_MEMORY_SCOPE_AGENT); }
__device__ __forceinline__ unsigned xb_xcc_id() { return (unsigned)__builtin_amdgcn_s_getreg((3 << 11) | 20) & 0xFu; }
#define XB_SPIN(cond, bar) do { unsigned _sp = 0; while (cond) { __builtin_amdgcn_s_sleep(1); \
    if ((++_sp & 255u) == 0u) { if (xb_ld(&(bar)[XB_TMO])) break; if (_sp > XB_SPIN_CAP) { atomicAdd(&(bar)[XB_TMO], 1u); break; } } } } while (0)
struct XcdBarrier { unsigned* bar; unsigned x; volatile LAS unsigned* st; };
__device__ __forceinline__ XcdBarrier xcd_barrier_post(unsigned* bar, volatile LAS unsigned* st) {
    XcdBarrier b; b.bar = bar; b.x = xb_xcc_id(); b.st = st;
    if (threadIdx.x == 0) (void)xb_add(&bar[XB_XCNT(b.x)], 1u);
    return b;
}
__device__ __forceinline__ void xcd_barrier_complete(unsigned* bar, unsigned x, unsigned& nloc, unsigned& nx) {
    const unsigned G = gridDim.x * gridDim.y * gridDim.z;
    unsigned sum, cnt, mine, sp = 0u;
    for (;;) {
        sum = 0u; cnt = 0u; mine = 0u;
#pragma unroll
        for (unsigned j = 0; j < 16; ++j) { const unsigned c = xb_ld(&bar[XB_XCNT(j)]); sum += c; cnt += (c > 0u) ? 1u : 0u; mine = (j == x) ? c : mine; }
        if (sum == G) break;
        __builtin_amdgcn_s_sleep(1);
        if ((++sp & 255u) == 0u) { if (xb_ld(&bar[XB_TMO])) break; if (sp > XB_SPIN_CAP) { atomicAdd(&bar[XB_TMO], 1u); break; } }
    }
    nloc = mine > 0u ? mine : 1u; nx = cnt > 0u ? cnt : 1u;
}
__device__ __forceinline__ void xcd_barrier(const XcdBarrier& b) {
    asm volatile("s_waitcnt vmcnt(0)" ::: "memory");
    __syncthreads();
    if (threadIdx.x == 0) {
        unsigned* bar = b.bar;
        __builtin_amdgcn_s_waitcnt(0);
        unsigned nloc = b.st[0], nx = b.st[1];
        if (nloc == 0u) { xcd_barrier_complete(bar, b.x, nloc, nx); b.st[0] = nloc; b.st[1] = nx; }
        const unsigned old = xb_add(&bar[XB_XSUB(b.x)], 1u);
        const unsigned gen = old / nloc;
        if (old + 1u == (gen + 1u) * nloc) {
            __builtin_amdgcn_fence(__ATOMIC_RELEASE, "agent");
            asm volatile("s_waitcnt vmcnt(0)" ::: "memory");
            const unsigned og = xb_add(&bar[XB_TOP], 1u);
            const unsigned tg = og / nx;
            if (og + 1u == (tg + 1u) * nx) xb_add(&bar[XB_TOPGEN], 1u);
            else XB_SPIN(xb_ld(&bar[XB_TOPGEN]) == tg, bar);
            __builtin_amdgcn_fence(__ATOMIC_ACQUIRE, "agent");
            xb_add(&bar[XB_XGEN(b.x)], 1u);
            asm volatile("s_waitcnt vmcnt(0)" ::: "memory");
        } else {
            XB_SPIN(xb_ld(&bar[XB_XGEN(b.x)]) == gen, bar);
            __builtin_amdgcn_fence(__ATOMIC_ACQUIRE, "agent");
            asm volatile("s_waitcnt vmcnt(0)" ::: "memory");
        }
    }
    __syncthreads();
}

__device__ __forceinline__ void ada_phase(LAS unsigned char* lds, const float* __restrict__ cvec, const float* __restrict__ w_ada, const float* __restrict__ b_ada, float* __restrict__ mod, int G, int c) {
    LAS float* ca = (LAS float*)lds;
    LAS float* part = (LAS float*)(lds + 32768);
    const int tid = threadIdx.x;
    __syncthreads();
    for (int i = tid; i < kB * kD; i += 512) { const float v = cvec[i]; ca[i] = v / (1.f + __expf(-v)); }
    __syncthreads();
    for (int cb = c; cb < 6 * kD / 48; cb += G) {
        const int n0 = cb * 48, cg = tid % 12, kr = tid / 12;
        if (tid < 504) {
            f32x4 a0 = {0.f, 0.f, 0.f, 0.f}, a1 = a0, a2 = a0, a3 = a0;
#pragma unroll 8
            for (int k = kr; k < kD; k += 42) { const f32x4 w = __builtin_nontemporal_load((const f32x4*)(w_ada + (size_t)k * (6 * kD) + n0 + cg * 4));
                a0 += ca[k] * w; a1 += ca[kD + k] * w; a2 += ca[2 * kD + k] * w; a3 += ca[3 * kD + k] * w; }
            LAS f32x4* pp = (LAS f32x4*)(part + (kr * 12 + cg) * 16); pp[0] = a0; pp[1] = a1; pp[2] = a2; pp[3] = a3;
        }
        __syncthreads();
        if (tid < 192) { const int col = tid % 48, b = tid / 48; float sum = 0.f;
            for (int r = 0; r < 42; ++r) sum += part[(r * 12 + (col >> 2)) * 16 + b * 4 + (col & 3)];
            mod[b * 6 * kD + n0 + col] = sum + b_ada[n0 + col]; }
        __syncthreads();
    }
}

__device__ __forceinline__ void norm1_phase(const float* __restrict__ x, const float* __restrict__ nw, const float* __restrict__ mod, bf16_t* __restrict__ out, int G, int c) {
    const int wid = threadIdx.x >> 6, lane = threadIdx.x & 63;
    for (int t = c * 8 + wid; t < kT; t += G * 8) {
        const int b = t / kS; const float* xr = x + (size_t)t * kD + lane * 4; const float* mb = mod + b * 6 * kD + lane * 4;
        f32x4 v[8]; float ss = 0.f;
#pragma unroll
        for (int j = 0; j < 8; ++j) { v[j] = *(const f32x4*)(xr + 256 * j); ss += v[j][0] * v[j][0] + v[j][1] * v[j][1] + v[j][2] * v[j][2] + v[j][3] * v[j][3]; }
        ss = wave_sum(ss);
        const float r = rsqrtf(ss * (1.f / kD) + kEPS);
#pragma unroll
        for (int j = 0; j < 8; ++j) { const f32x4 w = *(const f32x4*)(nw + lane * 4 + 256 * j), sh = *(const f32x4*)(mb + 256 * j), sc = *(const f32x4*)(mb + kD + 256 * j);
            const f32x4 y = v[j] * r * w * (1.f + sc) + sh; u32x2 o; o.x = pk_bf16(y[0], y[1]); o.y = pk_bf16(y[2], y[3]);
            *(u32x2*)(out + (size_t)t * kD + lane * 4 + 256 * j) = o; }
    }
}

constexpr int RT_STRIDE = 144;
__device__ __forceinline__ void norm2_router_phase(LAS unsigned char* lds, const float* __restrict__ x1, const float* __restrict__ nw, const float* __restrict__ mod,
                                                   const float* __restrict__ w_router, const float* __restrict__ b_router, unsigned char* __restrict__ h2,
                                                   float* __restrict__ gates, int* __restrict__ pair_e, int* __restrict__ pair_p, int* __restrict__ list, unsigned* __restrict__ ctrl, int G, int c) {
    const int tid = threadIdx.x, wid = tid >> 6, lane = tid & 63;
    LAS int* lcnt = (LAS int*)(lds + fg::MISC_OFF + 64);
    for (int blk = c; blk < kT / 32; blk += G) {
        __syncthreads();
        if (tid < 32) lcnt[tid] = 0;
        __syncthreads();
#pragma unroll 1
        for (int pass = 0; pass < 2; ++pass) {
            const int t0 = blk * 32 + wid * 4 + pass * 2, b = t0 / kS;
            float rs[2];
#pragma unroll
            for (int rr = 0; rr < 2; ++rr) { const float* xr = x1 + (size_t)(t0 + rr) * kD + 2 * lane; float ss = 0.f;
#pragma unroll
                for (int i = 0; i < 16; ++i) { const f32x2 v = *(const f32x2*)(xr + 128 * i); ss += v[0] * v[0] + v[1] * v[1]; }
                ss = wave_sum(ss); rs[rr] = rsqrtf(ss * (1.f / kD) + kEPS); }
            f32x4 acc[2][8];
#pragma unroll
            for (int rr = 0; rr < 2; ++rr)
#pragma unroll
                for (int q = 0; q < 8; ++q) acc[rr][q] = (f32x4){0.f, 0.f, 0.f, 0.f};
#pragma unroll 1
            for (int q = 0; q < 4; ++q) {
                __syncthreads();
#pragma unroll
                for (int j = 0; j < 8; ++j) { const int idx = tid + 512 * j, row = idx >> 3, ch = idx & 7;
                    *(LAS f32x4*)(lds + row * RT_STRIDE + ch * 16) = *(const f32x4*)(w_router + (size_t)(512 * q + row) * kE + ch * 4); }
                f32x2 yq[2][4];
#pragma unroll
                for (int ii = 0; ii < 4; ++ii) { const int n = 2 * lane + 128 * (4 * q + ii);
                    const f32x2 w = *(const f32x2*)(nw + n), sh = *(const f32x2*)(mod + b * 6 * kD + 3 * kD + n), sc = *(const f32x2*)(mod + b * 6 * kD + 4 * kD + n);
#pragma unroll
                    for (int rr = 0; rr < 2; ++rr) { const f32x2 v = *(const f32x2*)(x1 + (size_t)(t0 + rr) * kD + n); yq[rr][ii] = v * rs[rr] * w * (1.f + sc) + sh;
                        *(unsigned short*)(h2 + (size_t)(t0 + rr) * kD + n) = (unsigned short)__builtin_amdgcn_cvt_pk_fp8_f32(clamp448(yq[rr][ii][0]), clamp448(yq[rr][ii][1]), 0, false); } }
                __syncthreads();
#pragma unroll
                for (int ii = 0; ii < 4; ++ii)
#pragma unroll
                    for (int e = 0; e < 2; ++e) { const LAS unsigned char* wp = lds + (2 * lane + 128 * ii + e) * RT_STRIDE;
#pragma unroll
                        for (int ch = 0; ch < 8; ++ch) { const f32x4 wv = *(const LAS f32x4*)(wp + ch * 16);
                            acc[0][ch] += yq[0][ii][e] * wv; acc[1][ch] += yq[1][ii][e] * wv; } }
            }
#pragma unroll
            for (int rr = 0; rr < 2; ++rr) {
                float v16[16], v8[8], v4[4], v2[2], v1;
                { const bool up = lane & 32;
#pragma unroll
                  for (int j = 0; j < 16; ++j) { const float lo = acc[rr][j >> 2][j & 3], hi = acc[rr][4 + (j >> 2)][j & 3]; const float send = up ? lo : hi, keep = up ? hi : lo; v16[j] = keep + __shfl_xor(send, 32); } }
                { const bool up = lane & 16;
#pragma unroll
                  for (int j = 0; j < 8; ++j) { const float send = up ? v16[j] : v16[j + 8], keep = up ? v16[j + 8] : v16[j]; v8[j] = keep + __shfl_xor(send, 16); } }
                { const bool up = lane & 8;
#pragma unroll
                  for (int j = 0; j < 4; ++j) { const float send = up ? v8[j] : v8[j + 4], keep = up ? v8[j + 4] : v8[j]; v4[j] = keep + __shfl_xor(send, 8); } }
                { const bool up = lane & 4;
#pragma unroll
                  for (int j = 0; j < 2; ++j) { const float send = up ? v4[j] : v4[j + 2], keep = up ? v4[j + 2] : v4[j]; v2[j] = keep + __shfl_xor(send, 4); } }
                { const bool up = lane & 2; const float send = up ? v2[0] : v2[1], keep = up ? v2[1] : v2[0]; v1 = keep + __shfl_xor(send, 2); }
                v1 += __shfl_xor(v1, 1);
                const int e_mine = (lane >> 1) & 31;
                float mine = (lane & 1) ? -3.4e38f : v1 + b_router[e_mine];
                int idx[4]; float val[4];
#pragma unroll
                for (int k = 0; k < 4; ++k) { float bv = mine; int bi = e_mine + ((lane & 1) << 6);
#pragma unroll
                    for (int o = 32; o > 0; o >>= 1) { const float ov = __shfl_xor(bv, o); const int oi = __shfl_xor(bi, o); if (ov > bv || (ov == bv && oi < bi)) { bv = ov; bi = oi; } }
                    idx[k] = bi; val[k] = bv; if (!(lane & 1) && e_mine == bi) mine = -3.4e38f; }
                if (lane == 0) { const int t = t0 + rr, r32 = wid * 4 + pass * 2 + rr; float ex[4], sum = 0.f;
#pragma unroll
                    for (int k = 0; k < 4; ++k) { ex[k] = __expf(val[k] - val[0]); sum += ex[k]; }
                    const float inv = 1.f / sum;
#pragma unroll
                    for (int k = 0; k < 4; ++k) { gates[t * 4 + k] = ex[k] * inv; lcnt[64 + r32 * 4 + k] = idx[k]; lcnt[192 + r32 * 4 + k] = __hip_atomic_fetch_add(&lcnt[idx[k]], 1, __ATOMIC_RELAXED, __HIP_MEMORY_SCOPE_WORKGROUP); } }
            }
        }
        __syncthreads();
        if (tid < 32) { const int n = lcnt[tid]; lcnt[32 + tid] = n > 0 ? (int)atomicAdd(&ctrl[CT_CNT + 64 * tid], (unsigned)n) : 0; }
        __syncthreads();
        if (tid < 128) { const int e = lcnt[64 + tid], pos = lcnt[32 + e] + lcnt[192 + tid], t = blk * 32 + (tid >> 2);
            pair_e[t * 4 + (tid & 3)] = e; pair_p[t * 4 + (tid & 3)] = pos; list[(size_t)e * kT + pos] = t; }
    }
}

__device__ __forceinline__ void final_phase(const float* __restrict__ x1, const float* __restrict__ mod, const float* __restrict__ gates, const int* __restrict__ pair_e, const int* __restrict__ pair_p,
                                            const MoeTab M, const bf16_t* __restrict__ yp, float* __restrict__ out, int G, int c) {
    const int wid = threadIdx.x >> 6, lane = threadIdx.x & 63;
    for (int t = c * 8 + wid; t < kT; t += G * 8) {
        const int b = t / kS; float gk[4]; const bf16_t* rp[4];
#pragma unroll
        for (int k = 0; k < 4; ++k) { gk[k] = gates[t * 4 + k]; const int e = pair_e[t * 4 + k];
            rp[k] = yp + (size_t)(M.t[32 + e] + pair_p[t * 4 + k]) * kD + lane * 8; }
#pragma unroll
        for (int j = 0; j < 4; ++j) { f32x4 y0 = {0.f, 0.f, 0.f, 0.f}, y1 = y0;
#pragma unroll
            for (int k = 0; k < 4; ++k) { const u32x4 v = *(const u32x4*)(rp[k] + 512 * j);
                y0 += gk[k] * (f32x4){bflo(v.x), bfhi(v.x), bflo(v.y), bfhi(v.y)}; y1 += gk[k] * (f32x4){bflo(v.z), bfhi(v.z), bflo(v.w), bfhi(v.w)}; }
            const size_t o = (size_t)t * kD + lane * 8 + 512 * j; const float* gp = mod + b * 6 * kD + 5 * kD + lane * 8 + 512 * j;
            *(f32x4*)(out + o) = *(const f32x4*)(x1 + o) + *(const f32x4*)gp * y0; *(f32x4*)(out + o + 4) = *(const f32x4*)(x1 + o + 4) + *(const f32x4*)(gp + 4) * y1; }
    }
}

struct MegaArgs { const float* in[18]; float* out; unsigned char* ws; int ph_lo, ph_hi; };
constexpr int NPHASE = 10;
__global__ void __launch_bounds__(512, 2) mega(MegaArgs a) {
    extern __shared__ __attribute__((aligned(16))) unsigned char lds_raw[];
    LAS unsigned char* lds = (LAS unsigned char*)lds_raw;
    unsigned char* ws = a.ws;
    const int lo = a.ph_lo, hi = a.ph_hi;
#ifndef DUP_PHASE
#define DUP_PHASE -1
#endif
#define IN(k) (lo <= (k) && (k) < hi)
#define REP(k)
#define DUPQ(k) ((k) == DUP_PHASE)
#define SEAM(k) do { if (IN(k) && IN((k) + 1)) xcd_barrier(bar); } while (0)
    const int G = gridDim.x, c = blockIdx.x;
    unsigned* ctrl = (unsigned*)(ws + WS_CTRL);
    const int grp = (c >> 3) & 1, cpr = ((c >> 4) << 3) | (c & 7);
#define HOST_PRE(CC, r0, n)  do { if (grp == 0) convert_t_f8(lds, CC, (r0) + cpr, (r0) + (G / 2) * (n), G / 2); } while (0)
#define HOST_POST(CC, r0, n, q) convert_dyn(lds, CC, ctrl + CT_Q + 64 * (q), (r0) + (G / 2) * (n), (r0) + G * (n))
    const int r_p2 = 0, r_p3 = 64 * G, r_p5 = 88 * G, r_p6 = 112 * G;
    const CvtT C1 = cvt_make(a.in[14], (unsigned char*)(ws + WS_WE1), kD, 2 * kDFF);
    const CvtT C2 = cvt_make(a.in[16], (unsigned char*)(ws + WS_WE2), kDFF, kD);
    if (threadIdx.x == 0) *(LAS u32x4*)(lds + fg::MISC_OFF) = (u32x4){0u, 0u, 0u, 0u};
    __syncthreads();
    XcdBarrier bar; bar.bar = ctrl; bar.x = 0; bar.st = (volatile LAS unsigned*)(lds + fg::MISC_OFF);
    if (hi - lo > 1) bar = xcd_barrier_post(ctrl, (volatile LAS unsigned*)(lds + fg::MISC_OFF));
    float* mod = (float*)(ws + WS_MOD);
    if (IN(0)) REP(0) {
        ada_phase(lds, a.in[1], a.in[4], a.in[5], mod, G, c);
        const size_t gtid = (size_t)blockIdx.x * 512 + threadIdx.x, gstride = (size_t)G * 512;
        convert_seg(a.in[6], (bf16_t*)(ws + WS_WIN), (size_t)kD * kNPROJ / 8, gtid, gstride);
        convert_seg(a.in[11], (bf16_t*)(ws + WS_WO), (size_t)kD * kD / 8, gtid, gstride);
        { const f32x4* s4 = (const f32x4*)a.in[9]; const f32x4* sc4 = (const f32x4*)a.in[10]; u32x4* d4 = (u32x4*)(ws + WS_WPL);
          for (size_t i = gtid; i < (size_t)4 * kPG * kPG / 8; i += gstride) { const int g = (int)(i >> 13), n8 = (int)(i & 31);
              const f32x4 sa = sc4[g * 64 + n8 * 2], sb = sc4[g * 64 + n8 * 2 + 1]; const f32x4 a0 = s4[2 * i] * sa, b0 = s4[2 * i + 1] * sb;
              u32x4 w; w.x = pk_bf16(a0[0], a0[1]); w.y = pk_bf16(a0[2], a0[3]); w.z = pk_bf16(b0[0], b0[1]); w.w = pk_bf16(b0[2], b0[3]); d4[i] = w; } }
    }
    SEAM(0);
    if (IN(1)) REP(1) norm1_phase(a.in[0], a.in[2], mod, (bf16_t*)(ws + WS_H), G, c);
    if (IN(1) && DUPQ(1)) norm1_phase(a.in[0], a.in[2], mod, (bf16_t*)(ws + WS_H), G, c);
    SEAM(1);
    if (IN(2)) HOST_PRE(C1, r_p2, 64);
    if (IN(2)) REP(2) { JobInProj J; J.A = (const char*)(ws + WS_H); J.lda2 = kD * 2; J.ldb2 = kNPROJ * 2; J.bhalf2 = 256; J.K = kD; J.list = nullptr;
        J.B = (const char*)(ws + WS_WIN); J.out = (bf16_t*)(ws + WS_PROJ); J.S.init(kT, kNPROJ, G, c); fg::gemm_phase(lds, J); }
    if (IN(2) && DUPQ(2)) { JobInProj J; J.A = (const char*)(ws + WS_H); J.lda2 = kD * 2; J.ldb2 = kNPROJ * 2; J.bhalf2 = 256; J.K = kD; J.list = nullptr;
        J.B = (const char*)(ws + WS_WIN); J.out = (bf16_t*)(ws + WS_PROJ); J.S.init(kT, kNPROJ, G, c); fg::gemm_phase(lds, J); }
    if (IN(2)) HOST_POST(C1, r_p2, 64, 0);
    SEAM(2);
    if (IN(3)) HOST_PRE(C1, r_p3, 24);
    if (IN(3)) REP(3) { at::attn_phase(lds, (const bf16_t*)(ws + WS_PROJ), a.in[7], a.in[8], (bf16_t*)(ws + WS_CAT), G, c);
        pool_p_phase((const bf16_t*)(ws + WS_PROJ), (bf16_t*)(ws + WS_P), G, c); }
    if (IN(3) && DUPQ(3)) { at::attn_phase(lds, (const bf16_t*)(ws + WS_PROJ), a.in[7], a.in[8], (bf16_t*)(ws + WS_CAT), G, c);
        pool_p_phase((const bf16_t*)(ws + WS_PROJ), (bf16_t*)(ws + WS_P), G, c); }
    if (IN(3)) HOST_POST(C1, r_p3, 24, 1);
    SEAM(3);
    if (IN(4)) REP(4) { JobPool J; J.A = (const char*)(ws + WS_P); J.lda2 = kPW * 2; J.ldb2 = kPG * 2; J.bhalf2 = 256; J.K = kPG; J.list = nullptr;
        J.B = (const char*)(ws + WS_WPL); J.cat = (bf16_t*)(ws + WS_CAT); J.G = G; J.c = c; fg::gemm_phase(lds, J); }
    if (IN(4) && DUPQ(4)) { JobPool J; J.A = (const char*)(ws + WS_P); J.lda2 = kPW * 2; J.ldb2 = kPG * 2; J.bhalf2 = 256; J.K = kPG; J.list = nullptr;
        J.B = (const char*)(ws + WS_WPL); J.cat = (bf16_t*)(ws + WS_CAT); J.G = G; J.c = c; fg::gemm_phase(lds, J); }
    SEAM(4);
    if (IN(5)) HOST_PRE(C1, r_p5, 24);
    if (IN(5)) REP(5) { JobOutProj J; J.A = (const char*)(ws + WS_CAT); J.lda2 = kD * 2; J.ldb2 = kD * 2; J.bhalf2 = 256; J.K = kD; J.list = nullptr;
        J.B = (const char*)(ws + WS_WO); J.x = a.in[0]; J.mod = mod; J.x1 = (float*)(ws + WS_X1); J.S.init(kT, kD, G, c); fg::gemm_phase(lds, J); }
    if (IN(5) && DUPQ(5)) { JobOutProj J; J.A = (const char*)(ws + WS_CAT); J.lda2 = kD * 2; J.ldb2 = kD * 2; J.bhalf2 = 256; J.K = kD; J.list = nullptr;
        J.B = (const char*)(ws + WS_WO); J.x = a.in[0]; J.mod = mod; J.x1 = (float*)(ws + WS_X1); J.S.init(kT, kD, G, c); fg::gemm_phase(lds, J); }
    if (IN(5)) HOST_POST(C1, r_p5, 24, 2);
    SEAM(5);
    if (IN(6)) HOST_PRE(C1, r_p6, 16);
    if (IN(6)) REP(6) norm2_router_phase(lds, (const float*)(ws + WS_X1), a.in[3], mod, a.in[12], a.in[13], (unsigned char*)(ws + WS_H2), (float*)(ws + WS_GATES), (int*)(ws + WS_PAIRE), (int*)(ws + WS_PAIRP),
                                  (int*)(ws + WS_LIST), ctrl, G, c);
    if (IN(6)) HOST_POST(C1, r_p6, 16, 3);
    SEAM(6);
    if (IN(7)) HOST_PRE(C2, 0, 64);
    if (IN(7)) REP(7) { JobMoe1F8 J; J.A = (const char*)(ws + WS_H2); J.lda2 = kD; J.ldb2 = kD; J.bhalf2 = (unsigned)kDFF * kD; J.K = kD; J.list = (const int*)(ws + WS_LIST);
        J.B = (const char*)(ws + WS_WE1); J.b_in = a.in[15]; J.act = (unsigned char*)(ws + WS_ACT); J.M = moe_tables(lds, ctrl, kDFF / 128); J.G = G; J.c = c; fg::gemm_phase_f8(lds, J); }
    if (IN(7) && DUPQ(7)) { JobMoe1F8 J; J.A = (const char*)(ws + WS_H2); J.lda2 = kD; J.ldb2 = kD; J.bhalf2 = (unsigned)kDFF * kD; J.K = kD; J.list = (const int*)(ws + WS_LIST);
        J.B = (const char*)(ws + WS_WE1); J.b_in = a.in[15]; J.act = (unsigned char*)(ws + WS_ACT); J.M = moe_tables(lds, ctrl, kDFF / 128); J.G = G; J.c = c; fg::gemm_phase_f8(lds, J); }
    if (IN(7)) HOST_POST(C2, 0, 64, 4);
    SEAM(7);
    if (IN(8)) REP(8) { JobMoe2F8 J; J.A = (const char*)(ws + WS_ACT); J.lda2 = kDFF; J.ldb2 = kDFF; J.bhalf2 = 128u * kDFF; J.K = kDFF; J.list = nullptr;
        J.B = (const char*)(ws + WS_WE2); J.b_out = a.in[17]; J.yp = (bf16_t*)(ws + WS_YP); J.M = moe_tables(lds, ctrl, kD / 256); J.G = G; J.c = c; fg::gemm_phase_f8(lds, J); }
    if (IN(8) && DUPQ(8)) { JobMoe2F8 J; J.A = (const char*)(ws + WS_ACT); J.lda2 = kDFF; J.ldb2 = kDFF; J.bhalf2 = 128u * kDFF; J.K = kDFF; J.list = nullptr;
        J.B = (const char*)(ws + WS_WE2); J.b_out = a.in[17]; J.yp = (bf16_t*)(ws + WS_YP); J.M = moe_tables(lds, ctrl, kD / 256); J.G = G; J.c = c; fg::gemm_phase_f8(lds, J); }
    SEAM(8);
    if (IN(9)) REP(9) final_phase((const float*)(ws + WS_X1), mod, (const float*)(ws + WS_GATES), (const int*)(ws + WS_PAIRE), (const int*)(ws + WS_PAIRP), moe_tables(lds, ctrl, 1), (const bf16_t*)(ws + WS_YP), a.out, G, c);
    if (IN(9) && DUPQ(9)) final_phase((const float*)(ws + WS_X1), mod, (const float*)(ws + WS_GATES), (const int*)(ws + WS_PAIRE), (const int*)(ws + WS_PAIRP), moe_tables(lds, ctrl, 1), (const bf16_t*)(ws + WS_YP), a.out, G, c);
#undef IN
#undef SEAM
}

#ifndef N_LAUNCHES
#define N_LAUNCHES 1
#endif
extern "C" void kernel_launch(void* const* d_in, const int* in_sizes, int n_in, void* d_out, int out_size, void* d_ws, size_t ws_size, hipStream_t stream) {
    static int grid = 0;
    if (grid == 0) {
        int dev = 0, cus = 0;
        (void)hipGetDevice(&dev); (void)hipDeviceGetAttribute(&cus, hipDeviceAttributeMultiprocessorCount, dev);
        (void)hipFuncSetAttribute((const void*)mega, hipFuncAttributeMaxDynamicSharedMemorySize, fg::LDS_BYTES);
        grid = cus > 0 ? cus : 256;
    }
    MegaArgs a{}; for (int i = 0; i < 18; ++i) a.in[i] = (const float*)d_in[i]; a.out = (float*)d_out; a.ws = (unsigned char*)d_ws;
    (void)hipMemsetAsync((char*)d_ws + WS_CTRL, 0, 65536, stream);
    if (N_LAUNCHES == 1) { a.ph_lo = 0; a.ph_hi = NPHASE; hipLaunchKernelGGL(mega, dim3(grid), dim3(512), fg::LDS_BYTES, stream, a); }
    else for (int p = 0; p < NPHASE; ++p) { a.ph_lo = p; a.ph_hi = p + 1; hipLaunchKernelGGL(mega, dim3(grid), dim3(512), fg::LDS_BYTES, stream, a); }
}
```

```cpp
#include <hip/hip_runtime.h>
#include <stdint.h>

constexpr int kB = 4, kS = 2048, kD = 2048, kT = kB * kS;
constexpr int kHD = 128, kNH = 8, kSB = 1024, kPW = 1024, kPG = 256;
constexpr int kNPROJ = 4096, kE = 32, kTOPK = 4, kDFF = 2048;
constexpr float kEPS = 1e-6f;
constexpr int kMaxSlots = 160 * 256;

typedef unsigned short bf16_t;
__device__ __forceinline__ bf16_t f2bf(float f) { unsigned u = __float_as_uint(f); u += 0x7FFFu + ((u >> 16) & 1u); return (bf16_t)(u >> 16); }
__device__ __forceinline__ float bf2f(bf16_t b) { return __uint_as_float(((unsigned)b) << 16); }

constexpr size_t WS_CTRL   = 0;
constexpr size_t WS_MOD    = 65536;
constexpr size_t WS_H      = WS_MOD + (size_t)4 * 12288 * 4;
constexpr size_t WS_PROJ   = WS_H + (size_t)kT * kD * 2;
constexpr size_t WS_CAT    = WS_PROJ + (size_t)kT * kNPROJ * 2;
constexpr size_t WS_P      = WS_CAT + (size_t)kT * kD * 2;
constexpr size_t WS_X1     = WS_P + (size_t)kT * kPW * 2;
constexpr size_t WS_H2     = WS_X1 + (size_t)kT * kD * 4;
constexpr size_t WS_GATES  = WS_H2 + (size_t)kT * kD * 2;
constexpr size_t WS_PAIRE  = WS_GATES + (size_t)kT * 4 * 4;
constexpr size_t WS_PAIRP  = WS_PAIRE + (size_t)kT * 4 * 4;
constexpr size_t WS_LIST   = WS_PAIRP + (size_t)kT * 4 * 4;
constexpr size_t WS_ACT    = WS_LIST + (size_t)kE * kT * 4;
constexpr size_t WS_YP     = WS_ACT + (size_t)kMaxSlots * kDFF * 2;
constexpr size_t WS_END    = WS_YP + (size_t)kMaxSlots * kD * 2;
constexpr int CT_CNT = 4096;
constexpr int CT_ROWBASE = 4160;
constexpr int CT_Q = 8192;

#define LAS __attribute__((address_space(3)))
typedef short bf16x8 __attribute__((ext_vector_type(8)));
typedef short s16x4 __attribute__((ext_vector_type(4)));
typedef float f32x4 __attribute__((ext_vector_type(4)));
typedef float f32x2 __attribute__((ext_vector_type(2)));
typedef __bf16 bf16v2 __attribute__((ext_vector_type(2)));
typedef unsigned u32x2 __attribute__((ext_vector_type(2)));
typedef unsigned u32x4 __attribute__((ext_vector_type(4)));
typedef int i32x4 __attribute__((ext_vector_type(4)));
typedef int i32x8 __attribute__((ext_vector_type(8)));
__device__ __forceinline__ unsigned pk_bf16(float a, float b) { f32x2 v = {a, b}; bf16v2 r = __builtin_convertvector(v, bf16v2); return __builtin_bit_cast(unsigned, r); }

constexpr size_t WS_WIN  = WS_END;
constexpr size_t WS_WO   = WS_WIN + (size_t)kD * kNPROJ * 2;
constexpr size_t WS_WPL  = WS_WO + (size_t)kD * kD * 2;
constexpr size_t WS_WE1  = WS_WPL + (size_t)4 * kPG * kPG * 2;
constexpr size_t WS_WE2  = WS_WE1 + (size_t)kE * kD * 2 * kDFF * 2;
constexpr size_t WS_END2 = WS_WE2 + (size_t)kE * kDFF * kD * 2;

namespace fg {
constexpr int BM = 256, BK = 64, HALF = 128, HTB = 16384, STAGE_BYTES = 131072, NXCD = 8, WGM = 8;
constexpr int TAB_OFF = STAGE_BYTES;
constexpr int MISC_OFF = STAGE_BYTES + 2048;
constexpr int LDS_BYTES = STAGE_BYTES + 4096;
__device__ __forceinline__ int lds_byte(int r, int c) { const int st = (r >> 4) * 2 + (c >> 5), rr = r & 15, cc = c & 31, ob = rr * 64 + cc * 2; return st * 1024 + (ob ^ (((ob >> 9) & 1) << 5)); }
__device__ __forceinline__ void stage_rc(int b, int& R, int& C) { const int st = b / 1024, sb = b % 1024, swz = sb ^ (((sb >> 9) & 1) << 5); R = (st >> 1) * 16 + swz / 64; C = (st & 1) * 32 + (swz % 64) / 2; }

struct Unit { const char* bBase; int arow0; int nvalid; int e; int orow0; int ocol0; int acol2; };

struct StaticOrder {
    int nM, nN, nwg, G, c;
    __device__ void init(int M, int N, int G_, int c_) { nM = M / BM; nN = N / BM; nwg = nM * nN; G = G_; c = c_; }
    __device__ bool next(int i, int& pm, int& pn) const {
        const long L = (long)i * G + c; if (L >= nwg) return false;
        int wgid = (int)L; { const int q = nwg / NXCD, r = nwg % NXCD, xcd = wgid % NXCD, off = wgid / NXCD; wgid = (xcd < r ? xcd * (q + 1) : r * (q + 1) + (xcd - r) * q) + off; }
        const int nig = WGM * nN, gid = wgid / nig, fm = gid * WGM, gsz = (nM - fm) < WGM ? (nM - fm) : WGM;
        pm = fm + ((wgid % nig) % gsz); pn = (wgid % nig) / gsz; return true;
    }
};

template <int OFF> __device__ __forceinline__ s16x4 tr_read(unsigned addr) { s16x4 r; asm volatile("ds_read_b64_tr_b16 %0, %1 offset:%2" : "=&v"(r) : "v"(addr), "i"(OFF) : "memory"); return r; }
template <class Job>
__device__ __forceinline__ void gemm_phase(LAS unsigned char* lds, const Job& J) {
    const int tid = threadIdx.x, wid = __builtin_amdgcn_readfirstlane(tid >> 6), lane = tid & 63, wr = wid >> 2, wc = wid & 3, fr = lane & 15, fq = lane >> 4;
    const int nt = J.K / BK;
    unsigned voffB[2];
#pragma unroll
    for (int i = 0; i < 2; ++i) { int R, C; stage_rc(tid * 16 + i * 8192, R, C);
        const int b = tid * 16 + i * 8192, row = b >> 8, slot = (b >> 4) & 15, ch = slot ^ (((row & 3) << 2) | ((row >> 2) & 3)); voffB[i] = (unsigned)row * J.ldb2 + (unsigned)ch * 16u; }
    const size_t kstepB = (size_t)BK * J.ldb2;
    const unsigned ldsw = (unsigned)wid * 1024u;
    const int aoff = lds_byte(wr * 64 + fr, fq * 8);
    const int tq = (lane & 15) >> 2, tp = lane & 3;
    unsigned ba[2][2];
#pragma unroll
    for (int n = 0; n < 2; ++n)
#pragma unroll
        for (int t = 0; t < 2; ++t) ba[n][t] = (unsigned)(uintptr_t)lds + 256u * (8 * fq + 4 * t + tq) + 16u * ((4 * wc + 2 * n + (tp >> 1)) ^ ((tq << 2) | ((2 * fq + t) & 3))) + 8u * (tp & 1);
#define FG_SA(b, h) (65536 + ((b) * 2 + (h)) * HTB)
#define FG_SB(b, h) (((b) * 2 + (h)) * HTB)
#define FG_STAGE_A(bufoff, gk, vo) do { _Pragma("unroll") for (int _i = 0; _i < 2; ++_i) \
        __builtin_amdgcn_global_load_lds((const unsigned*)((gk) + (vo)[_i]), (LAS unsigned*)(lds + (bufoff) + ldsw + _i * 8192), 16, 0, 0); } while (0)
#define FG_STAGE_B(bufoff, gk) do { _Pragma("unroll") for (int _i = 0; _i < 2; ++_i) \
        __builtin_amdgcn_global_load_lds((const unsigned*)((gk) + voffB[_i]), (LAS unsigned*)(lds + (bufoff) + ldsw + _i * 8192), 16, 0, 0); } while (0)
#define FG_LDA(dst, b, h) do { _Pragma("unroll") for (int m = 0; m < 4; ++m) _Pragma("unroll") for (int k = 0; k < 2; ++k) dst[m][k] = *(const LAS bf16x8*)(lds + FG_SA(b, h) + aoff + m * 2048 + k * 1024); } while (0)
#define FG_LDB(dst, b, h) do { \
        dst##lo[0][0] = tr_read<FG_SB(b, h)>(ba[0][0]);        dst##hi[0][0] = tr_read<FG_SB(b, h)>(ba[0][1]); \
        dst##lo[0][1] = tr_read<FG_SB(b, h) + 8192>(ba[0][0]); dst##hi[0][1] = tr_read<FG_SB(b, h) + 8192>(ba[0][1]); \
        dst##lo[1][0] = tr_read<FG_SB(b, h)>(ba[1][0]);        dst##hi[1][0] = tr_read<FG_SB(b, h)>(ba[1][1]); \
        dst##lo[1][1] = tr_read<FG_SB(b, h) + 8192>(ba[1][0]); dst##hi[1][1] = tr_read<FG_SB(b, h) + 8192>(ba[1][1]); } while (0)
#define FG_PK(L, H) (bf16x8){L[0], L[1], L[2], L[3], H[0], H[1], H[2], H[3]}
#define FG_MMA(ai, bj, At, Bt) do { __builtin_amdgcn_s_setprio(1); _Pragma("unroll") for (int m = 0; m < 4; ++m) _Pragma("unroll") for (int n = 0; n < 2; ++n) _Pragma("unroll") for (int k = 0; k < 2; ++k) \
        acc[ai][bj][m][n] = __builtin_amdgcn_mfma_f32_16x16x32_bf16(FG_PK(Bt##lo[n][k], Bt##hi[n][k]), At[m][k], acc[ai][bj][m][n], 0, 0, 0); __builtin_amdgcn_s_setprio(0); } while (0)
#define FG_WAIT_V(n) asm volatile("s_waitcnt vmcnt(" #n ")" ::: "memory")
#define FG_WAIT_L(n) asm volatile("s_waitcnt lgkmcnt(" #n ")" ::: "memory")
#define FG_BAR __builtin_amdgcn_s_barrier()
#define FG_SCHED __builtin_amdgcn_sched_barrier(0)
#define FG_AOFF(dst, u, tabp) do { int _tz = threadIdx.x; asm volatile("" : "+v"(_tz)); _Pragma("unroll") for (int _i = 0; _i < 2; ++_i) { int _R, _C; stage_rc(_tz * 16 + _i * 8192, _R, _C); \
        _Pragma("unroll") for (int _h = 0; _h < 2; ++_h) { const int _r = _h * 128 + _R; \
        if (Job::GATHER) { const int _tok = (tabp)[_r < (u).nvalid ? _r : 0]; dst[_h][_i] = (unsigned)_tok * J.lda2 + (unsigned)(_C * 2); } \
        else dst[_h][_i] = (unsigned)((u).arow0 + _r) * J.lda2 + (unsigned)((u).acol2 + _C * 2); } } } while (0)
    Unit cur, nxt; int ui = 0;
    if (!J.next(0, cur)) return;
    LAS const int* tab0 = (LAS const int*)(lds + TAB_OFF);
    if (Job::GATHER) {
        if (wid == 0) __builtin_amdgcn_global_load_lds((const unsigned*)(J.list + cur.arow0 + lane * 4), (LAS unsigned*)(lds + TAB_OFF), 16, 0, 0);
        FG_WAIT_V(0); __syncthreads();
    }
    f32x4 acc[2][2][4][2];
#pragma unroll
    for (int a = 0; a < 2; ++a)
#pragma unroll
        for (int b = 0; b < 2; ++b)
#pragma unroll
            for (int m = 0; m < 4; ++m)
#pragma unroll
                for (int n = 0; n < 2; ++n) acc[a][b][m][n] = (f32x4){0.f, 0.f, 0.f, 0.f};
    bf16x8 At[4][2]; s16x4 B0lo[2][2], B0hi[2][2], B1lo[2][2], B1hi[2][2];
    unsigned vc[2][2];
    FG_AOFF(vc, cur, tab0);
    const char* const gA = J.A;
    const char* cB = cur.bBase;
    const unsigned bh2 = J.bhalf2;
    FG_STAGE_B(FG_SB(0, 0), cB); FG_STAGE_A(FG_SA(0, 0), gA, vc[0]); FG_STAGE_B(FG_SB(0, 1), cB + bh2); FG_STAGE_A(FG_SA(0, 1), gA, vc[1]);
    if (wr == 1) FG_BAR;
    FG_WAIT_V(4); FG_BAR;
    FG_STAGE_B(FG_SB(1, 0), cB + kstepB); FG_STAGE_A(FG_SA(1, 0), gA + 128, vc[0]); FG_STAGE_B(FG_SB(1, 1), cB + kstepB + bh2);
    FG_WAIT_V(6); FG_BAR;
    for (;;) {
        const bool has_next = J.next(ui + 1, nxt);
        if (!has_next) nxt = cur;
        if (Job::GATHER && has_next && wid == 0)
            __builtin_amdgcn_global_load_lds((const unsigned*)(J.list + nxt.arow0 + lane * 4), (LAS unsigned*)(lds + TAB_OFF + ((ui + 1) & 1) * 1024), 16, 0, 0);
        const char* nB = nxt.bBase;
        for (int t = 0; t < nt; t += 2) {
            const bool last = (t == nt - 2);
            const char* a1 = gA + (size_t)(t + 1) * 128;
            const char* a2 = last ? gA : gA + (size_t)(t + 2) * 128; const char* b2 = last ? nB : cB + (size_t)(t + 2) * kstepB;
            const char* a3 = a2 + 128; const char* b3 = b2 + kstepB;
            FG_LDB(B0, 0, 0); FG_SCHED; FG_LDA(At, 0, 0); FG_STAGE_A(FG_SA(1, 1), a1, vc[1]);
            if (last && has_next) { LAS const int* tabn = (LAS const int*)(lds + TAB_OFF + ((ui + 1) & 1) * 1024); FG_AOFF(vc, nxt, tabn); }
            FG_WAIT_L(8); FG_BAR; FG_WAIT_L(0); FG_SCHED; FG_MMA(0, 0, At, B0); FG_BAR; FG_SCHED;
            FG_LDB(B1, 0, 1); FG_STAGE_B(FG_SB(0, 0), b2);
            FG_BAR; FG_WAIT_L(0); FG_SCHED; FG_MMA(0, 1, At, B1); FG_BAR;
            FG_LDA(At, 0, 1); FG_STAGE_A(FG_SA(0, 0), a2, vc[0]);
            FG_BAR; FG_WAIT_L(0); FG_MMA(1, 0, At, B0); FG_BAR; FG_SCHED;
            FG_STAGE_B(FG_SB(0, 1), b2 + bh2);
            FG_WAIT_V(6); FG_BAR; FG_MMA(1, 1, At, B1); FG_BAR;
            FG_LDB(B0, 1, 0); FG_SCHED; FG_LDA(At, 1, 0); FG_STAGE_A(FG_SA(0, 1), a2, vc[1]);
            FG_WAIT_L(8); FG_BAR; FG_WAIT_L(0); FG_SCHED; FG_MMA(0, 0, At, B0); FG_BAR; FG_SCHED;
            FG_LDB(B1, 1, 1); FG_STAGE_B(FG_SB(1, 0), b3);
            FG_BAR; FG_WAIT_L(0); FG_SCHED; FG_MMA(0, 1, At, B1); FG_BAR;
            FG_LDA(At, 1, 1); FG_STAGE_A(FG_SA(1, 0), a3, vc[0]);
            FG_BAR; FG_WAIT_L(0); FG_MMA(1, 0, At, B0); FG_BAR; FG_SCHED;
            FG_STAGE_B(FG_SB(1, 1), b3 + bh2);
            FG_WAIT_V(6); FG_BAR; FG_MMA(1, 1, At, B1); FG_BAR;
        }
        J.epi(acc, cur, wr, wc, fr, fq);
        if (!has_next) break;
#pragma unroll
        for (int a = 0; a < 2; ++a)
#pragma unroll
            for (int b = 0; b < 2; ++b)
#pragma unroll
                for (int m = 0; m < 4; ++m)
#pragma unroll
                    for (int n = 0; n < 2; ++n) acc[a][b][m][n] = (f32x4){0.f, 0.f, 0.f, 0.f};
        cur = nxt; cB = nB; ++ui;
    }
    FG_WAIT_V(0);
    if (wr == 0) FG_BAR;
    FG_BAR;
}

#undef FG_SA
#undef FG_SB
#undef FG_STAGE_A
#undef FG_STAGE_B
#undef FG_LDA
#undef FG_LDB
#undef FG_MMA
#undef FG_WAIT_V
#undef FG_WAIT_L
#undef FG_BAR
#undef FG_SCHED
#undef FG_AOFF
template <class Job>
__device__ __forceinline__ void gemm_phase_f8(LAS unsigned char* lds, const Job& J) {
    const int tid = threadIdx.x, wid = __builtin_amdgcn_readfirstlane(tid >> 6), lane = tid & 63, wr = wid >> 2, wc = wid & 3, fr = lane & 15, fq = lane >> 4;
    const int nt = J.K / 128;
    unsigned voffB[2];
#pragma unroll
    for (int i = 0; i < 2; ++i) { int R, C; stage_rc(tid * 16 + i * 8192, R, C);
        voffB[i] = (unsigned)R * J.ldb2 + (unsigned)(C * 2); }
    const size_t kstepB = 128;
    const unsigned ldsw = (unsigned)wid * 1024u;
    const int aoff = lds_byte(wr * 64 + fr, fq * 8);
    const int boff = lds_byte(wc * 32 + fr, fq * 8);
#define FG_SA(b, h) (65536 + ((b) * 2 + (h)) * HTB)
#define FG_SB(b, h) (((b) * 2 + (h)) * HTB)
#define FG_STAGE_A(bufoff, gk, vo) do { _Pragma("unroll") for (int _i = 0; _i < 2; ++_i) \
        __builtin_amdgcn_global_load_lds((const unsigned*)((gk) + (vo)[_i]), (LAS unsigned*)(lds + (bufoff) + ldsw + _i * 8192), 16, 0, 0); } while (0)
#define FG_STAGE_B(bufoff, gk) do { _Pragma("unroll") for (int _i = 0; _i < 2; ++_i) \
        __builtin_amdgcn_global_load_lds((const unsigned*)((gk) + voffB[_i]), (LAS unsigned*)(lds + (bufoff) + ldsw + _i * 8192), 16, 0, 0); } while (0)
#define FG_LDA(dst, b, h) do { _Pragma("unroll") for (int m = 0; m < 4; ++m) _Pragma("unroll") for (int k = 0; k < 2; ++k) dst[m][k] = *(const LAS i32x4*)(lds + FG_SA(b, h) + aoff + m * 2048 + k * 1024); } while (0)
#define FG_LDB(dst, b, h) do { _Pragma("unroll") for (int n = 0; n < 2; ++n) _Pragma("unroll") for (int k = 0; k < 2; ++k) dst[n][k] = *(const LAS i32x4*)(lds + FG_SB(b, h) + boff + n * 2048 + k * 1024); } while (0)
#define FG_CAT8(X, Y) __builtin_shufflevector(X, Y, 0, 1, 2, 3, 4, 5, 6, 7)
#define FG_MMA(ai, bj, At, Bt) do { __builtin_amdgcn_s_setprio(1); _Pragma("unroll") for (int m = 0; m < 4; ++m) _Pragma("unroll") for (int n = 0; n < 2; ++n) \
        acc[ai][bj][m][n] = __builtin_amdgcn_mfma_scale_f32_16x16x128_f8f6f4(FG_CAT8(Bt[n][0], Bt[n][1]), FG_CAT8(At[m][0], At[m][1]), acc[ai][bj][m][n], 0, 0, 0, 0x79797979, 0, 0x7F7F7F7F); __builtin_amdgcn_s_setprio(0); } while (0)
#define FG_WAIT_V(n) asm volatile("s_waitcnt vmcnt(" #n ")" ::: "memory")
#define FG_WAIT_L(n) asm volatile("s_waitcnt lgkmcnt(" #n ")" ::: "memory")
#define FG_BAR __builtin_amdgcn_s_barrier()
#define FG_SCHED __builtin_amdgcn_sched_barrier(0)
#define FG_AOFF(dst, u, tabp) do { int _tz = threadIdx.x; asm volatile("" : "+v"(_tz)); _Pragma("unroll") for (int _i = 0; _i < 2; ++_i) { int _R, _C; stage_rc(_tz * 16 + _i * 8192, _R, _C); \
        _Pragma("unroll") for (int _h = 0; _h < 2; ++_h) { const int _r = _h * 128 + _R; \
        if (Job::GATHER) { const int _tok = (tabp)[_r < (u).nvalid ? _r : 0]; dst[_h][_i] = (unsigned)_tok * J.lda2 + (unsigned)(_C * 2); } \
        else dst[_h][_i] = (unsigned)((u).arow0 + _r) * J.lda2 + (unsigned)((u).acol2 + _C * 2); } } } while (0)
    Unit cur, nxt; int ui = 0;
    if (!J.next(0, cur)) return;
    LAS const int* tab0 = (LAS const int*)(lds + TAB_OFF);
    if (Job::GATHER) {
        if (wid == 0) __builtin_amdgcn_global_load_lds((const unsigned*)(J.list + cur.arow0 + lane * 4), (LAS unsigned*)(lds + TAB_OFF), 16, 0, 0);
        FG_WAIT_V(0); __syncthreads();
    }
    f32x4 acc[2][2][4][2];
#pragma unroll
    for (int a = 0; a < 2; ++a)
#pragma unroll
        for (int b = 0; b < 2; ++b)
#pragma unroll
            for (int m = 0; m < 4; ++m)
#pragma unroll
                for (int n = 0; n < 2; ++n) acc[a][b][m][n] = (f32x4){0.f, 0.f, 0.f, 0.f};
    i32x4 At[4][2], B0[2][2], B1[2][2];
    unsigned vc[2][2];
    FG_AOFF(vc, cur, tab0);
    const char* const gA = J.A;
    const char* cB = cur.bBase;
    const unsigned bh2 = J.bhalf2;
    FG_STAGE_B(FG_SB(0, 0), cB); FG_STAGE_A(FG_SA(0, 0), gA, vc[0]); FG_STAGE_B(FG_SB(0, 1), cB + bh2); FG_STAGE_A(FG_SA(0, 1), gA, vc[1]);
    if (wr == 1) FG_BAR;
    FG_WAIT_V(4); FG_BAR;
    FG_STAGE_B(FG_SB(1, 0), cB + kstepB); FG_STAGE_A(FG_SA(1, 0), gA + 128, vc[0]); FG_STAGE_B(FG_SB(1, 1), cB + kstepB + bh2);
    FG_WAIT_V(6); FG_BAR;
    for (;;) {
        const bool has_next = J.next(ui + 1, nxt);
        if (!has_next) nxt = cur;
        if (Job::GATHER && has_next && wid == 0)
            __builtin_amdgcn_global_load_lds((const unsigned*)(J.list + nxt.arow0 + lane * 4), (LAS unsigned*)(lds + TAB_OFF + ((ui + 1) & 1) * 1024), 16, 0, 0);
        const char* nB = nxt.bBase;
        for (int t = 0; t < nt; t += 2) {
            const bool last = (t == nt - 2);
            const char* a1 = gA + (size_t)(t + 1) * 128;
            const char* a2 = last ? gA : gA + (size_t)(t + 2) * 128; const char* b2 = last ? nB : cB + (size_t)(t + 2) * kstepB;
            const char* a3 = a2 + 128; const char* b3 = b2 + kstepB;
            FG_LDB(B0, 0, 0); FG_SCHED; FG_LDA(At, 0, 0); FG_STAGE_A(FG_SA(1, 1), a1, vc[1]);
            if (last && has_next) { LAS const int* tabn = (LAS const int*)(lds + TAB_OFF + ((ui + 1) & 1) * 1024); FG_AOFF(vc, nxt, tabn); }
            FG_WAIT_L(8); FG_BAR; FG_WAIT_L(0); FG_SCHED; FG_MMA(0, 0, At, B0); FG_BAR; FG_SCHED;
            FG_LDB(B1, 0, 1); FG_STAGE_B(FG_SB(0, 0), b2);
            FG_BAR; FG_WAIT_L(0); FG_SCHED; FG_MMA(0, 1, At, B1); FG_BAR;
            FG_LDA(At, 0, 1); FG_STAGE_A(FG_SA(0, 0), a2, vc[0]);
            FG_BAR; FG_WAIT_L(0); FG_MMA(1, 0, At, B0); FG_BAR; FG_SCHED;
            FG_STAGE_B(FG_SB(0, 1), b2 + bh2);
            FG_WAIT_V(6); FG_BAR; FG_MMA(1, 1, At, B1); FG_BAR;
            FG_LDB(B0, 1, 0); FG_SCHED; FG_LDA(At, 1, 0); FG_STAGE_A(FG_SA(0, 1), a2, vc[1]);
            FG_WAIT_L(8); FG_BAR; FG_WAIT_L(0); FG_SCHED; FG_MMA(0, 0, At, B0); FG_BAR; FG_SCHED;
            FG_LDB(B1, 1, 1); FG_STAGE_B(FG_SB(1, 0), b3);
            FG_BAR; FG_WAIT_L(0); FG_SCHED; FG_MMA(0, 1, At, B1); FG_BAR;
            FG_LDA(At, 1, 1); FG_STAGE_A(FG_SA(1, 0), a3, vc[0]);
            FG_BAR; FG_WAIT_L(0); FG_MMA(1, 0, At, B0); FG_BAR; FG_SCHED;
            FG_STAGE_B(FG_SB(1, 1), b3 + bh2);
            FG_WAIT_V(6); FG_BAR; FG_MMA(1, 1, At, B1); FG_BAR;
        }
        J.epi(acc, cur, wr, wc, fr, fq);
        if (!has_next) break;
#pragma unroll
        for (int a = 0; a < 2; ++a)
#pragma unroll
            for (int b = 0; b < 2; ++b)
#pragma unroll
                for (int m = 0; m < 4; ++m)
#pragma unroll
                    for (int n = 0; n < 2; ++n) acc[a][b][m][n] = (f32x4){0.f, 0.f, 0.f, 0.f};
        cur = nxt; cB = nB; ++ui;
    }
    FG_WAIT_V(0);
    if (wr == 0) FG_BAR;
    FG_BAR;
}
}

#define FG_FOR_ROWS for (int ai = 0; ai < 2; ++ai) _Pragma("unroll") for (int m = 0; m < 4; ++m)
struct JobInProj {
    static constexpr bool GATHER = false;
    const char* A; unsigned lda2, ldb2, bhalf2; int K; const int* list;
    const char* B; bf16_t* out; fg::StaticOrder S;
    __device__ __forceinline__ bool next(int i, fg::Unit& u) const { int pm, pn; if (!S.next(i, pm, pn)) return false;
        u.bBase = B + (size_t)pn * 512; u.arow0 = pm * 256; u.nvalid = 256; u.e = 0; u.orow0 = pm * 256; u.ocol0 = pn * 256; u.acol2 = 0; return true; }
    __device__ __forceinline__ void epi(const f32x4 (&acc)[2][2][4][2], const fg::Unit& u, int wr, int wc, int fr, int fq) const {
#pragma unroll
        FG_FOR_ROWS { bf16_t* rowp = out + (size_t)(u.orow0 + ai * 128 + wr * 64 + m * 16 + fr) * kNPROJ + u.ocol0 + wc * 32 + fq * 4;
#pragma unroll
            for (int bj = 0; bj < 2; ++bj)
#pragma unroll
                for (int n = 0; n < 2; ++n) { const f32x4 v = acc[ai][bj][m][n]; u32x2 w; w.x = pk_bf16(v[0], v[1]); w.y = pk_bf16(v[2], v[3]); *(u32x2*)(rowp + bj * 128 + n * 16) = w; } }
    }
};
struct JobPoolFold {
    static constexpr bool GATHER = false;
    const char* A; unsigned lda2, ldb2, bhalf2; int K; const int* list;
    const char* B; bf16_t* wo; int G, c;
    __device__ __forceinline__ bool next(int i, fg::Unit& u) const { const int L = i * G + c; if (L >= 32) return false; const int g = L >> 3, pn = L & 7;
        u.bBase = B + (size_t)g * kPG * kD * 2 + (size_t)pn * 512; u.arow0 = 0; u.nvalid = 256; u.e = g; u.orow0 = kSB + g * kPG; u.ocol0 = pn * 256; u.acol2 = g * kPG * kPG * 2; return true; }
    __device__ __forceinline__ void epi(const f32x4 (&acc)[2][2][4][2], const fg::Unit& u, int wr, int wc, int fr, int fq) const {
#pragma unroll
        FG_FOR_ROWS { bf16_t* rowp = wo + (size_t)(u.orow0 + ai * 128 + wr * 64 + m * 16 + fr) * kD + u.ocol0 + wc * 32 + fq * 4;
#pragma unroll
            for (int bj = 0; bj < 2; ++bj)
#pragma unroll
                for (int n = 0; n < 2; ++n) { const f32x4 v = acc[ai][bj][m][n]; u32x2 w; w.x = pk_bf16(v[0], v[1]); w.y = pk_bf16(v[2], v[3]); *(u32x2*)(rowp + bj * 128 + n * 16) = w; } }
    }
};
struct JobOutProj {
    static constexpr bool GATHER = false;
    const char* A; unsigned lda2, ldb2, bhalf2; int K; const int* list;
    const char* B; const float* x; const float* mod; float* x1; fg::StaticOrder S;
    __device__ __forceinline__ bool next(int i, fg::Unit& u) const { int pm, pn; if (!S.next(i, pm, pn)) return false;
        u.bBase = B + (size_t)pn * 512; u.arow0 = pm * 256; u.nvalid = 256; u.e = 0; u.orow0 = pm * 256; u.ocol0 = pn * 256; u.acol2 = 0; return true; }
    __device__ __forceinline__ void epi(const f32x4 (&acc)[2][2][4][2], const fg::Unit& u, int wr, int wc, int fr, int fq) const {
        const int b = u.orow0 / kS; f32x4 gt[2][2];
#pragma unroll
        for (int bj = 0; bj < 2; ++bj)
#pragma unroll
            for (int n = 0; n < 2; ++n) gt[bj][n] = *(const f32x4*)(mod + b * 6 * kD + 2 * kD + u.ocol0 + bj * 128 + wc * 32 + n * 16 + fq * 4);
#pragma unroll
        FG_FOR_ROWS { const size_t ro = (size_t)(u.orow0 + ai * 128 + wr * 64 + m * 16 + fr) * kD + u.ocol0 + wc * 32 + fq * 4;
#pragma unroll
            for (int bj = 0; bj < 2; ++bj)
#pragma unroll
                for (int n = 0; n < 2; ++n) { const f32x4 xv = *(const f32x4*)(x + ro + bj * 128 + n * 16); *(f32x4*)(x1 + ro + bj * 128 + n * 16) = xv + gt[bj][n] * acc[ai][bj][m][n]; } }
    }
};
struct MoeTab { LAS const int* t; int total;
    __device__ __forceinline__ bool decode(int i, int G, int c, int& e, int& jcol, int& rb, int& cnt, int& rowbase) const {
        const int L = (G % 8 == 0) ? i * G + (c % 8) * (G / 8) + c / 8 : i * G + c; if (L >= total) return false;
        int ee = 0; while (ee < kE - 1 && t[64 + ee + 1] <= L) ++ee;
        const int local = L - t[64 + ee], nrb = t[100 + ee]; jcol = local / nrb; rb = local - jcol * nrb; e = ee; cnt = t[ee]; rowbase = t[32 + ee]; return true; }
};
__device__ __forceinline__ MoeTab moe_tables(LAS unsigned char* lds, const unsigned* ctrl, int ncol) {
    LAS int* t = (LAS int*)(lds + fg::MISC_OFF + 64);
    __syncthreads();
    if (threadIdx.x == 0) { int base = 0, us = 0; for (int e = 0; e < kE; ++e) { const int cn = (int)ctrl[CT_CNT + 64 * e], nrb = (cn + 255) >> 8; t[e] = cn; t[32 + e] = base; t[64 + e] = us; t[100 + e] = nrb; base += nrb * 256; us += nrb * ncol; } t[64 + kE] = us; }
    __syncthreads();
    MoeTab M; M.t = t; M.total = t[64 + kE]; return M;
}
struct JobMoe1 {
    static constexpr bool GATHER = true;
    const char* A; unsigned lda2, ldb2, bhalf2; int K; const int* list;
    const char* B; const float* b_in; bf16_t* act; MoeTab M; int G, c;
    __device__ __forceinline__ bool next(int i, fg::Unit& u) const { int e, j, rb, cnt, rowbase; if (!M.decode(i, G, c, e, j, rb, cnt, rowbase)) return false;
        e = __builtin_amdgcn_readfirstlane(e); j = __builtin_amdgcn_readfirstlane(j); rb = __builtin_amdgcn_readfirstlane(rb); cnt = __builtin_amdgcn_readfirstlane(cnt); rowbase = __builtin_amdgcn_readfirstlane(rowbase);
        u.bBase = B + (size_t)e * ((size_t)kD * 2 * kDFF * 2) + (size_t)j * 256; u.arow0 = e * kT + rb * 256; u.nvalid = min(256, cnt - rb * 256); u.e = e; u.orow0 = rowbase + rb * 256; u.ocol0 = j * 128; u.acol2 = 0; return true; }
    __device__ __forceinline__ void epi(const f32x4 (&acc)[2][2][4][2], const fg::Unit& u, int wr, int wc, int fr, int fq) const {
        f32x4 bg[2], bl[2];
#pragma unroll
        for (int n = 0; n < 2; ++n) { const float* bp = b_in + (size_t)u.e * 2 * kDFF + u.ocol0 + wc * 32 + n * 16 + fq * 4; bg[n] = *(const f32x4*)bp; bl[n] = *(const f32x4*)(bp + kDFF); }
#pragma unroll
        FG_FOR_ROWS { bf16_t* rowp = act + (size_t)(u.orow0 + ai * 128 + wr * 64 + m * 16 + fr) * kDFF + u.ocol0 + wc * 32 + fq * 4;
#pragma unroll
            for (int n = 0; n < 2; ++n) { const f32x4 gv = acc[ai][0][m][n] + bg[n], lv = acc[ai][1][m][n] + bl[n]; float o[4];
#pragma unroll
                for (int j = 0; j < 4; ++j) { const float g = fminf(gv[j], 7.f), l = fminf(fmaxf(lv[j], -7.f), 7.f); o[j] = g * __builtin_amdgcn_rcpf(1.f + __expf(-1.702f * g)) * (l + 1.f); }
                u32x2 w; w.x = pk_bf16(o[0], o[1]); w.y = pk_bf16(o[2], o[3]); *(u32x2*)(rowp + n * 16) = w; } }
    }
};
struct JobMoe2 {
    static constexpr bool GATHER = false;
    const char* A; unsigned lda2, ldb2, bhalf2; int K; const int* list;
    const char* B; const float* b_out; bf16_t* yp; MoeTab M; int G, c;
    __device__ __forceinline__ bool next(int i, fg::Unit& u) const { int e, j, rb, cnt, rowbase; if (!M.decode(i, G, c, e, j, rb, cnt, rowbase)) return false;
        e = __builtin_amdgcn_readfirstlane(e); j = __builtin_amdgcn_readfirstlane(j); rb = __builtin_amdgcn_readfirstlane(rb); rowbase = __builtin_amdgcn_readfirstlane(rowbase);
        u.bBase = B + (size_t)e * ((size_t)kDFF * kD * 2) + (size_t)j * 512; u.arow0 = rowbase + rb * 256; u.nvalid = 256; u.e = e; u.orow0 = rowbase + rb * 256; u.ocol0 = j * 256; u.acol2 = 0; return true; }
    __device__ __forceinline__ void epi(const f32x4 (&acc)[2][2][4][2], const fg::Unit& u, int wr, int wc, int fr, int fq) const {
        f32x4 bo[2][2];
#pragma unroll
        for (int bj = 0; bj < 2; ++bj)
#pragma unroll
            for (int n = 0; n < 2; ++n) bo[bj][n] = *(const f32x4*)(b_out + (size_t)u.e * kD + u.ocol0 + bj * 128 + wc * 32 + n * 16 + fq * 4);
#pragma unroll
        FG_FOR_ROWS { bf16_t* rowp = yp + (size_t)(u.orow0 + ai * 128 + wr * 64 + m * 16 + fr) * kD + u.ocol0 + wc * 32 + fq * 4;
#pragma unroll
            for (int bj = 0; bj < 2; ++bj)
#pragma unroll
                for (int n = 0; n < 2; ++n) { const f32x4 v = acc[ai][bj][m][n] + bo[bj][n]; u32x2 w; w.x = pk_bf16(v[0], v[1]); w.y = pk_bf16(v[2], v[3]); *(u32x2*)(rowp + bj * 128 + n * 16) = w; } }
    }
};


__device__ __forceinline__ float wave_sum(float v) {
#pragma unroll
    for (int o = 32; o > 0; o >>= 1) v += __shfl_xor(v, o);
    return v; }
__device__ __forceinline__ float bflo(unsigned u) { return __uint_as_float(u << 16); }
__device__ __forceinline__ float bfhi(unsigned u) { return __uint_as_float(u & 0xFFFF0000u); }

namespace at {
typedef float f32x16 __attribute__((ext_vector_type(16)));
__device__ __forceinline__ unsigned off_b(unsigned row, unsigned ch) { return 256u * row + 16u * (ch ^ (((row & 3) << 2) | ((row >> 2) & 3))); }
constexpr float kC2 = 0.08838834764831845f * 1.4426950408889634f;
constexpr float kDoneThresh = 140.f;

__device__ __forceinline__ void attn_phase(LAS unsigned char* lds, const bf16_t* __restrict__ proj, const float* __restrict__ qw, const float* __restrict__ kw,
                                           bf16_t* __restrict__ cat, int G, int c) {
    const int tid = threadIdx.x, wid = __builtin_amdgcn_readfirstlane(tid >> 6), lane = tid & 63, ql = lane & 31, hf = lane >> 5;
    const unsigned ldsb = (unsigned)(uintptr_t)lds;
    const int skey = tid >> 4, sch = tid & 15;
    const unsigned X = ((ql & 3) << 2) | ((ql >> 2) & 3);
    const unsigned krow = 256u * ql, kY = 16u * (X ^ (unsigned)hf);
    const int tq = (lane & 15) >> 2, tp = lane & 3, blk = (lane >> 4) & 1;
    unsigned va[4][2];
#pragma unroll
    for (int cc = 0; cc < 4; ++cc)
#pragma unroll
        for (int t = 0; t < 2; ++t) va[cc][t] = 256u * (8 * t + 4 * hf + tq) + 16u * ((4 * cc + 2 * blk + (tp >> 1)) ^ ((tq << 2) | ((2 * t + hf) & 3))) + 8u * (tp & 1);
    for (int unit = c; unit < kB * kNH * 8; unit += G) {
        const int qb = unit & 7, bh = unit >> 3, h = bh & 7, b = bh >> 3;
        const int q0 = qb * 256, r0 = q0 + wid * 32;
        const bf16_t* base = proj + (size_t)(b * kS) * kNPROJ + h * kHD;
        LAS unsigned char* qlds = lds + 65536 + wid * 8192 + lane * 16;
        { u32x4 qr[8]; float ss = 0.f;
#pragma unroll
          for (int s = 0; s < 8; ++s) { qr[s] = *(const u32x4*)(base + (size_t)(r0 + ql) * kNPROJ + 16 * s + 8 * hf);
              const unsigned u[4] = {qr[s].x, qr[s].y, qr[s].z, qr[s].w};
#pragma unroll
              for (int e = 0; e < 4; ++e) { const float a = bflo(u[e]), bb = bfhi(u[e]); ss += a * a + bb * bb; } }
          ss += __shfl_xor(ss, 32);
          const float rq = rsqrtf(ss * (1.f / kHD) + kEPS) * kC2;
#pragma unroll
          for (int s = 0; s < 8; ++s) { const int d0 = 16 * s + 8 * hf;
              const f32x4 w0 = *(const f32x4*)(qw + d0) * *(const f32x4*)(kw + d0), w1 = *(const f32x4*)(qw + d0 + 4) * *(const f32x4*)(kw + d0 + 4);
              const unsigned u[4] = {qr[s].x, qr[s].y, qr[s].z, qr[s].w};
              u32x4 pk; pk.x = pk_bf16(bflo(u[0]) * rq * w0[0], bfhi(u[0]) * rq * w0[1]); pk.y = pk_bf16(bflo(u[1]) * rq * w0[2], bfhi(u[1]) * rq * w0[3]);
              pk.z = pk_bf16(bflo(u[2]) * rq * w1[0], bfhi(u[2]) * rq * w1[1]); pk.w = pk_bf16(bflo(u[3]) * rq * w1[2], bfhi(u[3]) * rq * w1[3]);
              *(LAS u32x4*)(qlds + 1024 * s) = pk; } }
        f32x16 o[4];
#pragma unroll
        for (int cc = 0; cc < 4; ++cc)
#pragma unroll
            for (int r = 0; r < 16; ++r) o[cc][r] = 0.f;
        float carry = 0.f; bool wactive = true;
        int jt = (q0 + 255) >> 6, cur = 0;
        u32x4 kr[2], vr[2];
#define AT_LOAD(jt_) do { _Pragma("unroll") for (int i = 0; i < 2; ++i) { const bf16_t* rp = base + (size_t)(64 * (jt_) + skey + 32 * i) * kNPROJ + sch * 8; \
            kr[i] = *(const u32x4*)(rp + kSB); vr[i] = *(const u32x4*)(rp + 2 * kSB); } } while (0)
        AT_LOAD(jt);
        for (;;) {
            LAS unsigned char* kbuf = lds + cur * 32768; LAS unsigned char* vbuf = kbuf + 16384;
#pragma unroll
            for (int i = 0; i < 2; ++i) { const unsigned u[4] = {kr[i].x, kr[i].y, kr[i].z, kr[i].w}; float f[8]; float ss = 0.f;
#pragma unroll
                for (int e = 0; e < 4; ++e) { f[2 * e] = bflo(u[e]); f[2 * e + 1] = bfhi(u[e]); ss += f[2 * e] * f[2 * e] + f[2 * e + 1] * f[2 * e + 1]; }
                ss += __shfl_xor(ss, 1); ss += __shfl_xor(ss, 2); ss += __shfl_xor(ss, 4); ss += __shfl_xor(ss, 8);
                const float rk = rsqrtf(ss * (1.f / kHD) + kEPS);
                u32x4 pk; pk.x = pk_bf16(f[0] * rk, f[1] * rk); pk.y = pk_bf16(f[2] * rk, f[3] * rk); pk.z = pk_bf16(f[4] * rk, f[5] * rk); pk.w = pk_bf16(f[6] * rk, f[7] * rk);
                const unsigned a = off_b(skey + 32 * i, sch);
                *(LAS u32x4*)(kbuf + a) = pk; *(LAS u32x4*)(vbuf + a) = vr[i]; }
            const int any = __syncthreads_or(wactive ? 1 : 0);
            if (!any) break;
            const int jtc = jt;
            if (jt > 0) AT_LOAD(jt - 1);
            if (wactive && 64 * jtc < r0 + 31) {
                f32x16 s0, s1;
#pragma unroll
                for (int r = 0; r < 16; ++r) { s0[r] = 0.f; s1[r] = 0.f; }
#pragma unroll
                for (int s = 0; s < 8; ++s) { const unsigned a = krow + ((32u * s) ^ kY);
                    const bf16x8 k0 = *(const LAS bf16x8*)(kbuf + a), k1 = *(const LAS bf16x8*)(kbuf + 8192 + a), qv = *(const LAS bf16x8*)(qlds + 1024 * s);
                    s0 = __builtin_amdgcn_mfma_f32_32x32x16_bf16(k0, qv, s0, 0, 0, 0); s1 = __builtin_amdgcn_mfma_f32_32x32x16_bf16(k1, qv, s1, 0, 0, 0); }
                const int tabs = r0 + ql, kbase0 = 64 * jtc + 4 * hf;
                float run = carry; u32x4 pfr[2][2];
#pragma unroll
                for (int kb = 1; kb >= 0; --kb) {
                    float sp[16], gp[4], T[4];
#pragma unroll
                    for (int r = 0; r < 16; ++r) { const float z = kb ? s1[r] : s0[r]; const int key = kbase0 + 32 * kb + 8 * (r >> 2) + (r & 3);
                        const float v = __builtin_amdgcn_logf(1.f + __builtin_amdgcn_exp2f(z)); sp[r] = key < tabs ? v : 0.f; }
#pragma unroll
                    for (int g = 0; g < 4; ++g) { const float gsum = (sp[4 * g] + sp[4 * g + 1]) + (sp[4 * g + 2] + sp[4 * g + 3]);
                        const auto sw = __builtin_amdgcn_permlane32_swap(__float_as_uint(gsum), __float_as_uint(gsum), false, false);
                        const float lo = __uint_as_float(sw[0]), hi = __uint_as_float(sw[1]);
                        T[g] = lo + hi; gp[g] = hf ? 0.f : hi; }
#pragma unroll
                    for (int g = 3; g >= 0; --g) { const float offs = run + gp[g];
                        const float c3 = offs + sp[4 * g + 3], c2 = c3 + sp[4 * g + 2], c1 = c2 + sp[4 * g + 1], c0 = c1 + sp[4 * g];
                        const float cs[4] = {c0, c1, c2, c3};
#pragma unroll
                        for (int i = 0; i < 4; ++i) { const int r = 4 * g + i; const float z = kb ? s1[r] : s0[r]; const int key = kbase0 + 32 * kb + 8 * g + i;
                            const float e = __builtin_amdgcn_exp2f(z - cs[i]); sp[r] = key < tabs ? e : 0.f; }
                        run += T[g]; }
#pragma unroll
                    for (int s2 = 0; s2 < 2; ++s2) { u32x4 pk; pk.x = pk_bf16(sp[8 * s2], sp[8 * s2 + 1]); pk.y = pk_bf16(sp[8 * s2 + 2], sp[8 * s2 + 3]);
                        pk.z = pk_bf16(sp[8 * s2 + 4], sp[8 * s2 + 5]); pk.w = pk_bf16(sp[8 * s2 + 6], sp[8 * s2 + 7]); pfr[kb][s2] = pk; }
                }
                carry = run;
                const unsigned vb0 = ldsb + (unsigned)cur * 32768u + 16384u;
#define AT_PV(cc) do { const unsigned a0 = vb0 + va[cc][0], a1 = vb0 + va[cc][1]; \
                    const s16x4 l00 = fg::tr_read<0>(a0), h00 = fg::tr_read<0>(a1), l01 = fg::tr_read<4096>(a0), h01 = fg::tr_read<4096>(a1); \
                    const s16x4 l10 = fg::tr_read<8192>(a0), h10 = fg::tr_read<8192>(a1), l11 = fg::tr_read<12288>(a0), h11 = fg::tr_read<12288>(a1); \
                    asm volatile("s_waitcnt lgkmcnt(0)" ::: "memory"); __builtin_amdgcn_sched_barrier(0); \
                    o[cc] = __builtin_amdgcn_mfma_f32_32x32x16_bf16(FG_PK(l00, h00), __builtin_bit_cast(bf16x8, pfr[0][0]), o[cc], 0, 0, 0); \
                    o[cc] = __builtin_amdgcn_mfma_f32_32x32x16_bf16(FG_PK(l01, h01), __builtin_bit_cast(bf16x8, pfr[0][1]), o[cc], 0, 0, 0); \
                    o[cc] = __builtin_amdgcn_mfma_f32_32x32x16_bf16(FG_PK(l10, h10), __builtin_bit_cast(bf16x8, pfr[1][0]), o[cc], 0, 0, 0); \
                    o[cc] = __builtin_amdgcn_mfma_f32_32x32x16_bf16(FG_PK(l11, h11), __builtin_bit_cast(bf16x8, pfr[1][1]), o[cc], 0, 0, 0); } while (0)
                AT_PV(0); AT_PV(1); AT_PV(2); AT_PV(3);
#undef AT_PV
                wactive = __any(carry <= kDoneThresh);
            }
            if (jt == 0) break;
            --jt; cur ^= 1;
        }
#undef AT_LOAD
        bf16_t* orow = cat + (size_t)(b * kS + r0 + ql) * kD + h * kHD + 4 * hf;
#pragma unroll
        for (int cc = 0; cc < 4; ++cc)
#pragma unroll
            for (int g = 0; g < 4; ++g) { u32x2 w; w.x = pk_bf16(o[cc][4 * g], o[cc][4 * g + 1]); w.y = pk_bf16(o[cc][4 * g + 2], o[cc][4 * g + 3]); *(u32x2*)(orow + 32 * cc + 8 * g) = w; }
        __syncthreads();
    }
}
}

__device__ __forceinline__ void pool_p_phase(const bf16_t* __restrict__ proj, bf16_t* __restrict__ p, int G, int c) {
    for (int idx = c * 512 + threadIdx.x; idx < kT * (kPW / 8); idx += G * 512) {
        const int c8 = idx & 127, t = idx >> 7, s = t & (kS - 1), g = c8 >> 5, w = 2 << g, cnt = min(s + 1, w);
        const bf16_t* up = proj + (size_t)t * kNPROJ + 3 * kSB + c8 * 8;
        u32x4 v[16];
#pragma unroll
        for (int i = 0; i < 16; ++i) v[i] = (i < cnt) ? *(const u32x4*)(up - (size_t)i * kNPROJ) : (u32x4){0u, 0u, 0u, 0u};
        float acc[8];
#pragma unroll
        for (int e = 0; e < 8; ++e) acc[e] = 0.f;
#pragma unroll
        for (int i = 0; i < 16; ++i) { acc[0] += bflo(v[i].x); acc[1] += bfhi(v[i].x); acc[2] += bflo(v[i].y); acc[3] += bfhi(v[i].y); acc[4] += bflo(v[i].z); acc[5] += bfhi(v[i].z); acc[6] += bflo(v[i].w); acc[7] += bfhi(v[i].w); }
        const float inv = 1.f / (float)cnt;
        const float u0[8] = {bflo(v[0].x), bfhi(v[0].x), bflo(v[0].y), bfhi(v[0].y), bflo(v[0].z), bfhi(v[0].z), bflo(v[0].w), bfhi(v[0].w)};
        u32x4 pk; pk.x = pk_bf16(acc[0] * inv - u0[0], acc[1] * inv - u0[1]); pk.y = pk_bf16(acc[2] * inv - u0[2], acc[3] * inv - u0[3]);
        pk.z = pk_bf16(acc[4] * inv - u0[4], acc[5] * inv - u0[5]); pk.w = pk_bf16(acc[6] * inv - u0[6], acc[7] * inv - u0[7]);
        *(u32x4*)(p + (size_t)t * kD + kSB + c8 * 8) = pk;
    }
}

__device__ __forceinline__ unsigned pk4_fp8(float a, float b, float c, float d) { int p = __builtin_amdgcn_cvt_pk_fp8_f32(a, b, 0, false); p = __builtin_amdgcn_cvt_pk_fp8_f32(c, d, p, true); return (unsigned)p; }
__device__ __forceinline__ float clamp448(float v) { return __builtin_amdgcn_fmed3f(v, -448.f, 448.f); }
constexpr float kWScale = 64.f;

struct JobMoe1F8 {
    static constexpr bool GATHER = true;
    const char* A; unsigned lda2, ldb2, bhalf2; int K; const int* list;
    const char* B; const float* b_in; unsigned char* act; MoeTab M; int G, c;
    __device__ __forceinline__ bool next(int i, fg::Unit& u) const { int e, j, rb, cnt, rowbase; if (!M.decode(i, G, c, e, j, rb, cnt, rowbase)) return false;
        e = __builtin_amdgcn_readfirstlane(e); j = __builtin_amdgcn_readfirstlane(j); rb = __builtin_amdgcn_readfirstlane(rb); cnt = __builtin_amdgcn_readfirstlane(cnt); rowbase = __builtin_amdgcn_readfirstlane(rowbase);
        u.bBase = B + (size_t)e * ((size_t)2 * kDFF * kD) + (size_t)j * 128 * kD; u.arow0 = e * kT + rb * 256; u.nvalid = min(256, cnt - rb * 256); u.e = e; u.orow0 = rowbase + rb * 256; u.ocol0 = j * 128; u.acol2 = 0; return true; }
    __device__ __forceinline__ void epi(const f32x4 (&acc)[2][2][4][2], const fg::Unit& u, int wr, int wc, int fr, int fq) const {
        f32x4 bg[2], bl[2];
#pragma unroll
        for (int n = 0; n < 2; ++n) { const float* bp = b_in + (size_t)u.e * 2 * kDFF + u.ocol0 + wc * 32 + n * 16 + fq * 4; bg[n] = *(const f32x4*)bp; bl[n] = *(const f32x4*)(bp + kDFF); }
#pragma unroll
        FG_FOR_ROWS { unsigned char* rowp = act + (size_t)(u.orow0 + ai * 128 + wr * 64 + m * 16 + fr) * kDFF + u.ocol0 + wc * 32 + fq * 4;
#pragma unroll
            for (int n = 0; n < 2; ++n) { const f32x4 gv = acc[ai][0][m][n] + bg[n], lv = acc[ai][1][m][n] + bl[n]; float o[4];
#pragma unroll
                for (int j = 0; j < 4; ++j) { const float g = fminf(gv[j], 7.f), l = fminf(fmaxf(lv[j], -7.f), 7.f); o[j] = clamp448(g * __builtin_amdgcn_rcpf(1.f + __expf(-1.702f * g)) * (l + 1.f)); }
                *(unsigned*)(rowp + n * 16) = pk4_fp8(o[0], o[1], o[2], o[3]); } }
    }
};
struct JobMoe2F8 {
    static constexpr bool GATHER = false;
    const char* A; unsigned lda2, ldb2, bhalf2; int K; const int* list;
    const char* B; const float* b_out; bf16_t* yp; MoeTab M; int G, c;
    __device__ __forceinline__ bool next(int i, fg::Unit& u) const { int e, j, rb, cnt, rowbase; if (!M.decode(i, G, c, e, j, rb, cnt, rowbase)) return false;
        e = __builtin_amdgcn_readfirstlane(e); j = __builtin_amdgcn_readfirstlane(j); rb = __builtin_amdgcn_readfirstlane(rb); rowbase = __builtin_amdgcn_readfirstlane(rowbase);
        u.bBase = B + (size_t)e * ((size_t)kDFF * kD) + (size_t)j * 256 * kDFF; u.arow0 = rowbase + rb * 256; u.nvalid = 256; u.e = e; u.orow0 = rowbase + rb * 256; u.ocol0 = j * 256; u.acol2 = 0; return true; }
    __device__ __forceinline__ void epi(const f32x4 (&acc)[2][2][4][2], const fg::Unit& u, int wr, int wc, int fr, int fq) const {
        f32x4 bo[2][2];
#pragma unroll
        for (int bj = 0; bj < 2; ++bj)
#pragma unroll
            for (int n = 0; n < 2; ++n) bo[bj][n] = *(const f32x4*)(b_out + (size_t)u.e * kD + u.ocol0 + bj * 128 + wc * 32 + n * 16 + fq * 4);
#pragma unroll
        FG_FOR_ROWS { bf16_t* rowp = yp + (size_t)(u.orow0 + ai * 128 + wr * 64 + m * 16 + fr) * kD + u.ocol0 + wc * 32 + fq * 4;
#pragma unroll
            for (int bj = 0; bj < 2; ++bj)
#pragma unroll
                for (int n = 0; n < 2; ++n) { const f32x4 v = acc[ai][bj][m][n] + bo[bj][n]; u32x2 w; w.x = pk_bf16(v[0], v[1]); w.y = pk_bf16(v[2], v[3]); *(u32x2*)(rowp + bj * 128 + n * 16) = w; } }
    }
};

struct CvtT { const float* src; unsigned char* dst; int K, N, tn, per; };
__device__ __forceinline__ CvtT cvt_make(const float* src, unsigned char* dst, int K, int N) { CvtT c; c.src = src; c.dst = dst; c.K = K; c.N = N; c.tn = N / 64; c.per = (K / 128) * (N / 64); return c; }
__device__ __forceinline__ void cvt_load(const CvtT& C, int t, int kq, int nc, f32x4 (&v)[4]) {
    const int mat = t / C.per, r = t - mat * C.per, kt = r / C.tn, nt_ = r - kt * C.tn;
    const float* sp = C.src + (size_t)mat * C.K * C.N + (size_t)(kt * 128 + 4 * kq) * C.N + nt_ * 64 + 4 * nc;
#pragma unroll
    for (int i = 0; i < 4; ++i) v[i] = __builtin_nontemporal_load((const f32x4*)(sp + (size_t)i * C.N));
}
__device__ __forceinline__ void cvt_emit(const CvtT& C, int t, LAS unsigned* L, const f32x4 (&v)[4], int kq, int nc, int rn, int rc) {
#pragma unroll
    for (int j = 0; j < 4; ++j) L[(4 * nc + j) * 33 + kq] = pk4_fp8(v[0][j] * kWScale, v[1][j] * kWScale, v[2][j] * kWScale, v[3][j] * kWScale);
    __syncthreads();
    const int mat = t / C.per, r = t - mat * C.per, kt = r / C.tn, nt_ = r - kt * C.tn;
    u32x4 o; o.x = L[rn * 33 + 4 * rc]; o.y = L[rn * 33 + 4 * rc + 1]; o.z = L[rn * 33 + 4 * rc + 2]; o.w = L[rn * 33 + 4 * rc + 3];
    __builtin_nontemporal_store(o, (u32x4*)(C.dst + (size_t)mat * C.K * C.N + (size_t)(nt_ * 64 + rn) * C.K + kt * 128 + rc * 16));
}
__device__ __forceinline__ void convert_t_f8(LAS unsigned char* lds, const CvtT C, int t0, int t1, int stride) {
    const int tid = threadIdx.x, kq = tid >> 4, nc = tid & 15, rn = tid >> 3, rc = tid & 7;
    f32x4 v0[4], v1[4], vn[4];
    __syncthreads();
    if (t0 < t1) cvt_load(C, t0, kq, nc, v0);
    if (t0 + stride < t1) cvt_load(C, t0 + stride, kq, nc, v1);
    int i = 0;
#pragma unroll 1
    for (int t = t0; t < t1; t += stride, ++i) {
        if (t + 2 * stride < t1) cvt_load(C, t + 2 * stride, kq, nc, vn);
        cvt_emit(C, t, (LAS unsigned*)(lds + (i & 1) * 8704), v0, kq, nc, rn, rc);
#pragma unroll
        for (int j = 0; j < 4; ++j) { v0[j] = v1[j]; v1[j] = vn[j]; }
    }
    __syncthreads();
}
__device__ __forceinline__ void convert_dyn(LAS unsigned char* lds, const CvtT C, unsigned* qctr, int dbase, int dend) {
    LAS int* bx = (LAS int*)(lds + 2 * 8704);
#pragma unroll 1
    for (;;) {
        __syncthreads();
        if (threadIdx.x == 0) bx[0] = dbase + (int)atomicAdd(qctr, 8u);
        __syncthreads();
        const int t0 = bx[0];
        if (t0 >= dend) break;
        convert_t_f8(lds, C, t0, min(t0 + 8, dend), 1);
    }
}

__device__ __forceinline__ void convert_seg(const float* __restrict__ src, bf16_t* __restrict__ dst, size_t n8, size_t gtid, size_t gstride) {
    const f32x4* s4 = (const f32x4*)src; u32x4* d4 = (u32x4*)dst;
#pragma unroll 4
    for (size_t i = gtid; i < n8; i += gstride) { const f32x4 a = __builtin_nontemporal_load(s4 + 2 * i), b = __builtin_nontemporal_load(s4 + 2 * i + 1);
        u32x4 w; w.x = pk_bf16(a[0], a[1]); w.y = pk_bf16(a[2], a[3]); w.z = pk_bf16(b[0], b[1]); w.w = pk_bf16(b[2], b[3]); d4[i] = w; }
}


#define XB_TMO      128
#define XB_XCNT(j)  (256  + 64 * (j))
#define XB_XSUB(j)  (1280 + 64 * (j))
#define XB_XGEN(j)  (2304 + 64 * (j))
#define XB_TOP      3328
#define XB_TOPGEN   3392
#define XCD_BAR_WORDS 3456
#define XB_SPIN_CAP (1u << 18)
__device__ __forceinline__ unsigned xb_ld(unsigned* p)              { return __hip_atomic_load(p, __ATOMIC_RELAXED, __HIP_MEMORY_SCOPE_AGENT); }
__device__ __forceinline__ unsigned xb_add(unsigned* p, unsigned v) { return __hip_atomic_fetch_add(p, v, __ATOMIC_RELAXED, __HIP_MEMORY_SCOPE_AGENT); }
__device__ __forceinline__ unsigned xb_xcc_id() { return (unsigned)__builtin_amdgcn_s_getreg((3 << 11) | 20) & 0xFu; }
#define XB_SPIN(cond, bar) do { unsigned _sp = 0; while (cond) { __builtin_amdgcn_s_sleep(1); \
    if ((++_sp & 255u) == 0u) { if (xb_ld(&(bar)[XB_TMO])) break; if (_sp > XB_SPIN_CAP) { atomicAdd(&(bar)[XB_TMO], 1u); break; } } } } while (0)
struct XcdBarrier { unsigned* bar; unsigned x; volatile LAS unsigned* st; };
__device__ __forceinline__ XcdBarrier xcd_barrier_post(unsigned* bar, volatile LAS unsigned* st) {
    XcdBarrier b; b.bar = bar; b.x = xb_xcc_id(); b.st = st;
    if (threadIdx.x == 0) (void)xb_add(&bar[XB_XCNT(b.x)], 1u);
    return b;
}
__device__ __forceinline__ void xcd_barrier_complete(unsigned* bar, unsigned x, unsigned& nloc, unsigned& nx) {
    const unsigned G = gridDim.x * gridDim.y * gridDim.z;
    unsigned sum, cnt, mine, sp = 0u;
    for (;;) {
        sum = 0u; cnt = 0u; mine = 0u;
#pragma unroll
        for (unsigned j = 0; j < 16; ++j) { const unsigned c = xb_ld(&bar[XB_XCNT(j)]); sum += c; cnt += (c > 0u) ? 1u : 0u; mine = (j == x) ? c : mine; }
        if (sum == G) break;
        __builtin_amdgcn_s_sleep(1);
        if ((++sp & 255u) == 0u) { if (xb_ld(&bar[XB_TMO])) break; if (sp > XB_SPIN_CAP) { atomicAdd(&bar[XB_TMO], 1u); break; } }
    }
    nloc = mine > 0u ? mine : 1u; nx = cnt > 0u ? cnt : 1u;
}
__device__ __forceinline__ void xcd_barrier(const XcdBarrier& b) {
    asm volatile("s_waitcnt vmcnt(0)" ::: "memory");
    __syncthreads();
    if (threadIdx.x == 0) {
        unsigned* bar = b.bar;
        __builtin_amdgcn_s_waitcnt(0);
        unsigned nloc = b.st[0], nx = b.st[1];
        if (nloc == 0u) { xcd_barrier_complete(bar, b.x, nloc, nx); b.st[0] = nloc; b.st[1] = nx; }
        const unsigned old = xb_add(&bar[XB_XSUB(b.x)], 1u);
        const unsigned gen = old / nloc;
        if (old + 1u == (gen + 1u) * nloc) {
            __builtin_amdgcn_fence(__ATOMIC_RELEASE, "agent");
            asm volatile("s_waitcnt vmcnt(0)" ::: "memory");
            const unsigned og = xb_add(&bar[XB_TOP], 1u);
            const unsigned tg = og / nx;
            if (og + 1u == (tg + 1u) * nx) xb_add(&bar[XB_TOPGEN], 1u);
            else XB_SPIN(xb_ld(&bar[XB_TOPGEN]) == tg, bar);
            __builtin_amdgcn_fence(__ATOMIC_ACQUIRE, "agent");
            xb_add(&bar[XB_XGEN(b.x)], 1u);
            asm volatile("s_waitcnt vmcnt(0)" ::: "memory");
        } else {
            XB_SPIN(xb_ld(&bar[XB_XGEN(b.x)]) == gen, bar);
            __builtin_amdgcn_fence(__ATOMIC_ACQUIRE, "agent");
            asm volatile("s_waitcnt vmcnt(0)" ::: "memory");
        }
    }
    __syncthreads();
}

__device__ __forceinline__ void ada_phase(LAS unsigned char* lds, const float* __restrict__ cvec, const float* __restrict__ w_ada, const float* __restrict__ b_ada, float* __restrict__ mod, int G, int c) {
    LAS float* ca = (LAS float*)lds;
    LAS float* part = (LAS float*)(lds + 32768);
    const int tid = threadIdx.x;
    __syncthreads();
    for (int i = tid; i < kB * kD; i += 512) { const float v = cvec[i]; ca[i] = v / (1.f + __expf(-v)); }
    __syncthreads();
    for (int cb = c; cb < 6 * kD / 48; cb += G) {
        const int n0 = cb * 48, cg = tid % 12, kr = tid / 12;
        if (tid < 504) {
            f32x4 a0 = {0.f, 0.f, 0.f, 0.f}, a1 = a0, a2 = a0, a3 = a0;
#pragma unroll 8
            for (int k = kr; k < kD; k += 42) { const f32x4 w = __builtin_nontemporal_load((const f32x4*)(w_ada + (size_t)k * (6 * kD) + n0 + cg * 4));
                a0 += ca[k] * w; a1 += ca[kD + k] * w; a2 += ca[2 * kD + k] * w; a3 += ca[3 * kD + k] * w; }
            LAS f32x4* pp = (LAS f32x4*)(part + (kr * 12 + cg) * 16); pp[0] = a0; pp[1] = a1; pp[2] = a2; pp[3] = a3;
        }
        __syncthreads();
        if (tid < 192) { const int col = tid % 48, b = tid / 48; float sum = 0.f;
            for (int r = 0; r < 42; ++r) sum += part[(r * 12 + (col >> 2)) * 16 + b * 4 + (col & 3)];
            mod[b * 6 * kD + n0 + col] = sum + b_ada[n0 + col]; }
        __syncthreads();
    }
}

__device__ __forceinline__ void norm1_phase(const float* __restrict__ x, const float* __restrict__ nw, const float* __restrict__ mod, bf16_t* __restrict__ out, int G, int c) {
    const int wid = threadIdx.x >> 6, lane = threadIdx.x & 63;
    for (int t = c * 8 + wid; t < kT; t += G * 8) {
        const int b = t / kS; const float* xr = x + (size_t)t * kD + lane * 4; const float* mb = mod + b * 6 * kD + lane * 4;
        f32x4 v[8]; float ss = 0.f;
#pragma unroll
        for (int j = 0; j < 8; ++j) { v[j] = *(const f32x4*)(xr + 256 * j); ss += v[j][0] * v[j][0] + v[j][1] * v[j][1] + v[j][2] * v[j][2] + v[j][3] * v[j][3]; }
        ss = wave_sum(ss);
        const float r = rsqrtf(ss * (1.f / kD) + kEPS);
#pragma unroll
        for (int j = 0; j < 8; ++j) { const f32x4 w = *(const f32x4*)(nw + lane * 4 + 256 * j), sh = *(const f32x4*)(mb + 256 * j), sc = *(const f32x4*)(mb + kD + 256 * j);
            const f32x4 y = v[j] * r * w * (1.f + sc) + sh; u32x2 o; o.x = pk_bf16(y[0], y[1]); o.y = pk_bf16(y[2], y[3]);
            *(u32x2*)(out + (size_t)t * kD + lane * 4 + 256 * j) = o; }
    }
}

__device__ __forceinline__ void split_bf16(const float (&v)[8], bf16x8& hi, bf16x8& lo) {
    u32x4 h, l;
#pragma unroll
    for (int i = 0; i < 4; ++i) { const unsigned hp = pk_bf16(v[2 * i], v[2 * i + 1]); h[i] = hp; l[i] = pk_bf16(v[2 * i] - bflo(hp), v[2 * i + 1] - bfhi(hp)); }
    hi = __builtin_bit_cast(bf16x8, h); lo = __builtin_bit_cast(bf16x8, l);
}
__device__ __forceinline__ void norm2_router_phase(LAS unsigned char* lds, const float* __restrict__ x1, const float* __restrict__ nw, const float* __restrict__ mod,
                                                   const float* __restrict__ w_router, const float* __restrict__ b_router, unsigned char* __restrict__ h2,
                                                   float* __restrict__ gates, int* __restrict__ pair_e, int* __restrict__ pair_p, int* __restrict__ list, unsigned* __restrict__ ctrl, int G, int c) {
    typedef float f32x16 __attribute__((ext_vector_type(16)));
    const int tid = threadIdx.x, wid = __builtin_amdgcn_readfirstlane(tid >> 6), lane = tid & 63, ql = lane & 31, hf = lane >> 5;
    LAS float* part = (LAS float*)lds;
    LAS float* rsL = (LAS float*)(lds + 32768);
    LAS int* lcnt = (LAS int*)(lds + fg::MISC_OFF + 64);
    for (int blk = c; blk < kT / 32; blk += G) {
        const int t0 = blk * 32, b = t0 / kS;
        __syncthreads();
        if (tid < 32) lcnt[tid] = 0;
#pragma unroll
        for (int rr = 0; rr < 4; ++rr) { const float* xr = x1 + (size_t)(t0 + 4 * wid + rr) * kD + 4 * lane; float ss = 0.f;
#pragma unroll
            for (int j = 0; j < 8; ++j) { const f32x4 v = *(const f32x4*)(xr + 256 * j); ss += v[0] * v[0] + v[1] * v[1] + v[2] * v[2] + v[3] * v[3]; }
            ss = wave_sum(ss); if (lane == 0) rsL[4 * wid + rr] = rsqrtf(ss * (1.f / kD) + kEPS); }
        __syncthreads();
        const float rq = rsL[ql];
        f32x16 acc;
#pragma unroll
        for (int r = 0; r < 16; ++r) acc[r] = 0.f;
        const float* xrow = x1 + (size_t)(t0 + ql) * kD + 256 * wid + 8 * hf;
        const float* mrow = mod + b * 6 * kD + 256 * wid + 8 * hf;
        unsigned char* hrow = h2 + (size_t)(t0 + ql) * kD + 256 * wid + 8 * hf;
        const float* wrow = w_router + (size_t)(256 * wid + 8 * hf) * kE + ql;
#pragma unroll 4
        for (int s = 0; s < 16; ++s) {
            const f32x4 xa = *(const f32x4*)(xrow + 16 * s), xb = *(const f32x4*)(xrow + 16 * s + 4);
            const f32x4 wa = *(const f32x4*)(nw + 256 * wid + 8 * hf + 16 * s), wb = *(const f32x4*)(nw + 256 * wid + 8 * hf + 16 * s + 4);
            const f32x4 sha = *(const f32x4*)(mrow + 3 * kD + 16 * s), shb = *(const f32x4*)(mrow + 3 * kD + 16 * s + 4);
            const f32x4 sca = *(const f32x4*)(mrow + 4 * kD + 16 * s), scb = *(const f32x4*)(mrow + 4 * kD + 16 * s + 4);
            const f32x4 ya = xa * rq * wa * (1.f + sca) + sha, yb = xb * rq * wb * (1.f + scb) + shb;
            const float y[8] = {ya[0], ya[1], ya[2], ya[3], yb[0], yb[1], yb[2], yb[3]};
            u32x2 hq; hq.x = pk4_fp8(clamp448(y[0]), clamp448(y[1]), clamp448(y[2]), clamp448(y[3])); hq.y = pk4_fp8(clamp448(y[4]), clamp448(y[5]), clamp448(y[6]), clamp448(y[7]));
            *(u32x2*)(hrow + 16 * s) = hq;
            float wv[8];
#pragma unroll
            for (int j = 0; j < 8; ++j) wv[j] = wrow[(size_t)(16 * s + j) * kE];
            bf16x8 yh, yl, wh, wl; split_bf16(y, yh, yl); split_bf16(wv, wh, wl);
            acc = __builtin_amdgcn_mfma_f32_32x32x16_bf16(yh, wh, acc, 0, 0, 0);
            acc = __builtin_amdgcn_mfma_f32_32x32x16_bf16(yl, wh, acc, 0, 0, 0);
            acc = __builtin_amdgcn_mfma_f32_32x32x16_bf16(yh, wl, acc, 0, 0, 0);
        }
#pragma unroll
        for (int r = 0; r < 16; ++r) part[(wid * 32 + (r & 3) + 8 * (r >> 2) + 4 * hf) * 32 + ql] = acc[r];
        __syncthreads();
#pragma unroll
        for (int rr = 0; rr < 4; ++rr) {
            const int tok = 4 * wid + rr;
            float v1 = 0.f;
#pragma unroll
            for (int w8 = 0; w8 < 8; ++w8) v1 += part[(w8 * 32 + tok) * 32 + ql];
            float mine = hf ? -3.4e38f : v1 + b_router[ql];
            int idx[4]; float val[4];
#pragma unroll
            for (int k = 0; k < 4; ++k) { float bv = mine; int bi = ql + (hf << 6);
#pragma unroll
                for (int o = 32; o > 0; o >>= 1) { const float ov = __shfl_xor(bv, o); const int oi = __shfl_xor(bi, o); if (ov > bv || (ov == bv && oi < bi)) { bv = ov; bi = oi; } }
                idx[k] = bi; val[k] = bv; if (!hf && ql == bi) mine = -3.4e38f; }
            if (lane == 0) { const int t = t0 + tok; float ex[4], sum = 0.f;
#pragma unroll
                for (int k = 0; k < 4; ++k) { ex[k] = __expf(val[k] - val[0]); sum += ex[k]; }
                const float inv = 1.f / sum;
#pragma unroll
                for (int k = 0; k < 4; ++k) { gates[t * 4 + k] = ex[k] * inv; lcnt[64 + tok * 4 + k] = idx[k]; lcnt[192 + tok * 4 + k] = __hip_atomic_fetch_add(&lcnt[idx[k]], 1, __ATOMIC_RELAXED, __HIP_MEMORY_SCOPE_WORKGROUP); } }
        }
        __syncthreads();
        if (tid < 32) { const int n = lcnt[tid]; lcnt[32 + tid] = n > 0 ? (int)atomicAdd(&ctrl[CT_CNT + 64 * tid], (unsigned)n) : 0; }
        __syncthreads();
        if (tid < 128) { const int e = lcnt[64 + tid], pos = lcnt[32 + e] + lcnt[192 + tid], t = blk * 32 + (tid >> 2);
            pair_e[t * 4 + (tid & 3)] = e; pair_p[t * 4 + (tid & 3)] = pos; list[(size_t)e * kT + pos] = t; }
    }
}

__device__ __forceinline__ void final_phase(const float* __restrict__ x1, const float* __restrict__ mod, const float* __restrict__ gates, const int* __restrict__ pair_e, const int* __restrict__ pair_p,
                                            const MoeTab M, const bf16_t* __restrict__ yp, float* __restrict__ out, int G, int c) {
    const int wid = threadIdx.x >> 6, lane = threadIdx.x & 63;
    for (int t = c * 8 + wid; t < kT; t += G * 8) {
        const int b = t / kS; float gk[4]; const bf16_t* rp[4];
#pragma unroll
        for (int k = 0; k < 4; ++k) { gk[k] = gates[t * 4 + k]; const int e = pair_e[t * 4 + k];
            rp[k] = yp + (size_t)(M.t[32 + e] + pair_p[t * 4 + k]) * kD + lane * 8; }
#pragma unroll
        for (int j = 0; j < 4; ++j) { f32x4 y0 = {0.f, 0.f, 0.f, 0.f}, y1 = y0;
#pragma unroll
            for (int k = 0; k < 4; ++k) { const u32x4 v = *(const u32x4*)(rp[k] + 512 * j);
                y0 += gk[k] * (f32x4){bflo(v.x), bfhi(v.x), bflo(v.y), bfhi(v.y)}; y1 += gk[k] * (f32x4){bflo(v.z), bfhi(v.z), bflo(v.w), bfhi(v.w)}; }
            const size_t o = (size_t)t * kD + lane * 8 + 512 * j; const float* gp = mod + b * 6 * kD + 5 * kD + lane * 8 + 512 * j;
            *(f32x4*)(out + o) = *(const f32x4*)(x1 + o) + *(const f32x4*)gp * y0; *(f32x4*)(out + o + 4) = *(const f32x4*)(x1 + o + 4) + *(const f32x4*)(gp + 4) * y1; }
    }
}

struct MegaArgs { const float* in[18]; float* out; unsigned char* ws; int ph_lo, ph_hi; };
constexpr int NPHASE = 10;
__global__ void __launch_bounds__(512, 2) mega(MegaArgs a) {
    extern __shared__ __attribute__((aligned(16))) unsigned char lds_raw[];
    LAS unsigned char* lds = (LAS unsigned char*)lds_raw;
    unsigned char* ws = a.ws;
    const int lo = a.ph_lo, hi = a.ph_hi;
#define IN(k) (lo <= (k) && (k) < hi)
#define SEAM(k) do { if (IN(k) && IN((k) + 1)) xcd_barrier(bar); } while (0)
    const int G = gridDim.x, c = blockIdx.x;
    unsigned* ctrl = (unsigned*)(ws + WS_CTRL);
    const int grp = (c >> 3) & 1, cpr = ((c >> 4) << 3) | (c & 7);
#define HOST_PRE(CC, r0, n)  do { if (grp == 0) convert_t_f8(lds, CC, (r0) + cpr, (r0) + (G / 2) * (n), G / 2); } while (0)
#define HOST_POST(CC, r0, n, q) convert_dyn(lds, CC, ctrl + CT_Q + 64 * (q), (r0) + (G / 2) * (n), (r0) + G * (n))
    const int r_p2 = 0, r_p3 = 56 * G, r_p5 = 84 * G, r_p6 = 92 * G;
    const CvtT C1 = cvt_make(a.in[14], (unsigned char*)(ws + WS_WE1), kD, 2 * kDFF);
    const CvtT C2 = cvt_make(a.in[16], (unsigned char*)(ws + WS_WE2), kDFF, kD);
    if (threadIdx.x == 0) *(LAS u32x4*)(lds + fg::MISC_OFF) = (u32x4){0u, 0u, 0u, 0u};
    __syncthreads();
    XcdBarrier bar; bar.bar = ctrl; bar.x = 0; bar.st = (volatile LAS unsigned*)(lds + fg::MISC_OFF);
    if (hi - lo > 1) bar = xcd_barrier_post(ctrl, (volatile LAS unsigned*)(lds + fg::MISC_OFF));
    float* mod = (float*)(ws + WS_MOD);
    if (IN(0)) {
        ada_phase(lds, a.in[1], a.in[4], a.in[5], mod, G, c);
        const size_t gtid = (size_t)blockIdx.x * 512 + threadIdx.x, gstride = (size_t)G * 512;
        convert_seg(a.in[6], (bf16_t*)(ws + WS_WIN), (size_t)kD * kNPROJ / 8, gtid, gstride);
        convert_seg(a.in[11], (bf16_t*)(ws + WS_WO), (size_t)kSB * kD / 8, gtid, gstride);
        convert_seg(a.in[11] + (size_t)kSB * kD, (bf16_t*)(ws + WS_P), (size_t)kPW * kD / 8, gtid, gstride);
        { const f32x4* s4 = (const f32x4*)a.in[9]; const f32x4* sc4 = (const f32x4*)a.in[10]; u32x4* d4 = (u32x4*)(ws + WS_WPL);
          for (size_t i = gtid; i < (size_t)4 * kPG * kPG / 8; i += gstride) { const int g = (int)(i >> 13), n8 = (int)(i & 31);
              const f32x4 sa = sc4[g * 64 + n8 * 2], sb = sc4[g * 64 + n8 * 2 + 1]; const f32x4 a0 = s4[2 * i] * sa, b0 = s4[2 * i + 1] * sb;
              u32x4 w; w.x = pk_bf16(a0[0], a0[1]); w.y = pk_bf16(a0[2], a0[3]); w.z = pk_bf16(b0[0], b0[1]); w.w = pk_bf16(b0[2], b0[3]); d4[i] = w; } }
    }
    SEAM(0);
    if (IN(1)) norm1_phase(a.in[0], a.in[2], mod, (bf16_t*)(ws + WS_H), G, c);
    if (IN(1)) { JobPoolFold J; J.A = (const char*)(ws + WS_WPL); J.lda2 = kPG * 2; J.ldb2 = kD * 2; J.bhalf2 = 256; J.K = kPG; J.list = nullptr;
        J.B = (const char*)(ws + WS_P); J.wo = (bf16_t*)(ws + WS_WO); J.G = G; J.c = c; fg::gemm_phase(lds, J); }
    SEAM(1);
    if (IN(2)) HOST_PRE(C1, r_p2, 56);
    if (IN(2)) { JobInProj J; J.A = (const char*)(ws + WS_H); J.lda2 = kD * 2; J.ldb2 = kNPROJ * 2; J.bhalf2 = 256; J.K = kD; J.list = nullptr;
        J.B = (const char*)(ws + WS_WIN); J.out = (bf16_t*)(ws + WS_PROJ); J.S.init(kT, kNPROJ, G, c); fg::gemm_phase(lds, J); }
    if (IN(2)) HOST_POST(C1, r_p2, 56, 0);
    SEAM(2);
    if (IN(3)) HOST_PRE(C1, r_p3, 28);
    if (IN(3)) { at::attn_phase(lds, (const bf16_t*)(ws + WS_PROJ), a.in[7], a.in[8], (bf16_t*)(ws + WS_CAT), G, c);
        pool_p_phase((const bf16_t*)(ws + WS_PROJ), (bf16_t*)(ws + WS_CAT), G, c); }
    if (IN(3)) HOST_POST(C1, r_p3, 28, 1);
    SEAM(3);
    if (IN(5)) HOST_PRE(C1, r_p5, 8);
    if (IN(5)) { JobOutProj J; J.A = (const char*)(ws + WS_CAT); J.lda2 = kD * 2; J.ldb2 = kD * 2; J.bhalf2 = 256; J.K = kD; J.list = nullptr;
        J.B = (const char*)(ws + WS_WO); J.x = a.in[0]; J.mod = mod; J.x1 = (float*)(ws + WS_X1); J.S.init(kT, kD, G, c); fg::gemm_phase(lds, J); }
    if (IN(5)) HOST_POST(C1, r_p5, 8, 2);
    SEAM(5);
    if (IN(6)) HOST_PRE(C1, r_p6, 36);
    if (IN(6)) norm2_router_phase(lds, (const float*)(ws + WS_X1), a.in[3], mod, a.in[12], a.in[13], (unsigned char*)(ws + WS_H2), (float*)(ws + WS_GATES), (int*)(ws + WS_PAIRE), (int*)(ws + WS_PAIRP),
                                  (int*)(ws + WS_LIST), ctrl, G, c);
    if (IN(6)) HOST_POST(C1, r_p6, 36, 3);
    SEAM(6);
    if (IN(7)) HOST_PRE(C2, 0, 64);
    if (IN(7)) { JobMoe1F8 J; J.A = (const char*)(ws + WS_H2); J.lda2 = kD; J.ldb2 = kD; J.bhalf2 = (unsigned)kDFF * kD; J.K = kD; J.list = (const int*)(ws + WS_LIST);
        J.B = (const char*)(ws + WS_WE1); J.b_in = a.in[15]; J.act = (unsigned char*)(ws + WS_ACT); J.M = moe_tables(lds, ctrl, kDFF / 128); J.G = G; J.c = c; fg::gemm_phase_f8(lds, J); }
    if (IN(7)) HOST_POST(C2, 0, 64, 4);
    SEAM(7);
    if (IN(8)) { JobMoe2F8 J; J.A = (const char*)(ws + WS_ACT); J.lda2 = kDFF; J.ldb2 = kDFF; J.bhalf2 = 128u * kDFF; J.K = kDFF; J.list = nullptr;
        J.B = (const char*)(ws + WS_WE2); J.b_out = a.in[17]; J.yp = (bf16_t*)(ws + WS_YP); J.M = moe_tables(lds, ctrl, kD / 256); J.G = G; J.c = c; fg::gemm_phase_f8(lds, J); }
    SEAM(8);
    if (IN(9)) final_phase((const float*)(ws + WS_X1), mod, (const float*)(ws + WS_GATES), (const int*)(ws + WS_PAIRE), (const int*)(ws + WS_PAIRP), moe_tables(lds, ctrl, 1), (const bf16_t*)(ws + WS_YP), a.out, G, c);
#undef IN
#undef SEAM
}

#ifndef N_LAUNCHES
#define N_LAUNCHES 1
#endif
extern "C" void kernel_launch(void* const* d_in, const int* in_sizes, int n_in, void* d_out, int out_size, void* d_ws, size_t ws_size, hipStream_t stream) {
    static int grid = 0;
    if (grid == 0) {
        int dev = 0, cus = 0;
        (void)hipGetDevice(&dev); (void)hipDeviceGetAttribute(&cus, hipDeviceAttributeMultiprocessorCount, dev);
        (void)hipFuncSetAttribute((const void*)mega, hipFuncAttributeMaxDynamicSharedMemorySize, fg::LDS_BYTES);
        (void)cus; grid = 256;
    }
    MegaArgs a{}; for (int i = 0; i < 18; ++i) a.in[i] = (const float*)d_in[i]; a.out = (float*)d_out; a.ws = (unsigned char*)d_ws;
    (void)hipMemsetAsync((char*)d_ws + WS_CTRL, 0, 65536, stream);
    if (N_LAUNCHES == 1) { a.ph_lo = 0; a.ph_hi = NPHASE; hipLaunchKernelGGL(mega, dim3(grid), dim3(512), fg::LDS_BYTES, stream, a); }
    else for (int p = 0; p < NPHASE; ++p) { a.ph_lo = p; a.ph_hi = p + 1; hipLaunchKernelGGL(mega, dim3(grid), dim3(512), fg::LDS_BYTES, stream, a); }
}
```

```cpp
#include <hip/hip_runtime.h>
#include <stdint.h>

constexpr int kB = 4, kS = 2048, kD = 2048, kT = kB * kS;
constexpr int kHD = 128, kNH = 8, kSB = 1024, kPW = 1024, kPG = 256;
constexpr int kNPROJ = 4096, kE = 32, kTOPK = 4, kDFF = 2048;
constexpr float kEPS = 1e-6f;
constexpr int kMaxSlots = 160 * 256;

typedef unsigned short bf16_t;
__device__ __forceinline__ bf16_t f2bf(float f) { unsigned u = __float_as_uint(f); u += 0x7FFFu + ((u >> 16) & 1u); return (bf16_t)(u >> 16); }
__device__ __forceinline__ float bf2f(bf16_t b) { return __uint_as_float(((unsigned)b) << 16); }

constexpr size_t WS_CTRL   = 0;
constexpr size_t WS_MOD    = 65536;
constexpr size_t WS_H      = WS_MOD + (size_t)4 * 12288 * 4;
constexpr size_t WS_PROJ   = WS_H + (size_t)kT * kD * 2;
constexpr size_t WS_CAT    = WS_PROJ + (size_t)kT * kNPROJ * 2;
constexpr size_t WS_P      = WS_CAT + (size_t)kT * kD * 2;
constexpr size_t WS_X1     = WS_P + (size_t)kT * kPW * 2;
constexpr size_t WS_H2     = WS_X1 + (size_t)kT * kD * 4;
constexpr size_t WS_GATES  = WS_H2 + (size_t)kT * kD * 2;
constexpr size_t WS_PAIRE  = WS_GATES + (size_t)kT * 4 * 4;
constexpr size_t WS_PAIRP  = WS_PAIRE + (size_t)kT * 4 * 4;
constexpr size_t WS_LIST   = WS_PAIRP + (size_t)kT * 4 * 4;
constexpr size_t WS_ACT    = WS_LIST + (size_t)kE * kT * 4;
constexpr size_t WS_YP     = WS_ACT + (size_t)kMaxSlots * kDFF * 2;
constexpr size_t WS_END    = WS_YP + (size_t)kMaxSlots * kD * 2;
constexpr int CT_CNT = 4096;
constexpr int CT_ROWBASE = 4160;
constexpr int CT_Q = 8192;

#define LAS __attribute__((address_space(3)))
typedef short bf16x8 __attribute__((ext_vector_type(8)));
typedef short s16x4 __attribute__((ext_vector_type(4)));
typedef float f32x4 __attribute__((ext_vector_type(4)));
typedef float f32x2 __attribute__((ext_vector_type(2)));
typedef __bf16 bf16v2 __attribute__((ext_vector_type(2)));
typedef unsigned u32x2 __attribute__((ext_vector_type(2)));
typedef unsigned u32x4 __attribute__((ext_vector_type(4)));
typedef int i32x4 __attribute__((ext_vector_type(4)));
typedef int i32x8 __attribute__((ext_vector_type(8)));
__device__ __forceinline__ unsigned pk_bf16(float a, float b) { f32x2 v = {a, b}; bf16v2 r = __builtin_convertvector(v, bf16v2); return __builtin_bit_cast(unsigned, r); }

constexpr size_t WS_WIN  = WS_END;
constexpr size_t WS_WO   = WS_WIN + (size_t)kD * kNPROJ * 2;
constexpr size_t WS_WPL  = WS_WO + (size_t)kD * kD * 2;
constexpr size_t WS_WE1  = WS_WPL + (size_t)4 * kPG * kPG * 2;
constexpr size_t WS_WE2  = WS_WE1 + (size_t)kE * kD * 2 * kDFF * 2;
constexpr size_t WS_END2 = WS_WE2 + (size_t)kE * kDFF * kD * 2;

namespace fg {
constexpr int BM = 256, BK = 64, HALF = 128, HTB = 16384, STAGE_BYTES = 131072, NXCD = 8, WGM = 8;
constexpr int TAB_OFF = STAGE_BYTES;
constexpr int MISC_OFF = STAGE_BYTES + 2048;
constexpr int LDS_BYTES = STAGE_BYTES + 4096;
__device__ __forceinline__ int lds_byte(int r, int c) { const int st = (r >> 4) * 2 + (c >> 5), rr = r & 15, cc = c & 31, ob = rr * 64 + cc * 2; return st * 1024 + (ob ^ (((ob >> 9) & 1) << 5)); }
__device__ __forceinline__ void stage_rc(int b, int& R, int& C) { const int st = b / 1024, sb = b % 1024, swz = sb ^ (((sb >> 9) & 1) << 5); R = (st >> 1) * 16 + swz / 64; C = (st & 1) * 32 + (swz % 64) / 2; }

struct Unit { const char* bBase; int arow0; int nvalid; int e; int orow0; int ocol0; int acol2; };

struct StaticOrder {
    int nM, nN, nwg, G, c;
    __device__ void init(int M, int N, int G_, int c_) { nM = M / BM; nN = N / BM; nwg = nM * nN; G = G_; c = c_; }
    __device__ bool next(int i, int& pm, int& pn) const {
        const long L = (long)i * G + c; if (L >= nwg) return false;
        int wgid = (int)L; { const int q = nwg / NXCD, r = nwg % NXCD, xcd = wgid % NXCD, off = wgid / NXCD; wgid = (xcd < r ? xcd * (q + 1) : r * (q + 1) + (xcd - r) * q) + off; }
        const int nig = WGM * nN, gid = wgid / nig, fm = gid * WGM, gsz = (nM - fm) < WGM ? (nM - fm) : WGM;
        pm = fm + ((wgid % nig) % gsz); pn = (wgid % nig) / gsz; return true;
    }
};

template <int OFF> __device__ __forceinline__ s16x4 tr_read(unsigned addr) { s16x4 r; asm volatile("ds_read_b64_tr_b16 %0, %1 offset:%2" : "=&v"(r) : "v"(addr), "i"(OFF) : "memory"); return r; }
template <class Job>
__device__ __forceinline__ void gemm_phase(LAS unsigned char* lds, const Job& J) {
    const int tid = threadIdx.x, wid = __builtin_amdgcn_readfirstlane(tid >> 6), lane = tid & 63, wr = wid >> 2, wc = wid & 3, fr = lane & 15, fq = lane >> 4;
    const int nt = J.K / BK;
    unsigned voffB[2];
#pragma unroll
    for (int i = 0; i < 2; ++i) { int R, C; stage_rc(tid * 16 + i * 8192, R, C);
        const int b = tid * 16 + i * 8192, row = b >> 8, slot = (b >> 4) & 15, ch = slot ^ (((row & 3) << 2) | ((row >> 2) & 3)); voffB[i] = (unsigned)row * J.ldb2 + (unsigned)ch * 16u; }
    const size_t kstepB = (size_t)BK * J.ldb2;
    const unsigned ldsw = (unsigned)wid * 1024u;
    const int aoff = lds_byte(wr * 64 + fr, fq * 8);
    const int tq = (lane & 15) >> 2, tp = lane & 3;
    unsigned ba[2][2];
#pragma unroll
    for (int n = 0; n < 2; ++n)
#pragma unroll
        for (int t = 0; t < 2; ++t) ba[n][t] = (unsigned)(uintptr_t)lds + 256u * (8 * fq + 4 * t + tq) + 16u * ((4 * wc + 2 * n + (tp >> 1)) ^ ((tq << 2) | ((2 * fq + t) & 3))) + 8u * (tp & 1);
#define FG_SA(b, h) (65536 + ((b) * 2 + (h)) * HTB)
#define FG_SB(b, h) (((b) * 2 + (h)) * HTB)
#define FG_STAGE_A(bufoff, gk, vo) do { _Pragma("unroll") for (int _i = 0; _i < 2; ++_i) \
        __builtin_amdgcn_global_load_lds((const unsigned*)((gk) + (vo)[_i]), (LAS unsigned*)(lds + (bufoff) + ldsw + _i * 8192), 16, 0, 0); } while (0)
#define FG_STAGE_B(bufoff, gk) do { _Pragma("unroll") for (int _i = 0; _i < 2; ++_i) \
        __builtin_amdgcn_global_load_lds((const unsigned*)((gk) + voffB[_i]), (LAS unsigned*)(lds + (bufoff) + ldsw + _i * 8192), 16, 0, 0); } while (0)
#define FG_LDA(dst, b, h) do { _Pragma("unroll") for (int m = 0; m < 4; ++m) _Pragma("unroll") for (int k = 0; k < 2; ++k) dst[m][k] = *(const LAS bf16x8*)(lds + FG_SA(b, h) + aoff + m * 2048 + k * 1024); } while (0)
#define FG_LDB(dst, b, h) do { \
        dst##lo[0][0] = tr_read<FG_SB(b, h)>(ba[0][0]);        dst##hi[0][0] = tr_read<FG_SB(b, h)>(ba[0][1]); \
        dst##lo[0][1] = tr_read<FG_SB(b, h) + 8192>(ba[0][0]); dst##hi[0][1] = tr_read<FG_SB(b, h) + 8192>(ba[0][1]); \
        dst##lo[1][0] = tr_read<FG_SB(b, h)>(ba[1][0]);        dst##hi[1][0] = tr_read<FG_SB(b, h)>(ba[1][1]); \
        dst##lo[1][1] = tr_read<FG_SB(b, h) + 8192>(ba[1][0]); dst##hi[1][1] = tr_read<FG_SB(b, h) + 8192>(ba[1][1]); } while (0)
#define FG_PK(L, H) (bf16x8){L[0], L[1], L[2], L[3], H[0], H[1], H[2], H[3]}
#define FG_MMA(ai, bj, At, Bt) do { __builtin_amdgcn_s_setprio(1); _Pragma("unroll") for (int m = 0; m < 4; ++m) _Pragma("unroll") for (int n = 0; n < 2; ++n) _Pragma("unroll") for (int k = 0; k < 2; ++k) \
        acc[ai][bj][m][n] = __builtin_amdgcn_mfma_f32_16x16x32_bf16(FG_PK(Bt##lo[n][k], Bt##hi[n][k]), At[m][k], acc[ai][bj][m][n], 0, 0, 0); __builtin_amdgcn_s_setprio(0); } while (0)
#define FG_WAIT_V(n) asm volatile("s_waitcnt vmcnt(" #n ")" ::: "memory")
#define FG_WAIT_L(n) asm volatile("s_waitcnt lgkmcnt(" #n ")" ::: "memory")
#define FG_BAR __builtin_amdgcn_s_barrier()
#define FG_SCHED __builtin_amdgcn_sched_barrier(0)
#define FG_AOFF(dst, u, tabp) do { int _tz = threadIdx.x; asm volatile("" : "+v"(_tz)); _Pragma("unroll") for (int _i = 0; _i < 2; ++_i) { int _R, _C; stage_rc(_tz * 16 + _i * 8192, _R, _C); \
        _Pragma("unroll") for (int _h = 0; _h < 2; ++_h) { const int _r = _h * 128 + _R; \
        if (Job::GATHER) { const int _tok = (tabp)[_r < (u).nvalid ? _r : 0]; dst[_h][_i] = (unsigned)_tok * J.lda2 + (unsigned)(_C * 2); } \
        else dst[_h][_i] = (unsigned)((u).arow0 + _r) * J.lda2 + (unsigned)((u).acol2 + _C * 2); } } } while (0)
    Unit cur, nxt; int ui = 0;
    if (!J.next(0, cur)) return;
    LAS const int* tab0 = (LAS const int*)(lds + TAB_OFF);
    if (Job::GATHER) {
        if (wid == 0) __builtin_amdgcn_global_load_lds((const unsigned*)(J.list + cur.arow0 + lane * 4), (LAS unsigned*)(lds + TAB_OFF), 16, 0, 0);
        FG_WAIT_V(0); __syncthreads();
    }
    f32x4 acc[2][2][4][2];
#pragma unroll
    for (int a = 0; a < 2; ++a)
#pragma unroll
        for (int b = 0; b < 2; ++b)
#pragma unroll
            for (int m = 0; m < 4; ++m)
#pragma unroll
                for (int n = 0; n < 2; ++n) acc[a][b][m][n] = (f32x4){0.f, 0.f, 0.f, 0.f};
    bf16x8 At[4][2]; s16x4 B0lo[2][2], B0hi[2][2], B1lo[2][2], B1hi[2][2];
    unsigned vc[2][2];
    FG_AOFF(vc, cur, tab0);
    const char* const gA = J.A;
    const char* cB = cur.bBase;
    const unsigned bh2 = J.bhalf2;
    FG_STAGE_B(FG_SB(0, 0), cB); FG_STAGE_A(FG_SA(0, 0), gA, vc[0]); FG_STAGE_B(FG_SB(0, 1), cB + bh2); FG_STAGE_A(FG_SA(0, 1), gA, vc[1]);
    if (wr == 1) FG_BAR;
    FG_WAIT_V(4); FG_BAR;
    FG_STAGE_B(FG_SB(1, 0), cB + kstepB); FG_STAGE_A(FG_SA(1, 0), gA + 128, vc[0]); FG_STAGE_B(FG_SB(1, 1), cB + kstepB + bh2);
    FG_WAIT_V(6); FG_BAR;
    for (;;) {
        const bool has_next = J.next(ui + 1, nxt);
        if (!has_next) nxt = cur;
        if (Job::GATHER && has_next && wid == 0)
            __builtin_amdgcn_global_load_lds((const unsigned*)(J.list + nxt.arow0 + lane * 4), (LAS unsigned*)(lds + TAB_OFF + ((ui + 1) & 1) * 1024), 16, 0, 0);
        const char* nB = nxt.bBase;
        for (int t = 0; t < nt; t += 2) {
            const bool last = (t == nt - 2);
            const char* a1 = gA + (size_t)(t + 1) * 128;
            const char* a2 = last ? gA : gA + (size_t)(t + 2) * 128; const char* b2 = last ? nB : cB + (size_t)(t + 2) * kstepB;
            const char* a3 = a2 + 128; const char* b3 = b2 + kstepB;
            FG_LDB(B0, 0, 0); FG_SCHED; FG_LDA(At, 0, 0); FG_STAGE_A(FG_SA(1, 1), a1, vc[1]);
            if (last && has_next) { LAS const int* tabn = (LAS const int*)(lds + TAB_OFF + ((ui + 1) & 1) * 1024); FG_AOFF(vc, nxt, tabn); }
            FG_WAIT_L(8); FG_BAR; FG_WAIT_L(0); FG_SCHED; FG_MMA(0, 0, At, B0); FG_BAR; FG_SCHED;
            FG_LDB(B1, 0, 1); FG_STAGE_B(FG_SB(0, 0), b2);
            FG_BAR; FG_WAIT_L(0); FG_SCHED; FG_MMA(0, 1, At, B1); FG_BAR;
            FG_LDA(At, 0, 1); FG_STAGE_A(FG_SA(0, 0), a2, vc[0]);
            FG_BAR; FG_WAIT_L(0); FG_MMA(1, 0, At, B0); FG_BAR; FG_SCHED;
            FG_STAGE_B(FG_SB(0, 1), b2 + bh2);
            FG_WAIT_V(6); FG_BAR; FG_MMA(1, 1, At, B1); FG_BAR;
            FG_LDB(B0, 1, 0); FG_SCHED; FG_LDA(At, 1, 0); FG_STAGE_A(FG_SA(0, 1), a2, vc[1]);
            FG_WAIT_L(8); FG_BAR; FG_WAIT_L(0); FG_SCHED; FG_MMA(0, 0, At, B0); FG_BAR; FG_SCHED;
            FG_LDB(B1, 1, 1); FG_STAGE_B(FG_SB(1, 0), b3);
            FG_BAR; FG_WAIT_L(0); FG_SCHED; FG_MMA(0, 1, At, B1); FG_BAR;
            FG_LDA(At, 1, 1); FG_STAGE_A(FG_SA(1, 0), a3, vc[0]);
            FG_BAR; FG_WAIT_L(0); FG_MMA(1, 0, At, B0); FG_BAR; FG_SCHED;
            FG_STAGE_B(FG_SB(1, 1), b3 + bh2);
            FG_WAIT_V(6); FG_BAR; FG_MMA(1, 1, At, B1); FG_BAR;
        }
        J.epi(acc, cur, wr, wc, fr, fq);
        if (!has_next) break;
#pragma unroll
        for (int a = 0; a < 2; ++a)
#pragma unroll
            for (int b = 0; b < 2; ++b)
#pragma unroll
                for (int m = 0; m < 4; ++m)
#pragma unroll
                    for (int n = 0; n < 2; ++n) acc[a][b][m][n] = (f32x4){0.f, 0.f, 0.f, 0.f};
        cur = nxt; cB = nB; ++ui;
    }
    FG_WAIT_V(0);
    if (wr == 0) FG_BAR;
    FG_BAR;
}

#undef FG_SA
#undef FG_SB
#undef FG_STAGE_A
#undef FG_STAGE_B
#undef FG_LDA
#undef FG_LDB
#undef FG_MMA
#undef FG_WAIT_V
#undef FG_WAIT_L
#undef FG_BAR
#undef FG_SCHED
#undef FG_AOFF
template <class Job>
__device__ __forceinline__ void gemm_phase_f8(LAS unsigned char* lds, const Job& J) {
    const int tid = threadIdx.x, wid = __builtin_amdgcn_readfirstlane(tid >> 6), lane = tid & 63, wr = wid >> 2, wc = wid & 3, fr = lane & 15, fq = lane >> 4;
    const int nt = J.K / 128;
    unsigned voffB[2];
#pragma unroll
    for (int i = 0; i < 2; ++i) { int R, C; stage_rc(tid * 16 + i * 8192, R, C);
        voffB[i] = (unsigned)R * J.ldb2 + (unsigned)(C * 2); }
    const size_t kstepB = 128;
    const unsigned ldsw = (unsigned)wid * 1024u;
    const int aoff = lds_byte(wr * 64 + fr, fq * 8);
    const int boff = lds_byte(wc * 32 + fr, fq * 8);
#define FG_SA(b, h) (65536 + ((b) * 2 + (h)) * HTB)
#define FG_SB(b, h) (((b) * 2 + (h)) * HTB)
#define FG_STAGE_A(bufoff, gk, vo) do { _Pragma("unroll") for (int _i = 0; _i < 2; ++_i) \
        __builtin_amdgcn_global_load_lds((const unsigned*)((gk) + (vo)[_i]), (LAS unsigned*)(lds + (bufoff) + ldsw + _i * 8192), 16, 0, 0); } while (0)
#define FG_STAGE_B(bufoff, gk) do { _Pragma("unroll") for (int _i = 0; _i < 2; ++_i) \
        __builtin_amdgcn_global_load_lds((const unsigned*)((gk) + voffB[_i]), (LAS unsigned*)(lds + (bufoff) + ldsw + _i * 8192), 16, 0, 0); } while (0)
#define FG_LDA(dst, b, h) do { _Pragma("unroll") for (int m = 0; m < 4; ++m) _Pragma("unroll") for (int k = 0; k < 2; ++k) dst[m][k] = *(const LAS i32x4*)(lds + FG_SA(b, h) + aoff + m * 2048 + k * 1024); } while (0)
#define FG_LDB(dst, b, h) do { _Pragma("unroll") for (int n = 0; n < 2; ++n) _Pragma("unroll") for (int k = 0; k < 2; ++k) dst[n][k] = *(const LAS i32x4*)(lds + FG_SB(b, h) + boff + n * 2048 + k * 1024); } while (0)
#define FG_CAT8(X, Y) __builtin_shufflevector(X, Y, 0, 1, 2, 3, 4, 5, 6, 7)
#define FG_MMA(ai, bj, At, Bt) do { __builtin_amdgcn_s_setprio(1); _Pragma("unroll") for (int m = 0; m < 4; ++m) _Pragma("unroll") for (int n = 0; n < 2; ++n) \
        acc[ai][bj][m][n] = __builtin_amdgcn_mfma_scale_f32_16x16x128_f8f6f4(FG_CAT8(Bt[n][0], Bt[n][1]), FG_CAT8(At[m][0], At[m][1]), acc[ai][bj][m][n], 0, 0, 0, 0x79797979, 0, 0x7F7F7F7F); __builtin_amdgcn_s_setprio(0); } while (0)
#define FG_WAIT_V(n) asm volatile("s_waitcnt vmcnt(" #n ")" ::: "memory")
#define FG_WAIT_L(n) asm volatile("s_waitcnt lgkmcnt(" #n ")" ::: "memory")
#define FG_BAR __builtin_amdgcn_s_barrier()
#define FG_SCHED __builtin_amdgcn_sched_barrier(0)
#define FG_AOFF(dst, u, tabp) do { int _tz = threadIdx.x; asm volatile("" : "+v"(_tz)); _Pragma("unroll") for (int _i = 0; _i < 2; ++_i) { int _R, _C; stage_rc(_tz * 16 + _i * 8192, _R, _C); \
        _Pragma("unroll") for (int _h = 0; _h < 2; ++_h) { const int _r = _h * 128 + _R; \
        if (Job::GATHER) { const int _tok = (tabp)[_r < (u).nvalid ? _r : 0]; dst[_h][_i] = (unsigned)_tok * J.lda2 + (unsigned)(_C * 2); } \
        else dst[_h][_i] = (unsigned)((u).arow0 + _r) * J.lda2 + (unsigned)((u).acol2 + _C * 2); } } } while (0)
    Unit cur, nxt; int ui = 0;
    if (!J.next(0, cur)) return;
    LAS const int* tab0 = (LAS const int*)(lds + TAB_OFF);
    if (Job::GATHER) {
        if (wid == 0) __builtin_amdgcn_global_load_lds((const unsigned*)(J.list + cur.arow0 + lane * 4), (LAS unsigned*)(lds + TAB_OFF), 16, 0, 0);
        FG_WAIT_V(0); __syncthreads();
    }
    f32x4 acc[2][2][4][2];
#pragma unroll
    for (int a = 0; a < 2; ++a)
#pragma unroll
        for (int b = 0; b < 2; ++b)
#pragma unroll
            for (int m = 0; m < 4; ++m)
#pragma unroll
                for (int n = 0; n < 2; ++n) acc[a][b][m][n] = (f32x4){0.f, 0.f, 0.f, 0.f};
    i32x4 At[4][2], B0[2][2], B1[2][2];
    unsigned vc[2][2];
    FG_AOFF(vc, cur, tab0);
    const char* const gA = J.A;
    const char* cB = cur.bBase;
    const unsigned bh2 = J.bhalf2;
    FG_STAGE_B(FG_SB(0, 0), cB); FG_STAGE_A(FG_SA(0, 0), gA, vc[0]); FG_STAGE_B(FG_SB(0, 1), cB + bh2); FG_STAGE_A(FG_SA(0, 1), gA, vc[1]);
    if (wr == 1) FG_BAR;
    FG_WAIT_V(4); FG_BAR;
    FG_STAGE_B(FG_SB(1, 0), cB + kstepB); FG_STAGE_A(FG_SA(1, 0), gA + 128, vc[0]); FG_STAGE_B(FG_SB(1, 1), cB + kstepB + bh2);
    FG_WAIT_V(6); FG_BAR;
    for (;;) {
        const bool has_next = J.next(ui + 1, nxt);
        if (!has_next) nxt = cur;
        if (Job::GATHER && has_next && wid == 0)
            __builtin_amdgcn_global_load_lds((const unsigned*)(J.list + nxt.arow0 + lane * 4), (LAS unsigned*)(lds + TAB_OFF + ((ui + 1) & 1) * 1024), 16, 0, 0);
        const char* nB = nxt.bBase;
        for (int t = 0; t < nt; t += 2) {
            const bool last = (t == nt - 2);
            const char* a1 = gA + (size_t)(t + 1) * 128;
            const char* a2 = last ? gA : gA + (size_t)(t + 2) * 128; const char* b2 = last ? nB : cB + (size_t)(t + 2) * kstepB;
            const char* a3 = a2 + 128; const char* b3 = b2 + kstepB;
            FG_LDB(B0, 0, 0); FG_SCHED; FG_LDA(At, 0, 0); FG_STAGE_A(FG_SA(1, 1), a1, vc[1]);
            if (last && has_next) { LAS const int* tabn = (LAS const int*)(lds + TAB_OFF + ((ui + 1) & 1) * 1024); FG_AOFF(vc, nxt, tabn); }
            FG_WAIT_L(8); FG_BAR; FG_WAIT_L(0); FG_SCHED; FG_MMA(0, 0, At, B0); FG_BAR; FG_SCHED;
            FG_LDB(B1, 0, 1); FG_STAGE_B(FG_SB(0, 0), b2);
            FG_BAR; FG_WAIT_L(0); FG_SCHED; FG_MMA(0, 1, At, B1); FG_BAR;
            FG_LDA(At, 0, 1); FG_STAGE_A(FG_SA(0, 0), a2, vc[0]);
            FG_BAR; FG_WAIT_L(0); FG_MMA(1, 0, At, B0); FG_BAR; FG_SCHED;
            FG_STAGE_B(FG_SB(0, 1), b2 + bh2);
            FG_WAIT_V(6); FG_BAR; FG_MMA(1, 1, At, B1); FG_BAR;
            FG_LDB(B0, 1, 0); FG_SCHED; FG_LDA(At, 1, 0); FG_STAGE_A(FG_SA(0, 1), a2, vc[1]);
            FG_WAIT_L(8); FG_BAR; FG_WAIT_L(0); FG_SCHED; FG_MMA(0, 0, At, B0); FG_BAR; FG_SCHED;
            FG_LDB(B1, 1, 1); FG_STAGE_B(FG_SB(1, 0), b3);
            FG_BAR; FG_WAIT_L(0); FG_SCHED; FG_MMA(0, 1, At, B1); FG_BAR;
            FG_LDA(At, 1, 1); FG_STAGE_A(FG_SA(1, 0), a3, vc[0]);
            FG_BAR; FG_WAIT_L(0); FG_MMA(1, 0, At, B0); FG_BAR; FG_SCHED;
            FG_STAGE_B(FG_SB(1, 1), b3 + bh2);
            FG_WAIT_V(6); FG_BAR; FG_MMA(1, 1, At, B1); FG_BAR;
        }
        J.epi(acc, cur, wr, wc, fr, fq);
        if (!has_next) break;
#pragma unroll
        for (int a = 0; a < 2; ++a)
#pragma unroll
            for (int b = 0; b < 2; ++b)
#pragma unroll
                for (int m = 0; m < 4; ++m)
#pragma unroll
                    for (int n = 0; n < 2; ++n) acc[a][b][m][n] = (f32x4){0.f, 0.f, 0.f, 0.f};
        cur = nxt; cB = nB; ++ui;
    }
    FG_WAIT_V(0);
    if (wr == 0) FG_BAR;
    FG_BAR;
}
}

#define FG_FOR_ROWS for (int ai = 0; ai < 2; ++ai) _Pragma("unroll") for (int m = 0; m < 4; ++m)
struct JobInProj {
    static constexpr bool GATHER = false;
    const char* A; unsigned lda2, ldb2, bhalf2; int K; const int* list;
    const char* B; bf16_t* out; fg::StaticOrder S;
    __device__ __forceinline__ bool next(int i, fg::Unit& u) const { int pm, pn; if (!S.next(i, pm, pn)) return false;
        u.bBase = B + (size_t)pn * 512; u.arow0 = pm * 256; u.nvalid = 256; u.e = 0; u.orow0 = pm * 256; u.ocol0 = pn * 256; u.acol2 = 0; return true; }
    __device__ __forceinline__ void epi(const f32x4 (&acc)[2][2][4][2], const fg::Unit& u, int wr, int wc, int fr, int fq) const {
#pragma unroll
        FG_FOR_ROWS { bf16_t* rowp = out + (size_t)(u.orow0 + ai * 128 + wr * 64 + m * 16 + fr) * kNPROJ + u.ocol0 + wc * 32 + fq * 4;
#pragma unroll
            for (int bj = 0; bj < 2; ++bj)
#pragma unroll
                for (int n = 0; n < 2; ++n) { const f32x4 v = acc[ai][bj][m][n]; u32x2 w; w.x = pk_bf16(v[0], v[1]); w.y = pk_bf16(v[2], v[3]); *(u32x2*)(rowp + bj * 128 + n * 16) = w; } }
    }
};
struct JobPoolFold {
    static constexpr bool GATHER = false;
    const char* A; unsigned lda2, ldb2, bhalf2; int K; const int* list;
    const char* B; bf16_t* wo; int G, c;
    __device__ __forceinline__ bool next(int i, fg::Unit& u) const { const int L = i * G + c; if (L >= 32) return false; const int g = L >> 3, pn = L & 7;
        u.bBase = B + (size_t)g * kPG * kD * 2 + (size_t)pn * 512; u.arow0 = 0; u.nvalid = 256; u.e = g; u.orow0 = kSB + g * kPG; u.ocol0 = pn * 256; u.acol2 = g * kPG * kPG * 2; return true; }
    __device__ __forceinline__ void epi(const f32x4 (&acc)[2][2][4][2], const fg::Unit& u, int wr, int wc, int fr, int fq) const {
#pragma unroll
        FG_FOR_ROWS { bf16_t* rowp = wo + (size_t)(u.orow0 + ai * 128 + wr * 64 + m * 16 + fr) * kD + u.ocol0 + wc * 32 + fq * 4;
#pragma unroll
            for (int bj = 0; bj < 2; ++bj)
#pragma unroll
                for (int n = 0; n < 2; ++n) { const f32x4 v = acc[ai][bj][m][n]; u32x2 w; w.x = pk_bf16(v[0], v[1]); w.y = pk_bf16(v[2], v[3]); *(u32x2*)(rowp + bj * 128 + n * 16) = w; } }
    }
};
struct JobOutProj {
    static constexpr bool GATHER = false;
    const char* A; unsigned lda2, ldb2, bhalf2; int K; const int* list;
    const char* B; const float* x; const float* mod; float* x1; fg::StaticOrder S;
    __device__ __forceinline__ bool next(int i, fg::Unit& u) const { int pm, pn; if (!S.next(i, pm, pn)) return false;
        u.bBase = B + (size_t)pn * 512; u.arow0 = pm * 256; u.nvalid = 256; u.e = 0; u.orow0 = pm * 256; u.ocol0 = pn * 256; u.acol2 = 0; return true; }
    __device__ __forceinline__ void epi(const f32x4 (&acc)[2][2][4][2], const fg::Unit& u, int wr, int wc, int fr, int fq) const {
        const int b = u.orow0 / kS; f32x4 gt[2][2];
#pragma unroll
        for (int bj = 0; bj < 2; ++bj)
#pragma unroll
            for (int n = 0; n < 2; ++n) gt[bj][n] = *(const f32x4*)(mod + b * 6 * kD + 2 * kD + u.ocol0 + bj * 128 + wc * 32 + n * 16 + fq * 4);
#pragma unroll
        FG_FOR_ROWS { const size_t ro = (size_t)(u.orow0 + ai * 128 + wr * 64 + m * 16 + fr) * kD + u.ocol0 + wc * 32 + fq * 4;
#pragma unroll
            for (int bj = 0; bj < 2; ++bj)
#pragma unroll
                for (int n = 0; n < 2; ++n) { const f32x4 xv = *(const f32x4*)(x + ro + bj * 128 + n * 16); *(f32x4*)(x1 + ro + bj * 128 + n * 16) = xv + gt[bj][n] * acc[ai][bj][m][n]; } }
    }
};
struct MoeTab { LAS const int* t; int total;
    __device__ __forceinline__ bool decode(int i, int G, int c, int& e, int& jcol, int& rb, int& cnt, int& rowbase) const {
        const int L = (G % 8 == 0) ? i * G + (c % 8) * (G / 8) + c / 8 : i * G + c; if (L >= total) return false;
        int ee = 0; while (ee < kE - 1 && t[64 + ee + 1] <= L) ++ee;
        const int local = L - t[64 + ee], nrb = t[100 + ee]; jcol = local / nrb; rb = local - jcol * nrb; e = ee; cnt = t[ee]; rowbase = t[32 + ee]; return true; }
};
__device__ __forceinline__ MoeTab moe_tables(LAS unsigned char* lds, const unsigned* ctrl, int ncol) {
    LAS int* t = (LAS int*)(lds + fg::MISC_OFF + 64);
    __syncthreads();
    if (threadIdx.x == 0) { int base = 0, us = 0; for (int e = 0; e < kE; ++e) { const int cn = (int)ctrl[CT_CNT + 64 * e], nrb = (cn + 255) >> 8; t[e] = cn; t[32 + e] = base; t[64 + e] = us; t[100 + e] = nrb; base += nrb * 256; us += nrb * ncol; } t[64 + kE] = us; }
    __syncthreads();
    MoeTab M; M.t = t; M.total = t[64 + kE]; return M;
}
struct JobMoe1 {
    static constexpr bool GATHER = true;
    const char* A; unsigned lda2, ldb2, bhalf2; int K; const int* list;
    const char* B; const float* b_in; bf16_t* act; MoeTab M; int G, c;
    __device__ __forceinline__ bool next(int i, fg::Unit& u) const { int e, j, rb, cnt, rowbase; if (!M.decode(i, G, c, e, j, rb, cnt, rowbase)) return false;
        e = __builtin_amdgcn_readfirstlane(e); j = __builtin_amdgcn_readfirstlane(j); rb = __builtin_amdgcn_readfirstlane(rb); cnt = __builtin_amdgcn_readfirstlane(cnt); rowbase = __builtin_amdgcn_readfirstlane(rowbase);
        u.bBase = B + (size_t)e * ((size_t)kD * 2 * kDFF * 2) + (size_t)j * 256; u.arow0 = e * kT + rb * 256; u.nvalid = min(256, cnt - rb * 256); u.e = e; u.orow0 = rowbase + rb * 256; u.ocol0 = j * 128; u.acol2 = 0; return true; }
    __device__ __forceinline__ void epi(const f32x4 (&acc)[2][2][4][2], const fg::Unit& u, int wr, int wc, int fr, int fq) const {
        f32x4 bg[2], bl[2];
#pragma unroll
        for (int n = 0; n < 2; ++n) { const float* bp = b_in + (size_t)u.e * 2 * kDFF + u.ocol0 + wc * 32 + n * 16 + fq * 4; bg[n] = *(const f32x4*)bp; bl[n] = *(const f32x4*)(bp + kDFF); }
#pragma unroll
        FG_FOR_ROWS { bf16_t* rowp = act + (size_t)(u.orow0 + ai * 128 + wr * 64 + m * 16 + fr) * kDFF + u.ocol0 + wc * 32 + fq * 4;
#pragma unroll
            for (int n = 0; n < 2; ++n) { const f32x4 gv = acc[ai][0][m][n] + bg[n], lv = acc[ai][1][m][n] + bl[n]; float o[4];
#pragma unroll
                for (int j = 0; j < 4; ++j) { const float g = fminf(gv[j], 7.f), l = fminf(fmaxf(lv[j], -7.f), 7.f); o[j] = g * __builtin_amdgcn_rcpf(1.f + __expf(-1.702f * g)) * (l + 1.f); }
                u32x2 w; w.x = pk_bf16(o[0], o[1]); w.y = pk_bf16(o[2], o[3]); *(u32x2*)(rowp + n * 16) = w; } }
    }
};
struct JobMoe2 {
    static constexpr bool GATHER = false;
    const char* A; unsigned lda2, ldb2, bhalf2; int K; const int* list;
    const char* B; const float* b_out; bf16_t* yp; MoeTab M; int G, c;
    __device__ __forceinline__ bool next(int i, fg::Unit& u) const { int e, j, rb, cnt, rowbase; if (!M.decode(i, G, c, e, j, rb, cnt, rowbase)) return false;
        e = __builtin_amdgcn_readfirstlane(e); j = __builtin_amdgcn_readfirstlane(j); rb = __builtin_amdgcn_readfirstlane(rb); rowbase = __builtin_amdgcn_readfirstlane(rowbase);
        u.bBase = B + (size_t)e * ((size_t)kDFF * kD * 2) + (size_t)j * 512; u.arow0 = rowbase + rb * 256; u.nvalid = 256; u.e = e; u.orow0 = rowbase + rb * 256; u.ocol0 = j * 256; u.acol2 = 0; return true; }
    __device__ __forceinline__ void epi(const f32x4 (&acc)[2][2][4][2], const fg::Unit& u, int wr, int wc, int fr, int fq) const {
        f32x4 bo[2][2];
#pragma unroll
        for (int bj = 0; bj < 2; ++bj)
#pragma unroll
            for (int n = 0; n < 2; ++n) bo[bj][n] = *(const f32x4*)(b_out + (size_t)u.e * kD + u.ocol0 + bj * 128 + wc * 32 + n * 16 + fq * 4);
#pragma unroll
        FG_FOR_ROWS { bf16_t* rowp = yp + (size_t)(u.orow0 + ai * 128 + wr * 64 + m * 16 + fr) * kD + u.ocol0 + wc * 32 + fq * 4;
#pragma unroll
            for (int bj = 0; bj < 2; ++bj)
#pragma unroll
                for (int n = 0; n < 2; ++n) { const f32x4 v = acc[ai][bj][m][n] + bo[bj][n]; u32x2 w; w.x = pk_bf16(v[0], v[1]); w.y = pk_bf16(v[2], v[3]); *(u32x2*)(rowp + bj * 128 + n * 16) = w; } }
    }
};


__device__ __forceinline__ float wave_sum(float v) {
#pragma unroll
    for (int o = 32; o > 0; o >>= 1) v += __shfl_xor(v, o);
    return v; }
__device__ __forceinline__ float bflo(unsigned u) { return __uint_as_float(u << 16); }
__device__ __forceinline__ float bfhi(unsigned u) { return __uint_as_float(u & 0xFFFF0000u); }

namespace at {
typedef float f32x16 __attribute__((ext_vector_type(16)));
__device__ __forceinline__ unsigned off_b(unsigned row, unsigned ch) { return 256u * row + 16u * (ch ^ (((row & 3) << 2) | ((row >> 2) & 3))); }
constexpr float kC2 = 0.08838834764831845f * 1.4426950408889634f;
constexpr float kDoneThresh = 140.f;

__device__ __forceinline__ void attn_phase(LAS unsigned char* lds, const bf16_t* __restrict__ proj, const float* __restrict__ qw, const float* __restrict__ kw,
                                           bf16_t* __restrict__ cat, int G, int c) {
    const int tid = threadIdx.x, wid = __builtin_amdgcn_readfirstlane(tid >> 6), lane = tid & 63, ql = lane & 31, hf = lane >> 5;
    const unsigned ldsb = (unsigned)(uintptr_t)lds;
    const int skey = tid >> 4, sch = tid & 15;
    const unsigned X = ((ql & 3) << 2) | ((ql >> 2) & 3);
    const unsigned krow = 256u * ql, kY = 16u * (X ^ (unsigned)hf);
    const int tq = (lane & 15) >> 2, tp = lane & 3, blk = (lane >> 4) & 1;
    unsigned va[4][2];
#pragma unroll
    for (int cc = 0; cc < 4; ++cc)
#pragma unroll
        for (int t = 0; t < 2; ++t) va[cc][t] = 256u * (8 * t + 4 * hf + tq) + 16u * ((4 * cc + 2 * blk + (tp >> 1)) ^ ((tq << 2) | ((2 * t + hf) & 3))) + 8u * (tp & 1);
    for (int unit = c; unit < kB * kNH * 8; unit += G) {
        const int qb = unit & 7, bh = unit >> 3, h = bh & 7, b = bh >> 3;
        const int q0 = qb * 256, r0 = q0 + wid * 32;
        const bf16_t* base = proj + (size_t)(b * kS) * kNPROJ + h * kHD;
        LAS unsigned char* qlds = lds + 65536 + wid * 8192 + lane * 16;
        { u32x4 qr[8]; float ss = 0.f;
#pragma unroll
          for (int s = 0; s < 8; ++s) { qr[s] = *(const u32x4*)(base + (size_t)(r0 + ql) * kNPROJ + 16 * s + 8 * hf);
              const unsigned u[4] = {qr[s].x, qr[s].y, qr[s].z, qr[s].w};
#pragma unroll
              for (int e = 0; e < 4; ++e) { const float a = bflo(u[e]), bb = bfhi(u[e]); ss += a * a + bb * bb; } }
          ss += __shfl_xor(ss, 32);
          const float rq = rsqrtf(ss * (1.f / kHD) + kEPS) * kC2;
#pragma unroll
          for (int s = 0; s < 8; ++s) { const int d0 = 16 * s + 8 * hf;
              const f32x4 w0 = *(const f32x4*)(qw + d0) * *(const f32x4*)(kw + d0), w1 = *(const f32x4*)(qw + d0 + 4) * *(const f32x4*)(kw + d0 + 4);
              const unsigned u[4] = {qr[s].x, qr[s].y, qr[s].z, qr[s].w};
              u32x4 pk; pk.x = pk_bf16(bflo(u[0]) * rq * w0[0], bfhi(u[0]) * rq * w0[1]); pk.y = pk_bf16(bflo(u[1]) * rq * w0[2], bfhi(u[1]) * rq * w0[3]);
              pk.z = pk_bf16(bflo(u[2]) * rq * w1[0], bfhi(u[2]) * rq * w1[1]); pk.w = pk_bf16(bflo(u[3]) * rq * w1[2], bfhi(u[3]) * rq * w1[3]);
              *(LAS u32x4*)(qlds + 1024 * s) = pk; } }
        f32x16 o[4];
#pragma unroll
        for (int cc = 0; cc < 4; ++cc)
#pragma unroll
            for (int r = 0; r < 16; ++r) o[cc][r] = 0.f;
        float carry = 0.f; bool wactive = true;
        int jt = (q0 + 255) >> 6, cur = 0;
        u32x4 kr[2], vr[2];
#define AT_LOAD(jt_) do { _Pragma("unroll") for (int i = 0; i < 2; ++i) { const bf16_t* rp = base + (size_t)(64 * (jt_) + skey + 32 * i) * kNPROJ + sch * 8; \
            kr[i] = *(const u32x4*)(rp + kSB); vr[i] = *(const u32x4*)(rp + 2 * kSB); } } while (0)
        AT_LOAD(jt);
        for (;;) {
            LAS unsigned char* kbuf = lds + cur * 32768; LAS unsigned char* vbuf = kbuf + 16384;
#pragma unroll
            for (int i = 0; i < 2; ++i) { const unsigned u[4] = {kr[i].x, kr[i].y, kr[i].z, kr[i].w}; float f[8]; float ss = 0.f;
#pragma unroll
                for (int e = 0; e < 4; ++e) { f[2 * e] = bflo(u[e]); f[2 * e + 1] = bfhi(u[e]); ss += f[2 * e] * f[2 * e] + f[2 * e + 1] * f[2 * e + 1]; }
                ss += __shfl_xor(ss, 1); ss += __shfl_xor(ss, 2); ss += __shfl_xor(ss, 4); ss += __shfl_xor(ss, 8);
                const float rk = rsqrtf(ss * (1.f / kHD) + kEPS);
                u32x4 pk; pk.x = pk_bf16(f[0] * rk, f[1] * rk); pk.y = pk_bf16(f[2] * rk, f[3] * rk); pk.z = pk_bf16(f[4] * rk, f[5] * rk); pk.w = pk_bf16(f[6] * rk, f[7] * rk);
                const unsigned a = off_b(skey + 32 * i, sch);
                *(LAS u32x4*)(kbuf + a) = pk; *(LAS u32x4*)(vbuf + a) = vr[i]; }
            const int any = __syncthreads_or(wactive ? 1 : 0);
            if (!any) break;
            const int jtc = jt;
            if (jt > 0) AT_LOAD(jt - 1);
            if (wactive && 64 * jtc < r0 + 31) {
                f32x16 s0, s1;
#pragma unroll
                for (int r = 0; r < 16; ++r) { s0[r] = 0.f; s1[r] = 0.f; }
#pragma unroll
                for (int s = 0; s < 8; ++s) { const unsigned a = krow + ((32u * s) ^ kY);
                    const bf16x8 k0 = *(const LAS bf16x8*)(kbuf + a), k1 = *(const LAS bf16x8*)(kbuf + 8192 + a), qv = *(const LAS bf16x8*)(qlds + 1024 * s);
                    s0 = __builtin_amdgcn_mfma_f32_32x32x16_bf16(k0, qv, s0, 0, 0, 0); s1 = __builtin_amdgcn_mfma_f32_32x32x16_bf16(k1, qv, s1, 0, 0, 0); }
                const int tabs = r0 + ql, kbase0 = 64 * jtc + 4 * hf;
                float run = carry; u32x4 pfr[2][2];
#pragma unroll
                for (int kb = 1; kb >= 0; --kb) {
                    float sp[16], gp[4], T[4];
#pragma unroll
                    for (int r = 0; r < 16; ++r) { const float z = kb ? s1[r] : s0[r]; const int key = kbase0 + 32 * kb + 8 * (r >> 2) + (r & 3);
                        const float v = __builtin_amdgcn_logf(1.f + __builtin_amdgcn_exp2f(z)); sp[r] = key < tabs ? v : 0.f; }
#pragma unroll
                    for (int g = 0; g < 4; ++g) { const float gsum = (sp[4 * g] + sp[4 * g + 1]) + (sp[4 * g + 2] + sp[4 * g + 3]);
                        const auto sw = __builtin_amdgcn_permlane32_swap(__float_as_uint(gsum), __float_as_uint(gsum), false, false);
                        const float lo = __uint_as_float(sw[0]), hi = __uint_as_float(sw[1]);
                        T[g] = lo + hi; gp[g] = hf ? 0.f : hi; }
#pragma unroll
                    for (int g = 3; g >= 0; --g) { const float offs = run + gp[g];
                        const float c3 = offs + sp[4 * g + 3], c2 = c3 + sp[4 * g + 2], c1 = c2 + sp[4 * g + 1], c0 = c1 + sp[4 * g];
                        const float cs[4] = {c0, c1, c2, c3};
#pragma unroll
                        for (int i = 0; i < 4; ++i) { const int r = 4 * g + i; const float z = kb ? s1[r] : s0[r]; const int key = kbase0 + 32 * kb + 8 * g + i;
                            const float e = __builtin_amdgcn_exp2f(z - cs[i]); sp[r] = key < tabs ? e : 0.f; }
                        run += T[g]; }
#pragma unroll
                    for (int s2 = 0; s2 < 2; ++s2) { u32x4 pk; pk.x = pk_bf16(sp[8 * s2], sp[8 * s2 + 1]); pk.y = pk_bf16(sp[8 * s2 + 2], sp[8 * s2 + 3]);
                        pk.z = pk_bf16(sp[8 * s2 + 4], sp[8 * s2 + 5]); pk.w = pk_bf16(sp[8 * s2 + 6], sp[8 * s2 + 7]); pfr[kb][s2] = pk; }
                }
                carry = run;
                const unsigned vb0 = ldsb + (unsigned)cur * 32768u + 16384u;
#define AT_PV(cc) do { const unsigned a0 = vb0 + va[cc][0], a1 = vb0 + va[cc][1]; \
                    const s16x4 l00 = fg::tr_read<0>(a0), h00 = fg::tr_read<0>(a1), l01 = fg::tr_read<4096>(a0), h01 = fg::tr_read<4096>(a1); \
                    const s16x4 l10 = fg::tr_read<8192>(a0), h10 = fg::tr_read<8192>(a1), l11 = fg::tr_read<12288>(a0), h11 = fg::tr_read<12288>(a1); \
                    asm volatile("s_waitcnt lgkmcnt(0)" ::: "memory"); __builtin_amdgcn_sched_barrier(0); \
                    o[cc] = __builtin_amdgcn_mfma_f32_32x32x16_bf16(FG_PK(l00, h00), __builtin_bit_cast(bf16x8, pfr[0][0]), o[cc], 0, 0, 0); \
                    o[cc] = __builtin_amdgcn_mfma_f32_32x32x16_bf16(FG_PK(l01, h01), __builtin_bit_cast(bf16x8, pfr[0][1]), o[cc], 0, 0, 0); \
                    o[cc] = __builtin_amdgcn_mfma_f32_32x32x16_bf16(FG_PK(l10, h10), __builtin_bit_cast(bf16x8, pfr[1][0]), o[cc], 0, 0, 0); \
                    o[cc] = __builtin_amdgcn_mfma_f32_32x32x16_bf16(FG_PK(l11, h11), __builtin_bit_cast(bf16x8, pfr[1][1]), o[cc], 0, 0, 0); } while (0)
                AT_PV(0); AT_PV(1); AT_PV(2); AT_PV(3);
#undef AT_PV
                wactive = __any(carry <= kDoneThresh);
            }
            if (jt == 0) break;
            --jt; cur ^= 1;
        }
#undef AT_LOAD
        bf16_t* orow = cat + (size_t)(b * kS + r0 + ql) * kD + h * kHD + 4 * hf;
#pragma unroll
        for (int cc = 0; cc < 4; ++cc)
#pragma unroll
            for (int g = 0; g < 4; ++g) { u32x2 w; w.x = pk_bf16(o[cc][4 * g], o[cc][4 * g + 1]); w.y = pk_bf16(o[cc][4 * g + 2], o[cc][4 * g + 3]); *(u32x2*)(orow + 32 * cc + 8 * g) = w; }
        __syncthreads();
    }
}
}

__device__ __forceinline__ void pool_p_phase(const bf16_t* __restrict__ proj, bf16_t* __restrict__ p, int G, int c) {
    for (int idx = c * 512 + threadIdx.x; idx < kT * (kPW / 8); idx += G * 512) {
        const int c8 = idx & 127, t = idx >> 7, s = t & (kS - 1), g = c8 >> 5, w = 2 << g, cnt = min(s + 1, w);
        const bf16_t* up = proj + (size_t)t * kNPROJ + 3 * kSB + c8 * 8;
        u32x4 v[16];
#pragma unroll
        for (int i = 0; i < 16; ++i) v[i] = (i < cnt) ? *(const u32x4*)(up - (size_t)i * kNPROJ) : (u32x4){0u, 0u, 0u, 0u};
        float acc[8];
#pragma unroll
        for (int e = 0; e < 8; ++e) acc[e] = 0.f;
#pragma unroll
        for (int i = 0; i < 16; ++i) { acc[0] += bflo(v[i].x); acc[1] += bfhi(v[i].x); acc[2] += bflo(v[i].y); acc[3] += bfhi(v[i].y); acc[4] += bflo(v[i].z); acc[5] += bfhi(v[i].z); acc[6] += bflo(v[i].w); acc[7] += bfhi(v[i].w); }
        const float inv = 1.f / (float)cnt;
        const float u0[8] = {bflo(v[0].x), bfhi(v[0].x), bflo(v[0].y), bfhi(v[0].y), bflo(v[0].z), bfhi(v[0].z), bflo(v[0].w), bfhi(v[0].w)};
        u32x4 pk; pk.x = pk_bf16(acc[0] * inv - u0[0], acc[1] * inv - u0[1]); pk.y = pk_bf16(acc[2] * inv - u0[2], acc[3] * inv - u0[3]);
        pk.z = pk_bf16(acc[4] * inv - u0[4], acc[5] * inv - u0[5]); pk.w = pk_bf16(acc[6] * inv - u0[6], acc[7] * inv - u0[7]);
        *(u32x4*)(p + (size_t)t * kD + kSB + c8 * 8) = pk;
    }
}

__device__ __forceinline__ unsigned pk4_fp8(float a, float b, float c, float d) { int p = __builtin_amdgcn_cvt_pk_fp8_f32(a, b, 0, false); p = __builtin_amdgcn_cvt_pk_fp8_f32(c, d, p, true); return (unsigned)p; }
__device__ __forceinline__ float clamp448(float v) { return __builtin_amdgcn_fmed3f(v, -448.f, 448.f); }
constexpr float kWScale = 64.f;

struct JobMoe1F8 {
    static constexpr bool GATHER = true;
    const char* A; unsigned lda2, ldb2, bhalf2; int K; const int* list;
    const char* B; const float* b_in; unsigned char* act; MoeTab M; int G, c;
    __device__ __forceinline__ bool next(int i, fg::Unit& u) const { int e, j, rb, cnt, rowbase; if (!M.decode(i, G, c, e, j, rb, cnt, rowbase)) return false;
        e = __builtin_amdgcn_readfirstlane(e); j = __builtin_amdgcn_readfirstlane(j); rb = __builtin_amdgcn_readfirstlane(rb); cnt = __builtin_amdgcn_readfirstlane(cnt); rowbase = __builtin_amdgcn_readfirstlane(rowbase);
        u.bBase = B + (size_t)e * ((size_t)2 * kDFF * kD) + (size_t)j * 128 * kD; u.arow0 = e * kT + rb * 256; u.nvalid = min(256, cnt - rb * 256); u.e = e; u.orow0 = rowbase + rb * 256; u.ocol0 = j * 128; u.acol2 = 0; return true; }
    __device__ __forceinline__ void epi(const f32x4 (&acc)[2][2][4][2], const fg::Unit& u, int wr, int wc, int fr, int fq) const {
        f32x4 bg[2], bl[2];
#pragma unroll
        for (int n = 0; n < 2; ++n) { const float* bp = b_in + (size_t)u.e * 2 * kDFF + u.ocol0 + wc * 32 + n * 16 + fq * 4; bg[n] = *(const f32x4*)bp; bl[n] = *(const f32x4*)(bp + kDFF); }
#pragma unroll
        FG_FOR_ROWS { unsigned char* rowp = act + (size_t)(u.orow0 + ai * 128 + wr * 64 + m * 16 + fr) * kDFF + u.ocol0 + wc * 32 + fq * 4;
#pragma unroll
            for (int n = 0; n < 2; ++n) { const f32x4 gv = acc[ai][0][m][n] + bg[n], lv = acc[ai][1][m][n] + bl[n]; float o[4];
#pragma unroll
                for (int j = 0; j < 4; ++j) { const float g = fminf(gv[j], 7.f), l = fminf(fmaxf(lv[j], -7.f), 7.f); o[j] = clamp448(g * __builtin_amdgcn_rcpf(1.f + __expf(-1.702f * g)) * (l + 1.f)); }
                *(unsigned*)(rowp + n * 16) = pk4_fp8(o[0], o[1], o[2], o[3]); } }
    }
};
struct JobMoe2F8 {
    static constexpr bool GATHER = false;
    const char* A; unsigned lda2, ldb2, bhalf2; int K; const int* list;
    const char* B; const float* b_out; unsigned char* yp; MoeTab M; int G, c;
    __device__ __forceinline__ bool next(int i, fg::Unit& u) const { int e, j, rb, cnt, rowbase; if (!M.decode(i, G, c, e, j, rb, cnt, rowbase)) return false;
        e = __builtin_amdgcn_readfirstlane(e); j = __builtin_amdgcn_readfirstlane(j); rb = __builtin_amdgcn_readfirstlane(rb); rowbase = __builtin_amdgcn_readfirstlane(rowbase);
        u.bBase = B + (size_t)e * ((size_t)kDFF * kD) + (size_t)j * 256 * kDFF; u.arow0 = rowbase + rb * 256; u.nvalid = 256; u.e = e; u.orow0 = rowbase + rb * 256; u.ocol0 = j * 256; u.acol2 = 0; return true; }
    __device__ __forceinline__ void epi(const f32x4 (&acc)[2][2][4][2], const fg::Unit& u, int wr, int wc, int fr, int fq) const {
        f32x4 bo[2][2];
#pragma unroll
        for (int bj = 0; bj < 2; ++bj)
#pragma unroll
            for (int n = 0; n < 2; ++n) bo[bj][n] = *(const f32x4*)(b_out + (size_t)u.e * kD + u.ocol0 + bj * 128 + wc * 32 + n * 16 + fq * 4);
#pragma unroll
        FG_FOR_ROWS { unsigned char* rowp = yp + (size_t)(u.orow0 + ai * 128 + wr * 64 + m * 16 + fr) * kD + u.ocol0 + wc * 32 + fq * 4;
#pragma unroll
            for (int bj = 0; bj < 2; ++bj)
#pragma unroll
                for (int n = 0; n < 2; ++n) { const f32x4 v = acc[ai][bj][m][n] + bo[bj][n]; *(unsigned*)(rowp + bj * 128 + n * 16) = pk4_fp8(clamp448(v[0]), clamp448(v[1]), clamp448(v[2]), clamp448(v[3])); } }
    }
};

struct CvtT { const float* src; unsigned char* dst; int K, N, tn, per; };
__device__ __forceinline__ CvtT cvt_make(const float* src, unsigned char* dst, int K, int N) { CvtT c; c.src = src; c.dst = dst; c.K = K; c.N = N; c.tn = N / 64; c.per = (K / 128) * (N / 64); return c; }
__device__ __forceinline__ void cvt_load(const CvtT& C, int t, int kq, int nc, f32x4 (&v)[4]) {
    const int mat = t / C.per, r = t - mat * C.per, kt = r / C.tn, nt_ = r - kt * C.tn;
    const float* sp = C.src + (size_t)mat * C.K * C.N + (size_t)(kt * 128 + 4 * kq) * C.N + nt_ * 64 + 4 * nc;
#pragma unroll
    for (int i = 0; i < 4; ++i) v[i] = __builtin_nontemporal_load((const f32x4*)(sp + (size_t)i * C.N));
}
__device__ __forceinline__ void cvt_emit(const CvtT& C, int t, LAS unsigned* L, const f32x4 (&v)[4], int kq, int nc, int rn, int rc) {
#pragma unroll
    for (int j = 0; j < 4; ++j) L[(4 * nc + j) * 33 + kq] = pk4_fp8(v[0][j] * kWScale, v[1][j] * kWScale, v[2][j] * kWScale, v[3][j] * kWScale);
    __syncthreads();
    const int mat = t / C.per, r = t - mat * C.per, kt = r / C.tn, nt_ = r - kt * C.tn;
    u32x4 o; o.x = L[rn * 33 + 4 * rc]; o.y = L[rn * 33 + 4 * rc + 1]; o.z = L[rn * 33 + 4 * rc + 2]; o.w = L[rn * 33 + 4 * rc + 3];
    __builtin_nontemporal_store(o, (u32x4*)(C.dst + (size_t)mat * C.K * C.N + (size_t)(nt_ * 64 + rn) * C.K + kt * 128 + rc * 16));
}
__device__ __forceinline__ void convert_t_f8(LAS unsigned char* lds, const CvtT C, int t0, int t1, int stride) {
    const int tid = threadIdx.x, kq = tid >> 4, nc = tid & 15, rn = tid >> 3, rc = tid & 7;
    f32x4 v0[4], v1[4], vn[4];
    __syncthreads();
    if (t0 < t1) cvt_load(C, t0, kq, nc, v0);
    if (t0 + stride < t1) cvt_load(C, t0 + stride, kq, nc, v1);
    int i = 0;
#pragma unroll 1
    for (int t = t0; t < t1; t += stride, ++i) {
        if (t + 2 * stride < t1) cvt_load(C, t + 2 * stride, kq, nc, vn);
        cvt_emit(C, t, (LAS unsigned*)(lds + (i & 1) * 8704), v0, kq, nc, rn, rc);
#pragma unroll
        for (int j = 0; j < 4; ++j) { v0[j] = v1[j]; v1[j] = vn[j]; }
    }
    __syncthreads();
}
__device__ __forceinline__ void convert_dyn(LAS unsigned char* lds, const CvtT C, unsigned* qctr, int dbase, int dend) {
    LAS int* bx = (LAS int*)(lds + 2 * 8704);
#pragma unroll 1
    for (;;) {
        __syncthreads();
        if (threadIdx.x == 0) bx[0] = dbase + (int)atomicAdd(qctr, 8u);
        __syncthreads();
        const int t0 = bx[0];
        if (t0 >= dend) break;
        convert_t_f8(lds, C, t0, min(t0 + 8, dend), 1);
    }
}

__device__ __forceinline__ void convert_seg(const float* __restrict__ src, bf16_t* __restrict__ dst, size_t n8, size_t gtid, size_t gstride) {
    const f32x4* s4 = (const f32x4*)src; u32x4* d4 = (u32x4*)dst;
#pragma unroll 4
    for (size_t i = gtid; i < n8; i += gstride) { const f32x4 a = __builtin_nontemporal_load(s4 + 2 * i), b = __builtin_nontemporal_load(s4 + 2 * i + 1);
        u32x4 w; w.x = pk_bf16(a[0], a[1]); w.y = pk_bf16(a[2], a[3]); w.z = pk_bf16(b[0], b[1]); w.w = pk_bf16(b[2], b[3]); d4[i] = w; }
}


#define XB_TMO      128
#define XB_XCNT(j)  (256  + 64 * (j))
#define XB_XSUB(j)  (1280 + 64 * (j))
#define XB_XGEN(j)  (2304 + 64 * (j))
#define XB_TOP      3328
#define XB_TOPGEN   3392
#define XCD_BAR_WORDS 3456
#define XB_SPIN_CAP (1u << 18)
__device__ __forceinline__ unsigned xb_ld(unsigned* p)              { return __hip_atomic_load(p, __ATOMIC_RELAXED, __HIP_MEMORY_SCOPE_AGENT); }
__device__ __forceinline__ unsigned xb_add(unsigned* p, unsigned v) { return __hip_atomic_fetch_add(p, v, __ATOMIC_RELAXED, __HIP_MEMORY_SCOPE_AGENT); }
__device__ __forceinline__ unsigned xb_xcc_id() { return (unsigned)__builtin_amdgcn_s_getreg((3 << 11) | 20) & 0xFu; }
#define XB_SPIN(cond, bar) do { unsigned _sp = 0; while (cond) { __builtin_amdgcn_s_sleep(1); \
    if ((++_sp & 255u) == 0u) { if (xb_ld(&(bar)[XB_TMO])) break; if (_sp > XB_SPIN_CAP) { atomicAdd(&(bar)[XB_TMO], 1u); break; } } } } while (0)
struct XcdBarrier { unsigned* bar; unsigned x; volatile LAS unsigned* st; };
__device__ __forceinline__ XcdBarrier xcd_barrier_post(unsigned* bar, volatile LAS unsigned* st) {
    XcdBarrier b; b.bar = bar; b.x = xb_xcc_id(); b.st = st;
    if (threadIdx.x == 0) (void)xb_add(&bar[XB_XCNT(b.x)], 1u);
    return b;
}
__device__ __forceinline__ void xcd_barrier_complete(unsigned* bar, unsigned x, unsigned& nloc, unsigned& nx) {
    const unsigned G = gridDim.x * gridDim.y * gridDim.z;
    unsigned sum, cnt, mine, sp = 0u;
    for (;;) {
        sum = 0u; cnt = 0u; mine = 0u;
#pragma unroll
        for (unsigned j = 0; j < 16; ++j) { const unsigned c = xb_ld(&bar[XB_XCNT(j)]); sum += c; cnt += (c > 0u) ? 1u : 0u; mine = (j == x) ? c : mine; }
        if (sum == G) break;
        __builtin_amdgcn_s_sleep(1);
        if ((++sp & 255u) == 0u) { if (xb_ld(&bar[XB_TMO])) break; if (sp > XB_SPIN_CAP) { atomicAdd(&bar[XB_TMO], 1u); break; } }
    }
    nloc = mine > 0u ? mine : 1u; nx = cnt > 0u ? cnt : 1u;
}
__device__ __forceinline__ void xcd_barrier(const XcdBarrier& b) {
    asm volatile("s_waitcnt vmcnt(0)" ::: "memory");
    __syncthreads();
    if (threadIdx.x == 0) {
        unsigned* bar = b.bar;
        __builtin_amdgcn_s_waitcnt(0);
        unsigned nloc = b.st[0], nx = b.st[1];
        if (nloc == 0u) { xcd_barrier_complete(bar, b.x, nloc, nx); b.st[0] = nloc; b.st[1] = nx; }
        const unsigned old = xb_add(&bar[XB_XSUB(b.x)], 1u);
        const unsigned gen = old / nloc;
        if (old + 1u == (gen + 1u) * nloc) {
            __builtin_amdgcn_fence(__ATOMIC_RELEASE, "agent");
            asm volatile("s_waitcnt vmcnt(0)" ::: "memory");
            const unsigned og = xb_add(&bar[XB_TOP], 1u);
            const unsigned tg = og / nx;
            if (og + 1u == (tg + 1u) * nx) xb_add(&bar[XB_TOPGEN], 1u);
            else XB_SPIN(xb_ld(&bar[XB_TOPGEN]) == tg, bar);
            __builtin_amdgcn_fence(__ATOMIC_ACQUIRE, "agent");
            xb_add(&bar[XB_XGEN(b.x)], 1u);
            asm volatile("s_waitcnt vmcnt(0)" ::: "memory");
        } else {
            XB_SPIN(xb_ld(&bar[XB_XGEN(b.x)]) == gen, bar);
            __builtin_amdgcn_fence(__ATOMIC_ACQUIRE, "agent");
            asm volatile("s_waitcnt vmcnt(0)" ::: "memory");
        }
    }
    __syncthreads();
}

__device__ __forceinline__ void ada_phase(LAS unsigned char* lds, const float* __restrict__ cvec, const float* __restrict__ w_ada, const float* __restrict__ b_ada, float* __restrict__ mod, int G, int c) {
    LAS float* ca = (LAS float*)lds;
    LAS float* part = (LAS float*)(lds + 32768);
    const int tid = threadIdx.x;
    __syncthreads();
    for (int i = tid; i < kB * kD; i += 512) { const float v = cvec[i]; ca[i] = v / (1.f + __expf(-v)); }
    __syncthreads();
    for (int cb = c; cb < 6 * kD / 48; cb += G) {
        const int n0 = cb * 48, cg = tid % 12, kr = tid / 12;
        if (tid < 504) {
            f32x4 a0 = {0.f, 0.f, 0.f, 0.f}, a1 = a0, a2 = a0, a3 = a0;
#pragma unroll 8
            for (int k = kr; k < kD; k += 42) { const f32x4 w = __builtin_nontemporal_load((const f32x4*)(w_ada + (size_t)k * (6 * kD) + n0 + cg * 4));
                a0 += ca[k] * w; a1 += ca[kD + k] * w; a2 += ca[2 * kD + k] * w; a3 += ca[3 * kD + k] * w; }
            LAS f32x4* pp = (LAS f32x4*)(part + (kr * 12 + cg) * 16); pp[0] = a0; pp[1] = a1; pp[2] = a2; pp[3] = a3;
        }
        __syncthreads();
        if (tid < 192) { const int col = tid % 48, b = tid / 48; float sum = 0.f;
            for (int r = 0; r < 42; ++r) sum += part[(r * 12 + (col >> 2)) * 16 + b * 4 + (col & 3)];
            mod[b * 6 * kD + n0 + col] = sum + b_ada[n0 + col]; }
        __syncthreads();
    }
}

__device__ __forceinline__ void norm1_phase(const float* __restrict__ x, const float* __restrict__ nw, const float* __restrict__ mod, bf16_t* __restrict__ out, int G, int c) {
    const int wid = threadIdx.x >> 6, lane = threadIdx.x & 63;
    for (int t = c * 8 + wid; t < kT; t += G * 8) {
        const int b = t / kS; const float* xr = x + (size_t)t * kD + lane * 4; const float* mb = mod + b * 6 * kD + lane * 4;
        f32x4 v[8]; float ss = 0.f;
#pragma unroll
        for (int j = 0; j < 8; ++j) { v[j] = *(const f32x4*)(xr + 256 * j); ss += v[j][0] * v[j][0] + v[j][1] * v[j][1] + v[j][2] * v[j][2] + v[j][3] * v[j][3]; }
        ss = wave_sum(ss);
        const float r = rsqrtf(ss * (1.f / kD) + kEPS);
#pragma unroll
        for (int j = 0; j < 8; ++j) { const f32x4 w = *(const f32x4*)(nw + lane * 4 + 256 * j), sh = *(const f32x4*)(mb + 256 * j), sc = *(const f32x4*)(mb + kD + 256 * j);
            const f32x4 y = v[j] * r * w * (1.f + sc) + sh; u32x2 o; o.x = pk_bf16(y[0], y[1]); o.y = pk_bf16(y[2], y[3]);
            *(u32x2*)(out + (size_t)t * kD + lane * 4 + 256 * j) = o; }
    }
}

__device__ __forceinline__ void split_bf16(const float (&v)[8], bf16x8& hi, bf16x8& lo) {
    u32x4 h, l;
#pragma unroll
    for (int i = 0; i < 4; ++i) { const unsigned hp = pk_bf16(v[2 * i], v[2 * i + 1]); h[i] = hp; l[i] = pk_bf16(v[2 * i] - bflo(hp), v[2 * i + 1] - bfhi(hp)); }
    hi = __builtin_bit_cast(bf16x8, h); lo = __builtin_bit_cast(bf16x8, l);
}
__device__ __forceinline__ void norm2_router_phase(LAS unsigned char* lds, const float* __restrict__ x1, const float* __restrict__ nw, const float* __restrict__ mod,
                                                   const float* __restrict__ w_router, const float* __restrict__ b_router, unsigned char* __restrict__ h2,
                                                   float* __restrict__ gates, int* __restrict__ pair_e, int* __restrict__ pair_p, int* __restrict__ list, unsigned* __restrict__ ctrl, int G, int c) {
    typedef float f32x16 __attribute__((ext_vector_type(16)));
    const int tid = threadIdx.x, wid = __builtin_amdgcn_readfirstlane(tid >> 6), lane = tid & 63, ql = lane & 31, hf = lane >> 5;
    LAS float* part = (LAS float*)lds;
    LAS float* rsL = (LAS float*)(lds + 32768);
    LAS int* lcnt = (LAS int*)(lds + fg::MISC_OFF + 64);
    for (int blk = c; blk < kT / 32; blk += G) {
        const int t0 = blk * 32, b = t0 / kS;
        __syncthreads();
        if (tid < 32) lcnt[tid] = 0;
#pragma unroll
        for (int rr = 0; rr < 4; ++rr) { const float* xr = x1 + (size_t)(t0 + 4 * wid + rr) * kD + 4 * lane; float ss = 0.f;
#pragma unroll
            for (int j = 0; j < 8; ++j) { const f32x4 v = *(const f32x4*)(xr + 256 * j); ss += v[0] * v[0] + v[1] * v[1] + v[2] * v[2] + v[3] * v[3]; }
            ss = wave_sum(ss); if (lane == 0) rsL[4 * wid + rr] = rsqrtf(ss * (1.f / kD) + kEPS); }
        __syncthreads();
        const float rq = rsL[ql];
        f32x16 acc;
#pragma unroll
        for (int r = 0; r < 16; ++r) acc[r] = 0.f;
        const float* xrow = x1 + (size_t)(t0 + ql) * kD + 256 * wid + 8 * hf;
        const float* mrow = mod + b * 6 * kD + 256 * wid + 8 * hf;
        unsigned char* hrow = h2 + (size_t)(t0 + ql) * kD + 256 * wid + 8 * hf;
        const float* wrow = w_router + (size_t)(256 * wid + 8 * hf) * kE + ql;
#pragma unroll 4
        for (int s = 0; s < 16; ++s) {
            const f32x4 xa = *(const f32x4*)(xrow + 16 * s), xb = *(const f32x4*)(xrow + 16 * s + 4);
            const f32x4 wa = *(const f32x4*)(nw + 256 * wid + 8 * hf + 16 * s), wb = *(const f32x4*)(nw + 256 * wid + 8 * hf + 16 * s + 4);
            const f32x4 sha = *(const f32x4*)(mrow + 3 * kD + 16 * s), shb = *(const f32x4*)(mrow + 3 * kD + 16 * s + 4);
            const f32x4 sca = *(const f32x4*)(mrow + 4 * kD + 16 * s), scb = *(const f32x4*)(mrow + 4 * kD + 16 * s + 4);
            const f32x4 ya = xa * rq * wa * (1.f + sca) + sha, yb = xb * rq * wb * (1.f + scb) + shb;
            const float y[8] = {ya[0], ya[1], ya[2], ya[3], yb[0], yb[1], yb[2], yb[3]};
            u32x2 hq; hq.x = pk4_fp8(clamp448(y[0]), clamp448(y[1]), clamp448(y[2]), clamp448(y[3])); hq.y = pk4_fp8(clamp448(y[4]), clamp448(y[5]), clamp448(y[6]), clamp448(y[7]));
            *(u32x2*)(hrow + 16 * s) = hq;
            float wv[8];
#pragma unroll
            for (int j = 0; j < 8; ++j) wv[j] = wrow[(size_t)(16 * s + j) * kE];
            bf16x8 yh, yl, wh, wl; split_bf16(y, yh, yl); split_bf16(wv, wh, wl);
            acc = __builtin_amdgcn_mfma_f32_32x32x16_bf16(yh, wh, acc, 0, 0, 0);
            acc = __builtin_amdgcn_mfma_f32_32x32x16_bf16(yl, wh, acc, 0, 0, 0);
            acc = __builtin_amdgcn_mfma_f32_32x32x16_bf16(yh, wl, acc, 0, 0, 0);
        }
#pragma unroll
        for (int r = 0; r < 16; ++r) part[(wid * 32 + (r & 3) + 8 * (r >> 2) + 4 * hf) * 32 + ql] = acc[r];
        __syncthreads();
#pragma unroll
        for (int rr = 0; rr < 4; ++rr) {
            const int tok = 4 * wid + rr;
            float v1 = 0.f;
#pragma unroll
            for (int w8 = 0; w8 < 8; ++w8) v1 += part[(w8 * 32 + tok) * 32 + ql];
            float mine = hf ? -3.4e38f : v1 + b_router[ql];
            int idx[4]; float val[4];
#pragma unroll
            for (int k = 0; k < 4; ++k) { float bv = mine; int bi = ql + (hf << 6);
#pragma unroll
                for (int o = 32; o > 0; o >>= 1) { const float ov = __shfl_xor(bv, o); const int oi = __shfl_xor(bi, o); if (ov > bv || (ov == bv && oi < bi)) { bv = ov; bi = oi; } }
                idx[k] = bi; val[k] = bv; if (!hf && ql == bi) mine = -3.4e38f; }
            if (lane == 0) { const int t = t0 + tok; float ex[4], sum = 0.f;
#pragma unroll
                for (int k = 0; k < 4; ++k) { ex[k] = __expf(val[k] - val[0]); sum += ex[k]; }
                const float inv = 1.f / sum;
#pragma unroll
                for (int k = 0; k < 4; ++k) { gates[t * 4 + k] = ex[k] * inv; lcnt[64 + tok * 4 + k] = idx[k]; lcnt[192 + tok * 4 + k] = __hip_atomic_fetch_add(&lcnt[idx[k]], 1, __ATOMIC_RELAXED, __HIP_MEMORY_SCOPE_WORKGROUP); } }
        }
        __syncthreads();
        if (tid < 32) { const int n = lcnt[tid]; lcnt[32 + tid] = n > 0 ? (int)atomicAdd(&ctrl[CT_CNT + 64 * tid], (unsigned)n) : 0; }
        __syncthreads();
        if (tid < 128) { const int e = lcnt[64 + tid], pos = lcnt[32 + e] + lcnt[192 + tid], t = blk * 32 + (tid >> 2);
            pair_e[t * 4 + (tid & 3)] = e; pair_p[t * 4 + (tid & 3)] = pos; list[(size_t)e * kT + pos] = t; }
    }
}

__device__ __forceinline__ void final_phase(const float* __restrict__ x1, const float* __restrict__ mod, const float* __restrict__ gates, const int* __restrict__ pair_e, const int* __restrict__ pair_p,
                                            const MoeTab M, const unsigned char* __restrict__ yp, float* __restrict__ out, int G, int c) {
    const int wid = threadIdx.x >> 6, lane = threadIdx.x & 63;
    for (int t = c * 8 + wid; t < kT; t += G * 8) {
        const int b = t / kS; float gk[4]; const unsigned char* rp[4];
#pragma unroll
        for (int k = 0; k < 4; ++k) { gk[k] = gates[t * 4 + k]; const int e = pair_e[t * 4 + k];
            rp[k] = yp + (size_t)(M.t[32 + e] + pair_p[t * 4 + k]) * kD + lane * 8; }
#pragma unroll
        for (int j = 0; j < 4; ++j) { f32x4 y0 = {0.f, 0.f, 0.f, 0.f}, y1 = y0;
#pragma unroll
            for (int k = 0; k < 4; ++k) { const u32x2 v = *(const u32x2*)(rp[k] + 512 * j);
                const f32x2 a0 = __builtin_amdgcn_cvt_pk_f32_fp8((int)v.x, false), a1 = __builtin_amdgcn_cvt_pk_f32_fp8((int)v.x, true), a2 = __builtin_amdgcn_cvt_pk_f32_fp8((int)v.y, false), a3 = __builtin_amdgcn_cvt_pk_f32_fp8((int)v.y, true);
                y0 += gk[k] * (f32x4){a0[0], a0[1], a1[0], a1[1]}; y1 += gk[k] * (f32x4){a2[0], a2[1], a3[0], a3[1]}; }
            const size_t o = (size_t)t * kD + lane * 8 + 512 * j; const float* gp = mod + b * 6 * kD + 5 * kD + lane * 8 + 512 * j;
            *(f32x4*)(out + o) = *(const f32x4*)(x1 + o) + *(const f32x4*)gp * y0; *(f32x4*)(out + o + 4) = *(const f32x4*)(x1 + o + 4) + *(const f32x4*)(gp + 4) * y1; }
    }
}

struct MegaArgs { const float* in[18]; float* out; unsigned char* ws; int ph_lo, ph_hi; };
constexpr int NPHASE = 10;
__global__ void __launch_bounds__(512, 2) mega(MegaArgs a) {
    extern __shared__ __attribute__((aligned(16))) unsigned char lds_raw[];
    LAS unsigned char* lds = (LAS unsigned char*)lds_raw;
    unsigned char* ws = a.ws;
    const int lo = a.ph_lo, hi = a.ph_hi;
#define IN(k) (lo <= (k) && (k) < hi)
#define SEAM(k) do { if (IN(k) && IN((k) + 1)) xcd_barrier(bar); } while (0)
    const int G = gridDim.x, c = blockIdx.x;
    unsigned* ctrl = (unsigned*)(ws + WS_CTRL);
    const int grp = (c >> 3) & 1, cpr = ((c >> 4) << 3) | (c & 7);
#define HOST_PRE(CC, r0, n)  do { if (grp == 0) convert_t_f8(lds, CC, (r0) + cpr, (r0) + (G / 2) * (n), G / 2); } while (0)
#define HOST_POST(CC, r0, n, q) convert_dyn(lds, CC, ctrl + CT_Q + 64 * (q), (r0) + (G / 2) * (n), (r0) + G * (n))
    const int r_p2 = 0, r_p3 = 56 * G, r_p5 = 84 * G, r_p6 = 92 * G;
    const CvtT C1 = cvt_make(a.in[14], (unsigned char*)(ws + WS_WE1), kD, 2 * kDFF);
    const CvtT C2 = cvt_make(a.in[16], (unsigned char*)(ws + WS_WE2), kDFF, kD);
    if (threadIdx.x == 0) *(LAS u32x4*)(lds + fg::MISC_OFF) = (u32x4){0u, 0u, 0u, 0u};
    __syncthreads();
    XcdBarrier bar; bar.bar = ctrl; bar.x = 0; bar.st = (volatile LAS unsigned*)(lds + fg::MISC_OFF);
    if (hi - lo > 1) bar = xcd_barrier_post(ctrl, (volatile LAS unsigned*)(lds + fg::MISC_OFF));
    float* mod = (float*)(ws + WS_MOD);
    if (IN(0)) {
        ada_phase(lds, a.in[1], a.in[4], a.in[5], mod, G, c);
        const size_t gtid = (size_t)blockIdx.x * 512 + threadIdx.x, gstride = (size_t)G * 512;
        convert_seg(a.in[6], (bf16_t*)(ws + WS_WIN), (size_t)kD * kNPROJ / 8, gtid, gstride);
        convert_seg(a.in[11], (bf16_t*)(ws + WS_WO), (size_t)kSB * kD / 8, gtid, gstride);
        convert_seg(a.in[11] + (size_t)kSB * kD, (bf16_t*)(ws + WS_P), (size_t)kPW * kD / 8, gtid, gstride);
        { const f32x4* s4 = (const f32x4*)a.in[9]; const f32x4* sc4 = (const f32x4*)a.in[10]; u32x4* d4 = (u32x4*)(ws + WS_WPL);
          for (size_t i = gtid; i < (size_t)4 * kPG * kPG / 8; i += gstride) { const int g = (int)(i >> 13), n8 = (int)(i & 31);
              const f32x4 sa = sc4[g * 64 + n8 * 2], sb = sc4[g * 64 + n8 * 2 + 1]; const f32x4 a0 = s4[2 * i] * sa, b0 = s4[2 * i + 1] * sb;
              u32x4 w; w.x = pk_bf16(a0[0], a0[1]); w.y = pk_bf16(a0[2], a0[3]); w.z = pk_bf16(b0[0], b0[1]); w.w = pk_bf16(b0[2], b0[3]); d4[i] = w; } }
    }
    SEAM(0);
    if (IN(1)) norm1_phase(a.in[0], a.in[2], mod, (bf16_t*)(ws + WS_H), G, c);
    if (IN(1)) { JobPoolFold J; J.A = (const char*)(ws + WS_WPL); J.lda2 = kPG * 2; J.ldb2 = kD * 2; J.bhalf2 = 256; J.K = kPG; J.list = nullptr;
        J.B = (const char*)(ws + WS_P); J.wo = (bf16_t*)(ws + WS_WO); J.G = G; J.c = c; fg::gemm_phase(lds, J); }
    SEAM(1);
    if (IN(2)) HOST_PRE(C1, r_p2, 56);
    if (IN(2)) { JobInProj J; J.A = (const char*)(ws + WS_H); J.lda2 = kD * 2; J.ldb2 = kNPROJ * 2; J.bhalf2 = 256; J.K = kD; J.list = nullptr;
        J.B = (const char*)(ws + WS_WIN); J.out = (bf16_t*)(ws + WS_PROJ); J.S.init(kT, kNPROJ, G, c); fg::gemm_phase(lds, J); }
    if (IN(2)) HOST_POST(C1, r_p2, 56, 0);
    SEAM(2);
    if (IN(3)) HOST_PRE(C1, r_p3, 28);
    if (IN(3)) { at::attn_phase(lds, (const bf16_t*)(ws + WS_PROJ), a.in[7], a.in[8], (bf16_t*)(ws + WS_CAT), G, c);
        pool_p_phase((const bf16_t*)(ws + WS_PROJ), (bf16_t*)(ws + WS_CAT), G, c); }
    if (IN(3)) HOST_POST(C1, r_p3, 28, 1);
    SEAM(3);
    if (IN(5)) HOST_PRE(C1, r_p5, 8);
    if (IN(5)) { JobOutProj J; J.A = (const char*)(ws + WS_CAT); J.lda2 = kD * 2; J.ldb2 = kD * 2; J.bhalf2 = 256; J.K = kD; J.list = nullptr;
        J.B = (const char*)(ws + WS_WO); J.x = a.in[0]; J.mod = mod; J.x1 = (float*)(ws + WS_X1); J.S.init(kT, kD, G, c); fg::gemm_phase(lds, J); }
    if (IN(5)) HOST_POST(C1, r_p5, 8, 2);
    SEAM(5);
    if (IN(6)) HOST_PRE(C1, r_p6, 36);
    if (IN(6)) norm2_router_phase(lds, (const float*)(ws + WS_X1), a.in[3], mod, a.in[12], a.in[13], (unsigned char*)(ws + WS_H2), (float*)(ws + WS_GATES), (int*)(ws + WS_PAIRE), (int*)(ws + WS_PAIRP),
                                  (int*)(ws + WS_LIST), ctrl, G, c);
    if (IN(6)) HOST_POST(C1, r_p6, 36, 3);
    SEAM(6);
    if (IN(7)) HOST_PRE(C2, 0, 64);
    if (IN(7)) { JobMoe1F8 J; J.A = (const char*)(ws + WS_H2); J.lda2 = kD; J.ldb2 = kD; J.bhalf2 = (unsigned)kDFF * kD; J.K = kD; J.list = (const int*)(ws + WS_LIST);
        J.B = (const char*)(ws + WS_WE1); J.b_in = a.in[15]; J.act = (unsigned char*)(ws + WS_ACT); J.M = moe_tables(lds, ctrl, kDFF / 128); J.G = G; J.c = c; fg::gemm_phase_f8(lds, J); }
    if (IN(7)) HOST_POST(C2, 0, 64, 4);
    SEAM(7);
    if (IN(8)) { JobMoe2F8 J; J.A = (const char*)(ws + WS_ACT); J.lda2 = kDFF; J.ldb2 = kDFF; J.bhalf2 = 128u * kDFF; J.K = kDFF; J.list = nullptr;
        J.B = (const char*)(ws + WS_WE2); J.b_out = a.in[17]; J.yp = (unsigned char*)(ws + WS_YP); J.M = moe_tables(lds, ctrl, kD / 256); J.G = G; J.c = c; fg::gemm_phase_f8(lds, J); }
    SEAM(8);
    if (IN(9)) final_phase((const float*)(ws + WS_X1), mod, (const float*)(ws + WS_GATES), (const int*)(ws + WS_PAIRE), (const int*)(ws + WS_PAIRP), moe_tables(lds, ctrl, 1), (const unsigned char*)(ws + WS_YP), a.out, G, c);
#undef IN
#undef SEAM
}

#ifndef N_LAUNCHES
#define N_LAUNCHES 1
#endif
extern "C" void kernel_launch(void* const* d_in, const int* in_sizes, int n_in, void* d_out, int out_size, void* d_ws, size_t ws_size, hipStream_t stream) {
    static int grid = 0;
    if (grid == 0) {
        int dev = 0, cus = 0;
        (void)hipGetDevice(&dev); (void)hipDeviceGetAttribute(&cus, hipDeviceAttributeMultiprocessorCount, dev);
        (void)hipFuncSetAttribute((const void*)mega, hipFuncAttributeMaxDynamicSharedMemorySize, fg::LDS_BYTES);
        (void)cus; grid = 256;
    }
    MegaArgs a{}; for (int i = 0; i < 18; ++i) a.in[i] = (const float*)d_in[i]; a.out = (float*)d_out; a.ws = (unsigned char*)d_ws;
    (void)hipMemsetAsync((char*)d_ws + WS_CTRL, 0, 65536, stream);
    if (N_LAUNCHES == 1) { a.ph_lo = 0; a.ph_hi = NPHASE; hipLaunchKernelGGL(mega, dim3(grid), dim3(512), fg::LDS_BYTES, stream, a); }
    else for (int p = 0; p < NPHASE; ++p) { a.ph_lo = p; a.ph_hi = p + 1; hipLaunchKernelGGL(mega, dim3(grid), dim3(512), fg::LDS_BYTES, stream, a); }
}
```

```cpp
#include <hip/hip_runtime.h>
#include <stdint.h>

constexpr int kB = 4, kS = 2048, kD = 2048, kT = kB * kS;
constexpr int kHD = 128, kNH = 8, kSB = 1024, kPW = 1024, kPG = 256;
constexpr int kNPROJ = 4096, kE = 32, kTOPK = 4, kDFF = 2048;
constexpr float kEPS = 1e-6f;
constexpr int kMaxSlots = 160 * 256;

typedef unsigned short bf16_t;
__device__ __forceinline__ bf16_t f2bf(float f) { unsigned u = __float_as_uint(f); u += 0x7FFFu + ((u >> 16) & 1u); return (bf16_t)(u >> 16); }
__device__ __forceinline__ float bf2f(bf16_t b) { return __uint_as_float(((unsigned)b) << 16); }

constexpr size_t WS_CTRL   = 0;
constexpr size_t WS_MOD    = 65536;
constexpr size_t WS_H      = WS_MOD + (size_t)4 * 12288 * 4;
constexpr size_t WS_PROJ   = WS_H + (size_t)kT * kD * 2;
constexpr size_t WS_CAT    = WS_PROJ + (size_t)kT * kNPROJ * 2;
constexpr size_t WS_P      = WS_CAT + (size_t)kT * kD * 2;
constexpr size_t WS_X1     = WS_P + (size_t)kT * kPW * 2;
constexpr size_t WS_H2     = WS_X1 + (size_t)kT * kD * 4;
constexpr size_t WS_GATES  = WS_H2 + (size_t)kT * kD * 2;
constexpr size_t WS_PAIRE  = WS_GATES + (size_t)kT * 4 * 4;
constexpr size_t WS_PAIRP  = WS_PAIRE + (size_t)kT * 4 * 4;
constexpr size_t WS_LIST   = WS_PAIRP + (size_t)kT * 4 * 4;
constexpr size_t WS_ACT    = WS_LIST + (size_t)kE * kT * 4;
constexpr size_t WS_YP     = WS_ACT + (size_t)kMaxSlots * kDFF * 2;
constexpr size_t WS_END    = WS_YP + (size_t)kMaxSlots * kD * 2;
constexpr int CT_CNT = 4096;
constexpr int CT_ROWBASE = 4160;
constexpr int CT_Q = 8192;

#define LAS __attribute__((address_space(3)))
typedef short bf16x8 __attribute__((ext_vector_type(8)));
typedef short s16x4 __attribute__((ext_vector_type(4)));
typedef float f32x4 __attribute__((ext_vector_type(4)));
typedef float f32x2 __attribute__((ext_vector_type(2)));
typedef __bf16 bf16v2 __attribute__((ext_vector_type(2)));
typedef unsigned u32x2 __attribute__((ext_vector_type(2)));
typedef unsigned u32x4 __attribute__((ext_vector_type(4)));
typedef int i32x4 __attribute__((ext_vector_type(4)));
typedef int i32x8 __attribute__((ext_vector_type(8)));
__device__ __forceinline__ unsigned pk_bf16(float a, float b) { f32x2 v = {a, b}; bf16v2 r = __builtin_convertvector(v, bf16v2); return __builtin_bit_cast(unsigned, r); }

constexpr size_t WS_WIN  = WS_END;
constexpr size_t WS_WO   = WS_WIN + (size_t)kD * kNPROJ * 2;
constexpr size_t WS_WPL  = WS_WO + (size_t)kD * kD * 2;
constexpr size_t WS_WE1  = WS_WPL + (size_t)4 * kPG * kPG * 2;
constexpr size_t WS_WE2  = WS_WE1 + (size_t)kE * kD * 2 * kDFF * 2;
constexpr size_t WS_END2 = WS_WE2 + (size_t)kE * kDFF * kD * 2;

namespace fg {
constexpr int BM = 256, BK = 64, HALF = 128, HTB = 16384, STAGE_BYTES = 131072, NXCD = 8, WGM = 8;
constexpr int TAB_OFF = STAGE_BYTES;
constexpr int MISC_OFF = STAGE_BYTES + 2048;
constexpr int LDS_BYTES = STAGE_BYTES + 4096;
__device__ __forceinline__ int lds_byte(int r, int c) { const int st = (r >> 4) * 2 + (c >> 5), rr = r & 15, cc = c & 31, ob = rr * 64 + cc * 2; return st * 1024 + (ob ^ (((ob >> 9) & 1) << 5)); }
__device__ __forceinline__ void stage_rc(int b, int& R, int& C) { const int st = b / 1024, sb = b % 1024, swz = sb ^ (((sb >> 9) & 1) << 5); R = (st >> 1) * 16 + swz / 64; C = (st & 1) * 32 + (swz % 64) / 2; }

struct Unit { const char* bBase; int arow0; int nvalid; int e; int orow0; int ocol0; int acol2; };

struct StaticOrder {
    int nM, nN, nwg, G, c;
    __device__ void init(int M, int N, int G_, int c_) { nM = M / BM; nN = N / BM; nwg = nM * nN; G = G_; c = c_; }
    __device__ bool next(int i, int& pm, int& pn) const {
        const long L = (long)i * G + c; if (L >= nwg) return false;
        int wgid = (int)L; { const int q = nwg / NXCD, r = nwg % NXCD, xcd = wgid % NXCD, off = wgid / NXCD; wgid = (xcd < r ? xcd * (q + 1) : r * (q + 1) + (xcd - r) * q) + off; }
        const int nig = WGM * nN, gid = wgid / nig, fm = gid * WGM, gsz = (nM - fm) < WGM ? (nM - fm) : WGM;
        pm = fm + ((wgid % nig) % gsz); pn = (wgid % nig) / gsz; return true;
    }
};

template <int OFF> __device__ __forceinline__ s16x4 tr_read(unsigned addr) { s16x4 r; asm volatile("ds_read_b64_tr_b16 %0, %1 offset:%2" : "=&v"(r) : "v"(addr), "i"(OFF) : "memory"); return r; }
template <class Job>
__device__ __forceinline__ void gemm_phase(LAS unsigned char* lds, const Job& J) {
    const int tid = threadIdx.x, wid = __builtin_amdgcn_readfirstlane(tid >> 6), lane = tid & 63, wr = wid >> 2, wc = wid & 3, fr = lane & 15, fq = lane >> 4;
    const int nt = J.K / BK;
    unsigned voffB[2];
#pragma unroll
    for (int i = 0; i < 2; ++i) { int R, C; stage_rc(tid * 16 + i * 8192, R, C);
        const int b = tid * 16 + i * 8192, row = b >> 8, slot = (b >> 4) & 15, ch = slot ^ (((row & 3) << 2) | ((row >> 2) & 3)); voffB[i] = (unsigned)row * J.ldb2 + (unsigned)ch * 16u; }
    const size_t kstepB = (size_t)BK * J.ldb2;
    const unsigned ldsw = (unsigned)wid * 1024u;
    const int aoff = lds_byte(wr * 64 + fr, fq * 8);
    const int tq = (lane & 15) >> 2, tp = lane & 3;
    unsigned ba[2][2];
#pragma unroll
    for (int n = 0; n < 2; ++n)
#pragma unroll
        for (int t = 0; t < 2; ++t) ba[n][t] = (unsigned)(uintptr_t)lds + 256u * (8 * fq + 4 * t + tq) + 16u * ((4 * wc + 2 * n + (tp >> 1)) ^ ((tq << 2) | ((2 * fq + t) & 3))) + 8u * (tp & 1);
#define FG_SA(b, h) (65536 + ((b) * 2 + (h)) * HTB)
#define FG_SB(b, h) (((b) * 2 + (h)) * HTB)
#define FG_STAGE_A(bufoff, gk, vo) do { _Pragma("unroll") for (int _i = 0; _i < 2; ++_i) \
        __builtin_amdgcn_global_load_lds((const unsigned*)((gk) + (vo)[_i]), (LAS unsigned*)(lds + (bufoff) + ldsw + _i * 8192), 16, 0, 0); } while (0)
#define FG_STAGE_B(bufoff, gk) do { _Pragma("unroll") for (int _i = 0; _i < 2; ++_i) \
        __builtin_amdgcn_global_load_lds((const unsigned*)((gk) + voffB[_i]), (LAS unsigned*)(lds + (bufoff) + ldsw + _i * 8192), 16, 0, 0); } while (0)
#define FG_LDA(dst, b, h) do { _Pragma("unroll") for (int m = 0; m < 4; ++m) _Pragma("unroll") for (int k = 0; k < 2; ++k) dst[m][k] = *(const LAS bf16x8*)(lds + FG_SA(b, h) + aoff + m * 2048 + k * 1024); } while (0)
#define FG_LDB(dst, b, h) do { \
        dst##lo[0][0] = tr_read<FG_SB(b, h)>(ba[0][0]);        dst##hi[0][0] = tr_read<FG_SB(b, h)>(ba[0][1]); \
        dst##lo[0][1] = tr_read<FG_SB(b, h) + 8192>(ba[0][0]); dst##hi[0][1] = tr_read<FG_SB(b, h) + 8192>(ba[0][1]); \
        dst##lo[1][0] = tr_read<FG_SB(b, h)>(ba[1][0]);        dst##hi[1][0] = tr_read<FG_SB(b, h)>(ba[1][1]); \
        dst##lo[1][1] = tr_read<FG_SB(b, h) + 8192>(ba[1][0]); dst##hi[1][1] = tr_read<FG_SB(b, h) + 8192>(ba[1][1]); } while (0)
#define FG_PK(L, H) (bf16x8){L[0], L[1], L[2], L[3], H[0], H[1], H[2], H[3]}
#define FG_MMA(ai, bj, At, Bt) do { __builtin_amdgcn_s_setprio(1); _Pragma("unroll") for (int m = 0; m < 4; ++m) _Pragma("unroll") for (int n = 0; n < 2; ++n) _Pragma("unroll") for (int k = 0; k < 2; ++k) \
        acc[ai][bj][m][n] = __builtin_amdgcn_mfma_f32_16x16x32_bf16(FG_PK(Bt##lo[n][k], Bt##hi[n][k]), At[m][k], acc[ai][bj][m][n], 0, 0, 0); __builtin_amdgcn_s_setprio(0); } while (0)
#define FG_WAIT_V(n) asm volatile("s_waitcnt vmcnt(" #n ")" ::: "memory")
#define FG_WAIT_L(n) asm volatile("s_waitcnt lgkmcnt(" #n ")" ::: "memory")
#define FG_BAR __builtin_amdgcn_s_barrier()
#define FG_SCHED __builtin_amdgcn_sched_barrier(0)
#define FG_AOFF(dst, u, tabp) do { int _tz = threadIdx.x; asm volatile("" : "+v"(_tz)); _Pragma("unroll") for (int _i = 0; _i < 2; ++_i) { int _R, _C; stage_rc(_tz * 16 + _i * 8192, _R, _C); \
        _Pragma("unroll") for (int _h = 0; _h < 2; ++_h) { const int _r = _h * 128 + _R; \
        if (Job::GATHER) { const int _tok = (tabp)[_r < (u).nvalid ? _r : 0]; dst[_h][_i] = (unsigned)_tok * J.lda2 + (unsigned)(_C * 2); } \
        else dst[_h][_i] = (unsigned)((u).arow0 + _r) * J.lda2 + (unsigned)((u).acol2 + _C * 2); } } } while (0)
    Unit cur, nxt; int ui = 0;
    if (!J.next(0, cur)) return;
    LAS const int* tab0 = (LAS const int*)(lds + TAB_OFF);
    if (Job::GATHER) {
        if (wid == 0) __builtin_amdgcn_global_load_lds((const unsigned*)(J.list + cur.arow0 + lane * 4), (LAS unsigned*)(lds + TAB_OFF), 16, 0, 0);
        FG_WAIT_V(0); __syncthreads();
    }
    f32x4 acc[2][2][4][2];
#pragma unroll
    for (int a = 0; a < 2; ++a)
#pragma unroll
        for (int b = 0; b < 2; ++b)
#pragma unroll
            for (int m = 0; m < 4; ++m)
#pragma unroll
                for (int n = 0; n < 2; ++n) acc[a][b][m][n] = (f32x4){0.f, 0.f, 0.f, 0.f};
    bf16x8 At[4][2]; s16x4 B0lo[2][2], B0hi[2][2], B1lo[2][2], B1hi[2][2];
    unsigned vc[2][2];
    FG_AOFF(vc, cur, tab0);
    const char* const gA = J.A;
    const char* cB = cur.bBase;
    const unsigned bh2 = J.bhalf2;
    FG_STAGE_B(FG_SB(0, 0), cB); FG_STAGE_A(FG_SA(0, 0), gA, vc[0]); FG_STAGE_B(FG_SB(0, 1), cB + bh2); FG_STAGE_A(FG_SA(0, 1), gA, vc[1]);
    if (wr == 1) FG_BAR;
    FG_WAIT_V(4); FG_BAR;
    FG_STAGE_B(FG_SB(1, 0), cB + kstepB); FG_STAGE_A(FG_SA(1, 0), gA + 128, vc[0]); FG_STAGE_B(FG_SB(1, 1), cB + kstepB + bh2);
    FG_WAIT_V(6); FG_BAR;
    for (;;) {
        const bool has_next = J.next(ui + 1, nxt);
        if (!has_next) nxt = cur;
        if (Job::GATHER && has_next && wid == 0)
            __builtin_amdgcn_global_load_lds((const unsigned*)(J.list + nxt.arow0 + lane * 4), (LAS unsigned*)(lds + TAB_OFF + ((ui + 1) & 1) * 1024), 16, 0, 0);
        const char* nB = nxt.bBase;
        for (int t = 0; t < nt; t += 2) {
            const bool last = (t == nt - 2);
            const char* a1 = gA + (size_t)(t + 1) * 128;
            const char* a2 = last ? gA : gA + (size_t)(t + 2) * 128; const char* b2 = last ? nB : cB + (size_t)(t + 2) * kstepB;
            const char* a3 = a2 + 128; const char* b3 = b2 + kstepB;
            FG_LDB(B0, 0, 0); FG_SCHED; FG_LDA(At, 0, 0); FG_STAGE_A(FG_SA(1, 1), a1, vc[1]);
            if (last && has_next) { LAS const int* tabn = (LAS const int*)(lds + TAB_OFF + ((ui + 1) & 1) * 1024); FG_AOFF(vc, nxt, tabn); }
            FG_WAIT_L(8); FG_BAR; FG_WAIT_L(0); FG_SCHED; FG_MMA(0, 0, At, B0); FG_BAR; FG_SCHED;
            FG_LDB(B1, 0, 1); FG_STAGE_B(FG_SB(0, 0), b2);
            FG_BAR; FG_WAIT_L(0); FG_SCHED; FG_MMA(0, 1, At, B1); FG_BAR;
            FG_LDA(At, 0, 1); FG_STAGE_A(FG_SA(0, 0), a2, vc[0]);
            FG_BAR; FG_WAIT_L(0); FG_MMA(1, 0, At, B0); FG_BAR; FG_SCHED;
            FG_STAGE_B(FG_SB(0, 1), b2 + bh2);
            FG_WAIT_V(6); FG_BAR; FG_MMA(1, 1, At, B1); FG_BAR;
            FG_LDB(B0, 1, 0); FG_SCHED; FG_LDA(At, 1, 0); FG_STAGE_A(FG_SA(0, 1), a2, vc[1]);
            FG_WAIT_L(8); FG_BAR; FG_WAIT_L(0); FG_SCHED; FG_MMA(0, 0, At, B0); FG_BAR; FG_SCHED;
            FG_LDB(B1, 1, 1); FG_STAGE_B(FG_SB(1, 0), b3);
            FG_BAR; FG_WAIT_L(0); FG_SCHED; FG_MMA(0, 1, At, B1); FG_BAR;
            FG_LDA(At, 1, 1); FG_STAGE_A(FG_SA(1, 0), a3, vc[0]);
            FG_BAR; FG_WAIT_L(0); FG_MMA(1, 0, At, B0); FG_BAR; FG_SCHED;
            FG_STAGE_B(FG_SB(1, 1), b3 + bh2);
            FG_WAIT_V(6); FG_BAR; FG_MMA(1, 1, At, B1); FG_BAR;
        }
        J.epi(acc, cur, wr, wc, fr, fq);
        if (!has_next) break;
#pragma unroll
        for (int a = 0; a < 2; ++a)
#pragma unroll
            for (int b = 0; b < 2; ++b)
#pragma unroll
                for (int m = 0; m < 4; ++m)
#pragma unroll
                    for (int n = 0; n < 2; ++n) acc[a][b][m][n] = (f32x4){0.f, 0.f, 0.f, 0.f};
        cur = nxt; cB = nB; ++ui;
    }
    FG_WAIT_V(0);
    if (wr == 0) FG_BAR;
    FG_BAR;
}

#undef FG_SA
#undef FG_SB
#undef FG_STAGE_A
#undef FG_STAGE_B
#undef FG_LDA
#undef FG_LDB
#undef FG_MMA
#undef FG_WAIT_V
#undef FG_WAIT_L
#undef FG_BAR
#undef FG_SCHED
#undef FG_AOFF
template <class Job>
__device__ __forceinline__ void gemm_phase_f8(LAS unsigned char* lds, const Job& J) {
    const int tid = threadIdx.x, wid = __builtin_amdgcn_readfirstlane(tid >> 6), lane = tid & 63, wr = wid >> 2, wc = wid & 3, fr = lane & 15, fq = lane >> 4;
    const int nt = J.K / 128;
    unsigned voffB[2];
#pragma unroll
    for (int i = 0; i < 2; ++i) { int R, C; stage_rc(tid * 16 + i * 8192, R, C);
        voffB[i] = (unsigned)R * J.ldb2 + (unsigned)(C * 2); }
    const size_t kstepB = 128;
    const unsigned ldsw = (unsigned)wid * 1024u;
    const int aoff = lds_byte(wr * 64 + fr, fq * 8);
    const int boff = lds_byte(wc * 32 + fr, fq * 8);
#define FG_SA(b, h) (65536 + ((b) * 2 + (h)) * HTB)
#define FG_SB(b, h) (((b) * 2 + (h)) * HTB)
#define FG_STAGE_A(bufoff, gk, vo) do { _Pragma("unroll") for (int _i = 0; _i < 2; ++_i) \
        __builtin_amdgcn_global_load_lds((const unsigned*)((gk) + (vo)[_i]), (LAS unsigned*)(lds + (bufoff) + ldsw + _i * 8192), 16, 0, 0); } while (0)
#define FG_STAGE_B(bufoff, gk) do { _Pragma("unroll") for (int _i = 0; _i < 2; ++_i) \
        __builtin_amdgcn_global_load_lds((const unsigned*)((gk) + voffB[_i]), (LAS unsigned*)(lds + (bufoff) + ldsw + _i * 8192), 16, 0, 0); } while (0)
#define FG_LDA(dst, b, h) do { _Pragma("unroll") for (int m = 0; m < 4; ++m) _Pragma("unroll") for (int k = 0; k < 2; ++k) dst[m][k] = *(const LAS i32x4*)(lds + FG_SA(b, h) + aoff + m * 2048 + k * 1024); } while (0)
#define FG_LDB(dst, b, h) do { _Pragma("unroll") for (int n = 0; n < 2; ++n) _Pragma("unroll") for (int k = 0; k < 2; ++k) dst[n][k] = *(const LAS i32x4*)(lds + FG_SB(b, h) + boff + n * 2048 + k * 1024); } while (0)
#define FG_CAT8(X, Y) __builtin_shufflevector(X, Y, 0, 1, 2, 3, 4, 5, 6, 7)
#define FG_MMA(ai, bj, At, Bt) do { __builtin_amdgcn_s_setprio(1); _Pragma("unroll") for (int m = 0; m < 4; ++m) _Pragma("unroll") for (int n = 0; n < 2; ++n) \
        acc[ai][bj][m][n] = __builtin_amdgcn_mfma_scale_f32_16x16x128_f8f6f4(FG_CAT8(Bt[n][0], Bt[n][1]), FG_CAT8(At[m][0], At[m][1]), acc[ai][bj][m][n], 0, 0, 0, 0x79797979, 0, 0x7F7F7F7F); __builtin_amdgcn_s_setprio(0); } while (0)
#define FG_WAIT_V(n) asm volatile("s_waitcnt vmcnt(" #n ")" ::: "memory")
#define FG_WAIT_L(n) asm volatile("s_waitcnt lgkmcnt(" #n ")" ::: "memory")
#define FG_BAR __builtin_amdgcn_s_barrier()
#define FG_SCHED __builtin_amdgcn_sched_barrier(0)
#define FG_AOFF(dst, u, tabp) do { int _tz = threadIdx.x; asm volatile("" : "+v"(_tz)); _Pragma("unroll") for (int _i = 0; _i < 2; ++_i) { int _R, _C; stage_rc(_tz * 16 + _i * 8192, _R, _C); \
        _Pragma("unroll") for (int _h = 0; _h < 2; ++_h) { const int _r = _h * 128 + _R; \
        if (Job::GATHER) { const int _tok = (tabp)[_r < (u).nvalid ? _r : 0]; dst[_h][_i] = (unsigned)_tok * J.lda2 + (unsigned)(_C * 2); } \
        else dst[_h][_i] = (unsigned)((u).arow0 + _r) * J.lda2 + (unsigned)((u).acol2 + _C * 2); } } } while (0)
    Unit cur, nxt; int ui = 0;
    if (!J.next(0, cur)) return;
    LAS const int* tab0 = (LAS const int*)(lds + TAB_OFF);
    if (Job::GATHER) {
        if (wid == 0) __builtin_amdgcn_global_load_lds((const unsigned*)(J.list + cur.arow0 + lane * 4), (LAS unsigned*)(lds + TAB_OFF), 16, 0, 0);
        FG_WAIT_V(0); __syncthreads();
    }
    f32x4 acc[2][2][4][2];
#pragma unroll
    for (int a = 0; a < 2; ++a)
#pragma unroll
        for (int b = 0; b < 2; ++b)
#pragma unroll
            for (int m = 0; m < 4; ++m)
#pragma unroll
                for (int n = 0; n < 2; ++n) acc[a][b][m][n] = (f32x4){0.f, 0.f, 0.f, 0.f};
    i32x4 At[4][2], B0[2][2], B1[2][2];
    unsigned vc[2][2];
    FG_AOFF(vc, cur, tab0);
    const char* const gA = J.A;
    const char* cB = cur.bBase;
    const unsigned bh2 = J.bhalf2;
    FG_STAGE_B(FG_SB(0, 0), cB); FG_STAGE_A(FG_SA(0, 0), gA, vc[0]); FG_STAGE_B(FG_SB(0, 1), cB + bh2); FG_STAGE_A(FG_SA(0, 1), gA, vc[1]);
    if (wr == 1) FG_BAR;
    FG_WAIT_V(4); FG_BAR;
    FG_STAGE_B(FG_SB(1, 0), cB + kstepB); FG_STAGE_A(FG_SA(1, 0), gA + 128, vc[0]); FG_STAGE_B(FG_SB(1, 1), cB + kstepB + bh2);
    FG_WAIT_V(6); FG_BAR;
    for (;;) {
        const bool has_next = J.next(ui + 1, nxt);
        if (!has_next) nxt = cur;
        if (Job::GATHER && has_next && wid == 0)
            __builtin_amdgcn_global_load_lds((const unsigned*)(J.list + nxt.arow0 + lane * 4), (LAS unsigned*)(lds + TAB_OFF + ((ui + 1) & 1) * 1024), 16, 0, 0);
        const char* nB = nxt.bBase;
        for (int t = 0; t < nt; t += 2) {
            const bool last = (t == nt - 2);
            const char* a1 = gA + (size_t)(t + 1) * 128;
            const char* a2 = last ? gA : gA + (size_t)(t + 2) * 128; const char* b2 = last ? nB : cB + (size_t)(t + 2) * kstepB;
            const char* a3 = a2 + 128; const char* b3 = b2 + kstepB;
            FG_LDB(B0, 0, 0); FG_SCHED; FG_LDA(At, 0, 0); FG_STAGE_A(FG_SA(1, 1), a1, vc[1]);
            if (last && has_next) { LAS const int* tabn = (LAS const int*)(lds + TAB_OFF + ((ui + 1) & 1) * 1024); FG_AOFF(vc, nxt, tabn); }
            FG_WAIT_L(8); FG_BAR; FG_WAIT_L(0); FG_SCHED; FG_MMA(0, 0, At, B0); FG_BAR; FG_SCHED;
            FG_LDB(B1, 0, 1); FG_STAGE_B(FG_SB(0, 0), b2);
            FG_BAR; FG_WAIT_L(0); FG_SCHED; FG_MMA(0, 1, At, B1); FG_BAR;
            FG_LDA(At, 0, 1); FG_STAGE_A(FG_SA(0, 0), a2, vc[0]);
            FG_BAR; FG_WAIT_L(0); FG_MMA(1, 0, At, B0); FG_BAR; FG_SCHED;
            FG_STAGE_B(FG_SB(0, 1), b2 + bh2);
            FG_WAIT_V(6); FG_BAR; FG_MMA(1, 1, At, B1); FG_BAR;
            FG_LDB(B0, 1, 0); FG_SCHED; FG_LDA(At, 1, 0); FG_STAGE_A(FG_SA(0, 1), a2, vc[1]);
            FG_WAIT_L(8); FG_BAR; FG_WAIT_L(0); FG_SCHED; FG_MMA(0, 0, At, B0); FG_BAR; FG_SCHED;
            FG_LDB(B1, 1, 1); FG_STAGE_B(FG_SB(1, 0), b3);
            FG_BAR; FG_WAIT_L(0); FG_SCHED; FG_MMA(0, 1, At, B1); FG_BAR;
            FG_LDA(At, 1, 1); FG_STAGE_A(FG_SA(1, 0), a3, vc[0]);
            FG_BAR; FG_WAIT_L(0); FG_MMA(1, 0, At, B0); FG_BAR; FG_SCHED;
            FG_STAGE_B(FG_SB(1, 1), b3 + bh2);
            FG_WAIT_V(6); FG_BAR; FG_MMA(1, 1, At, B1); FG_BAR;
        }
        J.epi(acc, cur, wr, wc, fr, fq);
        if (!has_next) break;
#pragma unroll
        for (int a = 0; a < 2; ++a)
#pragma unroll
            for (int b = 0; b < 2; ++b)
#pragma unroll
                for (int m = 0; m < 4; ++m)
#pragma unroll
                    for (int n = 0; n < 2; ++n) acc[a][b][m][n] = (f32x4){0.f, 0.f, 0.f, 0.f};
        cur = nxt; cB = nB; ++ui;
    }
    FG_WAIT_V(0);
    if (wr == 0) FG_BAR;
    FG_BAR;
}
}

#define FG_FOR_ROWS for (int ai = 0; ai < 2; ++ai) _Pragma("unroll") for (int m = 0; m < 4; ++m)
struct JobInProj {
    static constexpr bool GATHER = false;
    const char* A; unsigned lda2, ldb2, bhalf2; int K; const int* list;
    const char* B; bf16_t* out; fg::StaticOrder S;
    __device__ __forceinline__ bool next(int i, fg::Unit& u) const { int pm, pn; if (!S.next(i, pm, pn)) return false;
        u.bBase = B + (size_t)pn * 512; u.arow0 = pm * 256; u.nvalid = 256; u.e = 0; u.orow0 = pm * 256; u.ocol0 = pn * 256; u.acol2 = 0; return true; }
    __device__ __forceinline__ void epi(const f32x4 (&acc)[2][2][4][2], const fg::Unit& u, int wr, int wc, int fr, int fq) const {
#pragma unroll
        FG_FOR_ROWS { bf16_t* rowp = out + (size_t)(u.orow0 + ai * 128 + wr * 64 + m * 16 + fr) * kNPROJ + u.ocol0 + wc * 32 + fq * 4;
#pragma unroll
            for (int bj = 0; bj < 2; ++bj)
#pragma unroll
                for (int n = 0; n < 2; ++n) { const f32x4 v = acc[ai][bj][m][n]; u32x2 w; w.x = pk_bf16(v[0], v[1]); w.y = pk_bf16(v[2], v[3]); *(u32x2*)(rowp + bj * 128 + n * 16) = w; } }
    }
};
struct JobPoolFold {
    static constexpr bool GATHER = false;
    const char* A; unsigned lda2, ldb2, bhalf2; int K; const int* list;
    const char* B; bf16_t* wo; int G, c;
    __device__ __forceinline__ bool next(int i, fg::Unit& u) const { const int L = i * G + c; if (L >= 32) return false; const int g = L >> 3, pn = L & 7;
        u.bBase = B + (size_t)g * kPG * kD * 2 + (size_t)pn * 512; u.arow0 = 0; u.nvalid = 256; u.e = g; u.orow0 = kSB + g * kPG; u.ocol0 = pn * 256; u.acol2 = g * kPG * kPG * 2; return true; }
    __device__ __forceinline__ void epi(const f32x4 (&acc)[2][2][4][2], const fg::Unit& u, int wr, int wc, int fr, int fq) const {
#pragma unroll
        FG_FOR_ROWS { bf16_t* rowp = wo + (size_t)(u.orow0 + ai * 128 + wr * 64 + m * 16 + fr) * kD + u.ocol0 + wc * 32 + fq * 4;
#pragma unroll
            for (int bj = 0; bj < 2; ++bj)
#pragma unroll
                for (int n = 0; n < 2; ++n) { const f32x4 v = acc[ai][bj][m][n]; u32x2 w; w.x = pk_bf16(v[0], v[1]); w.y = pk_bf16(v[2], v[3]); *(u32x2*)(rowp + bj * 128 + n * 16) = w; } }
    }
};
struct JobOutProj {
    static constexpr bool GATHER = false;
    const char* A; unsigned lda2, ldb2, bhalf2; int K; const int* list;
    const char* B; const float* x; const float* mod; bf16_t* x1; fg::StaticOrder S;
    __device__ __forceinline__ bool next(int i, fg::Unit& u) const { int pm, pn; if (!S.next(i, pm, pn)) return false;
        u.bBase = B + (size_t)pn * 512; u.arow0 = pm * 256; u.nvalid = 256; u.e = 0; u.orow0 = pm * 256; u.ocol0 = pn * 256; u.acol2 = 0; return true; }
    __device__ __forceinline__ void epi(const f32x4 (&acc)[2][2][4][2], const fg::Unit& u, int wr, int wc, int fr, int fq) const {
        const int b = u.orow0 / kS; f32x4 gt[2][2];
#pragma unroll
        for (int bj = 0; bj < 2; ++bj)
#pragma unroll
            for (int n = 0; n < 2; ++n) gt[bj][n] = *(const f32x4*)(mod + b * 6 * kD + 2 * kD + u.ocol0 + bj * 128 + wc * 32 + n * 16 + fq * 4);
#pragma unroll
        FG_FOR_ROWS { const size_t ro = (size_t)(u.orow0 + ai * 128 + wr * 64 + m * 16 + fr) * kD + u.ocol0 + wc * 32 + fq * 4;
#pragma unroll
            for (int bj = 0; bj < 2; ++bj)
#pragma unroll
                for (int n = 0; n < 2; ++n) { const f32x4 v = *(const f32x4*)(x + ro + bj * 128 + n * 16) + gt[bj][n] * acc[ai][bj][m][n]; u32x2 w; w.x = pk_bf16(v[0], v[1]); w.y = pk_bf16(v[2], v[3]); *(u32x2*)(x1 + ro + bj * 128 + n * 16) = w; } }
    }
};
struct MoeTab { LAS const int* t; int total;
    __device__ __forceinline__ bool decode(int i, int G, int c, int& e, int& jcol, int& rb, int& cnt, int& rowbase) const {
        const int L = (G % 8 == 0) ? i * G + (c % 8) * (G / 8) + c / 8 : i * G + c; if (L >= total) return false;
        int ee = 0; while (ee < kE - 1 && t[64 + ee + 1] <= L) ++ee;
        const int local = L - t[64 + ee], nrb = t[100 + ee]; jcol = local / nrb; rb = local - jcol * nrb; e = ee; cnt = t[ee]; rowbase = t[32 + ee]; return true; }
};
__device__ __forceinline__ MoeTab moe_tables(LAS unsigned char* lds, const unsigned* ctrl, int ncol) {
    LAS int* t = (LAS int*)(lds + fg::MISC_OFF + 64);
    __syncthreads();
    if (threadIdx.x == 0) { int base = 0, us = 0; for (int e = 0; e < kE; ++e) { const int cn = (int)ctrl[CT_CNT + 64 * e], nrb = (cn + 255) >> 8; t[e] = cn; t[32 + e] = base; t[64 + e] = us; t[100 + e] = nrb; base += nrb * 256; us += nrb * ncol; } t[64 + kE] = us; }
    __syncthreads();
    MoeTab M; M.t = t; M.total = t[64 + kE]; return M;
}
struct JobMoe1 {
    static constexpr bool GATHER = true;
    const char* A; unsigned lda2, ldb2, bhalf2; int K; const int* list;
    const char* B; const float* b_in; bf16_t* act; MoeTab M; int G, c;
    __device__ __forceinline__ bool next(int i, fg::Unit& u) const { int e, j, rb, cnt, rowbase; if (!M.decode(i, G, c, e, j, rb, cnt, rowbase)) return false;
        e = __builtin_amdgcn_readfirstlane(e); j = __builtin_amdgcn_readfirstlane(j); rb = __builtin_amdgcn_readfirstlane(rb); cnt = __builtin_amdgcn_readfirstlane(cnt); rowbase = __builtin_amdgcn_readfirstlane(rowbase);
        u.bBase = B + (size_t)e * ((size_t)kD * 2 * kDFF * 2) + (size_t)j * 256; u.arow0 = e * kT + rb * 256; u.nvalid = min(256, cnt - rb * 256); u.e = e; u.orow0 = rowbase + rb * 256; u.ocol0 = j * 128; u.acol2 = 0; return true; }
    __device__ __forceinline__ void epi(const f32x4 (&acc)[2][2][4][2], const fg::Unit& u, int wr, int wc, int fr, int fq) const {
        f32x4 bg[2], bl[2];
#pragma unroll
        for (int n = 0; n < 2; ++n) { const float* bp = b_in + (size_t)u.e * 2 * kDFF + u.ocol0 + wc * 32 + n * 16 + fq * 4; bg[n] = *(const f32x4*)bp; bl[n] = *(const f32x4*)(bp + kDFF); }
#pragma unroll
        FG_FOR_ROWS { bf16_t* rowp = act + (size_t)(u.orow0 + ai * 128 + wr * 64 + m * 16 + fr) * kDFF + u.ocol0 + wc * 32 + fq * 4;
#pragma unroll
            for (int n = 0; n < 2; ++n) { const f32x4 gv = acc[ai][0][m][n] + bg[n], lv = acc[ai][1][m][n] + bl[n]; float o[4];
#pragma unroll
                for (int j = 0; j < 4; ++j) { const float g = fminf(gv[j], 7.f), l = fminf(fmaxf(lv[j], -7.f), 7.f); o[j] = g * __builtin_amdgcn_rcpf(1.f + __expf(-1.702f * g)) * (l + 1.f); }
                u32x2 w; w.x = pk_bf16(o[0], o[1]); w.y = pk_bf16(o[2], o[3]); *(u32x2*)(rowp + n * 16) = w; } }
    }
};
struct JobMoe2 {
    static constexpr bool GATHER = false;
    const char* A; unsigned lda2, ldb2, bhalf2; int K; const int* list;
    const char* B; const float* b_out; bf16_t* yp; MoeTab M; int G, c;
    __device__ __forceinline__ bool next(int i, fg::Unit& u) const { int e, j, rb, cnt, rowbase; if (!M.decode(i, G, c, e, j, rb, cnt, rowbase)) return false;
        e = __builtin_amdgcn_readfirstlane(e); j = __builtin_amdgcn_readfirstlane(j); rb = __builtin_amdgcn_readfirstlane(rb); rowbase = __builtin_amdgcn_readfirstlane(rowbase);
        u.bBase = B + (size_t)e * ((size_t)kDFF * kD * 2) + (size_t)j * 512; u.arow0 = rowbase + rb * 256; u.nvalid = 256; u.e = e; u.orow0 = rowbase + rb * 256; u.ocol0 = j * 256; u.acol2 = 0; return true; }
    __device__ __forceinline__ void epi(const f32x4 (&acc)[2][2][4][2], const fg::Unit& u, int wr, int wc, int fr, int fq) const {
        f32x4 bo[2][2];
#pragma unroll
        for (int bj = 0; bj < 2; ++bj)
#pragma unroll
            for (int n = 0; n < 2; ++n) bo[bj][n] = *(const f32x4*)(b_out + (size_t)u.e * kD + u.ocol0 + bj * 128 + wc * 32 + n * 16 + fq * 4);
#pragma unroll
        FG_FOR_ROWS { bf16_t* rowp = yp + (size_t)(u.orow0 + ai * 128 + wr * 64 + m * 16 + fr) * kD + u.ocol0 + wc * 32 + fq * 4;
#pragma unroll
            for (int bj = 0; bj < 2; ++bj)
#pragma unroll
                for (int n = 0; n < 2; ++n) { const f32x4 v = acc[ai][bj][m][n] + bo[bj][n]; u32x2 w; w.x = pk_bf16(v[0], v[1]); w.y = pk_bf16(v[2], v[3]); *(u32x2*)(rowp + bj * 128 + n * 16) = w; } }
    }
};


__device__ __forceinline__ float wave_sum(float v) {
#pragma unroll
    for (int o = 32; o > 0; o >>= 1) v += __shfl_xor(v, o);
    return v; }
__device__ __forceinline__ float bflo(unsigned u) { return __uint_as_float(u << 16); }
__device__ __forceinline__ float bfhi(unsigned u) { return __uint_as_float(u & 0xFFFF0000u); }

namespace at {
typedef float f32x16 __attribute__((ext_vector_type(16)));
__device__ __forceinline__ unsigned off_b(unsigned row, unsigned ch) { return 256u * row + 16u * (ch ^ (((row & 3) << 2) | ((row >> 2) & 3))); }
constexpr float kC2 = 0.08838834764831845f * 1.4426950408889634f;
constexpr float kDoneThresh = 140.f;

__device__ __forceinline__ void attn_phase(LAS unsigned char* lds, const bf16_t* __restrict__ proj, const float* __restrict__ qw, const float* __restrict__ kw,
                                           bf16_t* __restrict__ cat, int G, int c) {
    const int tid = threadIdx.x, wid = __builtin_amdgcn_readfirstlane(tid >> 6), lane = tid & 63, ql = lane & 31, hf = lane >> 5;
    const unsigned ldsb = (unsigned)(uintptr_t)lds;
    const int skey = tid >> 4, sch = tid & 15;
    const unsigned X = ((ql & 3) << 2) | ((ql >> 2) & 3);
    const unsigned krow = 256u * ql, kY = 16u * (X ^ (unsigned)hf);
    const int tq = (lane & 15) >> 2, tp = lane & 3, blk = (lane >> 4) & 1;
    unsigned va[4][2];
#pragma unroll
    for (int cc = 0; cc < 4; ++cc)
#pragma unroll
        for (int t = 0; t < 2; ++t) va[cc][t] = 256u * (8 * t + 4 * hf + tq) + 16u * ((4 * cc + 2 * blk + (tp >> 1)) ^ ((tq << 2) | ((2 * t + hf) & 3))) + 8u * (tp & 1);
    for (int unit = c; unit < kB * kNH * 8; unit += G) {
        const int qb = unit & 7, bh = unit >> 3, h = bh & 7, b = bh >> 3;
        const int q0 = qb * 256, r0 = q0 + wid * 32;
        const bf16_t* base = proj + (size_t)(b * kS) * kNPROJ + h * kHD;
        LAS unsigned char* qlds = lds + 65536 + wid * 8192 + lane * 16;
        { u32x4 qr[8]; float ss = 0.f;
#pragma unroll
          for (int s = 0; s < 8; ++s) { qr[s] = *(const u32x4*)(base + (size_t)(r0 + ql) * kNPROJ + 16 * s + 8 * hf);
              const unsigned u[4] = {qr[s].x, qr[s].y, qr[s].z, qr[s].w};
#pragma unroll
              for (int e = 0; e < 4; ++e) { const float a = bflo(u[e]), bb = bfhi(u[e]); ss += a * a + bb * bb; } }
          ss += __shfl_xor(ss, 32);
          const float rq = rsqrtf(ss * (1.f / kHD) + kEPS) * kC2;
#pragma unroll
          for (int s = 0; s < 8; ++s) { const int d0 = 16 * s + 8 * hf;
              const f32x4 w0 = *(const f32x4*)(qw + d0) * *(const f32x4*)(kw + d0), w1 = *(const f32x4*)(qw + d0 + 4) * *(const f32x4*)(kw + d0 + 4);
              const unsigned u[4] = {qr[s].x, qr[s].y, qr[s].z, qr[s].w};
              u32x4 pk; pk.x = pk_bf16(bflo(u[0]) * rq * w0[0], bfhi(u[0]) * rq * w0[1]); pk.y = pk_bf16(bflo(u[1]) * rq * w0[2], bfhi(u[1]) * rq * w0[3]);
              pk.z = pk_bf16(bflo(u[2]) * rq * w1[0], bfhi(u[2]) * rq * w1[1]); pk.w = pk_bf16(bflo(u[3]) * rq * w1[2], bfhi(u[3]) * rq * w1[3]);
              *(LAS u32x4*)(qlds + 1024 * s) = pk; } }
        f32x16 o[4];
#pragma unroll
        for (int cc = 0; cc < 4; ++cc)
#pragma unroll
            for (int r = 0; r < 16; ++r) o[cc][r] = 0.f;
        float carry = 0.f; bool wactive = true;
        int jt = (q0 + 255) >> 6, cur = 0;
        u32x4 kr[2], vr[2];
#define AT_LOAD(jt_) do { _Pragma("unroll") for (int i = 0; i < 2; ++i) { const bf16_t* rp = base + (size_t)(64 * (jt_) + skey + 32 * i) * kNPROJ + sch * 8; \
            kr[i] = *(const u32x4*)(rp + kSB); vr[i] = *(const u32x4*)(rp + 2 * kSB); } } while (0)
        AT_LOAD(jt);
        for (;;) {
            LAS unsigned char* kbuf = lds + cur * 32768; LAS unsigned char* vbuf = kbuf + 16384;
#pragma unroll
            for (int i = 0; i < 2; ++i) { const unsigned u[4] = {kr[i].x, kr[i].y, kr[i].z, kr[i].w}; float f[8]; float ss = 0.f;
#pragma unroll
                for (int e = 0; e < 4; ++e) { f[2 * e] = bflo(u[e]); f[2 * e + 1] = bfhi(u[e]); ss += f[2 * e] * f[2 * e] + f[2 * e + 1] * f[2 * e + 1]; }
                ss += __shfl_xor(ss, 1); ss += __shfl_xor(ss, 2); ss += __shfl_xor(ss, 4); ss += __shfl_xor(ss, 8);
                const float rk = rsqrtf(ss * (1.f / kHD) + kEPS);
                u32x4 pk; pk.x = pk_bf16(f[0] * rk, f[1] * rk); pk.y = pk_bf16(f[2] * rk, f[3] * rk); pk.z = pk_bf16(f[4] * rk, f[5] * rk); pk.w = pk_bf16(f[6] * rk, f[7] * rk);
                const unsigned a = off_b(skey + 32 * i, sch);
                *(LAS u32x4*)(kbuf + a) = pk; *(LAS u32x4*)(vbuf + a) = vr[i]; }
            const int any = __syncthreads_or(wactive ? 1 : 0);
            if (!any) break;
            const int jtc = jt;
            if (jt > 0) AT_LOAD(jt - 1);
            if (wactive && 64 * jtc < r0 + 31) {
                f32x16 s0, s1;
#pragma unroll
                for (int r = 0; r < 16; ++r) { s0[r] = 0.f; s1[r] = 0.f; }
#pragma unroll
                for (int s = 0; s < 8; ++s) { const unsigned a = krow + ((32u * s) ^ kY);
                    const bf16x8 k0 = *(const LAS bf16x8*)(kbuf + a), k1 = *(const LAS bf16x8*)(kbuf + 8192 + a), qv = *(const LAS bf16x8*)(qlds + 1024 * s);
                    s0 = __builtin_amdgcn_mfma_f32_32x32x16_bf16(k0, qv, s0, 0, 0, 0); s1 = __builtin_amdgcn_mfma_f32_32x32x16_bf16(k1, qv, s1, 0, 0, 0); }
                const int tabs = r0 + ql, kbase0 = 64 * jtc + 4 * hf;
                float run = carry; u32x4 pfr[2][2];
#pragma unroll
                for (int kb = 1; kb >= 0; --kb) {
                    float sp[16], gp[4], T[4];
#pragma unroll
                    for (int r = 0; r < 16; ++r) { const float z = kb ? s1[r] : s0[r]; const int key = kbase0 + 32 * kb + 8 * (r >> 2) + (r & 3);
                        const float v = __builtin_amdgcn_logf(1.f + __builtin_amdgcn_exp2f(z)); sp[r] = key < tabs ? v : 0.f; }
#pragma unroll
                    for (int g = 0; g < 4; ++g) { const float gsum = (sp[4 * g] + sp[4 * g + 1]) + (sp[4 * g + 2] + sp[4 * g + 3]);
                        const auto sw = __builtin_amdgcn_permlane32_swap(__float_as_uint(gsum), __float_as_uint(gsum), false, false);
                        const float lo = __uint_as_float(sw[0]), hi = __uint_as_float(sw[1]);
                        T[g] = lo + hi; gp[g] = hf ? 0.f : hi; }
#pragma unroll
                    for (int g = 3; g >= 0; --g) { const float offs = run + gp[g];
                        const float c3 = offs + sp[4 * g + 3], c2 = c3 + sp[4 * g + 2], c1 = c2 + sp[4 * g + 1], c0 = c1 + sp[4 * g];
                        const float cs[4] = {c0, c1, c2, c3};
#pragma unroll
                        for (int i = 0; i < 4; ++i) { const int r = 4 * g + i; const float z = kb ? s1[r] : s0[r]; const int key = kbase0 + 32 * kb + 8 * g + i;
                            const float e = __builtin_amdgcn_exp2f(z - cs[i]); sp[r] = key < tabs ? e : 0.f; }
                        run += T[g]; }
#pragma unroll
                    for (int s2 = 0; s2 < 2; ++s2) { u32x4 pk; pk.x = pk_bf16(sp[8 * s2], sp[8 * s2 + 1]); pk.y = pk_bf16(sp[8 * s2 + 2], sp[8 * s2 + 3]);
                        pk.z = pk_bf16(sp[8 * s2 + 4], sp[8 * s2 + 5]); pk.w = pk_bf16(sp[8 * s2 + 6], sp[8 * s2 + 7]); pfr[kb][s2] = pk; }
                }
                carry = run;
                const unsigned vb0 = ldsb + (unsigned)cur * 32768u + 16384u;
#define AT_PV(cc) do { const unsigned a0 = vb0 + va[cc][0], a1 = vb0 + va[cc][1]; \
                    const s16x4 l00 = fg::tr_read<0>(a0), h00 = fg::tr_read<0>(a1), l01 = fg::tr_read<4096>(a0), h01 = fg::tr_read<4096>(a1); \
                    const s16x4 l10 = fg::tr_read<8192>(a0), h10 = fg::tr_read<8192>(a1), l11 = fg::tr_read<12288>(a0), h11 = fg::tr_read<12288>(a1); \
                    asm volatile("s_waitcnt lgkmcnt(0)" ::: "memory"); __builtin_amdgcn_sched_barrier(0); \
                    o[cc] = __builtin_amdgcn_mfma_f32_32x32x16_bf16(FG_PK(l00, h00), __builtin_bit_cast(bf16x8, pfr[0][0]), o[cc], 0, 0, 0); \
                    o[cc] = __builtin_amdgcn_mfma_f32_32x32x16_bf16(FG_PK(l01, h01), __builtin_bit_cast(bf16x8, pfr[0][1]), o[cc], 0, 0, 0); \
                    o[cc] = __builtin_amdgcn_mfma_f32_32x32x16_bf16(FG_PK(l10, h10), __builtin_bit_cast(bf16x8, pfr[1][0]), o[cc], 0, 0, 0); \
                    o[cc] = __builtin_amdgcn_mfma_f32_32x32x16_bf16(FG_PK(l11, h11), __builtin_bit_cast(bf16x8, pfr[1][1]), o[cc], 0, 0, 0); } while (0)
                AT_PV(0); AT_PV(1); AT_PV(2); AT_PV(3);
#undef AT_PV
                wactive = __any(carry <= kDoneThresh);
            }
            if (jt == 0) break;
            --jt; cur ^= 1;
        }
#undef AT_LOAD
        bf16_t* orow = cat + (size_t)(b * kS + r0 + ql) * kD + h * kHD + 4 * hf;
#pragma unroll
        for (int cc = 0; cc < 4; ++cc)
#pragma unroll
            for (int g = 0; g < 4; ++g) { u32x2 w; w.x = pk_bf16(o[cc][4 * g], o[cc][4 * g + 1]); w.y = pk_bf16(o[cc][4 * g + 2], o[cc][4 * g + 3]); *(u32x2*)(orow + 32 * cc + 8 * g) = w; }
        __syncthreads();
    }
}
}

__device__ __forceinline__ void pool_p_phase(const bf16_t* __restrict__ proj, bf16_t* __restrict__ p, int G, int c) {
    for (int idx = c * 512 + threadIdx.x; idx < kT * (kPW / 8); idx += G * 512) {
        const int c8 = idx & 127, t = idx >> 7, s = t & (kS - 1), g = c8 >> 5, w = 2 << g, cnt = min(s + 1, w);
        const bf16_t* up = proj + (size_t)t * kNPROJ + 3 * kSB + c8 * 8;
        u32x4 v[16];
#pragma unroll
        for (int i = 0; i < 16; ++i) v[i] = (i < cnt) ? *(const u32x4*)(up - (size_t)i * kNPROJ) : (u32x4){0u, 0u, 0u, 0u};
        float acc[8];
#pragma unroll
        for (int e = 0; e < 8; ++e) acc[e] = 0.f;
#pragma unroll
        for (int i = 0; i < 16; ++i) { acc[0] += bflo(v[i].x); acc[1] += bfhi(v[i].x); acc[2] += bflo(v[i].y); acc[3] += bfhi(v[i].y); acc[4] += bflo(v[i].z); acc[5] += bfhi(v[i].z); acc[6] += bflo(v[i].w); acc[7] += bfhi(v[i].w); }
        const float inv = 1.f / (float)cnt;
        const float u0[8] = {bflo(v[0].x), bfhi(v[0].x), bflo(v[0].y), bfhi(v[0].y), bflo(v[0].z), bfhi(v[0].z), bflo(v[0].w), bfhi(v[0].w)};
        u32x4 pk; pk.x = pk_bf16(acc[0] * inv - u0[0], acc[1] * inv - u0[1]); pk.y = pk_bf16(acc[2] * inv - u0[2], acc[3] * inv - u0[3]);
        pk.z = pk_bf16(acc[4] * inv - u0[4], acc[5] * inv - u0[5]); pk.w = pk_bf16(acc[6] * inv - u0[6], acc[7] * inv - u0[7]);
        *(u32x4*)(p + (size_t)t * kD + kSB + c8 * 8) = pk;
    }
}

__device__ __forceinline__ unsigned pk4_fp8(float a, float b, float c, float d) { int p = __builtin_amdgcn_cvt_pk_fp8_f32(a, b, 0, false); p = __builtin_amdgcn_cvt_pk_fp8_f32(c, d, p, true); return (unsigned)p; }
__device__ __forceinline__ float clamp448(float v) { return __builtin_amdgcn_fmed3f(v, -448.f, 448.f); }
constexpr float kWScale = 64.f;

struct JobMoe1F8 {
    static constexpr bool GATHER = true;
    const char* A; unsigned lda2, ldb2, bhalf2; int K; const int* list;
    const char* B; const float* b_in; unsigned char* act; MoeTab M; int G, c;
    __device__ __forceinline__ bool next(int i, fg::Unit& u) const { int e, j, rb, cnt, rowbase; if (!M.decode(i, G, c, e, j, rb, cnt, rowbase)) return false;
        e = __builtin_amdgcn_readfirstlane(e); j = __builtin_amdgcn_readfirstlane(j); rb = __builtin_amdgcn_readfirstlane(rb); cnt = __builtin_amdgcn_readfirstlane(cnt); rowbase = __builtin_amdgcn_readfirstlane(rowbase);
        u.bBase = B + (size_t)e * ((size_t)2 * kDFF * kD) + (size_t)j * 128 * kD; u.arow0 = e * kT + rb * 256; u.nvalid = min(256, cnt - rb * 256); u.e = e; u.orow0 = rowbase + rb * 256; u.ocol0 = j * 128; u.acol2 = 0; return true; }
    __device__ __forceinline__ void epi(const f32x4 (&acc)[2][2][4][2], const fg::Unit& u, int wr, int wc, int fr, int fq) const {
        f32x4 bg[2], bl[2];
#pragma unroll
        for (int n = 0; n < 2; ++n) { const float* bp = b_in + (size_t)u.e * 2 * kDFF + u.ocol0 + wc * 32 + n * 16 + fq * 4; bg[n] = *(const f32x4*)bp; bl[n] = *(const f32x4*)(bp + kDFF); }
#pragma unroll
        FG_FOR_ROWS { unsigned char* rowp = act + (size_t)(u.orow0 + ai * 128 + wr * 64 + m * 16 + fr) * kDFF + u.ocol0 + wc * 32 + fq * 4;
#pragma unroll
            for (int n = 0; n < 2; ++n) { const f32x4 gv = acc[ai][0][m][n] + bg[n], lv = acc[ai][1][m][n] + bl[n]; float o[4];
#pragma unroll
                for (int j = 0; j < 4; ++j) { const float g = fminf(gv[j], 7.f), l = fminf(fmaxf(lv[j], -7.f), 7.f); o[j] = clamp448(g * __builtin_amdgcn_rcpf(1.f + __expf(-1.702f * g)) * (l + 1.f)); }
                *(unsigned*)(rowp + n * 16) = pk4_fp8(o[0], o[1], o[2], o[3]); } }
    }
};
struct JobMoe2F8 {
    static constexpr bool GATHER = false;
    const char* A; unsigned lda2, ldb2, bhalf2; int K; const int* list;
    const char* B; const float* b_out; unsigned char* yp; MoeTab M; int G, c;
    __device__ __forceinline__ bool next(int i, fg::Unit& u) const { int e, j, rb, cnt, rowbase; if (!M.decode(i, G, c, e, j, rb, cnt, rowbase)) return false;
        e = __builtin_amdgcn_readfirstlane(e); j = __builtin_amdgcn_readfirstlane(j); rb = __builtin_amdgcn_readfirstlane(rb); rowbase = __builtin_amdgcn_readfirstlane(rowbase);
        u.bBase = B + (size_t)e * ((size_t)kDFF * kD) + (size_t)j * 256 * kDFF; u.arow0 = rowbase + rb * 256; u.nvalid = 256; u.e = e; u.orow0 = rowbase + rb * 256; u.ocol0 = j * 256; u.acol2 = 0; return true; }
    __device__ __forceinline__ void epi(const f32x4 (&acc)[2][2][4][2], const fg::Unit& u, int wr, int wc, int fr, int fq) const {
        f32x4 bo[2][2];
#pragma unroll
        for (int bj = 0; bj < 2; ++bj)
#pragma unroll
            for (int n = 0; n < 2; ++n) bo[bj][n] = *(const f32x4*)(b_out + (size_t)u.e * kD + u.ocol0 + bj * 128 + wc * 32 + n * 16 + fq * 4);
#pragma unroll
        FG_FOR_ROWS { unsigned char* rowp = yp + (size_t)(u.orow0 + ai * 128 + wr * 64 + m * 16 + fr) * kD + u.ocol0 + wc * 32 + fq * 4;
#pragma unroll
            for (int bj = 0; bj < 2; ++bj)
#pragma unroll
                for (int n = 0; n < 2; ++n) { const f32x4 v = acc[ai][bj][m][n] + bo[bj][n]; *(unsigned*)(rowp + bj * 128 + n * 16) = pk4_fp8(clamp448(v[0]), clamp448(v[1]), clamp448(v[2]), clamp448(v[3])); } }
    }
};

struct CvtT { const float* src; unsigned char* dst; int K, N, tn, per; };
__device__ __forceinline__ CvtT cvt_make(const float* src, unsigned char* dst, int K, int N) { CvtT c; c.src = src; c.dst = dst; c.K = K; c.N = N; c.tn = N / 64; c.per = (K / 128) * (N / 64); return c; }
__device__ __forceinline__ void cvt_load(const CvtT& C, int t, int kq, int nc, f32x4 (&v)[4]) {
    const int mat = t / C.per, r = t - mat * C.per, kt = r / C.tn, nt_ = r - kt * C.tn;
    const float* sp = C.src + (size_t)mat * C.K * C.N + (size_t)(kt * 128 + 4 * kq) * C.N + nt_ * 64 + 4 * nc;
#pragma unroll
    for (int i = 0; i < 4; ++i) v[i] = __builtin_nontemporal_load((const f32x4*)(sp + (size_t)i * C.N));
}
__device__ __forceinline__ void cvt_emit(const CvtT& C, int t, LAS unsigned* L, const f32x4 (&v)[4], int kq, int nc, int rn, int rc) {
#pragma unroll
    for (int j = 0; j < 4; ++j) L[(4 * nc + j) * 33 + kq] = pk4_fp8(v[0][j] * kWScale, v[1][j] * kWScale, v[2][j] * kWScale, v[3][j] * kWScale);
    __syncthreads();
    const int mat = t / C.per, r = t - mat * C.per, kt = r / C.tn, nt_ = r - kt * C.tn;
    u32x4 o; o.x = L[rn * 33 + 4 * rc]; o.y = L[rn * 33 + 4 * rc + 1]; o.z = L[rn * 33 + 4 * rc + 2]; o.w = L[rn * 33 + 4 * rc + 3];
    __builtin_nontemporal_store(o, (u32x4*)(C.dst + (size_t)mat * C.K * C.N + (size_t)(nt_ * 64 + rn) * C.K + kt * 128 + rc * 16));
}
__device__ __forceinline__ void convert_t_f8(LAS unsigned char* lds, const CvtT C, int t0, int t1, int stride) {
    const int tid = threadIdx.x, kq = tid >> 4, nc = tid & 15, rn = tid >> 3, rc = tid & 7;
    f32x4 v0[4], v1[4], vn[4];
    __syncthreads();
    if (t0 < t1) cvt_load(C, t0, kq, nc, v0);
    if (t0 + stride < t1) cvt_load(C, t0 + stride, kq, nc, v1);
    int i = 0;
#pragma unroll 1
    for (int t = t0; t < t1; t += stride, ++i) {
        if (t + 2 * stride < t1) cvt_load(C, t + 2 * stride, kq, nc, vn);
        cvt_emit(C, t, (LAS unsigned*)(lds + (i & 1) * 8704), v0, kq, nc, rn, rc);
#pragma unroll
        for (int j = 0; j < 4; ++j) { v0[j] = v1[j]; v1[j] = vn[j]; }
    }
    __syncthreads();
}
__device__ __forceinline__ void convert_dyn(LAS unsigned char* lds, const CvtT C, unsigned* qctr, int dbase, int dend) {
    LAS int* bx = (LAS int*)(lds + 2 * 8704);
#pragma unroll 1
    for (;;) {
        __syncthreads();
        if (threadIdx.x == 0) bx[0] = dbase + (int)atomicAdd(qctr, 8u);
        __syncthreads();
        const int t0 = bx[0];
        if (t0 >= dend) break;
        convert_t_f8(lds, C, t0, min(t0 + 8, dend), 1);
    }
}

__device__ __forceinline__ void convert_seg(const float* __restrict__ src, bf16_t* __restrict__ dst, size_t n8, size_t gtid, size_t gstride) {
    const f32x4* s4 = (const f32x4*)src; u32x4* d4 = (u32x4*)dst;
#pragma unroll 4
    for (size_t i = gtid; i < n8; i += gstride) { const f32x4 a = __builtin_nontemporal_load(s4 + 2 * i), b = __builtin_nontemporal_load(s4 + 2 * i + 1);
        u32x4 w; w.x = pk_bf16(a[0], a[1]); w.y = pk_bf16(a[2], a[3]); w.z = pk_bf16(b[0], b[1]); w.w = pk_bf16(b[2], b[3]); d4[i] = w; }
}


#define XB_TMO      128
#define XB_XCNT(j)  (256  + 64 * (j))
#define XB_XSUB(j)  (1280 + 64 * (j))
#define XB_XGEN(j)  (2304 + 64 * (j))
#define XB_TOP      3328
#define XB_TOPGEN   3392
#define XCD_BAR_WORDS 3456
#define XB_SPIN_CAP (1u << 18)
__device__ __forceinline__ unsigned xb_ld(unsigned* p)              { return __hip_atomic_load(p, __ATOMIC_RELAXED, __HIP_MEMORY_SCOPE_AGENT); }
__device__ __forceinline__ unsigned xb_add(unsigned* p, unsigned v) { return __hip_atomic_fetch_add(p, v, __ATOMIC_RELAXED, __HIP_MEMORY_SCOPE_AGENT); }
__device__ __forceinline__ unsigned xb_xcc_id() { return (unsigned)__builtin_amdgcn_s_getreg((3 << 11) | 20) & 0xFu; }
#define XB_SPIN(cond, bar) do { unsigned _sp = 0; while (cond) { __builtin_amdgcn_s_sleep(1); \
    if ((++_sp & 255u) == 0u) { if (xb_ld(&(bar)[XB_TMO])) break; if (_sp > XB_SPIN_CAP) { atomicAdd(&(bar)[XB_TMO], 1u); break; } } } } while (0)
struct XcdBarrier { unsigned* bar; unsigned x; volatile LAS unsigned* st; };
__device__ __forceinline__ XcdBarrier xcd_barrier_post(unsigned* bar, volatile LAS unsigned* st) {
    XcdBarrier b; b.bar = bar; b.x = xb_xcc_id(); b.st = st;
    if (threadIdx.x == 0) (void)xb_add(&bar[XB_XCNT(b.x)], 1u);
    return b;
}
__device__ __forceinline__ void xcd_barrier_complete(unsigned* bar, unsigned x, unsigned& nloc, unsigned& nx) {
    const unsigned G = gridDim.x * gridDim.y * gridDim.z;
    unsigned sum, cnt, mine, sp = 0u;
    for (;;) {
        sum = 0u; cnt = 0u; mine = 0u;
#pragma unroll
        for (unsigned j = 0; j < 16; ++j) { const unsigned c = xb_ld(&bar[XB_XCNT(j)]); sum += c; cnt += (c > 0u) ? 1u : 0u; mine = (j == x) ? c : mine; }
        if (sum == G) break;
        __builtin_amdgcn_s_sleep(1);
        if ((++sp & 255u) == 0u) { if (xb_ld(&bar[XB_TMO])) break; if (sp > XB_SPIN_CAP) { atomicAdd(&bar[XB_TMO], 1u); break; } }
    }
    nloc = mine > 0u ? mine : 1u; nx = cnt > 0u ? cnt : 1u;
}
__device__ __forceinline__ void xcd_barrier(const XcdBarrier& b) {
    asm volatile("s_waitcnt vmcnt(0)" ::: "memory");
    __syncthreads();
    if (threadIdx.x == 0) {
        unsigned* bar = b.bar;
        __builtin_amdgcn_s_waitcnt(0);
        unsigned nloc = b.st[0], nx = b.st[1];
        if (nloc == 0u) { xcd_barrier_complete(bar, b.x, nloc, nx); b.st[0] = nloc; b.st[1] = nx; }
        const unsigned old = xb_add(&bar[XB_XSUB(b.x)], 1u);
        const unsigned gen = old / nloc;
        if (old + 1u == (gen + 1u) * nloc) {
            __builtin_amdgcn_fence(__ATOMIC_RELEASE, "agent");
            asm volatile("s_waitcnt vmcnt(0)" ::: "memory");
            const unsigned og = xb_add(&bar[XB_TOP], 1u);
            const unsigned tg = og / nx;
            if (og + 1u == (tg + 1u) * nx) xb_add(&bar[XB_TOPGEN], 1u);
            else XB_SPIN(xb_ld(&bar[XB_TOPGEN]) == tg, bar);
            __builtin_amdgcn_fence(__ATOMIC_ACQUIRE, "agent");
            xb_add(&bar[XB_XGEN(b.x)], 1u);
            asm volatile("s_waitcnt vmcnt(0)" ::: "memory");
        } else {
            XB_SPIN(xb_ld(&bar[XB_XGEN(b.x)]) == gen, bar);
            __builtin_amdgcn_fence(__ATOMIC_ACQUIRE, "agent");
            asm volatile("s_waitcnt vmcnt(0)" ::: "memory");
        }
    }
    __syncthreads();
}

__device__ __forceinline__ void ada_phase(LAS unsigned char* lds, const float* __restrict__ cvec, const float* __restrict__ w_ada, const float* __restrict__ b_ada, float* __restrict__ mod, int G, int c) {
    LAS float* ca = (LAS float*)lds;
    LAS float* part = (LAS float*)(lds + 32768);
    const int tid = threadIdx.x;
    __syncthreads();
    for (int i = tid; i < kB * kD; i += 512) { const float v = cvec[i]; ca[i] = v / (1.f + __expf(-v)); }
    __syncthreads();
    for (int cb = c; cb < 6 * kD / 48; cb += G) {
        const int n0 = cb * 48, cg = tid % 12, kr = tid / 12;
        if (tid < 504) {
            f32x4 a0 = {0.f, 0.f, 0.f, 0.f}, a1 = a0, a2 = a0, a3 = a0;
#pragma unroll 8
            for (int k = kr; k < kD; k += 42) { const f32x4 w = __builtin_nontemporal_load((const f32x4*)(w_ada + (size_t)k * (6 * kD) + n0 + cg * 4));
                a0 += ca[k] * w; a1 += ca[kD + k] * w; a2 += ca[2 * kD + k] * w; a3 += ca[3 * kD + k] * w; }
            LAS f32x4* pp = (LAS f32x4*)(part + (kr * 12 + cg) * 16); pp[0] = a0; pp[1] = a1; pp[2] = a2; pp[3] = a3;
        }
        __syncthreads();
        if (tid < 192) { const int col = tid % 48, b = tid / 48; float sum = 0.f;
            for (int r = 0; r < 42; ++r) sum += part[(r * 12 + (col >> 2)) * 16 + b * 4 + (col & 3)];
            mod[b * 6 * kD + n0 + col] = sum + b_ada[n0 + col]; }
        __syncthreads();
    }
}

__device__ __forceinline__ void norm1_phase(const float* __restrict__ x, const float* __restrict__ nw, const float* __restrict__ mod, bf16_t* __restrict__ out, int G, int c) {
    const int wid = threadIdx.x >> 6, lane = threadIdx.x & 63;
    for (int t = c * 8 + wid; t < kT; t += G * 8) {
        const int b = t / kS; const float* xr = x + (size_t)t * kD + lane * 4; const float* mb = mod + b * 6 * kD + lane * 4;
        f32x4 v[8]; float ss = 0.f;
#pragma unroll
        for (int j = 0; j < 8; ++j) { v[j] = *(const f32x4*)(xr + 256 * j); ss += v[j][0] * v[j][0] + v[j][1] * v[j][1] + v[j][2] * v[j][2] + v[j][3] * v[j][3]; }
        ss = wave_sum(ss);
        const float r = rsqrtf(ss * (1.f / kD) + kEPS);
#pragma unroll
        for (int j = 0; j < 8; ++j) { const f32x4 w = *(const f32x4*)(nw + lane * 4 + 256 * j), sh = *(const f32x4*)(mb + 256 * j), sc = *(const f32x4*)(mb + kD + 256 * j);
            const f32x4 y = v[j] * r * w * (1.f + sc) + sh; u32x2 o; o.x = pk_bf16(y[0], y[1]); o.y = pk_bf16(y[2], y[3]);
            *(u32x2*)(out + (size_t)t * kD + lane * 4 + 256 * j) = o; }
    }
}

__device__ __forceinline__ void split_bf16(const float (&v)[8], bf16x8& hi, bf16x8& lo) {
    u32x4 h, l;
#pragma unroll
    for (int i = 0; i < 4; ++i) { const unsigned hp = pk_bf16(v[2 * i], v[2 * i + 1]); h[i] = hp; l[i] = pk_bf16(v[2 * i] - bflo(hp), v[2 * i + 1] - bfhi(hp)); }
    hi = __builtin_bit_cast(bf16x8, h); lo = __builtin_bit_cast(bf16x8, l);
}
__device__ __forceinline__ void norm2_router_phase(LAS unsigned char* lds, const bf16_t* __restrict__ x1, const float* __restrict__ nw, const float* __restrict__ mod,
                                                   const float* __restrict__ w_router, const float* __restrict__ b_router, unsigned char* __restrict__ h2,
                                                   float* __restrict__ gates, int* __restrict__ pair_e, int* __restrict__ pair_p, int* __restrict__ list, unsigned* __restrict__ ctrl, int G, int c) {
    typedef float f32x16 __attribute__((ext_vector_type(16)));
    const int tid = threadIdx.x, wid = __builtin_amdgcn_readfirstlane(tid >> 6), lane = tid & 63, ql = lane & 31, hf = lane >> 5;
    LAS float* part = (LAS float*)lds;
    LAS float* rsL = (LAS float*)(lds + 32768);
    LAS int* lcnt = (LAS int*)(lds + fg::MISC_OFF + 64);
    for (int blk = c; blk < kT / 32; blk += G) {
        const int t0 = blk * 32, b = t0 / kS;
        __syncthreads();
        if (tid < 32) lcnt[tid] = 0;
#pragma unroll
        for (int rr = 0; rr < 4; ++rr) { const bf16_t* xr = x1 + (size_t)(t0 + 4 * wid + rr) * kD + 8 * lane; float ss = 0.f;
#pragma unroll
            for (int j = 0; j < 4; ++j) { const u32x4 v = *(const u32x4*)(xr + 512 * j);
#pragma unroll
                for (int q = 0; q < 4; ++q) { const float lo_ = bflo(v[q]), hi_ = bfhi(v[q]); ss += lo_ * lo_ + hi_ * hi_; } }
            ss = wave_sum(ss); if (lane == 0) rsL[4 * wid + rr] = rsqrtf(ss * (1.f / kD) + kEPS); }
        __syncthreads();
        const float rq = rsL[ql];
        f32x16 acc;
#pragma unroll
        for (int r = 0; r < 16; ++r) acc[r] = 0.f;
        const bf16_t* xrow = x1 + (size_t)(t0 + ql) * kD + 256 * wid + 8 * hf;
        const float* mrow = mod + b * 6 * kD + 256 * wid + 8 * hf;
        unsigned char* hrow = h2 + (size_t)(t0 + ql) * kD + 256 * wid + 8 * hf;
        const float* wrow = w_router + (size_t)(256 * wid + 8 * hf) * kE + ql;
#pragma unroll 4
        for (int s = 0; s < 16; ++s) {
            const u32x4 xq = *(const u32x4*)(xrow + 16 * s); const f32x4 xa = {bflo(xq.x), bfhi(xq.x), bflo(xq.y), bfhi(xq.y)}, xb = {bflo(xq.z), bfhi(xq.z), bflo(xq.w), bfhi(xq.w)};
            const f32x4 wa = *(const f32x4*)(nw + 256 * wid + 8 * hf + 16 * s), wb = *(const f32x4*)(nw + 256 * wid + 8 * hf + 16 * s + 4);
            const f32x4 sha = *(const f32x4*)(mrow + 3 * kD + 16 * s), shb = *(const f32x4*)(mrow + 3 * kD + 16 * s + 4);
            const f32x4 sca = *(const f32x4*)(mrow + 4 * kD + 16 * s), scb = *(const f32x4*)(mrow + 4 * kD + 16 * s + 4);
            const f32x4 ya = xa * rq * wa * (1.f + sca) + sha, yb = xb * rq * wb * (1.f + scb) + shb;
            const float y[8] = {ya[0], ya[1], ya[2], ya[3], yb[0], yb[1], yb[2], yb[3]};
            u32x2 hq; hq.x = pk4_fp8(clamp448(y[0]), clamp448(y[1]), clamp448(y[2]), clamp448(y[3])); hq.y = pk4_fp8(clamp448(y[4]), clamp448(y[5]), clamp448(y[6]), clamp448(y[7]));
            *(u32x2*)(hrow + 16 * s) = hq;
            float wv[8];
#pragma unroll
            for (int j = 0; j < 8; ++j) wv[j] = wrow[(size_t)(16 * s + j) * kE];
            bf16x8 yh, yl, wh, wl; split_bf16(y, yh, yl); split_bf16(wv, wh, wl);
            acc = __builtin_amdgcn_mfma_f32_32x32x16_bf16(yh, wh, acc, 0, 0, 0);
            acc = __builtin_amdgcn_mfma_f32_32x32x16_bf16(yl, wh, acc, 0, 0, 0);
            acc = __builtin_amdgcn_mfma_f32_32x32x16_bf16(yh, wl, acc, 0, 0, 0);
        }
#pragma unroll
        for (int r = 0; r < 16; ++r) part[(wid * 32 + (r & 3) + 8 * (r >> 2) + 4 * hf) * 32 + ql] = acc[r];
        __syncthreads();
#pragma unroll
        for (int rr = 0; rr < 4; ++rr) {
            const int tok = 4 * wid + rr;
            float v1 = 0.f;
#pragma unroll
            for (int w8 = 0; w8 < 8; ++w8) v1 += part[(w8 * 32 + tok) * 32 + ql];
            float mine = hf ? -3.4e38f : v1 + b_router[ql];
            int idx[4]; float val[4];
#pragma unroll
            for (int k = 0; k < 4; ++k) { float bv = mine; int bi = ql + (hf << 6);
#pragma unroll
                for (int o = 32; o > 0; o >>= 1) { const float ov = __shfl_xor(bv, o); const int oi = __shfl_xor(bi, o); if (ov > bv || (ov == bv && oi < bi)) { bv = ov; bi = oi; } }
                idx[k] = bi; val[k] = bv; if (!hf && ql == bi) mine = -3.4e38f; }
            if (lane == 0) { const int t = t0 + tok; float ex[4], sum = 0.f;
#pragma unroll
                for (int k = 0; k < 4; ++k) { ex[k] = __expf(val[k] - val[0]); sum += ex[k]; }
                const float inv = 1.f / sum;
#pragma unroll
                for (int k = 0; k < 4; ++k) { gates[t * 4 + k] = ex[k] * inv; lcnt[64 + tok * 4 + k] = idx[k]; lcnt[192 + tok * 4 + k] = __hip_atomic_fetch_add(&lcnt[idx[k]], 1, __ATOMIC_RELAXED, __HIP_MEMORY_SCOPE_WORKGROUP); } }
        }
        __syncthreads();
        if (tid < 32) { const int n = lcnt[tid]; lcnt[32 + tid] = n > 0 ? (int)atomicAdd(&ctrl[CT_CNT + 64 * tid], (unsigned)n) : 0; }
        __syncthreads();
        if (tid < 128) { const int e = lcnt[64 + tid], pos = lcnt[32 + e] + lcnt[192 + tid], t = blk * 32 + (tid >> 2);
            pair_e[t * 4 + (tid & 3)] = e; pair_p[t * 4 + (tid & 3)] = pos; list[(size_t)e * kT + pos] = t; }
    }
}

__device__ __forceinline__ void final_phase(const bf16_t* __restrict__ x1, const float* __restrict__ mod, const float* __restrict__ gates, const int* __restrict__ pair_e, const int* __restrict__ pair_p,
                                            const MoeTab M, const unsigned char* __restrict__ yp, float* __restrict__ out, int G, int c) {
    const int wid = threadIdx.x >> 6, lane = threadIdx.x & 63;
    for (int t = c * 8 + wid; t < kT; t += G * 8) {
        const int b = t / kS; float gk[4]; const unsigned char* rp[4];
#pragma unroll
        for (int k = 0; k < 4; ++k) { gk[k] = gates[t * 4 + k]; const int e = pair_e[t * 4 + k];
            rp[k] = yp + (size_t)(M.t[32 + e] + pair_p[t * 4 + k]) * kD + lane * 8; }
#pragma unroll
        for (int j = 0; j < 4; ++j) { f32x4 y0 = {0.f, 0.f, 0.f, 0.f}, y1 = y0;
#pragma unroll
            for (int k = 0; k < 4; ++k) { const u32x2 v = *(const u32x2*)(rp[k] + 512 * j);
                const f32x2 a0 = __builtin_amdgcn_cvt_pk_f32_fp8((int)v.x, false), a1 = __builtin_amdgcn_cvt_pk_f32_fp8((int)v.x, true), a2 = __builtin_amdgcn_cvt_pk_f32_fp8((int)v.y, false), a3 = __builtin_amdgcn_cvt_pk_f32_fp8((int)v.y, true);
                y0 += gk[k] * (f32x4){a0[0], a0[1], a1[0], a1[1]}; y1 += gk[k] * (f32x4){a2[0], a2[1], a3[0], a3[1]}; }
            const size_t o = (size_t)t * kD + lane * 8 + 512 * j; const float* gp = mod + b * 6 * kD + 5 * kD + lane * 8 + 512 * j;
            const u32x4 xq = *(const u32x4*)(x1 + o); const f32x4 xa = {bflo(xq.x), bfhi(xq.x), bflo(xq.y), bfhi(xq.y)}, xb = {bflo(xq.z), bfhi(xq.z), bflo(xq.w), bfhi(xq.w)};
            *(f32x4*)(out + o) = xa + *(const f32x4*)gp * y0; *(f32x4*)(out + o + 4) = xb + *(const f32x4*)(gp + 4) * y1; }
    }
}

struct MegaArgs { const float* in[18]; float* out; unsigned char* ws; int ph_lo, ph_hi; };
constexpr int NPHASE = 10;
__global__ void __launch_bounds__(512, 2) mega(MegaArgs a) {
    extern __shared__ __attribute__((aligned(16))) unsigned char lds_raw[];
    LAS unsigned char* lds = (LAS unsigned char*)lds_raw;
    unsigned char* ws = a.ws;
    const int lo = a.ph_lo, hi = a.ph_hi;
#define IN(k) (lo <= (k) && (k) < hi)
#define SEAM(k) do { if (IN(k) && IN((k) + 1)) xcd_barrier(bar); } while (0)
    const int G = gridDim.x, c = blockIdx.x;
    unsigned* ctrl = (unsigned*)(ws + WS_CTRL);
    const int grp = (c >> 3) & 1, cpr = ((c >> 4) << 3) | (c & 7);
#define HOST_PRE(CC, r0, n)  do { if (grp == 0) convert_t_f8(lds, CC, (r0) + cpr, (r0) + (G / 2) * (n), G / 2); } while (0)
#define HOST_POST(CC, r0, n, q) convert_dyn(lds, CC, ctrl + CT_Q + 64 * (q), (r0) + (G / 2) * (n), (r0) + G * (n))
    const int r_p2 = 0, r_p3 = 56 * G, r_p5 = 84 * G, r_p6 = 92 * G;
    const CvtT C1 = cvt_make(a.in[14], (unsigned char*)(ws + WS_WE1), kD, 2 * kDFF);
    const CvtT C2 = cvt_make(a.in[16], (unsigned char*)(ws + WS_WE2), kDFF, kD);
    if (threadIdx.x == 0) *(LAS u32x4*)(lds + fg::MISC_OFF) = (u32x4){0u, 0u, 0u, 0u};
    __syncthreads();
    XcdBarrier bar; bar.bar = ctrl; bar.x = 0; bar.st = (volatile LAS unsigned*)(lds + fg::MISC_OFF);
    if (hi - lo > 1) bar = xcd_barrier_post(ctrl, (volatile LAS unsigned*)(lds + fg::MISC_OFF));
    float* mod = (float*)(ws + WS_MOD);
    if (IN(0)) {
        ada_phase(lds, a.in[1], a.in[4], a.in[5], mod, G, c);
        const size_t gtid = (size_t)blockIdx.x * 512 + threadIdx.x, gstride = (size_t)G * 512;
        convert_seg(a.in[6], (bf16_t*)(ws + WS_WIN), (size_t)kD * kNPROJ / 8, gtid, gstride);
        convert_seg(a.in[11], (bf16_t*)(ws + WS_WO), (size_t)kSB * kD / 8, gtid, gstride);
        convert_seg(a.in[11] + (size_t)kSB * kD, (bf16_t*)(ws + WS_P), (size_t)kPW * kD / 8, gtid, gstride);
        { const f32x4* s4 = (const f32x4*)a.in[9]; const f32x4* sc4 = (const f32x4*)a.in[10]; u32x4* d4 = (u32x4*)(ws + WS_WPL);
          for (size_t i = gtid; i < (size_t)4 * kPG * kPG / 8; i += gstride) { const int g = (int)(i >> 13), n8 = (int)(i & 31);
              const f32x4 sa = sc4[g * 64 + n8 * 2], sb = sc4[g * 64 + n8 * 2 + 1]; const f32x4 a0 = s4[2 * i] * sa, b0 = s4[2 * i + 1] * sb;
              u32x4 w; w.x = pk_bf16(a0[0], a0[1]); w.y = pk_bf16(a0[2], a0[3]); w.z = pk_bf16(b0[0], b0[1]); w.w = pk_bf16(b0[2], b0[3]); d4[i] = w; } }
    }
    SEAM(0);
    if (IN(1)) norm1_phase(a.in[0], a.in[2], mod, (bf16_t*)(ws + WS_H), G, c);
    SEAM(1);
    if (IN(2)) HOST_PRE(C1, r_p2, 56);
    if (IN(2)) { JobInProj J; J.A = (const char*)(ws + WS_H); J.lda2 = kD * 2; J.ldb2 = kNPROJ * 2; J.bhalf2 = 256; J.K = kD; J.list = nullptr;
        J.B = (const char*)(ws + WS_WIN); J.out = (bf16_t*)(ws + WS_PROJ); J.S.init(kT, kNPROJ, G, c); fg::gemm_phase(lds, J); }
    if (IN(2)) { JobPoolFold J; J.A = (const char*)(ws + WS_WPL); J.lda2 = kPG * 2; J.ldb2 = kD * 2; J.bhalf2 = 256; J.K = kPG; J.list = nullptr;
        J.B = (const char*)(ws + WS_P); J.wo = (bf16_t*)(ws + WS_WO); J.G = G; J.c = c; fg::gemm_phase(lds, J); }
    if (IN(2)) HOST_POST(C1, r_p2, 56, 0);
    SEAM(2);
    if (IN(3)) HOST_PRE(C1, r_p3, 28);
    if (IN(3)) { at::attn_phase(lds, (const bf16_t*)(ws + WS_PROJ), a.in[7], a.in[8], (bf16_t*)(ws + WS_CAT), G, c);
        pool_p_phase((const bf16_t*)(ws + WS_PROJ), (bf16_t*)(ws + WS_CAT), G, c); }
    if (IN(3)) HOST_POST(C1, r_p3, 28, 1);
    SEAM(3);
    if (IN(5)) HOST_PRE(C1, r_p5, 8);
    if (IN(5)) { JobOutProj J; J.A = (const char*)(ws + WS_CAT); J.lda2 = kD * 2; J.ldb2 = kD * 2; J.bhalf2 = 256; J.K = kD; J.list = nullptr;
        J.B = (const char*)(ws + WS_WO); J.x = a.in[0]; J.mod = mod; J.x1 = (bf16_t*)(ws + WS_X1); J.S.init(kT, kD, G, c); fg::gemm_phase(lds, J); }
    if (IN(5)) HOST_POST(C1, r_p5, 8, 2);
    SEAM(5);
    if (IN(6)) HOST_PRE(C1, r_p6, 36);
    if (IN(6)) norm2_router_phase(lds, (const bf16_t*)(ws + WS_X1), a.in[3], mod, a.in[12], a.in[13], (unsigned char*)(ws + WS_H2), (float*)(ws + WS_GATES), (int*)(ws + WS_PAIRE), (int*)(ws + WS_PAIRP),
                                  (int*)(ws + WS_LIST), ctrl, G, c);
    if (IN(6)) HOST_POST(C1, r_p6, 36, 3);
    SEAM(6);
    if (IN(7)) HOST_PRE(C2, 0, 64);
    if (IN(7)) { JobMoe1F8 J; J.A = (const char*)(ws + WS_H2); J.lda2 = kD; J.ldb2 = kD; J.bhalf2 = (unsigned)kDFF * kD; J.K = kD; J.list = (const int*)(ws + WS_LIST);
        J.B = (const char*)(ws + WS_WE1); J.b_in = a.in[15]; J.act = (unsigned char*)(ws + WS_ACT); J.M = moe_tables(lds, ctrl, kDFF / 128); J.G = G; J.c = c; fg::gemm_phase_f8(lds, J); }
    if (IN(7)) HOST_POST(C2, 0, 64, 4);
    SEAM(7);
    if (IN(8)) { JobMoe2F8 J; J.A = (const char*)(ws + WS_ACT); J.lda2 = kDFF; J.ldb2 = kDFF; J.bhalf2 = 128u * kDFF; J.K = kDFF; J.list = nullptr;
        J.B = (const char*)(ws + WS_WE2); J.b_out = a.in[17]; J.yp = (unsigned char*)(ws + WS_YP); J.M = moe_tables(lds, ctrl, kD / 256); J.G = G; J.c = c; fg::gemm_phase_f8(lds, J); }
    SEAM(8);
    if (IN(9)) final_phase((const bf16_t*)(ws + WS_X1), mod, (const float*)(ws + WS_GATES), (const int*)(ws + WS_PAIRE), (const int*)(ws + WS_PAIRP), moe_tables(lds, ctrl, 1), (const unsigned char*)(ws + WS_YP), a.out, G, c);
#undef IN
#undef SEAM
}

#ifndef N_LAUNCHES
#define N_LAUNCHES 1
#endif
extern "C" void kernel_launch(void* const* d_in, const int* in_sizes, int n_in, void* d_out, int out_size, void* d_ws, size_t ws_size, hipStream_t stream) {
    static int grid = 0;
    if (grid == 0) {
        int dev = 0, cus = 0;
        (void)hipGetDevice(&dev); (void)hipDeviceGetAttribute(&cus, hipDeviceAttributeMultiprocessorCount, dev);
        (void)hipFuncSetAttribute((const void*)mega, hipFuncAttributeMaxDynamicSharedMemorySize, fg::LDS_BYTES);
        (void)cus; grid = 256;
    }
    MegaArgs a{}; for (int i = 0; i < 18; ++i) a.in[i] = (const float*)d_in[i]; a.out = (float*)d_out; a.ws = (unsigned char*)d_ws;
    (void)hipMemsetAsync((char*)d_ws + WS_CTRL, 0, 65536, stream);
    if (N_LAUNCHES == 1) { a.ph_lo = 0; a.ph_hi = NPHASE; hipLaunchKernelGGL(mega, dim3(grid), dim3(512), fg::LDS_BYTES, stream, a); }
    else for (int p = 0; p < NPHASE; ++p) { a.ph_lo = p; a.ph_hi = p + 1; hipLaunchKernelGGL(mega, dim3(grid), dim3(512), fg::LDS_BYTES, stream, a); }
}
```

```cpp
#include <hip/hip_runtime.h>
#include <stdint.h>

constexpr int kB = 4, kS = 2048, kD = 2048, kT = kB * kS;
constexpr int kHD = 128, kNH = 8, kSB = 1024, kPW = 1024, kPG = 256;
constexpr int kNPROJ = 4096, kE = 32, kTOPK = 4, kDFF = 2048;
constexpr float kEPS = 1e-6f;
constexpr int kMaxSlots = 160 * 256;

typedef unsigned short bf16_t;
__device__ __forceinline__ bf16_t f2bf(float f) { unsigned u = __float_as_uint(f); u += 0x7FFFu + ((u >> 16) & 1u); return (bf16_t)(u >> 16); }
__device__ __forceinline__ float bf2f(bf16_t b) { return __uint_as_float(((unsigned)b) << 16); }

constexpr size_t WS_CTRL   = 0;
constexpr size_t WS_MOD    = 65536;
constexpr size_t WS_H      = WS_MOD + (size_t)4 * 12288 * 4;
constexpr size_t WS_PROJ   = WS_H + (size_t)kT * kD * 2;
constexpr size_t WS_CAT    = WS_PROJ + (size_t)kT * kNPROJ * 2;
constexpr size_t WS_P      = WS_CAT + (size_t)kT * kD * 2;
constexpr size_t WS_X1     = WS_P + (size_t)kT * kPW * 2;
constexpr size_t WS_H2     = WS_X1 + (size_t)kT * kD * 4;
constexpr size_t WS_GATES  = WS_H2 + (size_t)kT * kD * 2;
constexpr size_t WS_PAIRE  = WS_GATES + (size_t)kT * 4 * 4;
constexpr size_t WS_PAIRP  = WS_PAIRE + (size_t)kT * 4 * 4;
constexpr size_t WS_LIST   = WS_PAIRP + (size_t)kT * 4 * 4;
constexpr size_t WS_ACT    = WS_LIST + (size_t)kE * kT * 4;
constexpr size_t WS_YP     = WS_ACT + (size_t)kMaxSlots * kDFF * 2;
constexpr size_t WS_END    = WS_YP + (size_t)kMaxSlots * kD * 2;
constexpr int CT_CNT = 4096;
constexpr int CT_ROWBASE = 4160;
constexpr int CT_Q = 8192;

#define LAS __attribute__((address_space(3)))
typedef short bf16x8 __attribute__((ext_vector_type(8)));
typedef short s16x4 __attribute__((ext_vector_type(4)));
typedef float f32x4 __attribute__((ext_vector_type(4)));
typedef float f32x2 __attribute__((ext_vector_type(2)));
typedef __bf16 bf16v2 __attribute__((ext_vector_type(2)));
typedef unsigned u32x2 __attribute__((ext_vector_type(2)));
typedef unsigned u32x4 __attribute__((ext_vector_type(4)));
typedef int i32x4 __attribute__((ext_vector_type(4)));
typedef int i32x8 __attribute__((ext_vector_type(8)));
__device__ __forceinline__ unsigned pk_bf16(float a, float b) { f32x2 v = {a, b}; bf16v2 r = __builtin_convertvector(v, bf16v2); return __builtin_bit_cast(unsigned, r); }

constexpr size_t WS_WIN  = WS_END;
constexpr size_t WS_WO   = WS_WIN + (size_t)kD * kNPROJ * 2;
constexpr size_t WS_WPL  = WS_WO + (size_t)kD * kD * 2;
constexpr size_t WS_WE1  = WS_WPL + (size_t)4 * kPG * kPG * 2;
constexpr size_t WS_WE2  = WS_WE1 + (size_t)kE * kD * 2 * kDFF * 2;
constexpr size_t WS_END2 = WS_WE2 + (size_t)kE * kDFF * kD * 2;
constexpr size_t WS_WRP  = WS_END2;

namespace fg {
constexpr int BM = 256, BK = 64, HALF = 128, HTB = 16384, STAGE_BYTES = 131072, NXCD = 8, WGM = 8;
constexpr int TAB_OFF = STAGE_BYTES;
constexpr int MISC_OFF = STAGE_BYTES + 2048;
constexpr int LDS_BYTES = STAGE_BYTES + 4096;
__device__ __forceinline__ int lds_byte(int r, int c) { const int st = (r >> 4) * 2 + (c >> 5), rr = r & 15, cc = c & 31, ob = rr * 64 + cc * 2; return st * 1024 + (ob ^ (((ob >> 9) & 1) << 5)); }
__device__ __forceinline__ void stage_rc(int b, int& R, int& C) { const int st = b / 1024, sb = b % 1024, swz = sb ^ (((sb >> 9) & 1) << 5); R = (st >> 1) * 16 + swz / 64; C = (st & 1) * 32 + (swz % 64) / 2; }

struct Unit { const char* bBase; int arow0; int nvalid; int e; int orow0; int ocol0; int acol2; };

struct StaticOrder {
    int nM, nN, nwg, G, c;
    __device__ void init(int M, int N, int G_, int c_) { nM = M / BM; nN = N / BM; nwg = nM * nN; G = G_; c = c_; }
    __device__ bool next(int i, int& pm, int& pn) const {
        const long L = (long)i * G + c; if (L >= nwg) return false;
        int wgid = (int)L; { const int q = nwg / NXCD, r = nwg % NXCD, xcd = wgid % NXCD, off = wgid / NXCD; wgid = (xcd < r ? xcd * (q + 1) : r * (q + 1) + (xcd - r) * q) + off; }
        const int nig = WGM * nN, gid = wgid / nig, fm = gid * WGM, gsz = (nM - fm) < WGM ? (nM - fm) : WGM;
        pm = fm + ((wgid % nig) % gsz); pn = (wgid % nig) / gsz; return true;
    }
};

template <int OFF> __device__ __forceinline__ s16x4 tr_read(unsigned addr) { s16x4 r; asm volatile("ds_read_b64_tr_b16 %0, %1 offset:%2" : "=&v"(r) : "v"(addr), "i"(OFF) : "memory"); return r; }
template <class Job>
__device__ __forceinline__ void gemm_phase(LAS unsigned char* lds, const Job& J) {
    const int tid = threadIdx.x, wid = __builtin_amdgcn_readfirstlane(tid >> 6), lane = tid & 63, wr = wid >> 2, wc = wid & 3, fr = lane & 15, fq = lane >> 4;
    const int nt = J.K / BK;
    unsigned voffB[2];
#pragma unroll
    for (int i = 0; i < 2; ++i) { int R, C; stage_rc(tid * 16 + i * 8192, R, C);
        const int b = tid * 16 + i * 8192, row = b >> 8, slot = (b >> 4) & 15, ch = slot ^ (((row & 3) << 2) | ((row >> 2) & 3)); voffB[i] = (unsigned)row * J.ldb2 + (unsigned)ch * 16u; }
    const size_t kstepB = (size_t)BK * J.ldb2;
    const unsigned ldsw = (unsigned)wid * 1024u;
    const int aoff = lds_byte(wr * 64 + fr, fq * 8);
    const int tq = (lane & 15) >> 2, tp = lane & 3;
    unsigned ba[2][2];
#pragma unroll
    for (int n = 0; n < 2; ++n)
#pragma unroll
        for (int t = 0; t < 2; ++t) ba[n][t] = (unsigned)(uintptr_t)lds + 256u * (8 * fq + 4 * t + tq) + 16u * ((4 * wc + 2 * n + (tp >> 1)) ^ ((tq << 2) | ((2 * fq + t) & 3))) + 8u * (tp & 1);
#define FG_SA(b, h) (65536 + ((b) * 2 + (h)) * HTB)
#define FG_SB(b, h) (((b) * 2 + (h)) * HTB)
#define FG_STAGE_A(bufoff, gk, vo) do { _Pragma("unroll") for (int _i = 0; _i < 2; ++_i) \
        __builtin_amdgcn_global_load_lds((const unsigned*)((gk) + (vo)[_i]), (LAS unsigned*)(lds + (bufoff) + ldsw + _i * 8192), 16, 0, 0); } while (0)
#define FG_STAGE_B(bufoff, gk) do { _Pragma("unroll") for (int _i = 0; _i < 2; ++_i) \
        __builtin_amdgcn_global_load_lds((const unsigned*)((gk) + voffB[_i]), (LAS unsigned*)(lds + (bufoff) + ldsw + _i * 8192), 16, 0, 0); } while (0)
#define FG_LDA(dst, b, h) do { _Pragma("unroll") for (int m = 0; m < 4; ++m) _Pragma("unroll") for (int k = 0; k < 2; ++k) dst[m][k] = *(const LAS bf16x8*)(lds + FG_SA(b, h) + aoff + m * 2048 + k * 1024); } while (0)
#define FG_LDB(dst, b, h) do { \
        dst##lo[0][0] = tr_read<FG_SB(b, h)>(ba[0][0]);        dst##hi[0][0] = tr_read<FG_SB(b, h)>(ba[0][1]); \
        dst##lo[0][1] = tr_read<FG_SB(b, h) + 8192>(ba[0][0]); dst##hi[0][1] = tr_read<FG_SB(b, h) + 8192>(ba[0][1]); \
        dst##lo[1][0] = tr_read<FG_SB(b, h)>(ba[1][0]);        dst##hi[1][0] = tr_read<FG_SB(b, h)>(ba[1][1]); \
        dst##lo[1][1] = tr_read<FG_SB(b, h) + 8192>(ba[1][0]); dst##hi[1][1] = tr_read<FG_SB(b, h) + 8192>(ba[1][1]); } while (0)
#define FG_PK(L, H) (bf16x8){L[0], L[1], L[2], L[3], H[0], H[1], H[2], H[3]}
#define FG_MMA(ai, bj, At, Bt) do { __builtin_amdgcn_s_setprio(1); _Pragma("unroll") for (int m = 0; m < 4; ++m) _Pragma("unroll") for (int n = 0; n < 2; ++n) _Pragma("unroll") for (int k = 0; k < 2; ++k) \
        acc[ai][bj][m][n] = __builtin_amdgcn_mfma_f32_16x16x32_bf16(FG_PK(Bt##lo[n][k], Bt##hi[n][k]), At[m][k], acc[ai][bj][m][n], 0, 0, 0); __builtin_amdgcn_s_setprio(0); } while (0)
#define FG_WAIT_V(n) asm volatile("s_waitcnt vmcnt(" #n ")" ::: "memory")
#define FG_WAIT_L(n) asm volatile("s_waitcnt lgkmcnt(" #n ")" ::: "memory")
#define FG_BAR __builtin_amdgcn_s_barrier()
#define FG_SCHED __builtin_amdgcn_sched_barrier(0)
#define FG_AOFF(dst, u, tabp) do { int _tz = threadIdx.x; asm volatile("" : "+v"(_tz)); _Pragma("unroll") for (int _i = 0; _i < 2; ++_i) { int _R, _C; stage_rc(_tz * 16 + _i * 8192, _R, _C); \
        _Pragma("unroll") for (int _h = 0; _h < 2; ++_h) { const int _r = _h * 128 + _R; \
        if (Job::GATHER) { const int _tok = (tabp)[_r < (u).nvalid ? _r : 0]; dst[_h][_i] = (unsigned)_tok * J.lda2 + (unsigned)(_C * 2); } \
        else dst[_h][_i] = (unsigned)((u).arow0 + _r) * J.lda2 + (unsigned)((u).acol2 + _C * 2); } } } while (0)
    Unit cur, nxt; int ui = 0;
    if (!J.next(0, cur)) return;
    LAS const int* tab0 = (LAS const int*)(lds + TAB_OFF);
    if (Job::GATHER) {
        if (wid == 0) __builtin_amdgcn_global_load_lds((const unsigned*)(J.list + cur.arow0 + lane * 4), (LAS unsigned*)(lds + TAB_OFF), 16, 0, 0);
        FG_WAIT_V(0); __syncthreads();
    }
    f32x4 acc[2][2][4][2];
#pragma unroll
    for (int a = 0; a < 2; ++a)
#pragma unroll
        for (int b = 0; b < 2; ++b)
#pragma unroll
            for (int m = 0; m < 4; ++m)
#pragma unroll
                for (int n = 0; n < 2; ++n) acc[a][b][m][n] = (f32x4){0.f, 0.f, 0.f, 0.f};
    bf16x8 At[4][2]; s16x4 B0lo[2][2], B0hi[2][2], B1lo[2][2], B1hi[2][2];
    unsigned vc[2][2];
    FG_AOFF(vc, cur, tab0);
    const char* const gA = J.A;
    const char* cB = cur.bBase;
    const unsigned bh2 = J.bhalf2;
    FG_STAGE_B(FG_SB(0, 0), cB); FG_STAGE_A(FG_SA(0, 0), gA, vc[0]); FG_STAGE_B(FG_SB(0, 1), cB + bh2); FG_STAGE_A(FG_SA(0, 1), gA, vc[1]);
    if (wr == 1) FG_BAR;
    FG_WAIT_V(4); FG_BAR;
    FG_STAGE_B(FG_SB(1, 0), cB + kstepB); FG_STAGE_A(FG_SA(1, 0), gA + 128, vc[0]); FG_STAGE_B(FG_SB(1, 1), cB + kstepB + bh2);
    FG_WAIT_V(6); FG_BAR;
    for (;;) {
        const bool has_next = J.next(ui + 1, nxt);
        if (!has_next) nxt = cur;
        if (Job::GATHER && has_next && wid == 0)
            __builtin_amdgcn_global_load_lds((const unsigned*)(J.list + nxt.arow0 + lane * 4), (LAS unsigned*)(lds + TAB_OFF + ((ui + 1) & 1) * 1024), 16, 0, 0);
        const char* nB = nxt.bBase;
        for (int t = 0; t < nt; t += 2) {
            const bool last = (t == nt - 2);
            const char* a1 = gA + (size_t)(t + 1) * 128;
            const char* a2 = last ? gA : gA + (size_t)(t + 2) * 128; const char* b2 = last ? nB : cB + (size_t)(t + 2) * kstepB;
            const char* a3 = a2 + 128; const char* b3 = b2 + kstepB;
            FG_LDB(B0, 0, 0); FG_SCHED; FG_LDA(At, 0, 0); FG_STAGE_A(FG_SA(1, 1), a1, vc[1]);
            if (last && has_next) { LAS const int* tabn = (LAS const int*)(lds + TAB_OFF + ((ui + 1) & 1) * 1024); FG_AOFF(vc, nxt, tabn); }
            FG_WAIT_L(8); FG_BAR; FG_WAIT_L(0); FG_SCHED; FG_MMA(0, 0, At, B0); FG_BAR; FG_SCHED;
            FG_LDB(B1, 0, 1); FG_STAGE_B(FG_SB(0, 0), b2);
            FG_BAR; FG_WAIT_L(0); FG_SCHED; FG_MMA(0, 1, At, B1); FG_BAR;
            FG_LDA(At, 0, 1); FG_STAGE_A(FG_SA(0, 0), a2, vc[0]);
            FG_BAR; FG_WAIT_L(0); FG_MMA(1, 0, At, B0); FG_BAR; FG_SCHED;
            FG_STAGE_B(FG_SB(0, 1), b2 + bh2);
            FG_WAIT_V(6); FG_BAR; FG_MMA(1, 1, At, B1); FG_BAR;
            FG_LDB(B0, 1, 0); FG_SCHED; FG_LDA(At, 1, 0); FG_STAGE_A(FG_SA(0, 1), a2, vc[1]);
            FG_WAIT_L(8); FG_BAR; FG_WAIT_L(0); FG_SCHED; FG_MMA(0, 0, At, B0); FG_BAR; FG_SCHED;
            FG_LDB(B1, 1, 1); FG_STAGE_B(FG_SB(1, 0), b3);
            FG_BAR; FG_WAIT_L(0); FG_SCHED; FG_MMA(0, 1, At, B1); FG_BAR;
            FG_LDA(At, 1, 1); FG_STAGE_A(FG_SA(1, 0), a3, vc[0]);
            FG_BAR; FG_WAIT_L(0); FG_MMA(1, 0, At, B0); FG_BAR; FG_SCHED;
            FG_STAGE_B(FG_SB(1, 1), b3 + bh2);
            FG_WAIT_V(6); FG_BAR; FG_MMA(1, 1, At, B1); FG_BAR;
        }
        J.epi(acc, cur, wr, wc, fr, fq);
        if (!has_next) break;
#pragma unroll
        for (int a = 0; a < 2; ++a)
#pragma unroll
            for (int b = 0; b < 2; ++b)
#pragma unroll
                for (int m = 0; m < 4; ++m)
#pragma unroll
                    for (int n = 0; n < 2; ++n) acc[a][b][m][n] = (f32x4){0.f, 0.f, 0.f, 0.f};
        cur = nxt; cB = nB; ++ui;
    }
    FG_WAIT_V(0);
    if (wr == 0) FG_BAR;
    FG_BAR;
}

#undef FG_SA
#undef FG_SB
#undef FG_STAGE_A
#undef FG_STAGE_B
#undef FG_LDA
#undef FG_LDB
#undef FG_MMA
#undef FG_WAIT_V
#undef FG_WAIT_L
#undef FG_BAR
#undef FG_SCHED
#undef FG_AOFF
template <class Job>
__device__ __forceinline__ void gemm_phase_f8(LAS unsigned char* lds, const Job& J) {
    const int tid = threadIdx.x, wid = __builtin_amdgcn_readfirstlane(tid >> 6), lane = tid & 63, wr = wid >> 2, wc = wid & 3, fr = lane & 15, fq = lane >> 4;
    const int nt = J.K / 128;
    unsigned voffB[2];
#pragma unroll
    for (int i = 0; i < 2; ++i) { int R, C; stage_rc(tid * 16 + i * 8192, R, C);
        voffB[i] = (unsigned)R * J.ldb2 + (unsigned)(C * 2); }
    const size_t kstepB = 128;
    const unsigned ldsw = (unsigned)wid * 1024u;
    const int aoff = lds_byte(wr * 64 + fr, fq * 8);
    const int boff = lds_byte(wc * 32 + fr, fq * 8);
#define FG_SA(b, h) (65536 + ((b) * 2 + (h)) * HTB)
#define FG_SB(b, h) (((b) * 2 + (h)) * HTB)
#define FG_STAGE_A(bufoff, gk, vo) do { _Pragma("unroll") for (int _i = 0; _i < 2; ++_i) \
        __builtin_amdgcn_global_load_lds((const unsigned*)((gk) + (vo)[_i]), (LAS unsigned*)(lds + (bufoff) + ldsw + _i * 8192), 16, 0, 0); } while (0)
#define FG_STAGE_B(bufoff, gk) do { _Pragma("unroll") for (int _i = 0; _i < 2; ++_i) \
        __builtin_amdgcn_global_load_lds((const unsigned*)((gk) + voffB[_i]), (LAS unsigned*)(lds + (bufoff) + ldsw + _i * 8192), 16, 0, 0); } while (0)
#define FG_LDA(dst, b, h) do { _Pragma("unroll") for (int m = 0; m < 4; ++m) _Pragma("unroll") for (int k = 0; k < 2; ++k) dst[m][k] = *(const LAS i32x4*)(lds + FG_SA(b, h) + aoff + m * 2048 + k * 1024); } while (0)
#define FG_LDB(dst, b, h) do { _Pragma("unroll") for (int n = 0; n < 2; ++n) _Pragma("unroll") for (int k = 0; k < 2; ++k) dst[n][k] = *(const LAS i32x4*)(lds + FG_SB(b, h) + boff + n * 2048 + k * 1024); } while (0)
#define FG_CAT8(X, Y) __builtin_shufflevector(X, Y, 0, 1, 2, 3, 4, 5, 6, 7)
#define FG_MMA(ai, bj, At, Bt) do { __builtin_amdgcn_s_setprio(1); _Pragma("unroll") for (int m = 0; m < 4; ++m) _Pragma("unroll") for (int n = 0; n < 2; ++n) \
        acc[ai][bj][m][n] = __builtin_amdgcn_mfma_scale_f32_16x16x128_f8f6f4(FG_CAT8(Bt[n][0], Bt[n][1]), FG_CAT8(At[m][0], At[m][1]), acc[ai][bj][m][n], 0, 0, 0, 0x79797979, 0, 0x7F7F7F7F); __builtin_amdgcn_s_setprio(0); } while (0)
#define FG_WAIT_V(n) asm volatile("s_waitcnt vmcnt(" #n ")" ::: "memory")
#define FG_WAIT_L(n) asm volatile("s_waitcnt lgkmcnt(" #n ")" ::: "memory")
#define FG_BAR __builtin_amdgcn_s_barrier()
#define FG_SCHED __builtin_amdgcn_sched_barrier(0)
#define FG_AOFF(dst, u, tabp) do { int _tz = threadIdx.x; asm volatile("" : "+v"(_tz)); _Pragma("unroll") for (int _i = 0; _i < 2; ++_i) { int _R, _C; stage_rc(_tz * 16 + _i * 8192, _R, _C); \
        _Pragma("unroll") for (int _h = 0; _h < 2; ++_h) { const int _r = _h * 128 + _R; \
        if (Job::GATHER) { const int _tok = (tabp)[_r < (u).nvalid ? _r : 0]; dst[_h][_i] = (unsigned)_tok * J.lda2 + (unsigned)(_C * 2); } \
        else dst[_h][_i] = (unsigned)((u).arow0 + _r) * J.lda2 + (unsigned)((u).acol2 + _C * 2); } } } while (0)
    Unit cur, nxt; int ui = 0;
    if (!J.next(0, cur)) return;
    LAS const int* tab0 = (LAS const int*)(lds + TAB_OFF);
    if (Job::GATHER) {
        if (wid == 0) __builtin_amdgcn_global_load_lds((const unsigned*)(J.list + cur.arow0 + lane * 4), (LAS unsigned*)(lds + TAB_OFF), 16, 0, 0);
        FG_WAIT_V(0); __syncthreads();
    }
    f32x4 acc[2][2][4][2];
#pragma unroll
    for (int a = 0; a < 2; ++a)
#pragma unroll
        for (int b = 0; b < 2; ++b)
#pragma unroll
            for (int m = 0; m < 4; ++m)
#pragma unroll
                for (int n = 0; n < 2; ++n) acc[a][b][m][n] = (f32x4){0.f, 0.f, 0.f, 0.f};
    i32x4 At[4][2], B0[2][2], B1[2][2];
    unsigned vc[2][2];
    FG_AOFF(vc, cur, tab0);
    const char* const gA = J.A;
    const char* cB = cur.bBase;
    const unsigned bh2 = J.bhalf2;
    FG_STAGE_B(FG_SB(0, 0), cB); FG_STAGE_A(FG_SA(0, 0), gA, vc[0]); FG_STAGE_B(FG_SB(0, 1), cB + bh2); FG_STAGE_A(FG_SA(0, 1), gA, vc[1]);
    if (wr == 1) FG_BAR;
    FG_WAIT_V(4); FG_BAR;
    FG_STAGE_B(FG_SB(1, 0), cB + kstepB); FG_STAGE_A(FG_SA(1, 0), gA + 128, vc[0]); FG_STAGE_B(FG_SB(1, 1), cB + kstepB + bh2);
    FG_WAIT_V(6); FG_BAR;
    for (;;) {
        const bool has_next = J.next(ui + 1, nxt);
        if (!has_next) nxt = cur;
        if (Job::GATHER && has_next && wid == 0)
            __builtin_amdgcn_global_load_lds((const unsigned*)(J.list + nxt.arow0 + lane * 4), (LAS unsigned*)(lds + TAB_OFF + ((ui + 1) & 1) * 1024), 16, 0, 0);
        const char* nB = nxt.bBase;
        for (int t = 0; t < nt; t += 2) {
            const bool last = (t == nt - 2);
            const char* a1 = gA + (size_t)(t + 1) * 128;
            const char* a2 = last ? gA : gA + (size_t)(t + 2) * 128; const char* b2 = last ? nB : cB + (size_t)(t + 2) * kstepB;
            const char* a3 = a2 + 128; const char* b3 = b2 + kstepB;
            FG_LDB(B0, 0, 0); FG_SCHED; FG_LDA(At, 0, 0); FG_STAGE_A(FG_SA(1, 1), a1, vc[1]);
            if (last && has_next) { LAS const int* tabn = (LAS const int*)(lds + TAB_OFF + ((ui + 1) & 1) * 1024); FG_AOFF(vc, nxt, tabn); }
            FG_WAIT_L(8); FG_BAR; FG_WAIT_L(0); FG_SCHED; FG_MMA(0, 0, At, B0); FG_BAR; FG_SCHED;
            FG_LDB(B1, 0, 1); FG_STAGE_B(FG_SB(0, 0), b2);
            FG_BAR; FG_WAIT_L(0); FG_SCHED; FG_MMA(0, 1, At, B1); FG_BAR;
            FG_LDA(At, 0, 1); FG_STAGE_A(FG_SA(0, 0), a2, vc[0]);
            FG_BAR; FG_WAIT_L(0); FG_MMA(1, 0, At, B0); FG_BAR; FG_SCHED;
            FG_STAGE_B(FG_SB(0, 1), b2 + bh2);
            FG_WAIT_V(6); FG_BAR; FG_MMA(1, 1, At, B1); FG_BAR;
            FG_LDB(B0, 1, 0); FG_SCHED; FG_LDA(At, 1, 0); FG_STAGE_A(FG_SA(0, 1), a2, vc[1]);
            FG_WAIT_L(8); FG_BAR; FG_WAIT_L(0); FG_SCHED; FG_MMA(0, 0, At, B0); FG_BAR; FG_SCHED;
            FG_LDB(B1, 1, 1); FG_STAGE_B(FG_SB(1, 0), b3);
            FG_BAR; FG_WAIT_L(0); FG_SCHED; FG_MMA(0, 1, At, B1); FG_BAR;
            FG_LDA(At, 1, 1); FG_STAGE_A(FG_SA(1, 0), a3, vc[0]);
            FG_BAR; FG_WAIT_L(0); FG_MMA(1, 0, At, B0); FG_BAR; FG_SCHED;
            FG_STAGE_B(FG_SB(1, 1), b3 + bh2);
            FG_WAIT_V(6); FG_BAR; FG_MMA(1, 1, At, B1); FG_BAR;
        }
        J.epi(acc, cur, wr, wc, fr, fq);
        if (!has_next) break;
#pragma unroll
        for (int a = 0; a < 2; ++a)
#pragma unroll
            for (int b = 0; b < 2; ++b)
#pragma unroll
                for (int m = 0; m < 4; ++m)
#pragma unroll
                    for (int n = 0; n < 2; ++n) acc[a][b][m][n] = (f32x4){0.f, 0.f, 0.f, 0.f};
        cur = nxt; cB = nB; ++ui;
    }
    FG_WAIT_V(0);
    if (wr == 0) FG_BAR;
    FG_BAR;
}
}

#define FG_FOR_ROWS for (int ai = 0; ai < 2; ++ai) _Pragma("unroll") for (int m = 0; m < 4; ++m)
struct JobInProj {
    static constexpr bool GATHER = false;
    const char* A; unsigned lda2, ldb2, bhalf2; int K; const int* list;
    const char* B; bf16_t* out; fg::StaticOrder S;
    __device__ __forceinline__ bool next(int i, fg::Unit& u) const { int pm, pn; if (!S.next(i, pm, pn)) return false;
        u.bBase = B + (size_t)pn * 512; u.arow0 = pm * 256; u.nvalid = 256; u.e = 0; u.orow0 = pm * 256; u.ocol0 = pn * 256; u.acol2 = 0; return true; }
    __device__ __forceinline__ void epi(const f32x4 (&acc)[2][2][4][2], const fg::Unit& u, int wr, int wc, int fr, int fq) const {
#pragma unroll
        FG_FOR_ROWS { bf16_t* rowp = out + (size_t)(u.orow0 + ai * 128 + wr * 64 + m * 16 + fr) * kNPROJ + u.ocol0 + wc * 32 + fq * 4;
#pragma unroll
            for (int bj = 0; bj < 2; ++bj)
#pragma unroll
                for (int n = 0; n < 2; ++n) { const f32x4 v = acc[ai][bj][m][n]; u32x2 w; w.x = pk_bf16(v[0], v[1]); w.y = pk_bf16(v[2], v[3]); *(u32x2*)(rowp + bj * 128 + n * 16) = w; } }
    }
};
struct JobPoolFold {
    static constexpr bool GATHER = false;
    const char* A; unsigned lda2, ldb2, bhalf2; int K; const int* list;
    const char* B; bf16_t* wo; int G, c;
    __device__ __forceinline__ bool next(int i, fg::Unit& u) const { const int L = i * G + c; if (L >= 32) return false; const int g = L >> 3, pn = L & 7;
        u.bBase = B + (size_t)g * kPG * kD * 2 + (size_t)pn * 512; u.arow0 = 0; u.nvalid = 256; u.e = g; u.orow0 = kSB + g * kPG; u.ocol0 = pn * 256; u.acol2 = g * kPG * kPG * 2; return true; }
    __device__ __forceinline__ void epi(const f32x4 (&acc)[2][2][4][2], const fg::Unit& u, int wr, int wc, int fr, int fq) const {
#pragma unroll
        FG_FOR_ROWS { bf16_t* rowp = wo + (size_t)(u.orow0 + ai * 128 + wr * 64 + m * 16 + fr) * kD + u.ocol0 + wc * 32 + fq * 4;
#pragma unroll
            for (int bj = 0; bj < 2; ++bj)
#pragma unroll
                for (int n = 0; n < 2; ++n) { const f32x4 v = acc[ai][bj][m][n]; u32x2 w; w.x = pk_bf16(v[0], v[1]); w.y = pk_bf16(v[2], v[3]); *(u32x2*)(rowp + bj * 128 + n * 16) = w; } }
    }
};
struct JobOutProj {
    static constexpr bool GATHER = false;
    const char* A; unsigned lda2, ldb2, bhalf2; int K; const int* list;
    const char* B; const float* x; const float* mod; bf16_t* x1; fg::StaticOrder S;
    __device__ __forceinline__ bool next(int i, fg::Unit& u) const { int pm, pn; if (!S.next(i, pm, pn)) return false;
        u.bBase = B + (size_t)pn * 512; u.arow0 = pm * 256; u.nvalid = 256; u.e = 0; u.orow0 = pm * 256; u.ocol0 = pn * 256; u.acol2 = 0; return true; }
    __device__ __forceinline__ void epi(const f32x4 (&acc)[2][2][4][2], const fg::Unit& u, int wr, int wc, int fr, int fq) const {
        const int b = u.orow0 / kS; f32x4 gt[2][2];
#pragma unroll
        for (int bj = 0; bj < 2; ++bj)
#pragma unroll
            for (int n = 0; n < 2; ++n) gt[bj][n] = *(const f32x4*)(mod + b * 6 * kD + 2 * kD + u.ocol0 + bj * 128 + wc * 32 + n * 16 + fq * 4);
#pragma unroll
        FG_FOR_ROWS { const size_t ro = (size_t)(u.orow0 + ai * 128 + wr * 64 + m * 16 + fr) * kD + u.ocol0 + wc * 32 + fq * 4;
#pragma unroll
            for (int bj = 0; bj < 2; ++bj)
#pragma unroll
                for (int n = 0; n < 2; ++n) { const f32x4 v = *(const f32x4*)(x + ro + bj * 128 + n * 16) + gt[bj][n] * acc[ai][bj][m][n]; u32x2 w; w.x = pk_bf16(v[0], v[1]); w.y = pk_bf16(v[2], v[3]); *(u32x2*)(x1 + ro + bj * 128 + n * 16) = w; } }
    }
};
struct MoeTab { LAS const int* t; int total;
    __device__ __forceinline__ bool decode(int i, int G, int c, int& e, int& jcol, int& rb, int& cnt, int& rowbase) const {
        const int L = (G % 8 == 0) ? i * G + (c % 8) * (G / 8) + c / 8 : i * G + c; if (L >= total) return false;
        int ee = 0; while (ee < kE - 1 && t[64 + ee + 1] <= L) ++ee;
        const int local = L - t[64 + ee], nrb = t[100 + ee]; jcol = local / nrb; rb = local - jcol * nrb; e = ee; cnt = t[ee]; rowbase = t[32 + ee]; return true; }
};
__device__ __forceinline__ MoeTab moe_tables(LAS unsigned char* lds, const unsigned* ctrl, int ncol) {
    LAS int* t = (LAS int*)(lds + fg::MISC_OFF + 64);
    __syncthreads();
    if (threadIdx.x == 0) { int base = 0, us = 0; for (int e = 0; e < kE; ++e) { const int cn = (int)ctrl[CT_CNT + 64 * e], nrb = (cn + 255) >> 8; t[e] = cn; t[32 + e] = base; t[64 + e] = us; t[100 + e] = nrb; base += nrb * 256; us += nrb * ncol; } t[64 + kE] = us; }
    __syncthreads();
    MoeTab M; M.t = t; M.total = t[64 + kE]; return M;
}
struct JobMoe1 {
    static constexpr bool GATHER = true;
    const char* A; unsigned lda2, ldb2, bhalf2; int K; const int* list;
    const char* B; const float* b_in; bf16_t* act; MoeTab M; int G, c;
    __device__ __forceinline__ bool next(int i, fg::Unit& u) const { int e, j, rb, cnt, rowbase; if (!M.decode(i, G, c, e, j, rb, cnt, rowbase)) return false;
        e = __builtin_amdgcn_readfirstlane(e); j = __builtin_amdgcn_readfirstlane(j); rb = __builtin_amdgcn_readfirstlane(rb); cnt = __builtin_amdgcn_readfirstlane(cnt); rowbase = __builtin_amdgcn_readfirstlane(rowbase);
        u.bBase = B + (size_t)e * ((size_t)kD * 2 * kDFF * 2) + (size_t)j * 256; u.arow0 = e * kT + rb * 256; u.nvalid = min(256, cnt - rb * 256); u.e = e; u.orow0 = rowbase + rb * 256; u.ocol0 = j * 128; u.acol2 = 0; return true; }
    __device__ __forceinline__ void epi(const f32x4 (&acc)[2][2][4][2], const fg::Unit& u, int wr, int wc, int fr, int fq) const {
        f32x4 bg[2], bl[2];
#pragma unroll
        for (int n = 0; n < 2; ++n) { const float* bp = b_in + (size_t)u.e * 2 * kDFF + u.ocol0 + wc * 32 + n * 16 + fq * 4; bg[n] = *(const f32x4*)bp; bl[n] = *(const f32x4*)(bp + kDFF); }
#pragma unroll
        FG_FOR_ROWS { bf16_t* rowp = act + (size_t)(u.orow0 + ai * 128 + wr * 64 + m * 16 + fr) * kDFF + u.ocol0 + wc * 32 + fq * 4;
#pragma unroll
            for (int n = 0; n < 2; ++n) { const f32x4 gv = acc[ai][0][m][n] + bg[n], lv = acc[ai][1][m][n] + bl[n]; float o[4];
#pragma unroll
                for (int j = 0; j < 4; ++j) { const float g = fminf(gv[j], 7.f), l = fminf(fmaxf(lv[j], -7.f), 7.f); o[j] = g * __builtin_amdgcn_rcpf(1.f + __expf(-1.702f * g)) * (l + 1.f); }
                u32x2 w; w.x = pk_bf16(o[0], o[1]); w.y = pk_bf16(o[2], o[3]); *(u32x2*)(rowp + n * 16) = w; } }
    }
};
struct JobMoe2 {
    static constexpr bool GATHER = false;
    const char* A; unsigned lda2, ldb2, bhalf2; int K; const int* list;
    const char* B; const float* b_out; bf16_t* yp; MoeTab M; int G, c;
    __device__ __forceinline__ bool next(int i, fg::Unit& u) const { int e, j, rb, cnt, rowbase; if (!M.decode(i, G, c, e, j, rb, cnt, rowbase)) return false;
        e = __builtin_amdgcn_readfirstlane(e); j = __builtin_amdgcn_readfirstlane(j); rb = __builtin_amdgcn_readfirstlane(rb); rowbase = __builtin_amdgcn_readfirstlane(rowbase);
        u.bBase = B + (size_t)e * ((size_t)kDFF * kD * 2) + (size_t)j * 512; u.arow0 = rowbase + rb * 256; u.nvalid = 256; u.e = e; u.orow0 = rowbase + rb * 256; u.ocol0 = j * 256; u.acol2 = 0; return true; }
    __device__ __forceinline__ void epi(const f32x4 (&acc)[2][2][4][2], const fg::Unit& u, int wr, int wc, int fr, int fq) const {
        f32x4 bo[2][2];
#pragma unroll
        for (int bj = 0; bj < 2; ++bj)
#pragma unroll
            for (int n = 0; n < 2; ++n) bo[bj][n] = *(const f32x4*)(b_out + (size_t)u.e * kD + u.ocol0 + bj * 128 + wc * 32 + n * 16 + fq * 4);
#pragma unroll
        FG_FOR_ROWS { bf16_t* rowp = yp + (size_t)(u.orow0 + ai * 128 + wr * 64 + m * 16 + fr) * kD + u.ocol0 + wc * 32 + fq * 4;
#pragma unroll
            for (int bj = 0; bj < 2; ++bj)
#pragma unroll
                for (int n = 0; n < 2; ++n) { const f32x4 v = acc[ai][bj][m][n] + bo[bj][n]; u32x2 w; w.x = pk_bf16(v[0], v[1]); w.y = pk_bf16(v[2], v[3]); *(u32x2*)(rowp + bj * 128 + n * 16) = w; } }
    }
};


__device__ __forceinline__ float wave_sum(float v) {
#pragma unroll
    for (int o = 32; o > 0; o >>= 1) v += __shfl_xor(v, o);
    return v; }
__device__ __forceinline__ float bflo(unsigned u) { return __uint_as_float(u << 16); }
__device__ __forceinline__ float bfhi(unsigned u) { return __uint_as_float(u & 0xFFFF0000u); }

namespace at {
typedef float f32x16 __attribute__((ext_vector_type(16)));
__device__ __forceinline__ unsigned off_b(unsigned row, unsigned ch) { return 256u * row + 16u * (ch ^ (((row & 3) << 2) | ((row >> 2) & 3))); }
constexpr float kC2 = 0.08838834764831845f * 1.4426950408889634f;
constexpr float kDoneThresh = 140.f;

__device__ __forceinline__ void attn_phase(LAS unsigned char* lds, const bf16_t* __restrict__ proj, const float* __restrict__ qw, const float* __restrict__ kw,
                                           bf16_t* __restrict__ cat, int G, int c) {
    const int tid = threadIdx.x, wid = __builtin_amdgcn_readfirstlane(tid >> 6), lane = tid & 63, ql = lane & 31, hf = lane >> 5;
    const unsigned ldsb = (unsigned)(uintptr_t)lds;
    const int skey = tid >> 4, sch = tid & 15;
    const unsigned X = ((ql & 3) << 2) | ((ql >> 2) & 3);
    const unsigned krow = 256u * ql, kY = 16u * (X ^ (unsigned)hf);
    const int tq = (lane & 15) >> 2, tp = lane & 3, blk = (lane >> 4) & 1;
    unsigned va[4][2];
#pragma unroll
    for (int cc = 0; cc < 4; ++cc)
#pragma unroll
        for (int t = 0; t < 2; ++t) va[cc][t] = 256u * (8 * t + 4 * hf + tq) + 16u * ((4 * cc + 2 * blk + (tp >> 1)) ^ ((tq << 2) | ((2 * t + hf) & 3))) + 8u * (tp & 1);
    for (int unit = c; unit < kB * kNH * 8; unit += G) {
        const int qb = unit & 7, bh = unit >> 3, h = bh & 7, b = bh >> 3;
        const int q0 = qb * 256, r0 = q0 + wid * 32;
        const bf16_t* base = proj + (size_t)(b * kS) * kNPROJ + h * kHD;
        LAS unsigned char* qlds = lds + 65536 + wid * 8192 + lane * 16;
        { u32x4 qr[8]; float ss = 0.f;
#pragma unroll
          for (int s = 0; s < 8; ++s) { qr[s] = *(const u32x4*)(base + (size_t)(r0 + ql) * kNPROJ + 16 * s + 8 * hf);
              const unsigned u[4] = {qr[s].x, qr[s].y, qr[s].z, qr[s].w};
#pragma unroll
              for (int e = 0; e < 4; ++e) { const float a = bflo(u[e]), bb = bfhi(u[e]); ss += a * a + bb * bb; } }
          ss += __shfl_xor(ss, 32);
          const float rq = rsqrtf(ss * (1.f / kHD) + kEPS) * kC2;
#pragma unroll
          for (int s = 0; s < 8; ++s) { const int d0 = 16 * s + 8 * hf;
              const f32x4 w0 = *(const f32x4*)(qw + d0) * *(const f32x4*)(kw + d0), w1 = *(const f32x4*)(qw + d0 + 4) * *(const f32x4*)(kw + d0 + 4);
              const unsigned u[4] = {qr[s].x, qr[s].y, qr[s].z, qr[s].w};
              u32x4 pk; pk.x = pk_bf16(bflo(u[0]) * rq * w0[0], bfhi(u[0]) * rq * w0[1]); pk.y = pk_bf16(bflo(u[1]) * rq * w0[2], bfhi(u[1]) * rq * w0[3]);
              pk.z = pk_bf16(bflo(u[2]) * rq * w1[0], bfhi(u[2]) * rq * w1[1]); pk.w = pk_bf16(bflo(u[3]) * rq * w1[2], bfhi(u[3]) * rq * w1[3]);
              *(LAS u32x4*)(qlds + 1024 * s) = pk; } }
        f32x16 o[4];
#pragma unroll
        for (int cc = 0; cc < 4; ++cc)
#pragma unroll
            for (int r = 0; r < 16; ++r) o[cc][r] = 0.f;
        float carry = 0.f; bool wactive = true;
        int jt = (q0 + 255) >> 6, cur = 0;
        u32x4 kr[2], vr[2];
#define AT_LOAD(jt_) do { _Pragma("unroll") for (int i = 0; i < 2; ++i) { const bf16_t* rp = base + (size_t)(64 * (jt_) + skey + 32 * i) * kNPROJ + sch * 8; \
            kr[i] = *(const u32x4*)(rp + kSB); vr[i] = *(const u32x4*)(rp + 2 * kSB); } } while (0)
        AT_LOAD(jt);
        for (;;) {
            LAS unsigned char* kbuf = lds + cur * 32768; LAS unsigned char* vbuf = kbuf + 16384;
#pragma unroll
            for (int i = 0; i < 2; ++i) { const unsigned u[4] = {kr[i].x, kr[i].y, kr[i].z, kr[i].w}; float f[8]; float ss = 0.f;
#pragma unroll
                for (int e = 0; e < 4; ++e) { f[2 * e] = bflo(u[e]); f[2 * e + 1] = bfhi(u[e]); ss += f[2 * e] * f[2 * e] + f[2 * e + 1] * f[2 * e + 1]; }
                ss += __shfl_xor(ss, 1); ss += __shfl_xor(ss, 2); ss += __shfl_xor(ss, 4); ss += __shfl_xor(ss, 8);
                const float rk = rsqrtf(ss * (1.f / kHD) + kEPS);
                u32x4 pk; pk.x = pk_bf16(f[0] * rk, f[1] * rk); pk.y = pk_bf16(f[2] * rk, f[3] * rk); pk.z = pk_bf16(f[4] * rk, f[5] * rk); pk.w = pk_bf16(f[6] * rk, f[7] * rk);
                const unsigned a = off_b(skey + 32 * i, sch);
                *(LAS u32x4*)(kbuf + a) = pk; *(LAS u32x4*)(vbuf + a) = vr[i]; }
            const int any = __syncthreads_or(wactive ? 1 : 0);
            if (!any) break;
            const int jtc = jt;
            if (jt > 0) AT_LOAD(jt - 1);
            if (wactive && 64 * jtc < r0 + 31) {
                f32x16 s0, s1;
#pragma unroll
                for (int r = 0; r < 16; ++r) { s0[r] = 0.f; s1[r] = 0.f; }
#pragma unroll
                for (int s = 0; s < 8; ++s) { const unsigned a = krow + ((32u * s) ^ kY);
                    const bf16x8 k0 = *(const LAS bf16x8*)(kbuf + a), k1 = *(const LAS bf16x8*)(kbuf + 8192 + a), qv = *(const LAS bf16x8*)(qlds + 1024 * s);
                    s0 = __builtin_amdgcn_mfma_f32_32x32x16_bf16(k0, qv, s0, 0, 0, 0); s1 = __builtin_amdgcn_mfma_f32_32x32x16_bf16(k1, qv, s1, 0, 0, 0); }
                const int tabs = r0 + ql, kbase0 = 64 * jtc + 4 * hf;
                float run = carry; u32x4 pfr[2][2];
#pragma unroll
                for (int kb = 1; kb >= 0; --kb) {
                    float sp[16], gp[4], T[4];
#pragma unroll
                    for (int r = 0; r < 16; ++r) { const float z = kb ? s1[r] : s0[r]; const int key = kbase0 + 32 * kb + 8 * (r >> 2) + (r & 3);
                        const float v = __builtin_amdgcn_logf(1.f + __builtin_amdgcn_exp2f(z)); sp[r] = key < tabs ? v : 0.f; }
#pragma unroll
                    for (int g = 0; g < 4; ++g) { const float gsum = (sp[4 * g] + sp[4 * g + 1]) + (sp[4 * g + 2] + sp[4 * g + 3]);
                        const auto sw = __builtin_amdgcn_permlane32_swap(__float_as_uint(gsum), __float_as_uint(gsum), false, false);
                        const float lo = __uint_as_float(sw[0]), hi = __uint_as_float(sw[1]);
                        T[g] = lo + hi; gp[g] = hf ? 0.f : hi; }
#pragma unroll
                    for (int g = 3; g >= 0; --g) { const float offs = run + gp[g];
                        const float c3 = offs + sp[4 * g + 3], c2 = c3 + sp[4 * g + 2], c1 = c2 + sp[4 * g + 1], c0 = c1 + sp[4 * g];
                        const float cs[4] = {c0, c1, c2, c3};
#pragma unroll
                        for (int i = 0; i < 4; ++i) { const int r = 4 * g + i; const float z = kb ? s1[r] : s0[r]; const int key = kbase0 + 32 * kb + 8 * g + i;
                            const float e = __builtin_amdgcn_exp2f(z - cs[i]); sp[r] = key < tabs ? e : 0.f; }
                        run += T[g]; }
#pragma unroll
                    for (int s2 = 0; s2 < 2; ++s2) { u32x4 pk; pk.x = pk_bf16(sp[8 * s2], sp[8 * s2 + 1]); pk.y = pk_bf16(sp[8 * s2 + 2], sp[8 * s2 + 3]);
                        pk.z = pk_bf16(sp[8 * s2 + 4], sp[8 * s2 + 5]); pk.w = pk_bf16(sp[8 * s2 + 6], sp[8 * s2 + 7]); pfr[kb][s2] = pk; }
                }
                carry = run;
                const unsigned vb0 = ldsb + (unsigned)cur * 32768u + 16384u;
#define AT_PV(cc) do { const unsigned a0 = vb0 + va[cc][0], a1 = vb0 + va[cc][1]; \
                    const s16x4 l00 = fg::tr_read<0>(a0), h00 = fg::tr_read<0>(a1), l01 = fg::tr_read<4096>(a0), h01 = fg::tr_read<4096>(a1); \
                    const s16x4 l10 = fg::tr_read<8192>(a0), h10 = fg::tr_read<8192>(a1), l11 = fg::tr_read<12288>(a0), h11 = fg::tr_read<12288>(a1); \
                    asm volatile("s_waitcnt lgkmcnt(0)" ::: "memory"); __builtin_amdgcn_sched_barrier(0); \
                    o[cc] = __builtin_amdgcn_mfma_f32_32x32x16_bf16(FG_PK(l00, h00), __builtin_bit_cast(bf16x8, pfr[0][0]), o[cc], 0, 0, 0); \
                    o[cc] = __builtin_amdgcn_mfma_f32_32x32x16_bf16(FG_PK(l01, h01), __builtin_bit_cast(bf16x8, pfr[0][1]), o[cc], 0, 0, 0); \
                    o[cc] = __builtin_amdgcn_mfma_f32_32x32x16_bf16(FG_PK(l10, h10), __builtin_bit_cast(bf16x8, pfr[1][0]), o[cc], 0, 0, 0); \
                    o[cc] = __builtin_amdgcn_mfma_f32_32x32x16_bf16(FG_PK(l11, h11), __builtin_bit_cast(bf16x8, pfr[1][1]), o[cc], 0, 0, 0); } while (0)
                AT_PV(0); AT_PV(1); AT_PV(2); AT_PV(3);
#undef AT_PV
                wactive = __any(carry <= kDoneThresh);
            }
            if (jt == 0) break;
            --jt; cur ^= 1;
        }
#undef AT_LOAD
        bf16_t* orow = cat + (size_t)(b * kS + r0 + ql) * kD + h * kHD + 4 * hf;
#pragma unroll
        for (int cc = 0; cc < 4; ++cc)
#pragma unroll
            for (int g = 0; g < 4; ++g) { u32x2 w; w.x = pk_bf16(o[cc][4 * g], o[cc][4 * g + 1]); w.y = pk_bf16(o[cc][4 * g + 2], o[cc][4 * g + 3]); *(u32x2*)(orow + 32 * cc + 8 * g) = w; }
        __syncthreads();
    }
}
}

__device__ __forceinline__ void pool_p_phase(const bf16_t* __restrict__ proj, bf16_t* __restrict__ p, int G, int c) {
    for (int idx = c * 512 + threadIdx.x; idx < kT * (kPW / 8); idx += G * 512) {
        const int c8 = idx & 127, t = idx >> 7, s = t & (kS - 1), g = c8 >> 5, w = 2 << g, cnt = min(s + 1, w);
        const bf16_t* up = proj + (size_t)t * kNPROJ + 3 * kSB + c8 * 8;
        u32x4 v[16];
#pragma unroll
        for (int i = 0; i < 16; ++i) v[i] = (i < cnt) ? *(const u32x4*)(up - (size_t)i * kNPROJ) : (u32x4){0u, 0u, 0u, 0u};
        float acc[8];
#pragma unroll
        for (int e = 0; e < 8; ++e) acc[e] = 0.f;
#pragma unroll
        for (int i = 0; i < 16; ++i) { acc[0] += bflo(v[i].x); acc[1] += bfhi(v[i].x); acc[2] += bflo(v[i].y); acc[3] += bfhi(v[i].y); acc[4] += bflo(v[i].z); acc[5] += bfhi(v[i].z); acc[6] += bflo(v[i].w); acc[7] += bfhi(v[i].w); }
        const float inv = 1.f / (float)cnt;
        const float u0[8] = {bflo(v[0].x), bfhi(v[0].x), bflo(v[0].y), bfhi(v[0].y), bflo(v[0].z), bfhi(v[0].z), bflo(v[0].w), bfhi(v[0].w)};
        u32x4 pk; pk.x = pk_bf16(acc[0] * inv - u0[0], acc[1] * inv - u0[1]); pk.y = pk_bf16(acc[2] * inv - u0[2], acc[3] * inv - u0[3]);
        pk.z = pk_bf16(acc[4] * inv - u0[4], acc[5] * inv - u0[5]); pk.w = pk_bf16(acc[6] * inv - u0[6], acc[7] * inv - u0[7]);
        *(u32x4*)(p + (size_t)t * kD + kSB + c8 * 8) = pk;
    }
}

__device__ __forceinline__ unsigned pk4_fp8(float a, float b, float c, float d) { int p = __builtin_amdgcn_cvt_pk_fp8_f32(a, b, 0, false); p = __builtin_amdgcn_cvt_pk_fp8_f32(c, d, p, true); return (unsigned)p; }
__device__ __forceinline__ float clamp448(float v) { return __builtin_amdgcn_fmed3f(v, -448.f, 448.f); }
constexpr float kWScale = 64.f;

struct JobMoe1F8 {
    static constexpr bool GATHER = true;
    const char* A; unsigned lda2, ldb2, bhalf2; int K; const int* list;
    const char* B; const float* b_in; unsigned char* act; MoeTab M; int G, c;
    __device__ __forceinline__ bool next(int i, fg::Unit& u) const { int e, j, rb, cnt, rowbase; if (!M.decode(i, G, c, e, j, rb, cnt, rowbase)) return false;
        e = __builtin_amdgcn_readfirstlane(e); j = __builtin_amdgcn_readfirstlane(j); rb = __builtin_amdgcn_readfirstlane(rb); cnt = __builtin_amdgcn_readfirstlane(cnt); rowbase = __builtin_amdgcn_readfirstlane(rowbase);
        u.bBase = B + (size_t)e * ((size_t)2 * kDFF * kD) + (size_t)j * 128 * kD; u.arow0 = e * kT + rb * 256; u.nvalid = min(256, cnt - rb * 256); u.e = e; u.orow0 = rowbase + rb * 256; u.ocol0 = j * 128; u.acol2 = 0; return true; }
    __device__ __forceinline__ void epi(const f32x4 (&acc)[2][2][4][2], const fg::Unit& u, int wr, int wc, int fr, int fq) const {
        f32x4 bg[2], bl[2];
#pragma unroll
        for (int n = 0; n < 2; ++n) { const float* bp = b_in + (size_t)u.e * 2 * kDFF + u.ocol0 + wc * 32 + n * 16 + fq * 4; bg[n] = *(const f32x4*)bp; bl[n] = *(const f32x4*)(bp + kDFF); }
#pragma unroll
        FG_FOR_ROWS { unsigned char* rowp = act + (size_t)(u.orow0 + ai * 128 + wr * 64 + m * 16 + fr) * kDFF + u.ocol0 + wc * 32 + fq * 4;
#pragma unroll
            for (int n = 0; n < 2; ++n) { const f32x4 gv = acc[ai][0][m][n] + bg[n], lv = acc[ai][1][m][n] + bl[n]; float o[4];
#pragma unroll
                for (int j = 0; j < 4; ++j) { const float g = fminf(gv[j], 7.f), l = fminf(fmaxf(lv[j], -7.f), 7.f); o[j] = clamp448(g * __builtin_amdgcn_rcpf(1.f + __expf(-1.702f * g)) * (l + 1.f)); }
                *(unsigned*)(rowp + n * 16) = pk4_fp8(o[0], o[1], o[2], o[3]); } }
    }
};
struct JobMoe2F8 {
    static constexpr bool GATHER = false;
    const char* A; unsigned lda2, ldb2, bhalf2; int K; const int* list;
    const char* B; const float* b_out; unsigned char* yp; MoeTab M; int G, c;
    __device__ __forceinline__ bool next(int i, fg::Unit& u) const { int e, j, rb, cnt, rowbase; if (!M.decode(i, G, c, e, j, rb, cnt, rowbase)) return false;
        e = __builtin_amdgcn_readfirstlane(e); j = __builtin_amdgcn_readfirstlane(j); rb = __builtin_amdgcn_readfirstlane(rb); rowbase = __builtin_amdgcn_readfirstlane(rowbase);
        u.bBase = B + (size_t)e * ((size_t)kDFF * kD) + (size_t)j * 256 * kDFF; u.arow0 = rowbase + rb * 256; u.nvalid = 256; u.e = e; u.orow0 = rowbase + rb * 256; u.ocol0 = j * 256; u.acol2 = 0; return true; }
    __device__ __forceinline__ void epi(const f32x4 (&acc)[2][2][4][2], const fg::Unit& u, int wr, int wc, int fr, int fq) const {
        f32x4 bo[2][2];
#pragma unroll
        for (int bj = 0; bj < 2; ++bj)
#pragma unroll
            for (int n = 0; n < 2; ++n) bo[bj][n] = *(const f32x4*)(b_out + (size_t)u.e * kD + u.ocol0 + bj * 128 + wc * 32 + n * 16 + fq * 4);
#pragma unroll
        FG_FOR_ROWS { unsigned char* rowp = yp + (size_t)(u.orow0 + ai * 128 + wr * 64 + m * 16 + fr) * kD + u.ocol0 + wc * 32 + fq * 4;
#pragma unroll
            for (int bj = 0; bj < 2; ++bj)
#pragma unroll
                for (int n = 0; n < 2; ++n) { const f32x4 v = acc[ai][bj][m][n] + bo[bj][n]; *(unsigned*)(rowp + bj * 128 + n * 16) = pk4_fp8(clamp448(v[0]), clamp448(v[1]), clamp448(v[2]), clamp448(v[3])); } }
    }
};

struct CvtT { const float* src; unsigned char* dst; int K, N, tn, per; };
__device__ __forceinline__ CvtT cvt_make(const float* src, unsigned char* dst, int K, int N) { CvtT c; c.src = src; c.dst = dst; c.K = K; c.N = N; c.tn = N / 64; c.per = (K / 128) * (N / 64); return c; }
__device__ __forceinline__ void cvt_load(const CvtT& C, int t, int kq, int nc, f32x4 (&v)[4]) {
    const int mat = t / C.per, r = t - mat * C.per, kt = r / C.tn, nt_ = r - kt * C.tn;
    const float* sp = C.src + (size_t)mat * C.K * C.N + (size_t)(kt * 128 + 4 * kq) * C.N + nt_ * 64 + 4 * nc;
#pragma unroll
    for (int i = 0; i < 4; ++i) v[i] = __builtin_nontemporal_load((const f32x4*)(sp + (size_t)i * C.N));
}
__device__ __forceinline__ void cvt_emit(const CvtT& C, int t, LAS unsigned* L, const f32x4 (&v)[4], int kq, int nc, int rn, int rc) {
#pragma unroll
    for (int j = 0; j < 4; ++j) L[(4 * nc + j) * 33 + kq] = pk4_fp8(v[0][j] * kWScale, v[1][j] * kWScale, v[2][j] * kWScale, v[3][j] * kWScale);
    __syncthreads();
    const int mat = t / C.per, r = t - mat * C.per, kt = r / C.tn, nt_ = r - kt * C.tn;
    u32x4 o; o.x = L[rn * 33 + 4 * rc]; o.y = L[rn * 33 + 4 * rc + 1]; o.z = L[rn * 33 + 4 * rc + 2]; o.w = L[rn * 33 + 4 * rc + 3];
    __builtin_nontemporal_store(o, (u32x4*)(C.dst + (size_t)mat * C.K * C.N + (size_t)(nt_ * 64 + rn) * C.K + kt * 128 + rc * 16));
}
__device__ __forceinline__ void convert_t_f8(LAS unsigned char* lds, const CvtT C, int t0, int t1, int stride) {
    const int tid = threadIdx.x, kq = tid >> 4, nc = tid & 15, rn = tid >> 3, rc = tid & 7;
    f32x4 v0[4], v1[4], vn[4];
    __syncthreads();
    if (t0 < t1) cvt_load(C, t0, kq, nc, v0);
    if (t0 + stride < t1) cvt_load(C, t0 + stride, kq, nc, v1);
    int i = 0;
#pragma unroll 1
    for (int t = t0; t < t1; t += stride, ++i) {
        if (t + 2 * stride < t1) cvt_load(C, t + 2 * stride, kq, nc, vn);
        cvt_emit(C, t, (LAS unsigned*)(lds + (i & 1) * 8704), v0, kq, nc, rn, rc);
#pragma unroll
        for (int j = 0; j < 4; ++j) { v0[j] = v1[j]; v1[j] = vn[j]; }
    }
    __syncthreads();
}
__device__ __forceinline__ void convert_dyn(LAS unsigned char* lds, const CvtT C, unsigned* qctr, int dbase, int dend) {
    LAS int* bx = (LAS int*)(lds + 2 * 8704);
#pragma unroll 1
    for (;;) {
        __syncthreads();
        if (threadIdx.x == 0) bx[0] = dbase + (int)atomicAdd(qctr, 8u);
        __syncthreads();
        const int t0 = bx[0];
        if (t0 >= dend) break;
        convert_t_f8(lds, C, t0, min(t0 + 8, dend), 1);
    }
}

__device__ __forceinline__ void convert_seg(const float* __restrict__ src, bf16_t* __restrict__ dst, size_t n8, size_t gtid, size_t gstride) {
    const f32x4* s4 = (const f32x4*)src; u32x4* d4 = (u32x4*)dst;
#pragma unroll 4
    for (size_t i = gtid; i < n8; i += gstride) { const f32x4 a = __builtin_nontemporal_load(s4 + 2 * i), b = __builtin_nontemporal_load(s4 + 2 * i + 1);
        u32x4 w; w.x = pk_bf16(a[0], a[1]); w.y = pk_bf16(a[2], a[3]); w.z = pk_bf16(b[0], b[1]); w.w = pk_bf16(b[2], b[3]); d4[i] = w; }
}


#define XB_TMO      128
#define XB_XCNT(j)  (256  + 64 * (j))
#define XB_XSUB(j)  (1280 + 64 * (j))
#define XB_XGEN(j)  (2304 + 64 * (j))
#define XB_TOP      3328
#define XB_TOPGEN   3392
#define XCD_BAR_WORDS 3456
#define XB_SPIN_CAP (1u << 18)
__device__ __forceinline__ unsigned xb_ld(unsigned* p)              { return __hip_atomic_load(p, __ATOMIC_RELAXED, __HIP_MEMORY_SCOPE_AGENT); }
__device__ __forceinline__ unsigned xb_add(unsigned* p, unsigned v) { return __hip_atomic_fetch_add(p, v, __ATOMIC_RELAXED, __HIP_MEMORY_SCOPE_AGENT); }
__device__ __forceinline__ unsigned xb_xcc_id() { return (unsigned)__builtin_amdgcn_s_getreg((3 << 11) | 20) & 0xFu; }
#define XB_SPIN(cond, bar) do { unsigned _sp = 0; while (cond) { __builtin_amdgcn_s_sleep(1); \
    if ((++_sp & 255u) == 0u) { if (xb_ld(&(bar)[XB_TMO])) break; if (_sp > XB_SPIN_CAP) { atomicAdd(&(bar)[XB_TMO], 1u); break; } } } } while (0)
struct XcdBarrier { unsigned* bar; unsigned x; volatile LAS unsigned* st; };
__device__ __forceinline__ XcdBarrier xcd_barrier_post(unsigned* bar, volatile LAS unsigned* st) {
    XcdBarrier b; b.bar = bar; b.x = xb_xcc_id(); b.st = st;
    if (threadIdx.x == 0) (void)xb_add(&bar[XB_XCNT(b.x)], 1u);
    return b;
}
__device__ __forceinline__ void xcd_barrier_complete(unsigned* bar, unsigned x, unsigned& nloc, unsigned& nx) {
    const unsigned G = gridDim.x * gridDim.y * gridDim.z;
    unsigned sum, cnt, mine, sp = 0u;
    for (;;) {
        sum = 0u; cnt = 0u; mine = 0u;
#pragma unroll
        for (unsigned j = 0; j < 16; ++j) { const unsigned c = xb_ld(&bar[XB_XCNT(j)]); sum += c; cnt += (c > 0u) ? 1u : 0u; mine = (j == x) ? c : mine; }
        if (sum == G) break;
        __builtin_amdgcn_s_sleep(1);
        if ((++sp & 255u) == 0u) { if (xb_ld(&bar[XB_TMO])) break; if (sp > XB_SPIN_CAP) { atomicAdd(&bar[XB_TMO], 1u); break; } }
    }
    nloc = mine > 0u ? mine : 1u; nx = cnt > 0u ? cnt : 1u;
}
__device__ __forceinline__ void xcd_barrier(const XcdBarrier& b) {
    asm volatile("s_waitcnt vmcnt(0)" ::: "memory");
    __syncthreads();
    if (threadIdx.x == 0) {
        unsigned* bar = b.bar;
        __builtin_amdgcn_s_waitcnt(0);
        unsigned nloc = b.st[0], nx = b.st[1];
        if (nloc == 0u) { xcd_barrier_complete(bar, b.x, nloc, nx); b.st[0] = nloc; b.st[1] = nx; }
        const unsigned old = xb_add(&bar[XB_XSUB(b.x)], 1u);
        const unsigned gen = old / nloc;
        if (old + 1u == (gen + 1u) * nloc) {
            __builtin_amdgcn_fence(__ATOMIC_RELEASE, "agent");
            asm volatile("s_waitcnt vmcnt(0)" ::: "memory");
            const unsigned og = xb_add(&bar[XB_TOP], 1u);
            const unsigned tg = og / nx;
            if (og + 1u == (tg + 1u) * nx) xb_add(&bar[XB_TOPGEN], 1u);
            else XB_SPIN(xb_ld(&bar[XB_TOPGEN]) == tg, bar);
            __builtin_amdgcn_fence(__ATOMIC_ACQUIRE, "agent");
            xb_add(&bar[XB_XGEN(b.x)], 1u);
            asm volatile("s_waitcnt vmcnt(0)" ::: "memory");
        } else {
            XB_SPIN(xb_ld(&bar[XB_XGEN(b.x)]) == gen, bar);
            __builtin_amdgcn_fence(__ATOMIC_ACQUIRE, "agent");
            asm volatile("s_waitcnt vmcnt(0)" ::: "memory");
        }
    }
    __syncthreads();
}

__device__ __forceinline__ void ada_phase(LAS unsigned char* lds, const float* __restrict__ cvec, const float* __restrict__ w_ada, const float* __restrict__ b_ada, float* __restrict__ mod, int G, int c) {
    LAS float* ca = (LAS float*)lds;
    LAS float* part = (LAS float*)(lds + 32768);
    const int tid = threadIdx.x;
    __syncthreads();
    for (int i = tid; i < kB * kD; i += 512) { const float v = cvec[i]; ca[i] = v / (1.f + __expf(-v)); }
    __syncthreads();
    for (int cb = c; cb < 6 * kD / 48; cb += G) {
        const int n0 = cb * 48, cg = tid % 12, kr = tid / 12;
        if (tid < 504) {
            f32x4 a0 = {0.f, 0.f, 0.f, 0.f}, a1 = a0, a2 = a0, a3 = a0;
#pragma unroll 8
            for (int k = kr; k < kD; k += 42) { const f32x4 w = __builtin_nontemporal_load((const f32x4*)(w_ada + (size_t)k * (6 * kD) + n0 + cg * 4));
                a0 += ca[k] * w; a1 += ca[kD + k] * w; a2 += ca[2 * kD + k] * w; a3 += ca[3 * kD + k] * w; }
            LAS f32x4* pp = (LAS f32x4*)(part + (kr * 12 + cg) * 16); pp[0] = a0; pp[1] = a1; pp[2] = a2; pp[3] = a3;
        }
        __syncthreads();
        if (tid < 192) { const int col = tid % 48, b = tid / 48; float sum = 0.f;
            for (int r = 0; r < 42; ++r) sum += part[(r * 12 + (col >> 2)) * 16 + b * 4 + (col & 3)];
            mod[b * 6 * kD + n0 + col] = sum + b_ada[n0 + col]; }
        __syncthreads();
    }
}

__device__ __forceinline__ void norm1_phase(const float* __restrict__ x, const float* __restrict__ nw, const float* __restrict__ mod, bf16_t* __restrict__ out, int G, int c) {
    const int wid = threadIdx.x >> 6, lane = threadIdx.x & 63;
    for (int t = c * 8 + wid; t < kT; t += G * 8) {
        const int b = t / kS; const float* xr = x + (size_t)t * kD + lane * 4; const float* mb = mod + b * 6 * kD + lane * 4;
        f32x4 v[8]; float ss = 0.f;
#pragma unroll
        for (int j = 0; j < 8; ++j) { v[j] = *(const f32x4*)(xr + 256 * j); ss += v[j][0] * v[j][0] + v[j][1] * v[j][1] + v[j][2] * v[j][2] + v[j][3] * v[j][3]; }
        ss = wave_sum(ss);
        const float r = rsqrtf(ss * (1.f / kD) + kEPS);
#pragma unroll
        for (int j = 0; j < 8; ++j) { const f32x4 w = *(const f32x4*)(nw + lane * 4 + 256 * j), sh = *(const f32x4*)(mb + 256 * j), sc = *(const f32x4*)(mb + kD + 256 * j);
            const f32x4 y = v[j] * r * w * (1.f + sc) + sh; u32x2 o; o.x = pk_bf16(y[0], y[1]); o.y = pk_bf16(y[2], y[3]);
            *(u32x2*)(out + (size_t)t * kD + lane * 4 + 256 * j) = o; }
    }
}

__device__ __forceinline__ void split_bf16(const float (&v)[8], bf16x8& hi, bf16x8& lo) {
    u32x4 h, l;
#pragma unroll
    for (int i = 0; i < 4; ++i) { const unsigned hp = pk_bf16(v[2 * i], v[2 * i + 1]); h[i] = hp; l[i] = pk_bf16(v[2 * i] - bflo(hp), v[2 * i + 1] - bfhi(hp)); }
    hi = __builtin_bit_cast(bf16x8, h); lo = __builtin_bit_cast(bf16x8, l);
}
__device__ __forceinline__ void pack_router(const float* __restrict__ w_router, u32x4* __restrict__ wrp, size_t gtid, size_t gstride) {
    for (size_t i = gtid; i < 8192; i += gstride) { const int w_ = (int)(i >> 10), s_ = (int)(i >> 6) & 15, ln = (int)i & 63, q_ = ln & 31, h_ = ln >> 5;
        float wv[8];
#pragma unroll
        for (int j = 0; j < 8; ++j) wv[j] = w_router[(size_t)(256 * w_ + 16 * s_ + 8 * h_ + j) * kE + q_];
        bf16x8 hi, lo; split_bf16(wv, hi, lo);
        wrp[(w_ * 16 + s_) * 128 + ln] = __builtin_bit_cast(u32x4, hi); wrp[(w_ * 16 + s_) * 128 + 64 + ln] = __builtin_bit_cast(u32x4, lo); }
}
__device__ __forceinline__ void norm2_router_phase(LAS unsigned char* lds, const bf16_t* __restrict__ x1, const float* __restrict__ nw, const float* __restrict__ mod,
                                                   const u32x4* __restrict__ wrp, const float* __restrict__ b_router, unsigned char* __restrict__ h2,
                                                   float* __restrict__ gates, int* __restrict__ pair_e, int* __restrict__ pair_p, int* __restrict__ list, unsigned* __restrict__ ctrl, int G, int c) {
    typedef float f32x16 __attribute__((ext_vector_type(16)));
    const int tid = threadIdx.x, wid = __builtin_amdgcn_readfirstlane(tid >> 6), lane = tid & 63, ql = lane & 31, hf = lane >> 5;
    LAS float* part = (LAS float*)lds;
    LAS float* ssq = (LAS float*)(lds + 32768);
    LAS float* cA = (LAS float*)(lds + 36864);
    LAS float* cB = (LAS float*)(lds + 45056);
    LAS float* lg = (LAS float*)(lds + 53248);
    LAS int* sidx = (LAS int*)(lds + 57344);
    LAS float* sval = (LAS float*)(lds + 57856);
    LAS int* lcnt = (LAS int*)(lds + fg::MISC_OFF + 64);
    { const int blk = c;
        const int t0 = blk * 32, b = t0 / kS;
        __syncthreads();
        if (tid < 32) lcnt[tid] = 0;
        const bf16_t* xrow = x1 + (size_t)(t0 + ql) * kD + 256 * wid + 8 * hf;
        const u32x4* wp = wrp + (size_t)wid * 16 * 128 + lane;
        u32x4 xq[16], wA[8], wB[8];
#pragma unroll
        for (int s = 0; s < 16; ++s) xq[s] = *(const u32x4*)(xrow + 16 * s);
#define RT_LDW(W, Q) do { _Pragma("unroll") for (int i = 0; i < 4; ++i) { W[2 * i] = wp[(4 * (Q) + i) * 128]; W[2 * i + 1] = wp[(4 * (Q) + i) * 128 + 64]; } } while (0)
        RT_LDW(wA, 0);
        { const float* mrow = mod + b * 6 * kD;
          const f32x4 w4 = *(const f32x4*)(nw + 4 * tid), sh = *(const f32x4*)(mrow + 3 * kD + 4 * tid), sc = *(const f32x4*)(mrow + 4 * kD + 4 * tid);
          *(LAS f32x4*)(cA + 4 * tid) = w4 * (1.f + sc); *(LAS f32x4*)(cB + 4 * tid) = sh; }
        float ss = 0.f;
#pragma unroll
        for (int s = 0; s < 16; ++s)
#pragma unroll
            for (int q = 0; q < 4; ++q) { const float lo_ = bflo(xq[s][q]), hi_ = bfhi(xq[s][q]); ss += lo_ * lo_ + hi_ * hi_; }
        ss += __shfl_xor(ss, 32);
        if (hf == 0) ssq[wid * 32 + ql] = ss;
        __syncthreads();
        float tot = 0.f;
#pragma unroll
        for (int w8 = 0; w8 < 8; ++w8) tot += ssq[w8 * 32 + ql];
        const float rq = rsqrtf(tot * (1.f / kD) + kEPS);
        f32x16 acc;
#pragma unroll
        for (int r = 0; r < 16; ++r) acc[r] = 0.f;
        unsigned char* hrow = h2 + (size_t)(t0 + ql) * kD + 256 * wid + 8 * hf;
#define RT_COMP(W, Q) do { _Pragma("unroll") for (int i = 0; i < 4; ++i) { const int s = 4 * (Q) + i; \
            const int k0 = 256 * wid + 8 * hf + 16 * s; \
            const f32x4 a0 = *(LAS const f32x4*)(cA + k0), a1 = *(LAS const f32x4*)(cA + k0 + 4), b0 = *(LAS const f32x4*)(cB + k0), b1 = *(LAS const f32x4*)(cB + k0 + 4); \
            const f32x4 xa = {bflo(xq[s].x), bfhi(xq[s].x), bflo(xq[s].y), bfhi(xq[s].y)}, xb = {bflo(xq[s].z), bfhi(xq[s].z), bflo(xq[s].w), bfhi(xq[s].w)}; \
            const f32x4 ya = xa * rq * a0 + b0, yb = xb * rq * a1 + b1; \
            const float y[8] = {ya[0], ya[1], ya[2], ya[3], yb[0], yb[1], yb[2], yb[3]}; \
            u32x2 hq; hq.x = pk4_fp8(clamp448(y[0]), clamp448(y[1]), clamp448(y[2]), clamp448(y[3])); hq.y = pk4_fp8(clamp448(y[4]), clamp448(y[5]), clamp448(y[6]), clamp448(y[7])); \
            *(u32x2*)(hrow + 16 * s) = hq; \
            bf16x8 yh, yl; split_bf16(y, yh, yl); \
            const bf16x8 whv = __builtin_bit_cast(bf16x8, W[2 * i]), wlv = __builtin_bit_cast(bf16x8, W[2 * i + 1]); \
            acc = __builtin_amdgcn_mfma_f32_32x32x16_bf16(yh, whv, acc, 0, 0, 0); \
            acc = __builtin_amdgcn_mfma_f32_32x32x16_bf16(yl, whv, acc, 0, 0, 0); \
            acc = __builtin_amdgcn_mfma_f32_32x32x16_bf16(yh, wlv, acc, 0, 0, 0); } } while (0)
        RT_LDW(wB, 1); RT_COMP(wA, 0);
        RT_LDW(wA, 2); RT_COMP(wB, 1);
        RT_LDW(wB, 3); RT_COMP(wA, 2);
        RT_COMP(wB, 3);
#undef RT_LDW
#undef RT_COMP
#pragma unroll
        for (int r = 0; r < 16; ++r) part[(wid * 32 + (r & 3) + 8 * (r >> 2) + 4 * hf) * 32 + ql] = acc[r];
        __syncthreads();
        const int tok = tid >> 4, e2 = (tid & 15) * 2;
        { float v0 = 0.f, v1 = 0.f;
#pragma unroll
          for (int w8 = 0; w8 < 8; ++w8) { const f32x2 pp = *(LAS const f32x2*)(part + (w8 * 32 + tok) * 32 + e2); v0 += pp[0]; v1 += pp[1]; }
          f32x2 o; o[0] = v0 + b_router[e2]; o[1] = v1 + b_router[e2 + 1]; *(LAS f32x2*)(lg + tok * 32 + e2) = o; }
        __syncthreads();
        { const f32x2 mine = *(LAS const f32x2*)(lg + tok * 32 + e2); int r0 = 0, r1 = 0;
#pragma unroll
          for (int j4 = 0; j4 < 8; ++j4) { const f32x4 v = *(LAS const f32x4*)(lg + tok * 32 + 4 * j4);
#pragma unroll
              for (int jj = 0; jj < 4; ++jj) { const int j = 4 * j4 + jj; const float vj = v[jj];
                  r0 += (vj > mine[0] || (vj == mine[0] && j < e2)) ? 1 : 0; r1 += (vj > mine[1] || (vj == mine[1] && j < e2 + 1)) ? 1 : 0; } }
          if (r0 < 4) { sidx[tok * 4 + r0] = e2; sval[tok * 4 + r0] = mine[0]; }
          if (r1 < 4) { sidx[tok * 4 + r1] = e2 + 1; sval[tok * 4 + r1] = mine[1]; } }
        __syncthreads();
        if (tid < 32) { const int t = t0 + tid; const i32x4 id = *(LAS const i32x4*)(sidx + 4 * tid); const f32x4 vv = *(LAS const f32x4*)(sval + 4 * tid); float ex[4], sum = 0.f;
#pragma unroll
            for (int k = 0; k < 4; ++k) { ex[k] = __expf(vv[k] - vv[0]); sum += ex[k]; }
            const float inv = 1.f / sum;
            f32x4 gv; gv[0] = ex[0] * inv; gv[1] = ex[1] * inv; gv[2] = ex[2] * inv; gv[3] = ex[3] * inv; *(f32x4*)(gates + t * 4) = gv;
#pragma unroll
            for (int k = 0; k < 4; ++k) { lcnt[64 + tid * 4 + k] = id[k]; lcnt[192 + tid * 4 + k] = __hip_atomic_fetch_add(&lcnt[id[k]], 1, __ATOMIC_RELAXED, __HIP_MEMORY_SCOPE_WORKGROUP); } }
        __syncthreads();
        if (tid < 32) { const int n = lcnt[tid]; lcnt[32 + tid] = n > 0 ? (int)atomicAdd(&ctrl[CT_CNT + 64 * tid], (unsigned)n) : 0; }
        __syncthreads();
        if (tid < 128) { const int e = lcnt[64 + tid], pos = lcnt[32 + e] + lcnt[192 + tid], t = blk * 32 + (tid >> 2);
            pair_e[t * 4 + (tid & 3)] = e; pair_p[t * 4 + (tid & 3)] = pos; list[(size_t)e * kT + pos] = t; }
    }
}

__device__ __forceinline__ void final_phase(const bf16_t* __restrict__ x1, const float* __restrict__ mod, const float* __restrict__ gates, const int* __restrict__ pair_e, const int* __restrict__ pair_p,
                                            const MoeTab M, const unsigned char* __restrict__ yp, float* __restrict__ out, int G, int c) {
    const int wid = threadIdx.x >> 6, lane = threadIdx.x & 63;
    for (int t = c * 8 + wid; t < kT; t += G * 8) {
        const int b = t / kS; float gk[4]; const unsigned char* rp[4];
#pragma unroll
        for (int k = 0; k < 4; ++k) { gk[k] = gates[t * 4 + k]; const int e = pair_e[t * 4 + k];
            rp[k] = yp + (size_t)(M.t[32 + e] + pair_p[t * 4 + k]) * kD + lane * 8; }
#pragma unroll
        for (int j = 0; j < 4; ++j) { f32x4 y0 = {0.f, 0.f, 0.f, 0.f}, y1 = y0;
#pragma unroll
            for (int k = 0; k < 4; ++k) { const u32x2 v = *(const u32x2*)(rp[k] + 512 * j);
                const f32x2 a0 = __builtin_amdgcn_cvt_pk_f32_fp8((int)v.x, false), a1 = __builtin_amdgcn_cvt_pk_f32_fp8((int)v.x, true), a2 = __builtin_amdgcn_cvt_pk_f32_fp8((int)v.y, false), a3 = __builtin_amdgcn_cvt_pk_f32_fp8((int)v.y, true);
                y0 += gk[k] * (f32x4){a0[0], a0[1], a1[0], a1[1]}; y1 += gk[k] * (f32x4){a2[0], a2[1], a3[0], a3[1]}; }
            const size_t o = (size_t)t * kD + lane * 8 + 512 * j; const float* gp = mod + b * 6 * kD + 5 * kD + lane * 8 + 512 * j;
            const u32x4 xq = *(const u32x4*)(x1 + o); const f32x4 xa = {bflo(xq.x), bfhi(xq.x), bflo(xq.y), bfhi(xq.y)}, xb = {bflo(xq.z), bfhi(xq.z), bflo(xq.w), bfhi(xq.w)};
            *(f32x4*)(out + o) = xa + *(const f32x4*)gp * y0; *(f32x4*)(out + o + 4) = xb + *(const f32x4*)(gp + 4) * y1; }
    }
}

struct MegaArgs { const float* in[18]; float* out; unsigned char* ws; int ph_lo, ph_hi; };
constexpr int NPHASE = 10;
__global__ void __launch_bounds__(512, 2) mega(MegaArgs a) {
    extern __shared__ __attribute__((aligned(16))) unsigned char lds_raw[];
    LAS unsigned char* lds = (LAS unsigned char*)lds_raw;
    unsigned char* ws = a.ws;
    const int lo = a.ph_lo, hi = a.ph_hi;
#define IN(k) (lo <= (k) && (k) < hi)
#define SEAM(k) do { if (IN(k) && IN((k) + 1)) xcd_barrier(bar); } while (0)
    const int G = gridDim.x, c = blockIdx.x;
    unsigned* ctrl = (unsigned*)(ws + WS_CTRL);
    const int grp = (c >> 3) & 1, cpr = ((c >> 4) << 3) | (c & 7);
#define HOST_PRE(CC, r0, n)  do { if (grp == 0) convert_t_f8(lds, CC, (r0) + cpr, (r0) + (G / 2) * (n), G / 2); } while (0)
#define HOST_POST(CC, r0, n, q) convert_dyn(lds, CC, ctrl + CT_Q + 64 * (q), (r0) + (G / 2) * (n), (r0) + G * (n))
    const int r_p2 = 0, r_p3 = 56 * G, r_p5 = 84 * G, r_p6 = 92 * G;
    const CvtT C1 = cvt_make(a.in[14], (unsigned char*)(ws + WS_WE1), kD, 2 * kDFF);
    const CvtT C2 = cvt_make(a.in[16], (unsigned char*)(ws + WS_WE2), kDFF, kD);
    if (threadIdx.x == 0) *(LAS u32x4*)(lds + fg::MISC_OFF) = (u32x4){0u, 0u, 0u, 0u};
    __syncthreads();
    XcdBarrier bar; bar.bar = ctrl; bar.x = 0; bar.st = (volatile LAS unsigned*)(lds + fg::MISC_OFF);
    if (hi - lo > 1) bar = xcd_barrier_post(ctrl, (volatile LAS unsigned*)(lds + fg::MISC_OFF));
    float* mod = (float*)(ws + WS_MOD);
    if (IN(0)) {
        ada_phase(lds, a.in[1], a.in[4], a.in[5], mod, G, c);
        const size_t gtid = (size_t)blockIdx.x * 512 + threadIdx.x, gstride = (size_t)G * 512;
        convert_seg(a.in[6], (bf16_t*)(ws + WS_WIN), (size_t)kD * kNPROJ / 8, gtid, gstride);
        convert_seg(a.in[11], (bf16_t*)(ws + WS_WO), (size_t)kSB * kD / 8, gtid, gstride);
        convert_seg(a.in[11] + (size_t)kSB * kD, (bf16_t*)(ws + WS_P), (size_t)kPW * kD / 8, gtid, gstride);
        pack_router(a.in[12], (u32x4*)(ws + WS_WRP), gtid, gstride);
        { const f32x4* s4 = (const f32x4*)a.in[9]; const f32x4* sc4 = (const f32x4*)a.in[10]; u32x4* d4 = (u32x4*)(ws + WS_WPL);
          for (size_t i = gtid; i < (size_t)4 * kPG * kPG / 8; i += gstride) { const int g = (int)(i >> 13), n8 = (int)(i & 31);
              const f32x4 sa = sc4[g * 64 + n8 * 2], sb = sc4[g * 64 + n8 * 2 + 1]; const f32x4 a0 = s4[2 * i] * sa, b0 = s4[2 * i + 1] * sb;
              u32x4 w; w.x = pk_bf16(a0[0], a0[1]); w.y = pk_bf16(a0[2], a0[3]); w.z = pk_bf16(b0[0], b0[1]); w.w = pk_bf16(b0[2], b0[3]); d4[i] = w; } }
    }
    SEAM(0);
    if (IN(1)) norm1_phase(a.in[0], a.in[2], mod, (bf16_t*)(ws + WS_H), G, c);
    SEAM(1);
    if (IN(2)) HOST_PRE(C1, r_p2, 56);
    if (IN(2)) { JobInProj J; J.A = (const char*)(ws + WS_H); J.lda2 = kD * 2; J.ldb2 = kNPROJ * 2; J.bhalf2 = 256; J.K = kD; J.list = nullptr;
        J.B = (const char*)(ws + WS_WIN); J.out = (bf16_t*)(ws + WS_PROJ); J.S.init(kT, kNPROJ, G, c); fg::gemm_phase(lds, J); }
    if (IN(2)) { JobPoolFold J; J.A = (const char*)(ws + WS_WPL); J.lda2 = kPG * 2; J.ldb2 = kD * 2; J.bhalf2 = 256; J.K = kPG; J.list = nullptr;
        J.B = (const char*)(ws + WS_P); J.wo = (bf16_t*)(ws + WS_WO); J.G = G; J.c = c; fg::gemm_phase(lds, J); }
    if (IN(2)) HOST_POST(C1, r_p2, 56, 0);
    SEAM(2);
    if (IN(3)) HOST_PRE(C1, r_p3, 28);
    if (IN(3)) { at::attn_phase(lds, (const bf16_t*)(ws + WS_PROJ), a.in[7], a.in[8], (bf16_t*)(ws + WS_CAT), G, c);
        pool_p_phase((const bf16_t*)(ws + WS_PROJ), (bf16_t*)(ws + WS_CAT), G, c); }
    if (IN(3)) HOST_POST(C1, r_p3, 28, 1);
    SEAM(3);
    if (IN(5)) HOST_PRE(C1, r_p5, 8);
    if (IN(5)) { JobOutProj J; J.A = (const char*)(ws + WS_CAT); J.lda2 = kD * 2; J.ldb2 = kD * 2; J.bhalf2 = 256; J.K = kD; J.list = nullptr;
        J.B = (const char*)(ws + WS_WO); J.x = a.in[0]; J.mod = mod; J.x1 = (bf16_t*)(ws + WS_X1); J.S.init(kT, kD, G, c); fg::gemm_phase(lds, J); }
    if (IN(5)) HOST_POST(C1, r_p5, 8, 2);
    SEAM(5);
    if (IN(6)) HOST_PRE(C1, r_p6, 36);
    if (IN(6)) norm2_router_phase(lds, (const bf16_t*)(ws + WS_X1), a.in[3], mod, (const u32x4*)(ws + WS_WRP), a.in[13], (unsigned char*)(ws + WS_H2), (float*)(ws + WS_GATES), (int*)(ws + WS_PAIRE), (int*)(ws + WS_PAIRP),
                                  (int*)(ws + WS_LIST), ctrl, G, c);
    if (IN(6)) HOST_POST(C1, r_p6, 36, 3);
    SEAM(6);
    if (IN(7)) HOST_PRE(C2, 0, 64);
    if (IN(7)) { JobMoe1F8 J; J.A = (const char*)(ws + WS_H2); J.lda2 = kD; J.ldb2 = kD; J.bhalf2 = (unsigned)kDFF * kD; J.K = kD; J.list = (const int*)(ws + WS_LIST);
        J.B = (const char*)(ws + WS_WE1); J.b_in = a.in[15]; J.act = (unsigned char*)(ws + WS_ACT); J.M = moe_tables(lds, ctrl, kDFF / 128); J.G = G; J.c = c; fg::gemm_phase_f8(lds, J); }
    if (IN(7)) HOST_POST(C2, 0, 64, 4);
    SEAM(7);
    if (IN(8)) { JobMoe2F8 J; J.A = (const char*)(ws + WS_ACT); J.lda2 = kDFF; J.ldb2 = kDFF; J.bhalf2 = 128u * kDFF; J.K = kDFF; J.list = nullptr;
        J.B = (const char*)(ws + WS_WE2); J.b_out = a.in[17]; J.yp = (unsigned char*)(ws + WS_YP); J.M = moe_tables(lds, ctrl, kD / 256); J.G = G; J.c = c; fg::gemm_phase_f8(lds, J); }
    SEAM(8);
    if (IN(9)) final_phase((const bf16_t*)(ws + WS_X1), mod, (const float*)(ws + WS_GATES), (const int*)(ws + WS_PAIRE), (const int*)(ws + WS_PAIRP), moe_tables(lds, ctrl, 1), (const unsigned char*)(ws + WS_YP), a.out, G, c);
#undef IN
#undef SEAM
}

#ifndef N_LAUNCHES
#define N_LAUNCHES 1
#endif
extern "C" void kernel_launch(void* const* d_in, const int* in_sizes, int n_in, void* d_out, int out_size, void* d_ws, size_t ws_size, hipStream_t stream) {
    static int grid = 0;
    if (grid == 0) {
        int dev = 0, cus = 0;
        (void)hipGetDevice(&dev); (void)hipDeviceGetAttribute(&cus, hipDeviceAttributeMultiprocessorCount, dev);
        (void)hipFuncSetAttribute((const void*)mega, hipFuncAttributeMaxDynamicSharedMemorySize, fg::LDS_BYTES);
        (void)cus; grid = 256;
    }
    MegaArgs a{}; for (int i = 0; i < 18; ++i) a.in[i] = (const float*)d_in[i]; a.out = (float*)d_out; a.ws = (unsigned char*)d_ws;
    (void)hipMemsetAsync((char*)d_ws + WS_CTRL, 0, 65536, stream);
    if (N_LAUNCHES == 1) { a.ph_lo = 0; a.ph_hi = NPHASE; hipLaunchKernelGGL(mega, dim3(grid), dim3(512), fg::LDS_BYTES, stream, a); }
    else for (int p = 0; p < NPHASE; ++p) { a.ph_lo = p; a.ph_hi = p + 1; hipLaunchKernelGGL(mega, dim3(grid), dim3(512), fg::LDS_BYTES, stream, a); }
}
```

```cpp
#include <hip/hip_runtime.h>
#include <stdint.h>

constexpr int kB = 4, kS = 2048, kD = 2048, kT = kB * kS;
constexpr int kHD = 128, kNH = 8, kSB = 1024, kPW = 1024, kPG = 256;
constexpr int kNPROJ = 4096, kE = 32, kTOPK = 4, kDFF = 2048;
constexpr float kEPS = 1e-6f;
constexpr int kMaxSlots = 160 * 256;

typedef unsigned short bf16_t;
__device__ __forceinline__ bf16_t f2bf(float f) { unsigned u = __float_as_uint(f); u += 0x7FFFu + ((u >> 16) & 1u); return (bf16_t)(u >> 16); }
__device__ __forceinline__ float bf2f(bf16_t b) { return __uint_as_float(((unsigned)b) << 16); }

constexpr size_t WS_CTRL   = 0;
constexpr size_t WS_MOD    = 65536;
constexpr size_t WS_H      = WS_MOD + (size_t)4 * 12288 * 4;
constexpr size_t WS_PROJ   = WS_H + (size_t)kT * kD * 2;
constexpr size_t WS_CAT    = WS_PROJ + (size_t)kT * kNPROJ * 2;
constexpr size_t WS_P      = WS_CAT + (size_t)kT * kD * 2;
constexpr size_t WS_X1     = WS_P + (size_t)kT * kPW * 2;
constexpr size_t WS_H2     = WS_X1 + (size_t)kT * kD * 4;
constexpr size_t WS_GATES  = WS_H2 + (size_t)kT * kD * 2;
constexpr size_t WS_PAIRE  = WS_GATES + (size_t)kT * 4 * 4;
constexpr size_t WS_PAIRP  = WS_PAIRE + (size_t)kT * 4 * 4;
constexpr size_t WS_LIST   = WS_PAIRP + (size_t)kT * 4 * 4;
constexpr size_t WS_ACT    = WS_LIST + (size_t)kE * kT * 4;
constexpr size_t WS_YP     = WS_ACT + (size_t)kMaxSlots * kDFF * 2;
constexpr size_t WS_END    = WS_YP + (size_t)kMaxSlots * kD * 2;
constexpr int CT_CNT = 4096;
constexpr int CT_ROWBASE = 4160;
constexpr int CT_Q = 8192;
constexpr int CT_W2L = CT_Q + 64 * 6;

#define LAS __attribute__((address_space(3)))
typedef short bf16x8 __attribute__((ext_vector_type(8)));
typedef short s16x4 __attribute__((ext_vector_type(4)));
typedef float f32x4 __attribute__((ext_vector_type(4)));
typedef float f32x2 __attribute__((ext_vector_type(2)));
typedef __bf16 bf16v2 __attribute__((ext_vector_type(2)));
typedef unsigned u32x2 __attribute__((ext_vector_type(2)));
typedef unsigned u32x4 __attribute__((ext_vector_type(4)));
typedef int i32x4 __attribute__((ext_vector_type(4)));
typedef int i32x8 __attribute__((ext_vector_type(8)));
__device__ __forceinline__ unsigned pk_bf16(float a, float b) { f32x2 v = {a, b}; bf16v2 r = __builtin_convertvector(v, bf16v2); return __builtin_bit_cast(unsigned, r); }

constexpr size_t WS_WIN  = WS_END;
constexpr size_t WS_WO   = WS_WIN + (size_t)kD * kNPROJ * 2;
constexpr size_t WS_WPL  = WS_WO + (size_t)kD * kD * 2;
constexpr size_t WS_WE1  = WS_WPL + (size_t)4 * kPG * kPG * 2;
constexpr size_t WS_WE2  = WS_WE1 + (size_t)kE * kD * 2 * kDFF * 2;
constexpr size_t WS_END2 = WS_WE2 + (size_t)kE * kDFF * kD * 2;
constexpr size_t WS_WRP  = WS_END2;

namespace fg {
constexpr int BM = 256, BK = 64, HALF = 128, HTB = 16384, STAGE_BYTES = 131072, NXCD = 8, WGM = 8;
constexpr int TAB_OFF = STAGE_BYTES;
constexpr int MISC_OFF = STAGE_BYTES + 2048;
constexpr int LDS_BYTES = STAGE_BYTES + 4096;
__device__ __forceinline__ int lds_byte(int r, int c) { const int st = (r >> 4) * 2 + (c >> 5), rr = r & 15, cc = c & 31, ob = rr * 64 + cc * 2; return st * 1024 + (ob ^ (((ob >> 9) & 1) << 5)); }
__device__ __forceinline__ void stage_rc(int b, int& R, int& C) { const int st = b / 1024, sb = b % 1024, swz = sb ^ (((sb >> 9) & 1) << 5); R = (st >> 1) * 16 + swz / 64; C = (st & 1) * 32 + (swz % 64) / 2; }

struct Unit { const char* bBase; int arow0; int nvalid; int e; int orow0; int ocol0; int acol2; };

struct StaticOrder {
    int nM, nN, nwg, G, c;
    __device__ void init(int M, int N, int G_, int c_) { nM = M / BM; nN = N / BM; nwg = nM * nN; G = G_; c = c_; }
    __device__ bool next(int i, int& pm, int& pn) const {
        const long L = (long)i * G + c; if (L >= nwg) return false;
        int wgid = (int)L; { const int q = nwg / NXCD, r = nwg % NXCD, xcd = wgid % NXCD, off = wgid / NXCD; wgid = (xcd < r ? xcd * (q + 1) : r * (q + 1) + (xcd - r) * q) + off; }
        const int nig = WGM * nN, gid = wgid / nig, fm = gid * WGM, gsz = (nM - fm) < WGM ? (nM - fm) : WGM;
        pm = fm + ((wgid % nig) % gsz); pn = (wgid % nig) / gsz; return true;
    }
};

template <int OFF> __device__ __forceinline__ s16x4 tr_read(unsigned addr) { s16x4 r; asm volatile("ds_read_b64_tr_b16 %0, %1 offset:%2" : "=&v"(r) : "v"(addr), "i"(OFF) : "memory"); return r; }
template <class Job>
__device__ __forceinline__ void gemm_phase(LAS unsigned char* lds, const Job& J) {
    const int tid = threadIdx.x, wid = __builtin_amdgcn_readfirstlane(tid >> 6), lane = tid & 63, wr = wid >> 2, wc = wid & 3, fr = lane & 15, fq = lane >> 4;
    const int nt = J.K / BK;
    unsigned voffB[2];
#pragma unroll
    for (int i = 0; i < 2; ++i) { int R, C; stage_rc(tid * 16 + i * 8192, R, C);
        const int b = tid * 16 + i * 8192, row = b >> 8, slot = (b >> 4) & 15, ch = slot ^ (((row & 3) << 2) | ((row >> 2) & 3)); voffB[i] = (unsigned)row * J.ldb2 + (unsigned)ch * 16u; }
    const size_t kstepB = (size_t)BK * J.ldb2;
    const unsigned ldsw = (unsigned)wid * 1024u;
    const int aoff = lds_byte(wr * 64 + fr, fq * 8);
    const int tq = (lane & 15) >> 2, tp = lane & 3;
    unsigned ba[2][2];
#pragma unroll
    for (int n = 0; n < 2; ++n)
#pragma unroll
        for (int t = 0; t < 2; ++t) ba[n][t] = (unsigned)(uintptr_t)lds + 256u * (8 * fq + 4 * t + tq) + 16u * ((4 * wc + 2 * n + (tp >> 1)) ^ ((tq << 2) | ((2 * fq + t) & 3))) + 8u * (tp & 1);
#define FG_SA(b, h) (65536 + ((b) * 2 + (h)) * HTB)
#define FG_SB(b, h) (((b) * 2 + (h)) * HTB)
#define FG_STAGE_A(bufoff, gk, vo) do { _Pragma("unroll") for (int _i = 0; _i < 2; ++_i) \
        __builtin_amdgcn_global_load_lds((const unsigned*)((gk) + (vo)[_i]), (LAS unsigned*)(lds + (bufoff) + ldsw + _i * 8192), 16, 0, 0); } while (0)
#define FG_STAGE_B(bufoff, gk) do { _Pragma("unroll") for (int _i = 0; _i < 2; ++_i) \
        __builtin_amdgcn_global_load_lds((const unsigned*)((gk) + voffB[_i]), (LAS unsigned*)(lds + (bufoff) + ldsw + _i * 8192), 16, 0, 0); } while (0)
#define FG_LDA(dst, b, h) do { _Pragma("unroll") for (int m = 0; m < 4; ++m) _Pragma("unroll") for (int k = 0; k < 2; ++k) dst[m][k] = *(const LAS bf16x8*)(lds + FG_SA(b, h) + aoff + m * 2048 + k * 1024); } while (0)
#define FG_LDB(dst, b, h) do { \
        dst##lo[0][0] = tr_read<FG_SB(b, h)>(ba[0][0]);        dst##hi[0][0] = tr_read<FG_SB(b, h)>(ba[0][1]); \
        dst##lo[0][1] = tr_read<FG_SB(b, h) + 8192>(ba[0][0]); dst##hi[0][1] = tr_read<FG_SB(b, h) + 8192>(ba[0][1]); \
        dst##lo[1][0] = tr_read<FG_SB(b, h)>(ba[1][0]);        dst##hi[1][0] = tr_read<FG_SB(b, h)>(ba[1][1]); \
        dst##lo[1][1] = tr_read<FG_SB(b, h) + 8192>(ba[1][0]); dst##hi[1][1] = tr_read<FG_SB(b, h) + 8192>(ba[1][1]); } while (0)
#define FG_PK(L, H) (bf16x8){L[0], L[1], L[2], L[3], H[0], H[1], H[2], H[3]}
#define FG_MMA(ai, bj, At, Bt) do { __builtin_amdgcn_s_setprio(1); _Pragma("unroll") for (int m = 0; m < 4; ++m) _Pragma("unroll") for (int n = 0; n < 2; ++n) _Pragma("unroll") for (int k = 0; k < 2; ++k) \
        acc[ai][bj][m][n] = __builtin_amdgcn_mfma_f32_16x16x32_bf16(FG_PK(Bt##lo[n][k], Bt##hi[n][k]), At[m][k], acc[ai][bj][m][n], 0, 0, 0); __builtin_amdgcn_s_setprio(0); } while (0)
#define FG_WAIT_V(n) asm volatile("s_waitcnt vmcnt(" #n ")" ::: "memory")
#define FG_WAIT_L(n) asm volatile("s_waitcnt lgkmcnt(" #n ")" ::: "memory")
#define FG_BAR __builtin_amdgcn_s_barrier()
#define FG_SCHED __builtin_amdgcn_sched_barrier(0)
#define FG_AOFF(dst, u, tabp) do { int _tz = threadIdx.x; asm volatile("" : "+v"(_tz)); _Pragma("unroll") for (int _i = 0; _i < 2; ++_i) { int _R, _C; stage_rc(_tz * 16 + _i * 8192, _R, _C); \
        _Pragma("unroll") for (int _h = 0; _h < 2; ++_h) { const int _r = _h * 128 + _R; \
        if (Job::GATHER) { const int _tok = (tabp)[_r < (u).nvalid ? _r : 0]; dst[_h][_i] = (unsigned)_tok * J.lda2 + (unsigned)(_C * 2); } \
        else dst[_h][_i] = (unsigned)((u).arow0 + _r) * J.lda2 + (unsigned)((u).acol2 + _C * 2); } } } while (0)
    Unit cur, nxt; int ui = 0;
    if (!J.next(0, cur)) return;
    LAS const int* tab0 = (LAS const int*)(lds + TAB_OFF);
    if (Job::GATHER) {
        if (wid == 0) __builtin_amdgcn_global_load_lds((const unsigned*)(J.list + cur.arow0 + lane * 4), (LAS unsigned*)(lds + TAB_OFF), 16, 0, 0);
        FG_WAIT_V(0); __syncthreads();
    }
    f32x4 acc[2][2][4][2];
#pragma unroll
    for (int a = 0; a < 2; ++a)
#pragma unroll
        for (int b = 0; b < 2; ++b)
#pragma unroll
            for (int m = 0; m < 4; ++m)
#pragma unroll
                for (int n = 0; n < 2; ++n) acc[a][b][m][n] = (f32x4){0.f, 0.f, 0.f, 0.f};
    bf16x8 At[4][2]; s16x4 B0lo[2][2], B0hi[2][2], B1lo[2][2], B1hi[2][2];
    unsigned vc[2][2];
    FG_AOFF(vc, cur, tab0);
    const char* const gA = J.A;
    const char* cB = cur.bBase;
    const unsigned bh2 = J.bhalf2;
    FG_STAGE_B(FG_SB(0, 0), cB); FG_STAGE_A(FG_SA(0, 0), gA, vc[0]); FG_STAGE_B(FG_SB(0, 1), cB + bh2); FG_STAGE_A(FG_SA(0, 1), gA, vc[1]);
    if (wr == 1) FG_BAR;
    FG_WAIT_V(4); FG_BAR;
    FG_STAGE_B(FG_SB(1, 0), cB + kstepB); FG_STAGE_A(FG_SA(1, 0), gA + 128, vc[0]); FG_STAGE_B(FG_SB(1, 1), cB + kstepB + bh2);
    FG_WAIT_V(6); FG_BAR;
    for (;;) {
        const bool has_next = J.next(ui + 1, nxt);
        if (!has_next) nxt = cur;
        if (Job::GATHER && has_next && wid == 0)
            __builtin_amdgcn_global_load_lds((const unsigned*)(J.list + nxt.arow0 + lane * 4), (LAS unsigned*)(lds + TAB_OFF + ((ui + 1) & 1) * 1024), 16, 0, 0);
        const char* nB = nxt.bBase;
        for (int t = 0; t < nt; t += 2) {
            const bool last = (t == nt - 2);
            const char* a1 = gA + (size_t)(t + 1) * 128;
            const char* a2 = last ? gA : gA + (size_t)(t + 2) * 128; const char* b2 = last ? nB : cB + (size_t)(t + 2) * kstepB;
            const char* a3 = a2 + 128; const char* b3 = b2 + kstepB;
            FG_LDB(B0, 0, 0); FG_SCHED; FG_LDA(At, 0, 0); FG_STAGE_A(FG_SA(1, 1), a1, vc[1]);
            if (last && has_next) { LAS const int* tabn = (LAS const int*)(lds + TAB_OFF + ((ui + 1) & 1) * 1024); FG_AOFF(vc, nxt, tabn); }
            FG_WAIT_L(8); FG_BAR; FG_WAIT_L(0); FG_SCHED; FG_MMA(0, 0, At, B0); FG_BAR; FG_SCHED;
            FG_LDB(B1, 0, 1); FG_STAGE_B(FG_SB(0, 0), b2);
            FG_BAR; FG_WAIT_L(0); FG_SCHED; FG_MMA(0, 1, At, B1); FG_BAR;
            FG_LDA(At, 0, 1); FG_STAGE_A(FG_SA(0, 0), a2, vc[0]);
            FG_BAR; FG_WAIT_L(0); FG_MMA(1, 0, At, B0); FG_BAR; FG_SCHED;
            FG_STAGE_B(FG_SB(0, 1), b2 + bh2);
            FG_WAIT_V(6); FG_BAR; FG_MMA(1, 1, At, B1); FG_BAR;
            FG_LDB(B0, 1, 0); FG_SCHED; FG_LDA(At, 1, 0); FG_STAGE_A(FG_SA(0, 1), a2, vc[1]);
            FG_WAIT_L(8); FG_BAR; FG_WAIT_L(0); FG_SCHED; FG_MMA(0, 0, At, B0); FG_BAR; FG_SCHED;
            FG_LDB(B1, 1, 1); FG_STAGE_B(FG_SB(1, 0), b3);
            FG_BAR; FG_WAIT_L(0); FG_SCHED; FG_MMA(0, 1, At, B1); FG_BAR;
            FG_LDA(At, 1, 1); FG_STAGE_A(FG_SA(1, 0), a3, vc[0]);
            FG_BAR; FG_WAIT_L(0); FG_MMA(1, 0, At, B0); FG_BAR; FG_SCHED;
            FG_STAGE_B(FG_SB(1, 1), b3 + bh2);
            FG_WAIT_V(6); FG_BAR; FG_MMA(1, 1, At, B1); FG_BAR;
        }
        J.epi(acc, cur, wr, wc, fr, fq);
        if (!has_next) break;
#pragma unroll
        for (int a = 0; a < 2; ++a)
#pragma unroll
            for (int b = 0; b < 2; ++b)
#pragma unroll
                for (int m = 0; m < 4; ++m)
#pragma unroll
                    for (int n = 0; n < 2; ++n) acc[a][b][m][n] = (f32x4){0.f, 0.f, 0.f, 0.f};
        cur = nxt; cB = nB; ++ui;
    }
    FG_WAIT_V(0);
    if (wr == 0) FG_BAR;
    FG_BAR;
}

#undef FG_SA
#undef FG_SB
#undef FG_STAGE_A
#undef FG_STAGE_B
#undef FG_LDA
#undef FG_LDB
#undef FG_MMA
#undef FG_WAIT_V
#undef FG_WAIT_L
#undef FG_BAR
#undef FG_SCHED
#undef FG_AOFF
template <class Job>
__device__ __forceinline__ void gemm_phase_f8(LAS unsigned char* lds, const Job& J) {
    const int tid = threadIdx.x, wid = __builtin_amdgcn_readfirstlane(tid >> 6), lane = tid & 63, wr = wid >> 2, wc = wid & 3, fr = lane & 15, fq = lane >> 4;
    const int nt = J.K / 128;
    unsigned voffB[2];
#pragma unroll
    for (int i = 0; i < 2; ++i) { int R, C; stage_rc(tid * 16 + i * 8192, R, C);
        voffB[i] = (unsigned)R * J.ldb2 + (unsigned)(C * 2); }
    const size_t kstepB = J.kstepB, kstepA = Job::ABLK ? 16384 : 128;
    const unsigned ldsw = (unsigned)wid * 1024u;
    const int aoff = lds_byte(wr * 64 + fr, fq * 8);
    const int boff = lds_byte(wc * 32 + fr, fq * 8);
#define FG_SA(b, h) (65536 + ((b) * 2 + (h)) * HTB)
#define FG_SB(b, h) (((b) * 2 + (h)) * HTB)
#define FG_STAGE_A(bufoff, gk, vo) do { _Pragma("unroll") for (int _i = 0; _i < 2; ++_i) \
        __builtin_amdgcn_global_load_lds((const unsigned*)((gk) + (vo)[_i]), (LAS unsigned*)(lds + (bufoff) + ldsw + _i * 8192), 16, 0, 0); } while (0)
#define FG_STAGE_B(bufoff, gk) do { _Pragma("unroll") for (int _i = 0; _i < 2; ++_i) \
        __builtin_amdgcn_global_load_lds((const unsigned*)((gk) + voffB[_i]), (LAS unsigned*)(lds + (bufoff) + ldsw + _i * 8192), 16, 0, 0); } while (0)
#define FG_LDA(dst, b, h) do { _Pragma("unroll") for (int m = 0; m < 4; ++m) _Pragma("unroll") for (int k = 0; k < 2; ++k) dst[m][k] = *(const LAS i32x4*)(lds + FG_SA(b, h) + aoff + m * 2048 + k * 1024); } while (0)
#define FG_LDB(dst, b, h) do { _Pragma("unroll") for (int n = 0; n < 2; ++n) _Pragma("unroll") for (int k = 0; k < 2; ++k) dst[n][k] = *(const LAS i32x4*)(lds + FG_SB(b, h) + boff + n * 2048 + k * 1024); } while (0)
#define FG_CAT8(X, Y) __builtin_shufflevector(X, Y, 0, 1, 2, 3, 4, 5, 6, 7)
#define FG_MMA(ai, bj, At, Bt) do { __builtin_amdgcn_s_setprio(1); _Pragma("unroll") for (int m = 0; m < 4; ++m) _Pragma("unroll") for (int n = 0; n < 2; ++n) \
        acc[ai][bj][m][n] = __builtin_amdgcn_mfma_scale_f32_16x16x128_f8f6f4(FG_CAT8(Bt[n][0], Bt[n][1]), FG_CAT8(At[m][0], At[m][1]), acc[ai][bj][m][n], 0, 0, 0, 0x79797979, 0, 0x7F7F7F7F); __builtin_amdgcn_s_setprio(0); } while (0)
#define FG_WAIT_V(n) asm volatile("s_waitcnt vmcnt(" #n ")" ::: "memory")
#define FG_WAIT_L(n) asm volatile("s_waitcnt lgkmcnt(" #n ")" ::: "memory")
#define FG_BAR __builtin_amdgcn_s_barrier()
#define FG_SCHED __builtin_amdgcn_sched_barrier(0)
#define FG_AOFF(dst, u, tabp) do { int _tz = threadIdx.x; asm volatile("" : "+v"(_tz)); _Pragma("unroll") for (int _i = 0; _i < 2; ++_i) { int _R, _C; stage_rc(_tz * 16 + _i * 8192, _R, _C); \
        _Pragma("unroll") for (int _h = 0; _h < 2; ++_h) { const int _r = _h * 128 + _R; \
        if (Job::GATHER) { const int _tok = (tabp)[_r < (u).nvalid ? _r : 0]; dst[_h][_i] = (unsigned)_tok * J.lda2 + (unsigned)(_C * 2); } \
        else if (Job::ABLK) dst[_h][_i] = (unsigned)(((u).arow0 >> 7) + _h) * 262144u + (unsigned)(_R * 128 + _C * 2); \
        else dst[_h][_i] = (unsigned)((u).arow0 + _r) * J.lda2 + (unsigned)((u).acol2 + _C * 2); } } } while (0)
    Unit cur, nxt; int ui = 0;
    if (!J.next(0, cur)) return;
    LAS const int* tab0 = (LAS const int*)(lds + TAB_OFF);
    if (Job::GATHER) {
        if (wid == 0) __builtin_amdgcn_global_load_lds((const unsigned*)(J.list + cur.arow0 + lane * 4), (LAS unsigned*)(lds + TAB_OFF), 16, 0, 0);
        FG_WAIT_V(0); __syncthreads();
    }
    f32x4 acc[2][2][4][2];
#pragma unroll
    for (int a = 0; a < 2; ++a)
#pragma unroll
        for (int b = 0; b < 2; ++b)
#pragma unroll
            for (int m = 0; m < 4; ++m)
#pragma unroll
                for (int n = 0; n < 2; ++n) acc[a][b][m][n] = (f32x4){0.f, 0.f, 0.f, 0.f};
    i32x4 At[4][2], B0[2][2], B1[2][2];
    unsigned vc[2][2];
    FG_AOFF(vc, cur, tab0);
    const char* const gA = J.A;
    const char* cB = cur.bBase;
    const unsigned bh2 = J.bhalf2;
    FG_STAGE_B(FG_SB(0, 0), cB); FG_STAGE_A(FG_SA(0, 0), gA, vc[0]); FG_STAGE_B(FG_SB(0, 1), cB + bh2); FG_STAGE_A(FG_SA(0, 1), gA, vc[1]);
    if (wr == 1) FG_BAR;
    FG_WAIT_V(4); FG_BAR;
    FG_STAGE_B(FG_SB(1, 0), cB + kstepB); FG_STAGE_A(FG_SA(1, 0), gA + kstepA, vc[0]); FG_STAGE_B(FG_SB(1, 1), cB + kstepB + bh2);
    FG_WAIT_V(6); FG_BAR;
    for (;;) {
        const bool has_next = J.next(ui + 1, nxt);
        if (!has_next) nxt = cur;
        if (Job::GATHER && has_next && wid == 0)
            __builtin_amdgcn_global_load_lds((const unsigned*)(J.list + nxt.arow0 + lane * 4), (LAS unsigned*)(lds + TAB_OFF + ((ui + 1) & 1) * 1024), 16, 0, 0);
        const char* nB = nxt.bBase;
        for (int t = 0; t < nt; t += 2) {
            const bool last = (t == nt - 2);
            const char* a1 = gA + (size_t)(t + 1) * kstepA;
            const char* a2 = last ? gA : gA + (size_t)(t + 2) * kstepA; const char* b2 = last ? nB : cB + (size_t)(t + 2) * kstepB;
            const char* a3 = a2 + kstepA; const char* b3 = b2 + kstepB;
            FG_LDB(B0, 0, 0); FG_SCHED; FG_LDA(At, 0, 0); FG_STAGE_A(FG_SA(1, 1), a1, vc[1]);
            if (last && has_next) { LAS const int* tabn = (LAS const int*)(lds + TAB_OFF + ((ui + 1) & 1) * 1024); FG_AOFF(vc, nxt, tabn); }
            FG_WAIT_L(8); FG_BAR; FG_WAIT_L(0); FG_SCHED; FG_MMA(0, 0, At, B0); FG_BAR; FG_SCHED;
            FG_LDB(B1, 0, 1); FG_STAGE_B(FG_SB(0, 0), b2);
            FG_BAR; FG_WAIT_L(0); FG_SCHED; FG_MMA(0, 1, At, B1); FG_BAR;
            FG_LDA(At, 0, 1); FG_STAGE_A(FG_SA(0, 0), a2, vc[0]);
            FG_BAR; FG_WAIT_L(0); FG_MMA(1, 0, At, B0); FG_BAR; FG_SCHED;
            FG_STAGE_B(FG_SB(0, 1), b2 + bh2);
            FG_WAIT_V(6); FG_BAR; FG_MMA(1, 1, At, B1); FG_BAR;
            FG_LDB(B0, 1, 0); FG_SCHED; FG_LDA(At, 1, 0); FG_STAGE_A(FG_SA(0, 1), a2, vc[1]);
            FG_WAIT_L(8); FG_BAR; FG_WAIT_L(0); FG_SCHED; FG_MMA(0, 0, At, B0); FG_BAR; FG_SCHED;
            FG_LDB(B1, 1, 1); FG_STAGE_B(FG_SB(1, 0), b3);
            FG_BAR; FG_WAIT_L(0); FG_SCHED; FG_MMA(0, 1, At, B1); FG_BAR;
            FG_LDA(At, 1, 1); FG_STAGE_A(FG_SA(1, 0), a3, vc[0]);
            FG_BAR; FG_WAIT_L(0); FG_MMA(1, 0, At, B0); FG_BAR; FG_SCHED;
            FG_STAGE_B(FG_SB(1, 1), b3 + bh2);
            FG_WAIT_V(6); FG_BAR; FG_MMA(1, 1, At, B1); FG_BAR;
        }
        J.epi(acc, cur, wr, wc, fr, fq);
        if (!has_next) break;
#pragma unroll
        for (int a = 0; a < 2; ++a)
#pragma unroll
            for (int b = 0; b < 2; ++b)
#pragma unroll
                for (int m = 0; m < 4; ++m)
#pragma unroll
                    for (int n = 0; n < 2; ++n) acc[a][b][m][n] = (f32x4){0.f, 0.f, 0.f, 0.f};
        cur = nxt; cB = nB; ++ui;
    }
    FG_WAIT_V(0);
    if (wr == 0) FG_BAR;
    FG_BAR;
}
}

#define FG_FOR_ROWS for (int ai = 0; ai < 2; ++ai) _Pragma("unroll") for (int m = 0; m < 4; ++m)
struct JobInProj {
    static constexpr bool GATHER = false;
    const char* A; unsigned lda2, ldb2, bhalf2; int K; const int* list;
    const char* B; bf16_t* out; fg::StaticOrder S;
    __device__ __forceinline__ bool next(int i, fg::Unit& u) const { int pm, pn; if (!S.next(i, pm, pn)) return false;
        u.bBase = B + (size_t)pn * 512; u.arow0 = pm * 256; u.nvalid = 256; u.e = 0; u.orow0 = pm * 256; u.ocol0 = pn * 256; u.acol2 = 0; return true; }
    __device__ __forceinline__ void epi(const f32x4 (&acc)[2][2][4][2], const fg::Unit& u, int wr, int wc, int fr, int fq) const {
#pragma unroll
        FG_FOR_ROWS { bf16_t* rowp = out + (size_t)(u.orow0 + ai * 128 + wr * 64 + m * 16 + fr) * kNPROJ + u.ocol0 + wc * 32 + fq * 4;
#pragma unroll
            for (int bj = 0; bj < 2; ++bj)
#pragma unroll
                for (int n = 0; n < 2; ++n) { const f32x4 v = acc[ai][bj][m][n]; u32x2 w; w.x = pk_bf16(v[0], v[1]); w.y = pk_bf16(v[2], v[3]); *(u32x2*)(rowp + bj * 128 + n * 16) = w; } }
    }
};
struct JobPoolFold {
    static constexpr bool GATHER = false;
    const char* A; unsigned lda2, ldb2, bhalf2; int K; const int* list;
    const char* B; bf16_t* wo; int G, c;
    __device__ __forceinline__ bool next(int i, fg::Unit& u) const { const int L = i * G + c; if (L >= 32) return false; const int g = L >> 3, pn = L & 7;
        u.bBase = B + (size_t)g * kPG * kD * 2 + (size_t)pn * 512; u.arow0 = 0; u.nvalid = 256; u.e = g; u.orow0 = kSB + g * kPG; u.ocol0 = pn * 256; u.acol2 = g * kPG * kPG * 2; return true; }
    __device__ __forceinline__ void epi(const f32x4 (&acc)[2][2][4][2], const fg::Unit& u, int wr, int wc, int fr, int fq) const {
#pragma unroll
        FG_FOR_ROWS { bf16_t* rowp = wo + (size_t)(u.orow0 + ai * 128 + wr * 64 + m * 16 + fr) * kD + u.ocol0 + wc * 32 + fq * 4;
#pragma unroll
            for (int bj = 0; bj < 2; ++bj)
#pragma unroll
                for (int n = 0; n < 2; ++n) { const f32x4 v = acc[ai][bj][m][n]; u32x2 w; w.x = pk_bf16(v[0], v[1]); w.y = pk_bf16(v[2], v[3]); *(u32x2*)(rowp + bj * 128 + n * 16) = w; } }
    }
};
struct JobOutProj {
    static constexpr bool GATHER = false;
    const char* A; unsigned lda2, ldb2, bhalf2; int K; const int* list;
    const char* B; const float* x; const float* mod; bf16_t* x1; fg::StaticOrder S;
    __device__ __forceinline__ bool next(int i, fg::Unit& u) const { int pm, pn; if (!S.next(i, pm, pn)) return false;
        u.bBase = B + (size_t)pn * 512; u.arow0 = pm * 256; u.nvalid = 256; u.e = 0; u.orow0 = pm * 256; u.ocol0 = pn * 256; u.acol2 = 0; return true; }
    __device__ __forceinline__ void epi(const f32x4 (&acc)[2][2][4][2], const fg::Unit& u, int wr, int wc, int fr, int fq) const {
        const int b = u.orow0 / kS; f32x4 gt[2][2];
#pragma unroll
        for (int bj = 0; bj < 2; ++bj)
#pragma unroll
            for (int n = 0; n < 2; ++n) gt[bj][n] = *(const f32x4*)(mod + b * 6 * kD + 2 * kD + u.ocol0 + bj * 128 + wc * 32 + n * 16 + fq * 4);
#pragma unroll
        for (int ai = 0; ai < 2; ++ai) { f32x4 xv[4][2][2];
            const size_t ro = (size_t)(u.orow0 + ai * 128 + wr * 64 + fr) * kD + u.ocol0 + wc * 32 + fq * 4;
#pragma unroll
            for (int m = 0; m < 4; ++m)
#pragma unroll
                for (int bj = 0; bj < 2; ++bj)
#pragma unroll
                    for (int n = 0; n < 2; ++n) xv[m][bj][n] = *(const f32x4*)(x + ro + (size_t)m * 16 * kD + bj * 128 + n * 16);
#pragma unroll
            for (int m = 0; m < 4; ++m)
#pragma unroll
                for (int bj = 0; bj < 2; ++bj)
#pragma unroll
                    for (int n = 0; n < 2; ++n) { const f32x4 v = xv[m][bj][n] + gt[bj][n] * acc[ai][bj][m][n]; u32x2 w; w.x = pk_bf16(v[0], v[1]); w.y = pk_bf16(v[2], v[3]);
                        *(u32x2*)(x1 + ro + (size_t)m * 16 * kD + bj * 128 + n * 16) = w; } }
    }
};
struct MoeTab { LAS const int* t; int total;
    __device__ __forceinline__ bool decode(int i, int G, int c, int& e, int& jcol, int& rb, int& cnt, int& rowbase) const {
        const int L = (G % 8 == 0) ? i * G + (c % 8) * (G / 8) + c / 8 : i * G + c; if (L >= total) return false;
        int ee = 0; while (ee < kE - 1 && t[64 + ee + 1] <= L) ++ee;
        const int local = L - t[64 + ee], nrb = t[100 + ee]; jcol = local / nrb; rb = local - jcol * nrb; e = ee; cnt = t[ee]; rowbase = t[32 + ee]; return true; }
};
__device__ __forceinline__ MoeTab moe_tables(LAS unsigned char* lds, const unsigned* ctrl, int ncol) {
    LAS int* t = (LAS int*)(lds + fg::MISC_OFF + 64);
    __syncthreads();
    if (threadIdx.x == 0) { int base = 0, us = 0; for (int e = 0; e < kE; ++e) { const int cn = (int)ctrl[CT_CNT + 64 * e], nrb = (cn + 255) >> 8; t[e] = cn; t[32 + e] = base; t[64 + e] = us; t[100 + e] = nrb; base += nrb * 256; us += nrb * ncol; } t[64 + kE] = us; }
    __syncthreads();
    MoeTab M; M.t = t; M.total = t[64 + kE]; return M;
}
struct JobMoe1 {
    static constexpr bool GATHER = true;
    const char* A; unsigned lda2, ldb2, bhalf2; int K; const int* list;
    const char* B; const float* b_in; bf16_t* act; MoeTab M; int G, c;
    __device__ __forceinline__ bool next(int i, fg::Unit& u) const { int e, j, rb, cnt, rowbase; if (!M.decode(i, G, c, e, j, rb, cnt, rowbase)) return false;
        e = __builtin_amdgcn_readfirstlane(e); j = __builtin_amdgcn_readfirstlane(j); rb = __builtin_amdgcn_readfirstlane(rb); cnt = __builtin_amdgcn_readfirstlane(cnt); rowbase = __builtin_amdgcn_readfirstlane(rowbase);
        u.bBase = B + (size_t)e * ((size_t)kD * 2 * kDFF * 2) + (size_t)j * 256; u.arow0 = e * kT + rb * 256; u.nvalid = min(256, cnt - rb * 256); u.e = e; u.orow0 = rowbase + rb * 256; u.ocol0 = j * 128; u.acol2 = 0; return true; }
    __device__ __forceinline__ void epi(const f32x4 (&acc)[2][2][4][2], const fg::Unit& u, int wr, int wc, int fr, int fq) const {
        f32x4 bg[2], bl[2];
#pragma unroll
        for (int n = 0; n < 2; ++n) { const float* bp = b_in + (size_t)u.e * 2 * kDFF + u.ocol0 + wc * 32 + n * 16 + fq * 4; bg[n] = *(const f32x4*)bp; bl[n] = *(const f32x4*)(bp + kDFF); }
#pragma unroll
        FG_FOR_ROWS { bf16_t* rowp = act + (size_t)(u.orow0 + ai * 128 + wr * 64 + m * 16 + fr) * kDFF + u.ocol0 + wc * 32 + fq * 4;
#pragma unroll
            for (int n = 0; n < 2; ++n) { const f32x4 gv = acc[ai][0][m][n] + bg[n], lv = acc[ai][1][m][n] + bl[n]; float o[4];
#pragma unroll
                for (int j = 0; j < 4; ++j) { const float g = fminf(gv[j], 7.f), l = fminf(fmaxf(lv[j], -7.f), 7.f); o[j] = g * __builtin_amdgcn_rcpf(1.f + __expf(-1.702f * g)) * (l + 1.f); }
                u32x2 w; w.x = pk_bf16(o[0], o[1]); w.y = pk_bf16(o[2], o[3]); *(u32x2*)(rowp + n * 16) = w; } }
    }
};
struct JobMoe2 {
    static constexpr bool GATHER = false;
    const char* A; unsigned lda2, ldb2, bhalf2; int K; const int* list;
    const char* B; const float* b_out; bf16_t* yp; MoeTab M; int G, c;
    __device__ __forceinline__ bool next(int i, fg::Unit& u) const { int e, j, rb, cnt, rowbase; if (!M.decode(i, G, c, e, j, rb, cnt, rowbase)) return false;
        e = __builtin_amdgcn_readfirstlane(e); j = __builtin_amdgcn_readfirstlane(j); rb = __builtin_amdgcn_readfirstlane(rb); rowbase = __builtin_amdgcn_readfirstlane(rowbase);
        u.bBase = B + (size_t)e * ((size_t)kDFF * kD * 2) + (size_t)j * 512; u.arow0 = rowbase + rb * 256; u.nvalid = 256; u.e = e; u.orow0 = rowbase + rb * 256; u.ocol0 = j * 256; u.acol2 = 0; return true; }
    __device__ __forceinline__ void epi(const f32x4 (&acc)[2][2][4][2], const fg::Unit& u, int wr, int wc, int fr, int fq) const {
        f32x4 bo[2][2];
#pragma unroll
        for (int bj = 0; bj < 2; ++bj)
#pragma unroll
            for (int n = 0; n < 2; ++n) bo[bj][n] = *(const f32x4*)(b_out + (size_t)u.e * kD + u.ocol0 + bj * 128 + wc * 32 + n * 16 + fq * 4);
#pragma unroll
        FG_FOR_ROWS { bf16_t* rowp = yp + (size_t)(u.orow0 + ai * 128 + wr * 64 + m * 16 + fr) * kD + u.ocol0 + wc * 32 + fq * 4;
#pragma unroll
            for (int bj = 0; bj < 2; ++bj)
#pragma unroll
                for (int n = 0; n < 2; ++n) { const f32x4 v = acc[ai][bj][m][n] + bo[bj][n]; u32x2 w; w.x = pk_bf16(v[0], v[1]); w.y = pk_bf16(v[2], v[3]); *(u32x2*)(rowp + bj * 128 + n * 16) = w; } }
    }
};


__device__ __forceinline__ float wave_sum(float v) {
#pragma unroll
    for (int o = 32; o > 0; o >>= 1) v += __shfl_xor(v, o);
    return v; }
__device__ __forceinline__ float bflo(unsigned u) { return __uint_as_float(u << 16); }
__device__ __forceinline__ float bfhi(unsigned u) { return __uint_as_float(u & 0xFFFF0000u); }

namespace at {
typedef float f32x16 __attribute__((ext_vector_type(16)));
__device__ __forceinline__ unsigned off_b(unsigned row, unsigned ch) { return 256u * row + 16u * (ch ^ (((row & 3) << 2) | ((row >> 2) & 3))); }
constexpr float kC2 = 0.08838834764831845f * 1.4426950408889634f;
constexpr float kDoneThresh = 0x1p-100f;

__device__ __forceinline__ void attn_phase(LAS unsigned char* lds, const bf16_t* __restrict__ proj, const float* __restrict__ qw, const float* __restrict__ kw,
                                           bf16_t* __restrict__ cat, int G, int c) {
    const int tid = threadIdx.x, wid = __builtin_amdgcn_readfirstlane(tid >> 6), lane = tid & 63, ql = lane & 31, hf = lane >> 5;
    const unsigned ldsb = (unsigned)(uintptr_t)lds;
    const int skey = tid >> 4, sch = tid & 15;
    const unsigned X = ((ql & 3) << 2) | ((ql >> 2) & 3);
    const unsigned krow = 256u * ql, kY = 16u * (X ^ (unsigned)hf);
    const int tq = (lane & 15) >> 2, tp = lane & 3, blk = (lane >> 4) & 1;
    unsigned va[4][2];
#pragma unroll
    for (int cc = 0; cc < 4; ++cc)
#pragma unroll
        for (int t = 0; t < 2; ++t) va[cc][t] = 256u * (8 * t + 4 * hf + tq) + 16u * ((4 * cc + 2 * blk + (tp >> 1)) ^ ((tq << 2) | ((2 * t + hf) & 3))) + 8u * (tp & 1);
    for (int unit = c; unit < kB * kNH * 8; unit += G) {
        const int qb = unit & 7, bh = unit >> 3, h = bh & 7, b = bh >> 3;
        const int q0 = qb * 256, r0 = q0 + wid * 32;
        const bf16_t* base = proj + (size_t)(b * kS) * kNPROJ + h * kHD;
        LAS unsigned char* qlds = lds + 65536 + wid * 8192 + lane * 16;
        { u32x4 qr[8]; float ss = 0.f;
#pragma unroll
          for (int s = 0; s < 8; ++s) { qr[s] = *(const u32x4*)(base + (size_t)(r0 + ql) * kNPROJ + 16 * s + 8 * hf);
              const unsigned u[4] = {qr[s].x, qr[s].y, qr[s].z, qr[s].w};
#pragma unroll
              for (int e = 0; e < 4; ++e) { const float a = bflo(u[e]), bb = bfhi(u[e]); ss += a * a + bb * bb; } }
          ss += __shfl_xor(ss, 32);
          const float rq = rsqrtf(ss * (1.f / kHD) + kEPS) * kC2;
#pragma unroll
          for (int s = 0; s < 8; ++s) { const int d0 = 16 * s + 8 * hf;
              const f32x4 w0 = *(const f32x4*)(qw + d0) * *(const f32x4*)(kw + d0), w1 = *(const f32x4*)(qw + d0 + 4) * *(const f32x4*)(kw + d0 + 4);
              const unsigned u[4] = {qr[s].x, qr[s].y, qr[s].z, qr[s].w};
              u32x4 pk; pk.x = pk_bf16(bflo(u[0]) * rq * w0[0], bfhi(u[0]) * rq * w0[1]); pk.y = pk_bf16(bflo(u[1]) * rq * w0[2], bfhi(u[1]) * rq * w0[3]);
              pk.z = pk_bf16(bflo(u[2]) * rq * w1[0], bfhi(u[2]) * rq * w1[1]); pk.w = pk_bf16(bflo(u[3]) * rq * w1[2], bfhi(u[3]) * rq * w1[3]);
              *(LAS u32x4*)(qlds + 1024 * s) = pk; } }
        f32x16 o[4];
#pragma unroll
        for (int cc = 0; cc < 4; ++cc)
#pragma unroll
            for (int r = 0; r < 16; ++r) o[cc][r] = 0.f;
        float carry = 1.f; bool wactive = true;
        int jt = (q0 + 255) >> 6, cur = 0;
        u32x4 kr[2], vr[2];
#define AT_LOAD(jt_) do { _Pragma("unroll") for (int i = 0; i < 2; ++i) { const bf16_t* rp = base + (size_t)(64 * (jt_) + skey + 32 * i) * kNPROJ + sch * 8; \
            kr[i] = *(const u32x4*)(rp + kSB); vr[i] = *(const u32x4*)(rp + 2 * kSB); } } while (0)
        AT_LOAD(jt);
        for (;;) {
            LAS unsigned char* kbuf = lds + cur * 32768; LAS unsigned char* vbuf = kbuf + 16384;
#pragma unroll
            for (int i = 0; i < 2; ++i) { const unsigned u[4] = {kr[i].x, kr[i].y, kr[i].z, kr[i].w}; float f[8]; float ss = 0.f;
#pragma unroll
                for (int e = 0; e < 4; ++e) { f[2 * e] = bflo(u[e]); f[2 * e + 1] = bfhi(u[e]); ss += f[2 * e] * f[2 * e] + f[2 * e + 1] * f[2 * e + 1]; }
                ss += __shfl_xor(ss, 1); ss += __shfl_xor(ss, 2); ss += __shfl_xor(ss, 4); ss += __shfl_xor(ss, 8);
                const float rk = rsqrtf(ss * (1.f / kHD) + kEPS);
                u32x4 pk; pk.x = pk_bf16(f[0] * rk, f[1] * rk); pk.y = pk_bf16(f[2] * rk, f[3] * rk); pk.z = pk_bf16(f[4] * rk, f[5] * rk); pk.w = pk_bf16(f[6] * rk, f[7] * rk);
                const unsigned a = off_b(skey + 32 * i, sch);
                *(LAS u32x4*)(kbuf + a) = pk; *(LAS u32x4*)(vbuf + a) = vr[i]; }
            const int any = __syncthreads_or(wactive ? 1 : 0);
            if (!any) break;
            const int jtc = jt;
            if (jt > 0) AT_LOAD(jt - 1);
            if (wactive && 64 * jtc < r0 + 31) {
                f32x16 s0, s1;
#pragma unroll
                for (int r = 0; r < 16; ++r) { s0[r] = 0.f; s1[r] = 0.f; }
#pragma unroll
                for (int s = 0; s < 8; ++s) { const unsigned a = krow + ((32u * s) ^ kY);
                    const bf16x8 k0 = *(const LAS bf16x8*)(kbuf + a), k1 = *(const LAS bf16x8*)(kbuf + 8192 + a), qv = *(const LAS bf16x8*)(qlds + 1024 * s);
                    s0 = __builtin_amdgcn_mfma_f32_32x32x16_bf16(k0, qv, s0, 0, 0, 0); s1 = __builtin_amdgcn_mfma_f32_32x32x16_bf16(k1, qv, s1, 0, 0, 0); }
                const int tabs = r0 + ql, kbase0 = 64 * jtc + 4 * hf;
                float run = carry; u32x4 pfr[2][2];
#pragma unroll
                for (int kb = 1; kb >= 0; --kb) {
                    float sp[16], gp[4], T[4];
#pragma unroll
                    for (int r = 0; r < 16; ++r) { const float z = kb ? s1[r] : s0[r]; const int key = kbase0 + 32 * kb + 8 * (r >> 2) + (r & 3);
                        const float v = __builtin_amdgcn_rcpf(1.f + __builtin_amdgcn_exp2f(z)); sp[r] = key < tabs ? v : 1.f; }
#pragma unroll
                    for (int g = 0; g < 4; ++g) { const float gprod = (sp[4 * g] * sp[4 * g + 1]) * (sp[4 * g + 2] * sp[4 * g + 3]);
                        const auto sw = __builtin_amdgcn_permlane32_swap(__float_as_uint(gprod), __float_as_uint(gprod), false, false);
                        const float lo = __uint_as_float(sw[0]), hi = __uint_as_float(sw[1]);
                        T[g] = lo * hi; gp[g] = hf ? 1.f : hi; }
#pragma unroll
                    for (int g = 3; g >= 0; --g) { const float offs = run * gp[g];
                        const float p3 = offs * sp[4 * g + 3], p2 = p3 * sp[4 * g + 2], p1 = p2 * sp[4 * g + 1], p0 = p1 * sp[4 * g];
                        sp[4 * g + 3] = offs - p3; sp[4 * g + 2] = p3 - p2; sp[4 * g + 1] = p2 - p1; sp[4 * g] = p1 - p0;
                        run *= T[g]; }
#pragma unroll
                    for (int s2 = 0; s2 < 2; ++s2) { u32x4 pk; pk.x = pk_bf16(sp[8 * s2], sp[8 * s2 + 1]); pk.y = pk_bf16(sp[8 * s2 + 2], sp[8 * s2 + 3]);
                        pk.z = pk_bf16(sp[8 * s2 + 4], sp[8 * s2 + 5]); pk.w = pk_bf16(sp[8 * s2 + 6], sp[8 * s2 + 7]); pfr[kb][s2] = pk; }
                }
                carry = run;
                const unsigned vb0 = ldsb + (unsigned)cur * 32768u + 16384u;
#define AT_PV(cc) do { const unsigned a0 = vb0 + va[cc][0], a1 = vb0 + va[cc][1]; \
                    const s16x4 l00 = fg::tr_read<0>(a0), h00 = fg::tr_read<0>(a1), l01 = fg::tr_read<4096>(a0), h01 = fg::tr_read<4096>(a1); \
                    const s16x4 l10 = fg::tr_read<8192>(a0), h10 = fg::tr_read<8192>(a1), l11 = fg::tr_read<12288>(a0), h11 = fg::tr_read<12288>(a1); \
                    asm volatile("s_waitcnt lgkmcnt(0)" ::: "memory"); __builtin_amdgcn_sched_barrier(0); \
                    o[cc] = __builtin_amdgcn_mfma_f32_32x32x16_bf16(FG_PK(l00, h00), __builtin_bit_cast(bf16x8, pfr[0][0]), o[cc], 0, 0, 0); \
                    o[cc] = __builtin_amdgcn_mfma_f32_32x32x16_bf16(FG_PK(l01, h01), __builtin_bit_cast(bf16x8, pfr[0][1]), o[cc], 0, 0, 0); \
                    o[cc] = __builtin_amdgcn_mfma_f32_32x32x16_bf16(FG_PK(l10, h10), __builtin_bit_cast(bf16x8, pfr[1][0]), o[cc], 0, 0, 0); \
                    o[cc] = __builtin_amdgcn_mfma_f32_32x32x16_bf16(FG_PK(l11, h11), __builtin_bit_cast(bf16x8, pfr[1][1]), o[cc], 0, 0, 0); } while (0)
                AT_PV(0); AT_PV(1); AT_PV(2); AT_PV(3);
#undef AT_PV
                wactive = __any(carry >= kDoneThresh);
            }
            if (jt == 0) break;
            --jt; cur ^= 1;
        }
#undef AT_LOAD
        bf16_t* orow = cat + (size_t)(b * kS + r0 + ql) * kD + h * kHD + 4 * hf;
#pragma unroll
        for (int cc = 0; cc < 4; ++cc)
#pragma unroll
            for (int g = 0; g < 4; ++g) { u32x2 w; w.x = pk_bf16(o[cc][4 * g], o[cc][4 * g + 1]); w.y = pk_bf16(o[cc][4 * g + 2], o[cc][4 * g + 3]); *(u32x2*)(orow + 32 * cc + 8 * g) = w; }
        __syncthreads();
    }
}
}

template <int W> __device__ __forceinline__ void pool_item(const bf16_t* __restrict__ up, int s, bf16_t* __restrict__ dst) {
    u32x4 v[W];
#pragma unroll
    for (int i = 0; i < W; ++i) v[i] = (i <= s) ? *(const u32x4*)(up - (size_t)i * kNPROJ) : (u32x4){0u, 0u, 0u, 0u};
    float acc[8];
#pragma unroll
    for (int e = 0; e < 8; ++e) acc[e] = 0.f;
#pragma unroll
    for (int i = 0; i < W; ++i) { acc[0] += bflo(v[i].x); acc[1] += bfhi(v[i].x); acc[2] += bflo(v[i].y); acc[3] += bfhi(v[i].y); acc[4] += bflo(v[i].z); acc[5] += bfhi(v[i].z); acc[6] += bflo(v[i].w); acc[7] += bfhi(v[i].w); }
    const float inv = 1.f / (float)min(s + 1, W);
    const float u0[8] = {bflo(v[0].x), bfhi(v[0].x), bflo(v[0].y), bfhi(v[0].y), bflo(v[0].z), bfhi(v[0].z), bflo(v[0].w), bfhi(v[0].w)};
    u32x4 pk; pk.x = pk_bf16(acc[0] * inv - u0[0], acc[1] * inv - u0[1]); pk.y = pk_bf16(acc[2] * inv - u0[2], acc[3] * inv - u0[3]);
    pk.z = pk_bf16(acc[4] * inv - u0[4], acc[5] * inv - u0[5]); pk.w = pk_bf16(acc[6] * inv - u0[6], acc[7] * inv - u0[7]);
    *(u32x4*)dst = pk;
}
__device__ __forceinline__ void pool_p_phase(const bf16_t* __restrict__ proj, bf16_t* __restrict__ p, int G, int c) {
    for (int idx = c * 512 + threadIdx.x; idx < kT * (kPW / 8); idx += G * 512) {
        const int wv = idx >> 6, tpair = wv >> 2, g = __builtin_amdgcn_readfirstlane((wv + tpair + (wv >> 11)) & 3), t = tpair * 2 + ((idx >> 5) & 1), c8 = g * 32 + (idx & 31), s = t & (kS - 1);
        const bf16_t* up = proj + (size_t)t * kNPROJ + 3 * kSB + c8 * 8; bf16_t* dst = p + (size_t)t * kD + kSB + c8 * 8;
        if (g == 0) pool_item<2>(up, s, dst); else if (g == 1) pool_item<4>(up, s, dst); else if (g == 2) pool_item<8>(up, s, dst); else pool_item<16>(up, s, dst);
    }
}

__device__ __forceinline__ unsigned pk4_fp8(float a, float b, float c, float d) { int p = __builtin_amdgcn_cvt_pk_fp8_f32(a, b, 0, false); p = __builtin_amdgcn_cvt_pk_fp8_f32(c, d, p, true); return (unsigned)p; }
__device__ __forceinline__ float clamp448(float v) { return __builtin_amdgcn_fmed3f(v, -448.f, 448.f); }
constexpr float kWScale = 64.f;

struct JobMoe1F8 {
    static constexpr bool GATHER = true, ABLK = false;
    const char* A; unsigned lda2, ldb2, bhalf2; int K; const int* list;
    const char* B; const float* b_in; unsigned char* act; MoeTab M; int G, c; size_t kstepB;
    __device__ __forceinline__ bool next(int i, fg::Unit& u) const { int e, j, rb, cnt, rowbase; if (!M.decode(i, G, c, e, j, rb, cnt, rowbase)) return false;
        e = __builtin_amdgcn_readfirstlane(e); j = __builtin_amdgcn_readfirstlane(j); rb = __builtin_amdgcn_readfirstlane(rb); cnt = __builtin_amdgcn_readfirstlane(cnt); rowbase = __builtin_amdgcn_readfirstlane(rowbase);
        u.bBase = B + (size_t)e * ((size_t)2 * kDFF * kD) + (size_t)j * 128 * kD; u.arow0 = e * kT + rb * 256; u.nvalid = min(256, cnt - rb * 256); u.e = e; u.orow0 = rowbase + rb * 256; u.ocol0 = j * 128; u.acol2 = 0; return true; }
    __device__ __forceinline__ void epi(const f32x4 (&acc)[2][2][4][2], const fg::Unit& u, int wr, int wc, int fr, int fq) const {
        f32x4 bg[2], bl[2];
#pragma unroll
        for (int n = 0; n < 2; ++n) { const float* bp = b_in + (size_t)u.e * 2 * kDFF + u.ocol0 + wc * 32 + n * 16 + fq * 4; bg[n] = *(const f32x4*)bp; bl[n] = *(const f32x4*)(bp + kDFF); }
#pragma unroll
        FG_FOR_ROWS { unsigned char* rowp = act + ((size_t)(((u.orow0 >> 7) + ai) * (kDFF / 128) + (u.ocol0 >> 7)) * 128 + wr * 64 + m * 16 + fr) * 128 + wc * 32 + fq * 4;
#pragma unroll
            for (int n = 0; n < 2; ++n) { const f32x4 gv = acc[ai][0][m][n] + bg[n], lv = acc[ai][1][m][n] + bl[n]; float o[4];
#pragma unroll
                for (int j = 0; j < 4; ++j) { const float g = fminf(gv[j], 7.f), l = fminf(fmaxf(lv[j], -7.f), 7.f); o[j] = clamp448(g * __builtin_amdgcn_rcpf(1.f + __expf(-1.702f * g)) * (l + 1.f)); }
                *(unsigned*)(rowp + n * 16) = pk4_fp8(o[0], o[1], o[2], o[3]); } }
    }
};
struct JobMoe2F8 {
    static constexpr bool GATHER = false, ABLK = true;
    const char* A; unsigned lda2, ldb2, bhalf2; int K; const int* list;
    const char* B; const float* b_out; unsigned char* yp; MoeTab M; int G, c; unsigned* flag; int e0, need; size_t kstepB;
    __device__ __forceinline__ bool next(int i, fg::Unit& u) const { int e, j, rb, cnt, rowbase; if (!M.decode(i, G, c, e, j, rb, cnt, rowbase)) return false;
        e = __builtin_amdgcn_readfirstlane(e); j = __builtin_amdgcn_readfirstlane(j); rb = __builtin_amdgcn_readfirstlane(rb); rowbase = __builtin_amdgcn_readfirstlane(rowbase);
        if (need > 0 && e >= e0) {
            unsigned sp = 0; while (__hip_atomic_load(flag, __ATOMIC_RELAXED, __HIP_MEMORY_SCOPE_AGENT) < (unsigned)need && ++sp < (1u << 16)) __builtin_amdgcn_s_sleep(2);
            asm volatile("" ::: "memory"); }
        u.bBase = B + (size_t)e * ((size_t)kDFF * kD) + (size_t)j * 256 * kDFF; u.arow0 = rowbase + rb * 256; u.nvalid = 256; u.e = e; u.orow0 = rowbase + rb * 256; u.ocol0 = j * 256; u.acol2 = 0; return true; }
    __device__ __forceinline__ void epi(const f32x4 (&acc)[2][2][4][2], const fg::Unit& u, int wr, int wc, int fr, int fq) const {
        f32x4 bo[2][2];
#pragma unroll
        for (int bj = 0; bj < 2; ++bj)
#pragma unroll
            for (int n = 0; n < 2; ++n) bo[bj][n] = *(const f32x4*)(b_out + (size_t)u.e * kD + u.ocol0 + bj * 128 + wc * 32 + n * 16 + fq * 4);
#pragma unroll
        FG_FOR_ROWS { unsigned char* rowp = yp + (size_t)(u.orow0 + ai * 128 + wr * 64 + m * 16 + fr) * kD + u.ocol0 + wc * 32 + fq * 4;
#pragma unroll
            for (int bj = 0; bj < 2; ++bj)
#pragma unroll
                for (int n = 0; n < 2; ++n) { const f32x4 v = acc[ai][bj][m][n] + bo[bj][n]; *(unsigned*)(rowp + bj * 128 + n * 16) = pk4_fp8(clamp448(v[0]), clamp448(v[1]), clamp448(v[2]), clamp448(v[3])); } }
    }
};

struct CvtT { const float* src; unsigned char* dst; int K, N, tn, per; };
__device__ __forceinline__ CvtT cvt_make(const float* src, unsigned char* dst, int K, int N) { CvtT c; c.src = src; c.dst = dst; c.K = K; c.N = N; c.tn = N / 64; c.per = (K / 128) * (N / 64); return c; }
__device__ __forceinline__ void cvt_load(const CvtT& C, int t, int kq, int nc, f32x4 (&v)[4]) {
    const int mat = t / C.per, r = t - mat * C.per, kt = r / C.tn, nt_ = r - kt * C.tn;
    const float* sp = C.src + (size_t)mat * C.K * C.N + (size_t)(kt * 128 + 4 * kq) * C.N + nt_ * 64 + 4 * nc;
#pragma unroll
    for (int i = 0; i < 4; ++i) v[i] = __builtin_nontemporal_load((const f32x4*)(sp + (size_t)i * C.N));
}
__device__ __forceinline__ void cvt_emit(const CvtT& C, int t, LAS unsigned* L, const f32x4 (&v)[4], int kq, int nc, int rn, int rc) {
#pragma unroll
    for (int j = 0; j < 4; ++j) L[(4 * nc + j) * 33 + kq] = pk4_fp8(v[0][j] * kWScale, v[1][j] * kWScale, v[2][j] * kWScale, v[3][j] * kWScale);
    __syncthreads();
    const int mat = t / C.per, r = t - mat * C.per, kt = r / C.tn, nt_ = r - kt * C.tn;
    u32x4 o; o.x = L[rn * 33 + 4 * rc]; o.y = L[rn * 33 + 4 * rc + 1]; o.z = L[rn * 33 + 4 * rc + 2]; o.w = L[rn * 33 + 4 * rc + 3];
    __builtin_nontemporal_store(o, (u32x4*)(C.dst + (size_t)mat * C.K * C.N + ((size_t)((nt_ >> 1) * (C.K >> 7) + kt) * 128 + (nt_ & 1) * 64 + rn) * 128 + rc * 16));
}
__device__ __forceinline__ void convert_t_f8(LAS unsigned char* lds, const CvtT C, int t0, int t1, int stride) {
    const int tid = threadIdx.x, kq = tid >> 4, nc = tid & 15, rn = tid >> 3, rc = tid & 7;
    f32x4 s0[4], s1[4], s2[4], s3[4];
    __syncthreads();
    if (t0 + 0 * stride < t1) cvt_load(C, t0 + 0 * stride, kq, nc, s0);
    if (t0 + 1 * stride < t1) cvt_load(C, t0 + 1 * stride, kq, nc, s1);
    if (t0 + 2 * stride < t1) cvt_load(C, t0 + 2 * stride, kq, nc, s2);
    if (t0 + 3 * stride < t1) cvt_load(C, t0 + 3 * stride, kq, nc, s3);
    const int dd = 4 * stride;
#pragma unroll 1
    for (int t = t0; t < t1;) {
        cvt_emit(C, t, (LAS unsigned*)lds, s0, kq, nc, rn, rc);
        if (t + dd < t1) cvt_load(C, t + dd, kq, nc, s0);
        t += stride; if (t >= t1) break;
        cvt_emit(C, t, (LAS unsigned*)(lds + 8704), s1, kq, nc, rn, rc);
        if (t + dd < t1) cvt_load(C, t + dd, kq, nc, s1);
        t += stride; if (t >= t1) break;
        cvt_emit(C, t, (LAS unsigned*)lds, s2, kq, nc, rn, rc);
        if (t + dd < t1) cvt_load(C, t + dd, kq, nc, s2);
        t += stride; if (t >= t1) break;
        cvt_emit(C, t, (LAS unsigned*)(lds + 8704), s3, kq, nc, rn, rc);
        if (t + dd < t1) cvt_load(C, t + dd, kq, nc, s3);
        t += stride;
    }
    __syncthreads();
}
__device__ __forceinline__ void convert_dyn(LAS unsigned char* lds, const CvtT C, unsigned* qctr, int dbase, int dend) {
    LAS int* bx = (LAS int*)(lds + 2 * 8704);
    const int N = dend - dbase, NA = ((N * 3) >> 2) & ~7, NB = ((N - NA) >> 1) & ~3, CA = NA >> 3, CB = NB >> 2;
#pragma unroll 1
    for (;;) {
        __syncthreads();
        if (threadIdx.x == 0) bx[0] = (int)atomicAdd(qctr, 1u);
        __syncthreads();
        const int ci = bx[0];
        const int t0 = dbase + (ci < CA ? 8 * ci : ci < CA + CB ? NA + 4 * (ci - CA) : NA + NB + 2 * (ci - CA - CB)), sz = ci < CA ? 8 : ci < CA + CB ? 4 : 2;
        if (t0 >= dend) break;
        convert_t_f8(lds, C, t0, min(t0 + sz, dend), 1);
    }
}

__device__ __forceinline__ void convert_seg(const float* __restrict__ src, bf16_t* __restrict__ dst, size_t n8, size_t gtid, size_t gstride) {
    const f32x4* s4 = (const f32x4*)src; u32x4* d4 = (u32x4*)dst;
#pragma unroll 4
    for (size_t i = gtid; i < n8; i += gstride) { const f32x4 a = __builtin_nontemporal_load(s4 + 2 * i), b = __builtin_nontemporal_load(s4 + 2 * i + 1);
        u32x4 w; w.x = pk_bf16(a[0], a[1]); w.y = pk_bf16(a[2], a[3]); w.z = pk_bf16(b[0], b[1]); w.w = pk_bf16(b[2], b[3]); d4[i] = w; }
}


#define XB_TMO      128
#define XB_XCNT(j)  (256  + 64 * (j))
#define XB_XSUB(j)  (1280 + 64 * (j))
#define XB_XGEN(j)  (2304 + 64 * (j))
#define XB_TOP      3328
#define XB_TOPGEN   3392
#define XCD_BAR_WORDS 3456
#define XB_SPIN_CAP (1u << 18)
__device__ __forceinline__ unsigned xb_ld(unsigned* p)              { return __hip_atomic_load(p, __ATOMIC_RELAXED, __HIP_MEMORY_SCOPE_AGENT); }
__device__ __forceinline__ unsigned xb_add(unsigned* p, unsigned v) { return __hip_atomic_fetch_add(p, v, __ATOMIC_RELAXED, __HIP_MEMORY_SCOPE_AGENT); }
__device__ __forceinline__ unsigned xb_xcc_id() { return (unsigned)__builtin_amdgcn_s_getreg((3 << 11) | 20) & 0xFu; }
#define XB_SPIN(cond, bar) do { unsigned _sp = 0; while (cond) { __builtin_amdgcn_s_sleep(1); \
    if ((++_sp & 255u) == 0u) { if (xb_ld(&(bar)[XB_TMO])) break; if (_sp > XB_SPIN_CAP) { atomicAdd(&(bar)[XB_TMO], 1u); break; } } } } while (0)
struct XcdBarrier { unsigned* bar; unsigned x; volatile LAS unsigned* st; };
__device__ __forceinline__ XcdBarrier xcd_barrier_post(unsigned* bar, volatile LAS unsigned* st) {
    XcdBarrier b; b.bar = bar; b.x = xb_xcc_id(); b.st = st;
    if (threadIdx.x == 0) (void)xb_add(&bar[XB_XCNT(b.x)], 1u);
    return b;
}
__device__ __forceinline__ void xcd_barrier_complete(unsigned* bar, unsigned x, unsigned& nloc, unsigned& nx) {
    const unsigned G = gridDim.x * gridDim.y * gridDim.z;
    unsigned sum, cnt, mine, sp = 0u;
    for (;;) {
        sum = 0u; cnt = 0u; mine = 0u;
#pragma unroll
        for (unsigned j = 0; j < 16; ++j) { const unsigned c = xb_ld(&bar[XB_XCNT(j)]); sum += c; cnt += (c > 0u) ? 1u : 0u; mine = (j == x) ? c : mine; }
        if (sum == G) break;
        __builtin_amdgcn_s_sleep(1);
        if ((++sp & 255u) == 0u) { if (xb_ld(&bar[XB_TMO])) break; if (sp > XB_SPIN_CAP) { atomicAdd(&bar[XB_TMO], 1u); break; } }
    }
    nloc = mine > 0u ? mine : 1u; nx = cnt > 0u ? cnt : 1u;
}
__device__ __forceinline__ unsigned xcd_arrive(const XcdBarrier& b) {
    asm volatile("s_waitcnt vmcnt(0)" ::: "memory");
    __syncthreads();
    unsigned gen = 0u;
    if (threadIdx.x == 0) {
        unsigned* bar = b.bar;
        __builtin_amdgcn_s_waitcnt(0);
        unsigned nloc = b.st[0], nx = b.st[1];
        if (nloc == 0u) { xcd_barrier_complete(bar, b.x, nloc, nx); b.st[0] = nloc; b.st[1] = nx; }
        const unsigned old = xb_add(&bar[XB_XSUB(b.x)], 1u);
        gen = old / nloc;
        if (old + 1u == (gen + 1u) * nloc) {
            __builtin_amdgcn_fence(__ATOMIC_RELEASE, "agent");
            asm volatile("s_waitcnt vmcnt(0)" ::: "memory");
            const unsigned og = xb_add(&bar[XB_TOP], 1u);
            const unsigned tg = og / nx;
            if (og + 1u == (tg + 1u) * nx) xb_add(&bar[XB_TOPGEN], 1u);
        }
    }
    return gen;
}
__device__ __forceinline__ void xcd_wait(const XcdBarrier& b, unsigned gen) {
    if (threadIdx.x == 0) {
        unsigned* bar = b.bar;
        XB_SPIN(xb_ld(&bar[XB_TOPGEN]) == gen, bar);
        __builtin_amdgcn_fence(__ATOMIC_ACQUIRE, "agent");
        asm volatile("s_waitcnt vmcnt(0)" ::: "memory");
    }
    __syncthreads();
}
__device__ __forceinline__ void xcd_barrier(const XcdBarrier& b) { const unsigned g = xcd_arrive(b); xcd_wait(b, g); }

__device__ __forceinline__ void ada_phase(LAS unsigned char* lds, const float* __restrict__ cvec, const float* __restrict__ w_ada, const float* __restrict__ b_ada, float* __restrict__ mod, int G, int c) {
    LAS float* ca = (LAS float*)lds;
    LAS float* part = (LAS float*)(lds + 32768);
    const int tid = threadIdx.x;
    __syncthreads();
    for (int i = tid; i < kB * kD; i += 512) { const float v = cvec[i]; ca[i] = v / (1.f + __expf(-v)); }
    __syncthreads();
    for (int cb = c; cb < 6 * kD / 64; cb += G) {
        const int n0 = cb * 64, cg = tid & 15, kr = tid >> 4;
        f32x4 a0 = {0.f, 0.f, 0.f, 0.f}, a1 = a0, a2 = a0, a3 = a0;
#pragma unroll 16
        for (int k = kr; k < kD; k += 32) { const f32x4 w = __builtin_nontemporal_load((const f32x4*)(w_ada + (size_t)k * (6 * kD) + n0 + cg * 4));
            a0 += ca[k] * w; a1 += ca[kD + k] * w; a2 += ca[2 * kD + k] * w; a3 += ca[3 * kD + k] * w; }
        LAS f32x4* pp = (LAS f32x4*)(part + (kr * 16 + cg) * 16); pp[0] = a0; pp[1] = a1; pp[2] = a2; pp[3] = a3;
        __syncthreads();
        if (tid < 256) { const int col = tid & 63, b = tid >> 6; float sum = 0.f;
#pragma unroll 8
            for (int r = 0; r < 32; ++r) sum += part[(r * 16 + (col >> 2)) * 16 + b * 4 + (col & 3)];
            mod[b * 6 * kD + n0 + col] = sum + b_ada[n0 + col]; }
        __syncthreads();
    }
}

__device__ __forceinline__ void norm1_phase(const float* __restrict__ x, const float* __restrict__ nw, const float* __restrict__ mod, bf16_t* __restrict__ out, int G, int c) {
    const int wid = threadIdx.x >> 6, lane = threadIdx.x & 63;
    for (int t = c * 8 + wid; t < kT; t += G * 8) {
        const int b = t / kS; const float* xr = x + (size_t)t * kD + lane * 4; const float* mb = mod + b * 6 * kD + lane * 4;
        f32x4 v[8]; float ss = 0.f;
#pragma unroll
        for (int j = 0; j < 8; ++j) { v[j] = *(const f32x4*)(xr + 256 * j); ss += v[j][0] * v[j][0] + v[j][1] * v[j][1] + v[j][2] * v[j][2] + v[j][3] * v[j][3]; }
        ss = wave_sum(ss);
        const float r = rsqrtf(ss * (1.f / kD) + kEPS);
#pragma unroll
        for (int j = 0; j < 8; ++j) { const f32x4 w = *(const f32x4*)(nw + lane * 4 + 256 * j), sh = *(const f32x4*)(mb + 256 * j), sc = *(const f32x4*)(mb + kD + 256 * j);
            const f32x4 y = v[j] * r * w * (1.f + sc) + sh; u32x2 o; o.x = pk_bf16(y[0], y[1]); o.y = pk_bf16(y[2], y[3]);
            *(u32x2*)(out + (size_t)t * kD + lane * 4 + 256 * j) = o; }
    }
}

__device__ __forceinline__ void split_bf16(const float (&v)[8], bf16x8& hi, bf16x8& lo) {
    u32x4 h, l;
#pragma unroll
    for (int i = 0; i < 4; ++i) { const unsigned hp = pk_bf16(v[2 * i], v[2 * i + 1]); h[i] = hp; l[i] = pk_bf16(v[2 * i] - bflo(hp), v[2 * i + 1] - bfhi(hp)); }
    hi = __builtin_bit_cast(bf16x8, h); lo = __builtin_bit_cast(bf16x8, l);
}
__device__ __forceinline__ void pack_router(const float* __restrict__ w_router, u32x4* __restrict__ wrp, size_t gtid, size_t gstride) {
    for (size_t i = gtid; i < 8192; i += gstride) { const int w_ = (int)(i >> 10), s_ = (int)(i >> 6) & 15, ln = (int)i & 63, q_ = ln & 31, h_ = ln >> 5;
        float wv[8];
#pragma unroll
        for (int j = 0; j < 8; ++j) wv[j] = w_router[(size_t)(256 * w_ + 16 * s_ + 8 * h_ + j) * kE + q_];
        bf16x8 hi, lo; split_bf16(wv, hi, lo);
        wrp[(w_ * 16 + s_) * 128 + ln] = __builtin_bit_cast(u32x4, hi); wrp[(w_ * 16 + s_) * 128 + 64 + ln] = __builtin_bit_cast(u32x4, lo); }
}
__device__ __forceinline__ void norm2_router_phase(LAS unsigned char* lds, const bf16_t* __restrict__ x1, const float* __restrict__ nw, const float* __restrict__ mod,
                                                   const u32x4* __restrict__ wrp, const float* __restrict__ b_router, unsigned char* __restrict__ h2,
                                                   float* __restrict__ gates, int* __restrict__ pair_e, int* __restrict__ pair_p, int* __restrict__ list, unsigned* __restrict__ ctrl, int G, int c) {
    typedef float f32x16 __attribute__((ext_vector_type(16)));
    const int tid = threadIdx.x, wid = __builtin_amdgcn_readfirstlane(tid >> 6), lane = tid & 63, ql = lane & 31, hf = lane >> 5;
    LAS float* part = (LAS float*)lds;
    LAS float* ssq = (LAS float*)(lds + 32768);
    LAS float* cA = (LAS float*)(lds + 36864);
    LAS float* cB = (LAS float*)(lds + 45056);
    LAS float* lg = (LAS float*)(lds + 53248);
    LAS int* sidx = (LAS int*)(lds + 57344);
    LAS float* sval = (LAS float*)(lds + 57856);
    LAS int* lcnt = (LAS int*)(lds + fg::MISC_OFF + 64);
    { const int blk = c;
        const int t0 = blk * 32, b = t0 / kS;
        __syncthreads();
        if (tid < 32) lcnt[tid] = 0;
        const bf16_t* xrow = x1 + (size_t)(t0 + ql) * kD + 256 * wid + 8 * hf;
        const u32x4* wp = wrp + (size_t)wid * 16 * 128 + lane;
        u32x4 xq[16], wA[8], wB[8];
#pragma unroll
        for (int s = 0; s < 16; ++s) xq[s] = *(const u32x4*)(xrow + 16 * s);
#define RT_LDW(W, Q) do { _Pragma("unroll") for (int i = 0; i < 4; ++i) { W[2 * i] = wp[(4 * (Q) + i) * 128]; W[2 * i + 1] = wp[(4 * (Q) + i) * 128 + 64]; } } while (0)
        RT_LDW(wA, 0);
        { const float* mrow = mod + b * 6 * kD;
          const f32x4 w4 = *(const f32x4*)(nw + 4 * tid), sh = *(const f32x4*)(mrow + 3 * kD + 4 * tid), sc = *(const f32x4*)(mrow + 4 * kD + 4 * tid);
          *(LAS f32x4*)(cA + 4 * tid) = w4 * (1.f + sc); *(LAS f32x4*)(cB + 4 * tid) = sh; }
        float ss = 0.f;
#pragma unroll
        for (int s = 0; s < 16; ++s)
#pragma unroll
            for (int q = 0; q < 4; ++q) { const float lo_ = bflo(xq[s][q]), hi_ = bfhi(xq[s][q]); ss += lo_ * lo_ + hi_ * hi_; }
        ss += __shfl_xor(ss, 32);
        if (hf == 0) ssq[wid * 32 + ql] = ss;
        __syncthreads();
        float tot = 0.f;
#pragma unroll
        for (int w8 = 0; w8 < 8; ++w8) tot += ssq[w8 * 32 + ql];
        const float rq = rsqrtf(tot * (1.f / kD) + kEPS);
        f32x16 acc;
#pragma unroll
        for (int r = 0; r < 16; ++r) acc[r] = 0.f;
        unsigned char* hrow = h2 + (size_t)(t0 + ql) * kD + 256 * wid + 8 * hf;
#define RT_COMP(W, Q) do { _Pragma("unroll") for (int i = 0; i < 4; ++i) { const int s = 4 * (Q) + i; \
            const int k0 = 256 * wid + 8 * hf + 16 * s; \
            const f32x4 a0 = *(LAS const f32x4*)(cA + k0), a1 = *(LAS const f32x4*)(cA + k0 + 4), b0 = *(LAS const f32x4*)(cB + k0), b1 = *(LAS const f32x4*)(cB + k0 + 4); \
            const f32x4 xa = {bflo(xq[s].x), bfhi(xq[s].x), bflo(xq[s].y), bfhi(xq[s].y)}, xb = {bflo(xq[s].z), bfhi(xq[s].z), bflo(xq[s].w), bfhi(xq[s].w)}; \
            const f32x4 ya = xa * rq * a0 + b0, yb = xb * rq * a1 + b1; \
            const float y[8] = {ya[0], ya[1], ya[2], ya[3], yb[0], yb[1], yb[2], yb[3]}; \
            u32x2 hq; hq.x = pk4_fp8(clamp448(y[0]), clamp448(y[1]), clamp448(y[2]), clamp448(y[3])); hq.y = pk4_fp8(clamp448(y[4]), clamp448(y[5]), clamp448(y[6]), clamp448(y[7])); \
            *(u32x2*)(hrow + 16 * s) = hq; \
            bf16x8 yh, yl; split_bf16(y, yh, yl); \
            const bf16x8 whv = __builtin_bit_cast(bf16x8, W[2 * i]), wlv = __builtin_bit_cast(bf16x8, W[2 * i + 1]); \
            acc = __builtin_amdgcn_mfma_f32_32x32x16_bf16(yh, whv, acc, 0, 0, 0); \
            acc = __builtin_amdgcn_mfma_f32_32x32x16_bf16(yl, whv, acc, 0, 0, 0); \
            acc = __builtin_amdgcn_mfma_f32_32x32x16_bf16(yh, wlv, acc, 0, 0, 0); } } while (0)
        RT_LDW(wB, 1); RT_COMP(wA, 0);
        RT_LDW(wA, 2); RT_COMP(wB, 1);
        RT_LDW(wB, 3); RT_COMP(wA, 2);
        RT_COMP(wB, 3);
#undef RT_LDW
#undef RT_COMP
#pragma unroll
        for (int r = 0; r < 16; ++r) part[(wid * 32 + (r & 3) + 8 * (r >> 2) + 4 * hf) * 32 + ql] = acc[r];
        __syncthreads();
        const int tok = tid >> 4, e2 = (tid & 15) * 2;
        { float v0 = 0.f, v1 = 0.f;
#pragma unroll
          for (int w8 = 0; w8 < 8; ++w8) { const f32x2 pp = *(LAS const f32x2*)(part + (w8 * 32 + tok) * 32 + e2); v0 += pp[0]; v1 += pp[1]; }
          f32x2 o; o[0] = v0 + b_router[e2]; o[1] = v1 + b_router[e2 + 1]; *(LAS f32x2*)(lg + tok * 32 + e2) = o; }
        __syncthreads();
        { const f32x2 mine = *(LAS const f32x2*)(lg + tok * 32 + e2); int r0 = 0, r1 = 0;
#pragma unroll
          for (int j4 = 0; j4 < 8; ++j4) { const f32x4 v = *(LAS const f32x4*)(lg + tok * 32 + 4 * j4);
#pragma unroll
              for (int jj = 0; jj < 4; ++jj) { const int j = 4 * j4 + jj; const float vj = v[jj];
                  r0 += (vj > mine[0] || (vj == mine[0] && j < e2)) ? 1 : 0; r1 += (vj > mine[1] || (vj == mine[1] && j < e2 + 1)) ? 1 : 0; } }
          if (r0 < 4) { sidx[tok * 4 + r0] = e2; sval[tok * 4 + r0] = mine[0]; }
          if (r1 < 4) { sidx[tok * 4 + r1] = e2 + 1; sval[tok * 4 + r1] = mine[1]; } }
        __syncthreads();
        if (tid < 32) { const int t = t0 + tid; const i32x4 id = *(LAS const i32x4*)(sidx + 4 * tid); const f32x4 vv = *(LAS const f32x4*)(sval + 4 * tid); float ex[4], sum = 0.f;
#pragma unroll
            for (int k = 0; k < 4; ++k) { ex[k] = __expf(vv[k] - vv[0]); sum += ex[k]; }
            const float inv = 1.f / sum;
            f32x4 gv; gv[0] = ex[0] * inv; gv[1] = ex[1] * inv; gv[2] = ex[2] * inv; gv[3] = ex[3] * inv; *(f32x4*)(gates + t * 4) = gv;
#pragma unroll
            for (int k = 0; k < 4; ++k) { lcnt[64 + tid * 4 + k] = id[k]; lcnt[192 + tid * 4 + k] = __hip_atomic_fetch_add(&lcnt[id[k]], 1, __ATOMIC_RELAXED, __HIP_MEMORY_SCOPE_WORKGROUP); } }
        __syncthreads();
        if (tid < 32) { const int n = lcnt[tid]; lcnt[32 + tid] = n > 0 ? (int)atomicAdd(&ctrl[CT_CNT + 64 * tid], (unsigned)n) : 0; }
        __syncthreads();
        if (tid < 128) { const int e = lcnt[64 + tid], pos = lcnt[32 + e] + lcnt[192 + tid], t = blk * 32 + (tid >> 2);
            pair_e[t * 4 + (tid & 3)] = e; pair_p[t * 4 + (tid & 3)] = pos; list[(size_t)e * kT + pos] = t; }
    }
}

__device__ __forceinline__ void final_phase(const bf16_t* __restrict__ x1, const float* __restrict__ mod, const float* __restrict__ gates, const int* __restrict__ pair_e, const int* __restrict__ pair_p,
                                            const MoeTab M, const unsigned char* __restrict__ yp, float* __restrict__ out, int G, int c) {
    const int wid = threadIdx.x >> 6, lane = threadIdx.x & 63;
    for (int t = c * 8 + wid; t < kT; t += G * 8) {
        const int b = t / kS; float gk[4]; const unsigned char* rp[4];
#pragma unroll
        for (int k = 0; k < 4; ++k) { gk[k] = gates[t * 4 + k]; const int e = pair_e[t * 4 + k];
            rp[k] = yp + (size_t)(M.t[32 + e] + pair_p[t * 4 + k]) * kD + lane * 8; }
#pragma unroll
        for (int j = 0; j < 4; ++j) { f32x4 y0 = {0.f, 0.f, 0.f, 0.f}, y1 = y0;
#pragma unroll
            for (int k = 0; k < 4; ++k) { const u32x2 v = *(const u32x2*)(rp[k] + 512 * j);
                const f32x2 a0 = __builtin_amdgcn_cvt_pk_f32_fp8((int)v.x, false), a1 = __builtin_amdgcn_cvt_pk_f32_fp8((int)v.x, true), a2 = __builtin_amdgcn_cvt_pk_f32_fp8((int)v.y, false), a3 = __builtin_amdgcn_cvt_pk_f32_fp8((int)v.y, true);
                y0 += gk[k] * (f32x4){a0[0], a0[1], a1[0], a1[1]}; y1 += gk[k] * (f32x4){a2[0], a2[1], a3[0], a3[1]}; }
            const size_t o = (size_t)t * kD + lane * 8 + 512 * j; const float* gp = mod + b * 6 * kD + 5 * kD + lane * 8 + 512 * j;
            const u32x4 xq = *(const u32x4*)(x1 + o); const f32x4 xa = {bflo(xq.x), bfhi(xq.x), bflo(xq.y), bfhi(xq.y)}, xb = {bflo(xq.z), bfhi(xq.z), bflo(xq.w), bfhi(xq.w)};
            *(f32x4*)(out + o) = xa + *(const f32x4*)gp * y0; *(f32x4*)(out + o + 4) = xb + *(const f32x4*)(gp + 4) * y1; }
    }
}

constexpr int kLate = 24;
struct MegaArgs { const float* in[18]; float* out; unsigned char* ws; int ph_lo, ph_hi; };
constexpr int NPHASE = 10;
__global__ void __launch_bounds__(512, 2) mega(MegaArgs a) {
    extern __shared__ __attribute__((aligned(16))) unsigned char lds_raw[];
    LAS unsigned char* lds = (LAS unsigned char*)lds_raw;
    unsigned char* ws = a.ws;
    const int lo = a.ph_lo, hi = a.ph_hi;
#define IN(k) (lo <= (k) && (k) < hi)
#define SEAM(k) do { if (IN(k) && IN((k) + 1)) xcd_barrier(bar); } while (0)
#define ARRIVE(k) const unsigned tk##k = (IN(k) && IN((k) + 1)) ? xcd_arrive(bar) : 0u
#define WAIT(k) do { if (IN(k) && IN((k) + 1)) xcd_wait(bar, tk##k); } while (0)
    const int G = gridDim.x, c = blockIdx.x;
    unsigned* ctrl = (unsigned*)(ws + WS_CTRL);
    const int grp = (c >> 3) & 1, cpr = ((c >> 4) << 3) | (c & 7);
#define HOST_PRE(CC, r0, n)  do { if (grp == 0) convert_t_f8(lds, CC, (r0) + cpr, (r0) + (G / 2) * ((n) * 7 / 8), G / 2); } while (0)
#define HOST_POST(CC, r0, n, q) convert_dyn(lds, CC, ctrl + CT_Q + 64 * (q), (r0) + (G / 2) * ((n) * 7 / 8), (r0) + G * (n))
    const int r_p2 = 0, r_p3 = 64 * G, r_p5 = 100 * G, r_p6 = 116 * G;
    const CvtT C1 = cvt_make(a.in[14], (unsigned char*)(ws + WS_WE1), kD, 2 * kDFF);
    const CvtT C2 = cvt_make(a.in[16], (unsigned char*)(ws + WS_WE2), kDFF, kD);
    if (threadIdx.x == 0) *(LAS u32x4*)(lds + fg::MISC_OFF) = (u32x4){0u, 0u, 0u, 0u};
    __syncthreads();
    XcdBarrier bar; bar.bar = ctrl; bar.x = 0; bar.st = (volatile LAS unsigned*)(lds + fg::MISC_OFF);
    if (hi - lo > 1) bar = xcd_barrier_post(ctrl, (volatile LAS unsigned*)(lds + fg::MISC_OFF));
    float* mod = (float*)(ws + WS_MOD);
    if (IN(0)) {
        ada_phase(lds, a.in[1], a.in[4], a.in[5], mod, G, c);
        const int nslot = c < 192 ? 1 : 5, slot0 = c < 192 ? c : 192 + 5 * (c - 192);
        for (int sl = 0; sl < nslot; ++sl) {
        const size_t gtid = (size_t)(slot0 + sl) * 512 + threadIdx.x, gstride = (size_t)512 * 512;
        convert_seg(a.in[6], (bf16_t*)(ws + WS_WIN), (size_t)kD * kNPROJ / 8, gtid, gstride);
        convert_seg(a.in[11], (bf16_t*)(ws + WS_WO), (size_t)kSB * kD / 8, gtid, gstride);
        convert_seg(a.in[11] + (size_t)kSB * kD, (bf16_t*)(ws + WS_P), (size_t)kPW * kD / 8, gtid, gstride);
        pack_router(a.in[12], (u32x4*)(ws + WS_WRP), gtid, gstride);
        { const f32x4* s4 = (const f32x4*)a.in[9]; const f32x4* sc4 = (const f32x4*)a.in[10]; u32x4* d4 = (u32x4*)(ws + WS_WPL);
          for (size_t i = gtid; i < (size_t)4 * kPG * kPG / 8; i += gstride) { const int g = (int)(i >> 13), n8 = (int)(i & 31);
              const f32x4 sa = sc4[g * 64 + n8 * 2], sb = sc4[g * 64 + n8 * 2 + 1]; const f32x4 a0 = s4[2 * i] * sa, b0 = s4[2 * i + 1] * sb;
              u32x4 w; w.x = pk_bf16(a0[0], a0[1]); w.y = pk_bf16(a0[2], a0[3]); w.z = pk_bf16(b0[0], b0[1]); w.w = pk_bf16(b0[2], b0[3]); d4[i] = w; } }
        }
    }
    SEAM(0);
    if (IN(1)) norm1_phase(a.in[0], a.in[2], mod, (bf16_t*)(ws + WS_H), G, c);
    ARRIVE(1);
    if (IN(2)) HOST_PRE(C1, r_p2, 64);
    WAIT(1);
    if (IN(2)) { JobInProj J; J.A = (const char*)(ws + WS_H); J.lda2 = kD * 2; J.ldb2 = kNPROJ * 2; J.bhalf2 = 256; J.K = kD; J.list = nullptr;
        J.B = (const char*)(ws + WS_WIN); J.out = (bf16_t*)(ws + WS_PROJ); J.S.init(kT, kNPROJ, G, c); fg::gemm_phase(lds, J); }
    if (IN(2)) { JobPoolFold J; J.A = (const char*)(ws + WS_WPL); J.lda2 = kPG * 2; J.ldb2 = kD * 2; J.bhalf2 = 256; J.K = kPG; J.list = nullptr;
        J.B = (const char*)(ws + WS_P); J.wo = (bf16_t*)(ws + WS_WO); J.G = G; J.c = grp == 1 ? cpr : G;
        fg::gemm_phase(lds, J); }
    ARRIVE(2);
    if (IN(2)) HOST_POST(C1, r_p2, 64, 0);
    if (IN(3)) HOST_PRE(C1, r_p3, 36);
    WAIT(2);
    if (IN(3)) { at::attn_phase(lds, (const bf16_t*)(ws + WS_PROJ), a.in[7], a.in[8], (bf16_t*)(ws + WS_CAT), G, c);
        pool_p_phase((const bf16_t*)(ws + WS_PROJ), (bf16_t*)(ws + WS_CAT), G, c); }
    ARRIVE(3);
    if (IN(3)) HOST_POST(C1, r_p3, 36, 1);
    if (IN(5)) HOST_PRE(C1, r_p5, 16);
    WAIT(3);
    if (IN(5)) { JobOutProj J; J.A = (const char*)(ws + WS_CAT); J.lda2 = kD * 2; J.ldb2 = kD * 2; J.bhalf2 = 256; J.K = kD; J.list = nullptr;
        J.B = (const char*)(ws + WS_WO); J.x = a.in[0]; J.mod = mod; J.x1 = (bf16_t*)(ws + WS_X1); J.S.init(kT, kD, G, c); fg::gemm_phase(lds, J); }
    ARRIVE(5);
    if (IN(5)) HOST_POST(C1, r_p5, 16, 2);
    if (IN(6)) HOST_PRE(C1, r_p6, 12);
    WAIT(5);
    if (IN(6)) norm2_router_phase(lds, (const bf16_t*)(ws + WS_X1), a.in[3], mod, (const u32x4*)(ws + WS_WRP), a.in[13], (unsigned char*)(ws + WS_H2), (float*)(ws + WS_GATES), (int*)(ws + WS_PAIRE), (int*)(ws + WS_PAIRP),
                                  (int*)(ws + WS_LIST), ctrl, G, c);
    ARRIVE(6);
    if (IN(6)) HOST_POST(C1, r_p6, 12, 3);
    const int w2s = 56 * (G / 2);
    if (IN(7) && grp == 0) convert_t_f8(lds, C2, cpr, w2s, G / 2);
    WAIT(6);
    int d8 = 0;
    if (IN(7) || IN(8)) { const MoeTab M0 = moe_tables(lds, ctrl, kD / 256); const int U8 = M0.total, R8 = (U8 + G - 1) / G; d8 = kLate * (G - (U8 - G * (R8 - 1))); }
    const int w2n = 64 * G - d8;
    if (IN(7)) { JobMoe1F8 J; J.A = (const char*)(ws + WS_H2); J.lda2 = kD; J.ldb2 = 128; J.kstepB = 16384; J.bhalf2 = (unsigned)kDFF * kD; J.K = kD; J.list = (const int*)(ws + WS_LIST);
        J.B = (const char*)(ws + WS_WE1); J.b_in = a.in[15]; J.act = (unsigned char*)(ws + WS_ACT); J.M = moe_tables(lds, ctrl, kDFF / 128); J.G = G; J.c = c; fg::gemm_phase_f8(lds, J); }
    if (IN(7)) convert_dyn(lds, C2, ctrl + CT_Q + 64 * 4, w2s, w2n);
    ARRIVE(7);
    if (IN(8) && d8 > 0) { const int nshort = d8 / kLate, rem = G - nshort, rank = (c % 8) * (G / 8) + c / 8;
        if (rank >= rem) { convert_t_f8(lds, C2, w2n + (rank - rem), 64 * G, nshort);
            asm volatile("s_waitcnt vmcnt(0)" ::: "memory"); __syncthreads();
            if (threadIdx.x == 0) __hip_atomic_fetch_add(ctrl + CT_W2L, 1u, __ATOMIC_RELEASE, __HIP_MEMORY_SCOPE_AGENT); } }
    WAIT(7);
    if (IN(8)) { JobMoe2F8 J; J.flag = ctrl + CT_W2L; J.e0 = w2n / 512; J.need = d8 / kLate; J.A = (const char*)(ws + WS_ACT); J.lda2 = kDFF; J.ldb2 = 128; J.kstepB = 16384; J.bhalf2 = 128u * kDFF; J.K = kDFF; J.list = nullptr;
        J.B = (const char*)(ws + WS_WE2); J.b_out = a.in[17]; J.yp = (unsigned char*)(ws + WS_YP); J.M = moe_tables(lds, ctrl, kD / 256); J.G = G; J.c = c; fg::gemm_phase_f8(lds, J); }
    SEAM(8);
    if (IN(9)) final_phase((const bf16_t*)(ws + WS_X1), mod, (const float*)(ws + WS_GATES), (const int*)(ws + WS_PAIRE), (const int*)(ws + WS_PAIRP), moe_tables(lds, ctrl, 1), (const unsigned char*)(ws + WS_YP), a.out, G, c);
#undef IN
#undef SEAM
}

#ifndef N_LAUNCHES
#define N_LAUNCHES 1
#endif
extern "C" void kernel_launch(void* const* d_in, const int* in_sizes, int n_in, void* d_out, int out_size, void* d_ws, size_t ws_size, hipStream_t stream) {
    static int grid = 0;
    if (grid == 0) {
        int dev = 0, cus = 0;
        (void)hipGetDevice(&dev); (void)hipDeviceGetAttribute(&cus, hipDeviceAttributeMultiprocessorCount, dev);
        (void)hipFuncSetAttribute((const void*)mega, hipFuncAttributeMaxDynamicSharedMemorySize, fg::LDS_BYTES);
        (void)cus; grid = 256;
    }
    MegaArgs a{}; for (int i = 0; i < 18; ++i) a.in[i] = (const float*)d_in[i]; a.out = (float*)d_out; a.ws = (unsigned char*)d_ws;
    (void)hipMemsetAsync((char*)d_ws + WS_CTRL, 0, 65536, stream);
    if (N_LAUNCHES == 1) { a.ph_lo = 0; a.ph_hi = NPHASE; hipLaunchKernelGGL(mega, dim3(grid), dim3(512), fg::LDS_BYTES, stream, a); }
    else for (int p = 0; p < NPHASE; ++p) { a.ph_lo = p; a.ph_hi = p + 1; hipLaunchKernelGGL(mega, dim3(grid), dim3(512), fg::LDS_BYTES, stream, a); }
}
```
